# Optimizing an MI355X kernel written in HIP

```python
import math
import jax
import jax.numpy as jnp
from jax import lax
import numpy as np

D_MODEL = 2048
BATCH = 4
SEQ = 4096
DEPTH = 4

CTX_LEN = 256
GRID_W = 64
HEAD_DIM = 128
N_GROUPS = 4
GROUP_WIDTH = D_MODEL // N_GROUPS
GROUP_HEADS = GROUP_WIDTH // HEAD_DIM
D_MIX = N_GROUPS * GROUP_WIDTH
GDN_CONV = 5
GDN_CHUNK = 64
GLA_DK = HEAD_DIM // 2
GLA_RANK = 16
GLA_TAU = 16.0
DIAG_CHUNK = 16
NA_ROWS = 8
NA_COLS = 16
ROPE_BASE = 10000.0
N_EXPERTS = 16
EC_CAPACITY = 2
D_EXPERT = D_MODEL // 2
DEEPNORM_ALPHA = (2 * DEPTH) ** 0.25
DEEPNORM_BETA = (8 * DEPTH) ** -0.25
LN_EPS = 1e-5
NORM_EPS = 1e-6

SPLIT_SIZES = (
    GROUP_WIDTH, GROUP_WIDTH, GROUP_WIDTH, GROUP_WIDTH, 2 * GROUP_HEADS, 2 * GROUP_HEADS,
    GROUP_HEADS * GLA_DK, GROUP_HEADS * GLA_DK, GROUP_WIDTH, GROUP_WIDTH, 2 * GLA_RANK,
    GROUP_WIDTH, GROUP_WIDTH, GROUP_WIDTH, 2 * GROUP_WIDTH,
    GROUP_WIDTH, GROUP_WIDTH, GROUP_WIDTH,
)
N_IN = sum(SPLIT_SIZES)
SPLIT_POINTS = [sum(SPLIT_SIZES[:i + 1]) for i in range(len(SPLIT_SIZES) - 1)]

kernel_name = 'hybrid_flow_backbone'

F32 = jnp.float32


def layer_norm(x, g, b):
    xf = x.astype(F32)
    mu = jnp.mean(xf, axis=-1, keepdims=True)
    var = jnp.mean(jnp.square(xf - mu), axis=-1, keepdims=True)
    y = (xf - mu) * lax.rsqrt(var + LN_EPS)
    return (y * g.astype(F32) + b.astype(F32)).astype(x.dtype)


def modulate(x, shift, scale):
    xf = x.astype(F32)
    mu = jnp.mean(xf, axis=-1, keepdims=True)
    var = jnp.mean(jnp.square(xf - mu), axis=-1, keepdims=True)
    y = (xf - mu) * lax.rsqrt(var + LN_EPS)
    return (y * (1.0 + scale.astype(F32)) + shift.astype(F32)).astype(x.dtype)


def rms_norm(x, g):
    xf = x.astype(F32)
    return xf * lax.rsqrt(jnp.mean(jnp.square(xf), axis=-1, keepdims=True) + NORM_EPS) * g.astype(F32)


def l2_normalize(x):
    return x * lax.rsqrt(jnp.sum(jnp.square(x), axis=-1, keepdims=True) + NORM_EPS)


def to_heads(t, n):
    bn, tt, w = t.shape
    return t.reshape(bn, tt, n, w // n).transpose(0, 2, 1, 3)


def from_heads(t):
    bn, n, tt, d = t.shape
    return t.transpose(0, 2, 1, 3).reshape(bn, tt, n * d)


def short_conv(x, w):
    k = w.shape[0]
    return lax.conv_general_dilated(x, w[:, None, :].astype(x.dtype), (1,), [(k // 2, k // 2)],
                                    dimension_numbers=('NWC', 'WIO', 'NWC'),
                                    feature_group_count=x.shape[-1])


def axial_rope(x):
    length, dk = x.shape[2], x.shape[3]
    half = dk // 2
    nf = half // 2
    t = jnp.arange(length)
    inv = ROPE_BASE ** (-jnp.arange(nf, dtype=F32) / nf)

    def rot(xh, pos):
        ang = pos.astype(F32)[:, None] * inv
        cos, sin = jnp.cos(ang).astype(xh.dtype), jnp.sin(ang).astype(xh.dtype)
        x1, x2 = xh[..., :nf], xh[..., nf:]
        return jnp.concatenate([x1 * cos - x2 * sin, x1 * sin + x2 * cos], axis=-1)

    return jnp.concatenate([rot(x[..., :half], t // GRID_W), rot(x[..., half:], t % GRID_W)], axis=-1)


def reverse_segments(z, tc):
    return jnp.concatenate([jnp.flip(z[:, :, :tc], 2), jnp.flip(z[:, :, tc:], 2)], axis=2)


def bidirectional(run, tc, shared, fwd, bwd):
    o_f = run(*shared, *fwd)
    o_b = run(*(reverse_segments(t, tc) for t in shared), *(reverse_segments(t, tc) for t in bwd))
    return o_f + reverse_segments(o_b, tc)


def gated_delta_chunked(q, k, v, log_a, beta):
    bn, h, tt, dk = q.shape
    dv = v.shape[-1]
    c = GDN_CHUNK
    n = tt // c
    q = q.astype(F32).reshape(bn, h, n, c, dk)
    k = k.astype(F32).reshape(bn, h, n, c, dk)
    v = v.astype(F32).reshape(bn, h, n, c, dv)
    beta = beta.astype(F32).reshape(bn, h, n, c)
    g = jnp.cumsum(log_a.astype(F32).reshape(bn, h, n, c), axis=-1)
    incl = jnp.tril(jnp.ones((c, c), bool))
    strict = jnp.tril(jnp.ones((c, c), bool), -1)
    diff = g[..., :, None] - g[..., None, :]
    dec_strict = jnp.exp(jnp.where(strict, diff, -jnp.inf))
    dec_incl = jnp.exp(jnp.where(incl, diff, -jnp.inf))
    a_mat = beta[..., :, None] * jnp.einsum('bhnid,bhnjd->bhnij', k, k) * dec_strict
    rhs = jnp.concatenate([beta[..., None] * v, (beta * jnp.exp(g))[..., None] * k], axis=-1)
    sol = lax.linalg.triangular_solve(a_mat + jnp.eye(c, dtype=F32), rhs, left_side=True,
                                      lower=True, unit_diagonal=True)
    u, w = sol[..., :dv], sol[..., dv:]
    p = jnp.einsum('bhnid,bhnjd->bhnij', q, k) * dec_incl
    qg = q * jnp.exp(g)[..., None]
    kd = k * jnp.exp(g[..., -1:] - g)[..., None]
    g_end = jnp.exp(g[..., -1])

    def step(s, xs):
        qg_n, w_n, u_n, p_n, kd_n, ge_n = xs
        v_new = u_n - jnp.einsum('bhcd,bhde->bhce', w_n, s)
        o_n = jnp.einsum('bhcd,bhde->bhce', qg_n, s) + jnp.einsum('bhij,bhje->bhie', p_n, v_new)
        s = ge_n[..., None, None] * s + jnp.einsum('bhcd,bhce->bhde', kd_n, v_new)
        return s, o_n

    xs = tuple(jnp.moveaxis(t, 2, 0) for t in (qg, w, u, p, kd, g_end))
    _, o = lax.scan(step, jnp.zeros((bn, h, dk, dv), F32), xs)
    return jnp.moveaxis(o, 0, 2).reshape(bn, h, tt, dv)


def diag_gated_chunked(q, k, v, log_a):
    bn, h, tt, dk = q.shape
    dv = v.shape[-1]
    c = DIAG_CHUNK
    n = tt // c
    q, k, log_a = (t.astype(F32).reshape(bn, h, n, c, dk) for t in (q, k, log_a))
    v = v.astype(F32).reshape(bn, h, n, c, dv)
    b = jnp.cumsum(log_a, axis=3)
    incl = jnp.tril(jnp.ones((c, c), bool))
    diff = b[:, :, :, :, None, :] - b[:, :, :, None, :, :]
    decay = jnp.exp(jnp.where(incl[:, :, None], diff, -jnp.inf))
    p = jnp.sum(q[:, :, :, :, None, :] * k[:, :, :, None, :, :] * decay, axis=-1)
    qg = q * jnp.exp(b)
    kd = k * jnp.exp(b[:, :, :, -1:, :] - b)
    a_end = jnp.exp(b[:, :, :, -1, :])

    def step(s, xs):
        qg_n, kd_n, v_n, p_n, a_n = xs
        o_n = jnp.einsum('bhcd,bhde->bhce', qg_n, s) + jnp.einsum('bhij,bhje->bhie', p_n, v_n)
        s = a_n[..., None] * s + jnp.einsum('bhcd,bhce->bhde', kd_n, v_n)
        return s, o_n

    xs = tuple(jnp.moveaxis(t, 2, 0) for t in (qg, kd, v, p, a_end))
    _, o = lax.scan(step, jnp.zeros((bn, h, dk, dv), F32), xs)
    return jnp.moveaxis(o, 0, 2).reshape(bn, h, tt, dv)


def hgrn_run(q, i_val, k_f, log_f):
    return diag_gated_chunked(q, k_f, i_val, log_f)


def neighbourhood_attention(q_lat, k_lat, v_lat, q_ctx, k_ctx, v_ctx, rpb):
    bn, h, length, d = q_lat.shape
    rows = length // GRID_W
    kr = min(NA_ROWS, rows)
    kc = NA_COLS
    scale = d ** -0.5
    r = np.arange(rows)
    cq = np.arange(GRID_W)
    row_idx = np.clip(r - kr // 2, 0, rows - kr)[:, None] + np.arange(kr)[None, :]
    col_start = np.clip(cq - kc // 2, 0, GRID_W - kc)
    col_in = (cq[None, :] >= col_start[:, None]) & (cq[None, :] < col_start[:, None] + kc)
    dr = row_idx - r[:, None] + NA_ROWS - 1
    dc = np.clip(cq[None, :] - cq[:, None], -(kc - 1), kc - 1) + NA_COLS - 1
    bias = rpb.astype(F32)[:, dr[:, None, :, None], dc[None, :, None, :]]
    qg = q_lat.reshape(bn, h, rows, GRID_W, d)
    k_blk = k_lat.reshape(bn, h, rows, GRID_W, d)[:, :, row_idx]
    v_blk = v_lat.reshape(bn, h, rows, GRID_W, d)[:, :, row_idx]
    s_loc = jnp.einsum('bhrqd,bhrjkd->bhrqjk', qg, k_blk).astype(F32) * scale + bias[None]
    s_loc = jnp.where(col_in[:, None, :], s_loc, -jnp.inf)
    s_ctx = jnp.einsum('bhrqd,bhcd->bhrqc', qg, k_ctx).astype(F32) * scale
    s = jnp.concatenate([s_loc.reshape(bn, h, rows, GRID_W, kr * GRID_W), s_ctx], axis=-1)
    pr = jax.nn.softmax(s, axis=-1).astype(v_lat.dtype)
    p_loc = pr[..., :kr * GRID_W].reshape(bn, h, rows, GRID_W, kr, GRID_W)
    p_ctx = pr[..., kr * GRID_W:]
    o_lat = (jnp.einsum('bhrqjk,bhrjkd->bhrqd', p_loc, v_blk)
             + jnp.einsum('bhrqc,bhcd->bhrqd', p_ctx, v_ctx)).reshape(bn, h, length, d)
    s_cc = jnp.einsum('bhqd,bhkd->bhqk', q_ctx, k_ctx).astype(F32) * scale
    o_ctx = jnp.einsum('bhqk,bhkd->bhqd', jax.nn.softmax(s_cc, axis=-1).astype(v_ctx.dtype), v_ctx)
    return o_ctx, o_lat


def hybrid_mixer(u_ctx, u_lat, w_in, conv_w, a_log, dt_bias, gdn_g, gla_wg, gla_bg, gla_g, lb, hgrn_g, rpb):
    tc = u_ctx.shape[1]
    u = jnp.concatenate([u_ctx, u_lat], axis=1)
    bn, tt, _ = u.shape
    h = GROUP_HEADS
    (a_q, a_k, a_v, a_z, a_beta, a_dec, b_q, b_k, b_v, b_r, b_code,
     c_q, c_i, c_g, c_f, d_q, d_k, d_v) = jnp.split(jnp.einsum('btd,de->bte', u, w_in), SPLIT_POINTS, axis=-1)

    qkv = jnp.concatenate([a_q, a_k, a_v], axis=-1)
    qkv = jax.nn.silu(jnp.concatenate([short_conv(qkv[:, :tc], conv_w), short_conv(qkv[:, tc:], conv_w)], axis=1))
    q, k, v = (to_heads(t, h).astype(F32) for t in jnp.split(qkv, 3, axis=-1))
    q = l2_normalize(q) * HEAD_DIM ** -0.5
    k = l2_normalize(k)
    beta = jnp.transpose(jax.nn.sigmoid(a_beta.astype(F32)).reshape(bn, tt, 2, h), (2, 0, 3, 1))
    log_a = -jnp.exp(a_log.astype(F32)) * jax.nn.softplus(a_dec.astype(F32).reshape(bn, tt, 2, h) + dt_bias.astype(F32))
    log_a = jnp.transpose(log_a, (2, 0, 3, 1))
    o = bidirectional(gated_delta_chunked, tc, (q, k, v), (log_a[0], beta[0]), (log_a[1], beta[1]))
    o_gdn = from_heads(rms_norm(o, gdn_g)) * jax.nn.silu(a_z.astype(F32))

    q = to_heads(b_q, h).astype(F32) * GLA_DK ** -0.5
    k = to_heads(b_k, h).astype(F32)
    q = jnp.concatenate([q[:, :, :tc], axial_rope(q[:, :, tc:])], axis=2)
    k = jnp.concatenate([k[:, :, :tc], axial_rope(k[:, :, tc:])], axis=2)
    v = to_heads(b_v, h).astype(F32)
    gate = jnp.einsum('btzr,zrk->zbtk', b_code.astype(F32).reshape(bn, tt, 2, GLA_RANK), gla_wg.astype(F32))
    gate = gate + gla_bg.astype(F32)[:, None, None, :]
    log_g = (jax.nn.log_sigmoid(gate) / GLA_TAU).reshape(2, bn, tt, h, GLA_DK).transpose(0, 1, 3, 2, 4)
    o = bidirectional(diag_gated_chunked, tc, (q, k, v), (log_g[0],), (log_g[1],))
    o_gla = from_heads(rms_norm(o, gla_g)) * jax.nn.silu(b_r.astype(F32))

    q = to_heads(c_q, h).astype(F32)
    i_val = to_heads(c_i, h).astype(F32)
    lbf = lb.astype(F32)
    f = lbf + (1.0 - lbf) * jax.nn.sigmoid(c_f.astype(F32).reshape(bn, tt, 2, GROUP_WIDTH))
    f = f.reshape(bn, tt, 2, h, HEAD_DIM).transpose(2, 0, 3, 1, 4)
    log_f = jnp.log(f)
    k_f = 1.0 - f
    o = bidirectional(hgrn_run, tc, (q, i_val), (k_f[0], log_f[0]), (k_f[1], log_f[1]))
    o_hgrn = from_heads(rms_norm(o, hgrn_g)) * jax.nn.sigmoid(c_g.astype(F32))

    q, k, v = (to_heads(t, h) for t in (d_q, d_k, d_v))
    o_c, o_l = neighbourhood_attention(q[:, :, tc:], k[:, :, tc:], v[:, :, tc:],
                                       q[:, :, :tc], k[:, :, :tc], v[:, :, :tc], rpb)
    o_na = from_heads(jnp.concatenate([o_c, o_l], axis=2)).astype(F32)

    mixed = jnp.concatenate([o_gdn, o_gla, o_hgrn, o_na], axis=-1).astype(u.dtype)
    return mixed[:, :tc], mixed[:, tc:]


def expert_choice_ffn(u, w_router, w1, w3, w2):
    bn, tt, _ = u.shape
    cap = EC_CAPACITY * tt // N_EXPERTS
    aff = jax.nn.softmax(jnp.einsum('btd,de->bte', u, w_router).astype(F32), axis=-1)
    gate, idx = lax.top_k(jnp.swapaxes(aff, 1, 2), cap)
    bidx = jnp.arange(bn)[:, None, None]
    xs = u[bidx, idx]
    hid = jax.nn.silu(jnp.einsum('becd,edf->becf', xs, w1)) * jnp.einsum('becd,edf->becf', xs, w3)
    y = jnp.einsum('becf,efd->becd', hid, w2) * gate[..., None].astype(u.dtype)
    return jnp.zeros_like(u).at[bidx, idx].add(y)


def setup_inputs(seed: int = 0) -> dict:
    key = jax.random.key(seed)
    ks = jax.random.split(key, 24)
    d = D_MODEL

    def nrm(k, shape, scale):
        return jax.random.normal(k, shape, F32) * scale

    dt = jnp.exp(jax.random.uniform(ks[12], (DEPTH, 2, GROUP_HEADS), F32, math.log(1e-3), math.log(1e-1)))
    return {
        'x': nrm(ks[0], (BATCH, SEQ, d), 1.0),
        'c': nrm(ks[1], (BATCH, d), 1.0),
        'ctx': nrm(ks[2], (BATCH, CTX_LEN, d), 1.0),
        'c_ctx': nrm(ks[3], (d,), 1.0),
        'w_mod': nrm(ks[4], (DEPTH, d, 6 * d), 0.5 * d ** -0.5),
        'b_mod': nrm(ks[5], (DEPTH, 6 * d), 0.01),
        'w_in': nrm(ks[6], (DEPTH, d, N_IN), d ** -0.5),
        'w_out': nrm(ks[7], (DEPTH, D_MIX, d), D_MIX ** -0.5 * DEEPNORM_BETA),
        'ln_g': 1.0 + nrm(ks[8], (DEPTH, 2, d), 0.02),
        'ln_b': nrm(ks[9], (DEPTH, 2, d), 0.02),
        'gdn_conv': nrm(ks[10], (DEPTH, GDN_CONV, 3 * GROUP_WIDTH), GDN_CONV ** -0.5),
        'gdn_a_log': jnp.log(jax.random.uniform(ks[11], (DEPTH, 2, GROUP_HEADS), F32, 1.0, 16.0)),
        'gdn_dt_bias': dt + jnp.log(-jnp.expm1(-dt)),
        'gdn_norm': 1.0 + nrm(ks[13], (DEPTH, HEAD_DIM), 0.02),
        'gla_w_gate': nrm(ks[14], (DEPTH, 2, GLA_RANK, GROUP_HEADS * GLA_DK), GLA_RANK ** -0.5),
        'gla_b_gate': nrm(ks[15], (DEPTH, 2, GROUP_HEADS * GLA_DK), 0.01),
        'gla_norm': 1.0 + nrm(ks[16], (DEPTH, HEAD_DIM), 0.02),
        'hgrn_gamma': nrm(ks[17], (2, DEPTH, GROUP_WIDTH), 0.5),
        'hgrn_norm': 1.0 + nrm(ks[18], (DEPTH, HEAD_DIM), 0.02),
        'na_rpb': nrm(ks[19], (DEPTH, GROUP_HEADS, 2 * NA_ROWS - 1, 2 * NA_COLS - 1), 0.1),
        'moe_router': nrm(ks[20], (DEPTH, d, N_EXPERTS), d ** -0.5),
        'moe_w1': nrm(ks[21], (DEPTH, N_EXPERTS, d, D_EXPERT), d ** -0.5),
        'moe_w3': nrm(ks[22], (DEPTH, N_EXPERTS, d, D_EXPERT), d ** -0.5),
        'moe_w2': nrm(ks[23], (DEPTH, N_EXPERTS, D_EXPERT, d), D_EXPERT ** -0.5 * DEEPNORM_BETA),
    }


def reference(x, c, ctx, c_ctx, w_mod, b_mod, w_in, w_out, ln_g, ln_b, gdn_conv, gdn_a_log, gdn_dt_bias,
              gdn_norm, gla_w_gate, gla_b_gate, gla_norm, hgrn_gamma, hgrn_norm, na_rpb,
              moe_router, moe_w1, moe_w3, moe_w2):
    p_lb = jax.nn.softmax(hgrn_gamma.astype(F32), axis=1)
    lower = jnp.cumsum(p_lb, axis=1) - p_lb[:, :1]
    h = ctx
    s_c = jax.nn.silu(c)
    s_cc = jax.nn.silu(c_ctx)
    for l in range(DEPTH):
        keep_ctx = l < DEPTH - 1
        mod = jnp.split((s_c @ w_mod[l] + b_mod[l])[:, None, :], 6, axis=-1)
        mod_c = jnp.split(s_cc @ w_mod[l] + b_mod[l], 6, axis=-1)
        m_ctx, m_lat = hybrid_mixer(modulate(h, mod_c[0], mod_c[1]), modulate(x, mod[0], mod[1]),
                                    w_in[l], gdn_conv[l], gdn_a_log[l], gdn_dt_bias[l], gdn_norm[l],
                                    gla_w_gate[l], gla_b_gate[l], gla_norm[l], lower[:, l], hgrn_norm[l],
                                    na_rpb[l])
        x = layer_norm(DEEPNORM_ALPHA * x + mod[2] * (m_lat @ w_out[l]), ln_g[l, 0], ln_b[l, 0])
        if keep_ctx:
            h = layer_norm(DEEPNORM_ALPHA * h + mod_c[2] * (m_ctx @ w_out[l]), ln_g[l, 0], ln_b[l, 0])
        y = expert_choice_ffn(modulate(x, mod[3], mod[4]), moe_router[l], moe_w1[l], moe_w3[l], moe_w2[l])
        x = layer_norm(DEEPNORM_ALPHA * x + mod[5] * y, ln_g[l, 1], ln_b[l, 1])
        if keep_ctx:
            yc = expert_choice_ffn(modulate(h, mod_c[3], mod_c[4]), moe_router[l], moe_w1[l], moe_w3[l], moe_w2[l])
            h = layer_norm(DEEPNORM_ALPHA * h + mod_c[5] * yc, ln_g[l, 1], ln_b[l, 1])
    return x
```

```cpp
#include <hip/hip_runtime.h>
#include <cstdio>
#include <cstdint>
#ifndef MK_N_LAUNCHES
#define MK_N_LAUNCHES 1
#endif
namespace pg8 {
#define PG8_LAS __attribute__((address_space(3)))
typedef unsigned short bf16_t;
typedef short bf16x8 __attribute__((ext_vector_type(8)));
typedef float f32x4 __attribute__((ext_vector_type(4)));
typedef unsigned u32x4 __attribute__((ext_vector_type(4)));
constexpr int BM = 256, BK = 64, HALF = 128, HTB = HALF * BK * 2  , STAGE_BYTES = 8 * HTB, NXCD = 8, WGM = 8;

__host__ __device__ __forceinline__ int lds_byte(int r, int c) { const int st = (r >> 4) * 2 + (c >> 5), rr = r & 15, cc = c & 31, ob = rr * 64 + cc * 2; return st * 1024 + (ob ^ (((ob >> 9) & 1) << 5)); }
__host__ __device__ __forceinline__ void stage_rc(int b, int& R, int& C) { const int st = b / 1024, sb = b % 1024, swz = sb ^ (((sb >> 9) & 1) << 5); R = (st >> 1) * 16 + swz / 64; C = (st & 1) * 32 + (swz % 64) / 2; }
__host__ __device__ __forceinline__ int perm32(int rho) { const int n = rho >> 4, i = rho & 15; return 8 * (i >> 2) + 4 * n + (i & 3); }

struct Unit { int pm, pn; };
struct Gemm { const bf16_t* A; const bf16_t* Bt; int M, N, K; };

struct StaticOrder {
    int nM, nN, nwg, G, c;
    __host__ __device__ void init(int M, int N, int G_, int c_) { nM = M / BM; nN = N / BM; nwg = nM * nN; G = G_; c = c_; }
    __host__ __device__ bool next(int i, Unit& u) const {
        const long L = (long)i * G + c; if (L >= nwg) return false;
        int wgid = (int)L; { const int q = nwg / NXCD, r = nwg % NXCD, xcd = wgid % NXCD, off = wgid / NXCD; wgid = (xcd < r ? xcd * (q + 1) : r * (q + 1) + (xcd - r) * q) + off; }
        const int nig = WGM * nN, gid = wgid / nig, fm = gid * WGM, gsz = (nM - fm) < WGM ? (nM - fm) : WGM;
        u.pm = fm + ((wgid % nig) % gsz); u.pn = (wgid % nig) / gsz; return true;
    }
    __device__ __forceinline__ void a_ready(const Unit&) const {}
    __device__ __forceinline__ void done(const Unit&) const {}
};
struct CountedOrder : StaticOrder {
    const unsigned* ready; unsigned need; unsigned* tmo;
    __device__ __forceinline__ void a_ready(const Unit& u) const {
        if (threadIdx.x < 64) {
            const unsigned long long t0 = __builtin_amdgcn_s_memrealtime(); unsigned polls = 0;
            while ((unsigned)__builtin_amdgcn_readfirstlane(__hip_atomic_load(ready + 64 * u.pm, __ATOMIC_RELAXED, __HIP_MEMORY_SCOPE_AGENT)) < need) {
                if ((++polls & 255u) == 0u && __builtin_amdgcn_readfirstlane(__hip_atomic_load(tmo, __ATOMIC_RELAXED, __HIP_MEMORY_SCOPE_AGENT)) != 0u) break;
                if (__builtin_amdgcn_s_memrealtime() - t0 > 2000000ull) {
                    if (threadIdx.x == 0) { unsigned expect = 0u; __hip_atomic_compare_exchange_strong(tmo + 1, &expect, 0x600u | (unsigned)(u.pm & 0xff), __ATOMIC_RELAXED, __ATOMIC_RELAXED, __HIP_MEMORY_SCOPE_AGENT); __hip_atomic_store(tmo, 1u, __ATOMIC_RELAXED, __HIP_MEMORY_SCOPE_AGENT); }
                    break; }
                __builtin_amdgcn_s_sleep(2); }
            __builtin_amdgcn_fence(__ATOMIC_ACQUIRE, "agent");
            asm volatile("s_waitcnt vmcnt(0)" ::: "memory");
        }
#if !defined(BROKEN_HOOK_NO_BARRIER)
        asm volatile("" ::: "memory"); __builtin_amdgcn_s_barrier(); asm volatile("" ::: "memory");
#endif
    }
};

typedef float f32x2_cv __attribute__((ext_vector_type(2)));
typedef __bf16 bf16x2_cv __attribute__((ext_vector_type(2)));
__device__ __forceinline__ unsigned cvt_pk_bf16(float lo, float hi) { const bf16x2_cv v = __builtin_convertvector((f32x2_cv){lo, hi}, bf16x2_cv); return __builtin_bit_cast(unsigned, v); }
typedef float f32x2 __attribute__((ext_vector_type(2)));
__device__ __forceinline__ f32x2 gelu_pk(f32x2 v) {
    const f32x2 av = __builtin_elementwise_abs(v), d = av * 0.2316418882f + 1.0f;
    f32x2 t; t.x = __builtin_amdgcn_rcpf(d.x); t.y = __builtin_amdgcn_rcpf(d.y);
    f32x2 q = t * 0.5307027145f + (-0.7265760135f); q = q * t + 0.7107068705f; q = q * t + (-0.142248368f); q = q * t + 0.127414796f; q = q * t;
    const f32x2 s = (v * v) * (-0.72134752044f);
    f32x2 e; e.x = __builtin_amdgcn_exp2f(s.x); e.y = __builtin_amdgcn_exp2f(s.y);
    const f32x2 m = v * (q * e), r = v - m;
    f32x2 o; o.x = v.x < 0.f ? m.x : r.x; o.y = v.y < 0.f ? m.y : r.y; return o;
}

struct EpiF32 {
    static constexpr bool PERM = false, AFTER_DRAIN = false;
    float* C; int ldc; const float* bias;
    __device__ __forceinline__ void operator()(const f32x4 (&acc)[2][2][4][2], const Unit& u, int wr, int wc, int fr, int fq) const {
        const int row0 = u.pm * BM + wr * 64 + fr, col0 = u.pn * BM + wc * 32 + 4 * fq;
        f32x4 bv[2][2];
#pragma unroll
        for (int bj = 0; bj < 2; ++bj)
#pragma unroll
            for (int n = 0; n < 2; ++n) bv[bj][n] = bias ? *(const f32x4*)(bias + col0 + bj * HALF + n * 16) : (f32x4){0.f, 0.f, 0.f, 0.f};
#pragma unroll
        for (int ai = 0; ai < 2; ++ai)
#pragma unroll
            for (int m = 0; m < 4; ++m) { float* rowp = C + (size_t)(row0 + ai * HALF + m * 16) * ldc + col0;
#pragma unroll
                for (int bj = 0; bj < 2; ++bj)
#pragma unroll
                    for (int n = 0; n < 2; ++n) *(f32x4*)(rowp + bj * HALF + n * 16) = acc[ai][bj][m][n] + bv[bj][n]; }
    }
};
template <int ACT  > struct EpiBf16 {
    static constexpr bool PERM = true, AFTER_DRAIN = false;
    bf16_t* O; int ldc; const float* bias; int split_cols; size_t split_stride;
    __device__ __forceinline__ void operator()(const f32x4 (&acc)[2][2][4][2], const Unit& u, int wr, int wc, int fr, int fq) const {
        const int row0 = u.pm * BM + wr * 64 + fr; int colt = u.pn * BM; bf16_t* base = O;
        if (split_cols) { const int t = colt / split_cols; base += (size_t)t * split_stride; colt -= t * split_cols; }
        const int col0 = colt + wc * 32 + 8 * fq, bcol0 = u.pn * BM + wc * 32 + 8 * fq;
        f32x4 bv[2][2];
#pragma unroll
        for (int bj = 0; bj < 2; ++bj)
#pragma unroll
            for (int n = 0; n < 2; ++n) bv[bj][n] = bias ? *(const f32x4*)(bias + bcol0 + bj * HALF + 4 * n) : (f32x4){0.f, 0.f, 0.f, 0.f};
#pragma unroll
        for (int ai = 0; ai < 2; ++ai)
#pragma unroll
            for (int m = 0; m < 4; ++m) { bf16_t* rowp = base + (size_t)(row0 + ai * HALF + m * 16) * ldc + col0;
#pragma unroll
                for (int bj = 0; bj < 2; ++bj) { f32x4 v0 = acc[ai][bj][m][0] + bv[bj][0], v1 = acc[ai][bj][m][1] + bv[bj][1];
                    if (ACT == 1) { f32x2 a = gelu_pk((f32x2){v0[0], v0[1]}), b = gelu_pk((f32x2){v0[2], v0[3]}), c = gelu_pk((f32x2){v1[0], v1[1]}), d = gelu_pk((f32x2){v1[2], v1[3]});
                        v0 = (f32x4){a.x, a.y, b.x, b.y}; v1 = (f32x4){c.x, c.y, d.x, d.y}; }
                    if (ACT == 2) {
#pragma unroll
                        for (int j = 0; j < 4; ++j) { v0[j] = 0.5f * v0[j] * (1.0f + erff(v0[j] * 0.70710678f)); v1[j] = 0.5f * v1[j] * (1.0f + erff(v1[j] * 0.70710678f)); } }
                    u32x4 w; w.x = cvt_pk_bf16(v0[0], v0[1]); w.y = cvt_pk_bf16(v0[2], v0[3]); w.z = cvt_pk_bf16(v1[0], v1[1]); w.w = cvt_pk_bf16(v1[2], v1[3]);
                    *(u32x4*)(rowp + bj * HALF) = w; } }
    }
};

struct PanelStats {
    unsigned* xbuf;
    unsigned* cnt;
    unsigned* tmo;
    int ntn; float eps;
    unsigned code;
    __device__ __forceinline__ bool run(const f32x4 (&v)[2][2][4][2], const Unit& u, int wr, int wc, int fr, int fq, PG8_LAS unsigned char* lds, int wid, int lane) const {
        typedef float f32x2v __attribute__((ext_vector_type(2)));
        PG8_LAS f32x2v* P = (PG8_LAS f32x2v*)lds;
        PG8_LAS f32x2v* S = (PG8_LAS f32x2v*)(lds + 8192);
        PG8_LAS unsigned* flag = (PG8_LAS unsigned*)(lds + 8192 + 2048);
#pragma unroll
        for (int ai = 0; ai < 2; ++ai)
#pragma unroll
            for (int m = 0; m < 4; ++m) {
                float s = 0.f;
#pragma unroll
                for (int bj = 0; bj < 2; ++bj)
#pragma unroll
                    for (int n = 0; n < 2; ++n) { const f32x4 x = v[ai][bj][m][n]; s += (x[0] + x[1]) + (x[2] + x[3]); }
                s += __shfl_xor(s, 16); s += __shfl_xor(s, 32);
                const float mw = s * (1.0f / 64.0f); float q = 0.f;
#pragma unroll
                for (int bj = 0; bj < 2; ++bj)
#pragma unroll
                    for (int n = 0; n < 2; ++n) { const f32x4 d = v[ai][bj][m][n] - mw; q += (d[0] * d[0] + d[1] * d[1]) + (d[2] * d[2] + d[3] * d[3]); }
                q += __shfl_xor(q, 16); q += __shfl_xor(q, 32);
                if (fq == 0) P[(ai * HALF + wr * 64 + m * 16 + fr) * 4 + wc] = (f32x2v){mw, q};
            }
        asm volatile("s_waitcnt lgkmcnt(0)" ::: "memory"); __builtin_amdgcn_s_barrier(); asm volatile("" ::: "memory");
#if defined(BROKEN_NO_WAIT)
        if (blockIdx.x >= 64) { const long long t0 = clock64(); while (clock64() - t0 < 60000) __builtin_amdgcn_s_sleep(8); }
#endif
        const int row = wid * 32 + (lane & 31);
        if (lane < 32) {
            const f32x2v a = P[row * 4 + 0], b = P[row * 4 + 1], c = P[row * 4 + 2], d = P[row * 4 + 3];
            const float mt = (a.x + b.x + c.x + d.x) * 0.25f;
            const float da = a.x - mt, db = b.x - mt, dc = c.x - mt, dd = d.x - mt;
            const float m2 = (a.y + b.y) + (c.y + d.y) + 64.0f * ((da * da + db * db) + (dc * dc + dd * dd));
            unsigned long long* slot = (unsigned long long*)xbuf + ((size_t)(u.pm * BM + row) * 4 + u.pn);
            __hip_atomic_store(slot, ((unsigned long long)__float_as_uint(m2) << 32) | __float_as_uint(mt), __ATOMIC_RELAXED, __HIP_MEMORY_SCOPE_AGENT);
        }
        asm volatile("s_waitcnt vmcnt(0)" ::: "memory");
        if (lane == 0) __hip_atomic_fetch_add(cnt + 64 * u.pm, 1u, __ATOMIC_RELAXED, __HIP_MEMORY_SCOPE_AGENT);
        if (wid == 0) {
            bool dead = false; const unsigned long long t0 = __builtin_amdgcn_s_memrealtime(); const unsigned want = 8u * (unsigned)ntn;
            for (;;) {
#if defined(BROKEN_NO_WAIT)
                break;
#endif
                if ((unsigned)__builtin_amdgcn_readfirstlane(__hip_atomic_load(cnt + 64 * u.pm, __ATOMIC_RELAXED, __HIP_MEMORY_SCOPE_AGENT)) >= want) break;
                if (__builtin_amdgcn_s_memrealtime() - t0 > 2000000ull) {
                    if (lane == 0) { unsigned expect = 0u; __hip_atomic_compare_exchange_strong(tmo + 1, &expect, code | (unsigned)(u.pm & 0xff), __ATOMIC_RELAXED, __ATOMIC_RELAXED, __HIP_MEMORY_SCOPE_AGENT);
                                     __hip_atomic_store(tmo, 1u, __ATOMIC_RELAXED, __HIP_MEMORY_SCOPE_AGENT); }
                    dead = true; break; }
                __builtin_amdgcn_s_sleep(2);
            }
            __builtin_amdgcn_fence(__ATOMIC_ACQUIRE, "agent");
            if (lane == 0) flag[0] = dead ? 1u : 0u;
        }
        asm volatile("s_waitcnt vmcnt(0) lgkmcnt(0)" ::: "memory"); __builtin_amdgcn_s_barrier(); asm volatile("" ::: "memory");
        const bool bad = flag[0] != 0u;
        if (lane < 32) {
            const unsigned long long* slot = (const unsigned long long*)xbuf + (size_t)(u.pm * BM + row) * 4; float mt[4], m2[4]; float ms = 0.f;
#pragma unroll
            for (int t = 0; t < 4; ++t) { if (t < ntn) { const unsigned long long w = __hip_atomic_load(slot + t, __ATOMIC_RELAXED, __HIP_MEMORY_SCOPE_AGENT); mt[t] = __uint_as_float((unsigned)w); m2[t] = __uint_as_float((unsigned)(w >> 32)); } else { mt[t] = 0.f; m2[t] = 0.f; } ms += mt[t]; }
            const float mean = ms / (float)ntn; float q = 0.f;
#pragma unroll
            for (int t = 0; t < 4; ++t) if (t < ntn) { const float dm = mt[t] - mean; q += m2[t] + 256.0f * dm * dm; }
            S[row] = (f32x2v){mean, 1.0f / sqrtf(q / (256.0f * (float)ntn) + eps)};
        }
        asm volatile("s_waitcnt lgkmcnt(0)" ::: "memory"); __builtin_amdgcn_s_barrier(); asm volatile("" ::: "memory");
        return bad;
    }
};
struct EpiLnRes {
    static constexpr bool PERM = false, AFTER_DRAIN = true;
    const float* base; float* out; int ldc; const float* bias; PanelStats st; unsigned poison;
    __device__ __forceinline__ void refuse(size_t i0, size_t stride, int M, int N) const { const float q = __builtin_nanf(""); for (size_t i = i0; i < (size_t)M * N; i += stride) out[(i / N) * ldc + i % N] = q;
        if (i0 == 0) { unsigned expect = 0u; __hip_atomic_compare_exchange_strong(st.tmo + 1, &expect, 0x7f0u, __ATOMIC_RELAXED, __ATOMIC_RELAXED, __HIP_MEMORY_SCOPE_AGENT); __hip_atomic_store(st.tmo, 1u, __ATOMIC_RELAXED, __HIP_MEMORY_SCOPE_AGENT); } }
    __device__ __forceinline__ void fused(f32x4 (&acc)[2][2][4][2], const Unit& u, int wr, int wc, int fr, int fq, PG8_LAS unsigned char* lds, int wid, int lane) const {
        typedef float f32x2v __attribute__((ext_vector_type(2)));
        const PG8_LAS f32x2v* S = (const PG8_LAS f32x2v*)(lds + 8192);
        const int col0 = u.pn * BM + wc * 32 + 4 * fq;
#pragma unroll
        for (int bj = 0; bj < 2; ++bj)
#pragma unroll
            for (int n = 0; n < 2; ++n) { const f32x4 bv = bias ? *(const f32x4*)(bias + col0 + bj * HALF + n * 16) : (f32x4){0.f, 0.f, 0.f, 0.f};
#pragma unroll
                for (int ai = 0; ai < 2; ++ai)
#pragma unroll
                    for (int m = 0; m < 4; ++m) acc[ai][bj][m][n] += bv; }
        const bool bad = st.run(acc, u, wr, wc, fr, fq, lds, wid, lane) || poison != 0u;
        const float qnan = __builtin_nanf("");
#pragma unroll
        for (int ai = 0; ai < 2; ++ai)
#pragma unroll
            for (int m = 0; m < 4; ++m) { const int r = ai * HALF + wr * 64 + m * 16 + fr; const f32x2v sr = S[r]; const size_t off = (size_t)(u.pm * BM + r) * ldc + col0;
#pragma unroll
                for (int bj = 0; bj < 2; ++bj)
#pragma unroll
                    for (int n = 0; n < 2; ++n) { const f32x4 bs = *(const f32x4*)(base + off + bj * HALF + n * 16); f32x4 o = bs + (acc[ai][bj][m][n] - sr.x) * sr.y;
                        if (bad) o = (f32x4){qnan, qnan, qnan, qnan}; *(f32x4*)(out + off + bj * HALF + n * 16) = o; }
                asm volatile("" ::: "memory"); }
    }
};
struct EpiLnResLn {
    static constexpr bool PERM = false, AFTER_DRAIN = true;
    const float* base; float* out; bf16_t* xn; int ldc; const float* bias; PanelStats st1, st2; unsigned poison;
    __device__ __forceinline__ void refuse(size_t i0, size_t stride, int M, int N) const { const float q = __builtin_nanf(""); for (size_t i = i0; i < (size_t)M * N; i += stride) { const size_t o = (i / N) * ldc + i % N; out[o] = q; xn[o] = (bf16_t)0x7fc0u; }
        if (i0 == 0) { unsigned expect = 0u; __hip_atomic_compare_exchange_strong(st1.tmo + 1, &expect, 0x7f0u, __ATOMIC_RELAXED, __ATOMIC_RELAXED, __HIP_MEMORY_SCOPE_AGENT); __hip_atomic_store(st1.tmo, 1u, __ATOMIC_RELAXED, __HIP_MEMORY_SCOPE_AGENT); } }
    __device__ __forceinline__ void fused(f32x4 (&acc)[2][2][4][2], const Unit& u, int wr, int wc, int fr, int fq, PG8_LAS unsigned char* lds, int wid, int lane) const {
        typedef float f32x2v __attribute__((ext_vector_type(2))); typedef unsigned u32x2v __attribute__((ext_vector_type(2)));
        const PG8_LAS f32x2v* S = (const PG8_LAS f32x2v*)(lds + 8192);
        const int col0 = u.pn * BM + wc * 32 + 4 * fq;
#pragma unroll
        for (int bj = 0; bj < 2; ++bj)
#pragma unroll
            for (int n = 0; n < 2; ++n) { const f32x4 bv = bias ? *(const f32x4*)(bias + col0 + bj * HALF + n * 16) : (f32x4){0.f, 0.f, 0.f, 0.f};
#pragma unroll
                for (int ai = 0; ai < 2; ++ai)
#pragma unroll
                    for (int m = 0; m < 4; ++m) acc[ai][bj][m][n] += bv; }
        bool bad = st1.run(acc, u, wr, wc, fr, fq, lds, wid, lane) || poison != 0u;
        const float qnan = __builtin_nanf("");
#pragma unroll
        for (int ai = 0; ai < 2; ++ai)
#pragma unroll
            for (int m = 0; m < 4; ++m) { const int r = ai * HALF + wr * 64 + m * 16 + fr; const f32x2v sr = S[r]; const size_t off = (size_t)(u.pm * BM + r) * ldc + col0;
#pragma unroll
                for (int bj = 0; bj < 2; ++bj)
#pragma unroll
                    for (int n = 0; n < 2; ++n) { const f32x4 bs = *(const f32x4*)(base + off + bj * HALF + n * 16); acc[ai][bj][m][n] = bs + (acc[ai][bj][m][n] - sr.x) * sr.y; }
                asm volatile("" : "+v"(acc[ai][0][m][0]), "+v"(acc[ai][0][m][1]), "+v"(acc[ai][1][m][0]), "+v"(acc[ai][1][m][1]));
                if (m & 1) asm volatile("" ::: "memory"); }
        const bool bad1 = bad;
        bad = st2.run(acc, u, wr, wc, fr, fq, lds, wid, lane) || bad;
#pragma unroll
        for (int ai = 0; ai < 2; ++ai)
#pragma unroll
            for (int m = 0; m < 4; ++m) { const int r = ai * HALF + wr * 64 + m * 16 + fr; const f32x2v sr = S[r]; const size_t off = (size_t)(u.pm * BM + r) * ldc + col0;
#pragma unroll
                for (int bj = 0; bj < 2; ++bj)
#pragma unroll
                    for (int n = 0; n < 2; ++n) { const f32x4 x1 = acc[ai][bj][m][n]; *(f32x4*)(out + off + bj * HALF + n * 16) = bad1 ? (f32x4){qnan, qnan, qnan, qnan} : x1;
                        const f32x4 o = (x1 - sr.x) * sr.y; u32x2v w; w.x = cvt_pk_bf16(o[0], o[1]); w.y = cvt_pk_bf16(o[2], o[3]);
                        if (bad) { w.x = 0x7fc07fc0u; w.y = 0x7fc07fc0u; } *(u32x2v*)(xn + off + bj * HALF + n * 16) = w; }
                asm volatile("" ::: "memory"); }
    }
};

template <class Epi, class Sched, bool STAMP = false>
__device__ __forceinline__ void gemm_phase(PG8_LAS unsigned char* lds, const Gemm g, const Sched& S, const Epi& E, unsigned long long* stamps, int tid_in) {
    int tid_ = tid_in; asm volatile("" : "+v"(tid_));
    const int tid = tid_, wid = __builtin_amdgcn_readfirstlane(tid >> 6), lane = tid & 63, wr = wid >> 2, wc = wid & 3, fr = lane & 15, fq = lane >> 4;
    const int K = g.K, nt = K / BK;
    int ts_lo = 0, ts_hi = 0, nts = 0; const unsigned long long rt_entry = STAMP ? (unsigned long long)wall_clock64() : 0ull;
#define PG8_STAMP() do { if (STAMP && wid == 0 && nts < 64) { const unsigned long long _c = (unsigned long long)clock64(); \
        ts_lo = (lane == nts) ? (int)(unsigned)_c : ts_lo; ts_hi = (lane == nts) ? (int)(unsigned)(_c >> 32) : ts_hi; ++nts; } } while (0)
    PG8_STAMP();
    unsigned voffA[2], voffB[2];
#pragma unroll
    for (int i = 0; i < 2; ++i) { int R, C; stage_rc(tid * 16 + i * 8192, R, C); const int Rb = Epi::PERM ? ((R & ~31) + perm32(R & 31)) : R;
        voffA[i] = (unsigned)(R * K + C) * 2u; voffB[i] = (unsigned)(Rb * K + C) * 2u; }
    const size_t kstep = (size_t)(BK * 2);
    const size_t hstep = (size_t)HALF * K * 2;
    const size_t tstep = 2 * hstep;
    const unsigned ldsw = (unsigned)wid * 1024u;
    const int aoff = lds_byte(wr * 64 + fr, fq * 8), boff = lds_byte(wc * 32 + fr, fq * 8);
#define PG8_SA(b, h) (((b) * 2 + (h)) * HTB)
#define PG8_SB(b, h) ((4 + (b) * 2 + (h)) * HTB)
#define PG8_STAGE(bufoff, gbase, voff) do { _Pragma("unroll") for (int _i = 0; _i < 2; ++_i) \
        __builtin_amdgcn_global_load_lds((const unsigned*)((const char*)(gbase) + (voff)[_i]), (PG8_LAS unsigned*)(lds + (bufoff) + ldsw + _i * 8192), 16, 0, 0); } while (0)
#define PG8_LDA(dst, b, h) do { _Pragma("unroll") for (int m = 0; m < 4; ++m) _Pragma("unroll") for (int k = 0; k < 2; ++k) dst[m][k] = *(const PG8_LAS bf16x8*)(lds + PG8_SA(b, h) + aoff + m * 2048 + k * 1024); } while (0)
#define PG8_LDB(dst, b, h) do { _Pragma("unroll") for (int n = 0; n < 2; ++n) _Pragma("unroll") for (int k = 0; k < 2; ++k) dst[n][k] = *(const PG8_LAS bf16x8*)(lds + PG8_SB(b, h) + boff + n * 2048 + k * 1024); } while (0)
#define PG8_MMA(ai, bj, At, Bt) do { __builtin_amdgcn_s_setprio(1); _Pragma("unroll") for (int m = 0; m < 4; ++m) _Pragma("unroll") for (int n = 0; n < 2; ++n) _Pragma("unroll") for (int k = 0; k < 2; ++k) \
        acc[ai][bj][m][n] = __builtin_amdgcn_mfma_f32_16x16x32_bf16(Bt[n][k], At[m][k], acc[ai][bj][m][n], 0, 0, 0); __builtin_amdgcn_s_setprio(0); } while (0)
#define PG8_WAIT_V(n) asm volatile("s_waitcnt vmcnt(" #n ")" ::: "memory")
#define PG8_WAIT_L(n) asm volatile("s_waitcnt lgkmcnt(" #n ")" ::: "memory")
#define PG8_BAR __builtin_amdgcn_s_barrier()
#define PG8_SCHED __builtin_amdgcn_sched_barrier(0)
    Unit cur, nxt; int ui = 0;
    if (!S.next(0, cur)) return;
    f32x4 acc[2][2][4][2];
#pragma unroll
    for (int a = 0; a < 2; ++a)
#pragma unroll
        for (int b = 0; b < 2; ++b)
#pragma unroll
            for (int m = 0; m < 4; ++m)
#pragma unroll
                for (int n = 0; n < 2; ++n) acc[a][b][m][n] = (f32x4){0.f, 0.f, 0.f, 0.f};
    bf16x8 At[4][2], B0[2][2], B1[2][2];
    const char* cA = (const char*)g.A + (size_t)cur.pm * tstep; const char* cB = (const char*)g.Bt + (size_t)cur.pn * tstep;
    S.a_ready(cur);
    PG8_STAGE(PG8_SB(0, 0), cB, voffB); PG8_STAGE(PG8_SA(0, 0), cA, voffA); PG8_STAGE(PG8_SB(0, 1), cB + hstep, voffB); PG8_STAGE(PG8_SA(0, 1), cA + hstep, voffA);
    if (wr == 1) PG8_BAR;
    PG8_WAIT_V(4); PG8_BAR;
    PG8_STAGE(PG8_SB(1, 0), cB + kstep, voffB); PG8_STAGE(PG8_SA(1, 0), cA + kstep, voffA); PG8_STAGE(PG8_SB(1, 1), cB + hstep + kstep, voffB);
    PG8_WAIT_V(6); PG8_BAR;
    PG8_STAMP();
    for (;;) {
        const bool has_next = S.next(ui + 1, nxt);
        const char* nA = has_next ? (const char*)g.A + (size_t)nxt.pm * tstep : cA; const char* nB = has_next ? (const char*)g.Bt + (size_t)nxt.pn * tstep : cB;
        for (int t = 0; t < nt; t += 2) {
            const bool last = (t == nt - 2);
            const char* a1 = cA + (size_t)(t + 1) * kstep;
            const char* a2 = last ? nA : cA + (size_t)(t + 2) * kstep; const char* b2 = last ? nB : cB + (size_t)(t + 2) * kstep;
            const char* a3 = a2 + kstep; const char* b3 = b2 + kstep;
            if (last && has_next) S.a_ready(nxt);
            PG8_LDB(B0, 0, 0); PG8_SCHED; PG8_LDA(At, 0, 0); PG8_STAGE(PG8_SA(1, 1), a1 + hstep, voffA);
            PG8_WAIT_L(8); PG8_BAR; PG8_WAIT_L(0); PG8_MMA(0, 0, At, B0); PG8_BAR; PG8_SCHED;
            PG8_LDB(B1, 0, 1); PG8_STAGE(PG8_SB(0, 0), b2, voffB);
            PG8_BAR; PG8_WAIT_L(0); PG8_MMA(0, 1, At, B1); PG8_BAR;
            PG8_LDA(At, 0, 1); PG8_STAGE(PG8_SA(0, 0), a2, voffA);
            PG8_BAR; PG8_WAIT_L(0); PG8_MMA(1, 0, At, B0); PG8_BAR; PG8_SCHED;
            PG8_STAGE(PG8_SB(0, 1), b2 + hstep, voffB);
            PG8_WAIT_V(6); PG8_BAR; PG8_MMA(1, 1, At, B1); PG8_BAR;
            PG8_LDB(B0, 1, 0); PG8_SCHED; PG8_LDA(At, 1, 0); PG8_STAGE(PG8_SA(0, 1), a2 + hstep, voffA);
            PG8_WAIT_L(8); PG8_BAR; PG8_WAIT_L(0); PG8_MMA(0, 0, At, B0); PG8_BAR; PG8_SCHED;
            PG8_LDB(B1, 1, 1); PG8_STAGE(PG8_SB(1, 0), b3, voffB);
            PG8_BAR; PG8_WAIT_L(0); PG8_MMA(0, 1, At, B1); PG8_BAR;
            PG8_LDA(At, 1, 1); PG8_STAGE(PG8_SA(1, 0), a3, voffA);
            PG8_BAR; PG8_WAIT_L(0); PG8_MMA(1, 0, At, B0); PG8_BAR; PG8_SCHED;
            PG8_STAGE(PG8_SB(1, 1), b3 + hstep, voffB);
            PG8_WAIT_V(6); PG8_BAR; PG8_MMA(1, 1, At, B1); PG8_BAR;
        }
        PG8_STAMP();
        if constexpr (!Epi::AFTER_DRAIN) { E(acc, cur, wr, wc, fr, fq); S.done(cur); }
        PG8_STAMP();
        if (!has_next) break;
#pragma unroll
        for (int a = 0; a < 2; ++a)
#pragma unroll
            for (int b = 0; b < 2; ++b)
#pragma unroll
                for (int m = 0; m < 4; ++m)
#pragma unroll
                    for (int n = 0; n < 2; ++n) acc[a][b][m][n] = (f32x4){0.f, 0.f, 0.f, 0.f};
        cur = nxt; cA = nA; cB = nB; ++ui;
    }
    PG8_WAIT_V(0);
    if (wr == 0) PG8_BAR;
    PG8_BAR;
    if constexpr (Epi::AFTER_DRAIN) { E.fused(acc, cur, wr, wc, fr, fq, lds, wid, lane); S.done(cur); }
    PG8_STAMP();
    if (STAMP && wid == 0) { stamps[lane] = lane < nts ? (((unsigned long long)(unsigned)ts_hi << 32) | (unsigned)ts_lo) : 0ull;
        if (lane == 62) stamps[62] = rt_entry; if (lane == 63) stamps[63] = (unsigned long long)wall_clock64(); }
#undef PG8_STAMP
#undef PG8_SA
#undef PG8_SB
#undef PG8_STAGE
#undef PG8_LDA
#undef PG8_LDB
#undef PG8_MMA
#undef PG8_WAIT_V
#undef PG8_WAIT_L
#undef PG8_BAR
#undef PG8_SCHED
}
}
#define XB_TMO      128
#define XB_XCNT(j)  (256  + 64 * (j))
#define XB_XSUB(j)  (1280 + 64 * (j))
#define XB_XGEN(j)  (2304 + 64 * (j))
#define XB_TOP      3328
#define XB_TOPGEN   3392
#define XCD_BAR_WORDS 3456
#define XB_SPIN_CAP (1u << 18)
#define LAS __attribute__((address_space(3)))

__device__ __forceinline__ unsigned xb_ld(unsigned* p)              { return __hip_atomic_load(p, __ATOMIC_RELAXED, __HIP_MEMORY_SCOPE_AGENT); }
__device__ __forceinline__ unsigned xb_add(unsigned* p, unsigned v) { return __hip_atomic_fetch_add(p, v, __ATOMIC_RELAXED, __HIP_MEMORY_SCOPE_AGENT); }
__device__ __forceinline__ unsigned xb_xcc_id() { return (unsigned)__builtin_amdgcn_s_getreg((3 << 11) | 20) & 0xFu; }
#define XB_SPIN(cond, bar) do { unsigned _sp = 0; while (cond) { __builtin_amdgcn_s_sleep(1); \
    if ((++_sp & 255u) == 0u) { if (xb_ld(&(bar)[XB_TMO])) break; if (_sp > XB_SPIN_CAP) { atomicAdd(&(bar)[XB_TMO], 1u); break; } } } } while (0)

struct XcdBarrier {
    unsigned* bar; unsigned x;
    volatile LAS unsigned* st;
};

__device__ __forceinline__ XcdBarrier xcd_barrier_post(unsigned* bar, volatile LAS unsigned* st) {
    XcdBarrier b; b.bar = bar; b.x = xb_xcc_id(); b.st = st;
    if (threadIdx.x == 0) (void)xb_add(&bar[XB_XCNT(b.x)], 1u);
    return b;
}
__device__ __forceinline__ void xcd_barrier_complete(unsigned* bar, unsigned x, unsigned& nloc, unsigned& nx) {
    const unsigned G = gridDim.x * gridDim.y * gridDim.z;
    unsigned sum, cnt, mine, sp = 0u;
    for (;;) {
        sum = 0u; cnt = 0u; mine = 0u;
#pragma unroll
        for (unsigned j = 0; j < 16; ++j) { const unsigned c = xb_ld(&bar[XB_XCNT(j)]); sum += c; cnt += (c > 0u) ? 1u : 0u; mine = (j == x) ? c : mine; }
        if (sum == G) break;
        __builtin_amdgcn_s_sleep(1);
        if ((++sp & 255u) == 0u) { if (xb_ld(&bar[XB_TMO])) break; if (sp > XB_SPIN_CAP) { atomicAdd(&bar[XB_TMO], 1u); break; } }
    }
    nloc = mine > 0u ? mine : 1u; nx = cnt > 0u ? cnt : 1u;
}

__device__ __forceinline__ void xcd_barrier(const XcdBarrier& b) {
    asm volatile("s_waitcnt vmcnt(0)" ::: "memory");
    __syncthreads();
    if (threadIdx.x == 0) {
        unsigned* bar = b.bar;
        __builtin_amdgcn_s_waitcnt(0);
        unsigned nloc = b.st[0], nx = b.st[1];
        if (nloc == 0u) { xcd_barrier_complete(bar, b.x, nloc, nx); b.st[0] = nloc; b.st[1] = nx; }
        const unsigned old = xb_add(&bar[XB_XSUB(b.x)], 1u);
        const unsigned gen = old / nloc;
        if (old + 1u == (gen + 1u) * nloc) {
            __builtin_amdgcn_fence(__ATOMIC_RELEASE, "agent");
            asm volatile("s_waitcnt vmcnt(0)" ::: "memory");
            const unsigned og = xb_add(&bar[XB_TOP], 1u);
            const unsigned tg = og / nx;
            if (og + 1u == (tg + 1u) * nx) xb_add(&bar[XB_TOPGEN], 1u);
            else XB_SPIN(xb_ld(&bar[XB_TOPGEN]) == tg, bar);
            __builtin_amdgcn_fence(__ATOMIC_ACQUIRE, "agent");
            xb_add(&bar[XB_XGEN(b.x)], 1u);
            asm volatile("s_waitcnt vmcnt(0)" ::: "memory");
        } else {
            XB_SPIN(xb_ld(&bar[XB_XGEN(b.x)]) == gen, bar);
            __builtin_amdgcn_fence(__ATOMIC_ACQUIRE, "agent");
            asm volatile("s_waitcnt vmcnt(0)" ::: "memory");
        }
    }
    __syncthreads();
}

namespace mk {
typedef unsigned short bf16_t;
typedef short bf16x8 __attribute__((ext_vector_type(8)));
typedef float f32x4 __attribute__((ext_vector_type(4)));
typedef unsigned u32x2 __attribute__((ext_vector_type(2)));
typedef unsigned u32x4 __attribute__((ext_vector_type(4)));
#define LDSP __attribute__((address_space(3)))

constexpr int D = 2048, NB = 4, SEQ = 4096, DEPTH = 4, CTX = 256, T = CTX + SEQ, MROWS = NB * T;
constexpr int NIN = 7728, NINP = 7936, NCH = T / 64;
constexpr int C_AQ = 0, C_AK = 512, C_AV = 1024, C_AZ = 1536, C_ABETA = 2048, C_ADEC = 2056,
              C_BQ = 2064, C_BK = 2320, C_BV = 2576, C_BR = 3088, C_BCODE = 3600,
              C_CQ = 3632, C_CI = 4144, C_CG = 4656, C_CF = 5168, C_DQ = 6192, C_DK = 6704, C_DV = 7216;
constexpr int NEXP = 16, EROWS = 2304;
constexpr float ALPHA = 1.681792830507429f;
constexpr float LN_EPS = 1e-5f, NORM_EPS = 1e-6f;
constexpr int NCC = NB * 4 * 2 * NCH;

enum { I_X = 0, I_C, I_CTX, I_CCTX, I_WMOD, I_BMOD, I_WIN, I_WOUT, I_LNG, I_LNB, I_CONV, I_ALOG, I_DTB, I_GDNN, I_GLAW, I_GLAB, I_GLAN, I_HGAM, I_HGN, I_RPB, I_ROUT, I_W1, I_W3, I_W2 };

constexpr size_t WS_BAR = 0;
constexpr size_t WS_MODV = 16384;
constexpr size_t WS_AFF = WS_MODV + 983040;
constexpr size_t WS_INV = WS_AFF + 1114112;
constexpr size_t WS_IDX = WS_INV + 1114112;
constexpr size_t WS_GATE = WS_IDX + 147456;
constexpr size_t WS_WIN = WS_GATE + 147456;
constexpr size_t WS_WOUT = WS_WIN + 32505856;
constexpr size_t WS_W13 = WS_WOUT + 8388608;
constexpr size_t WS_W2 = WS_W13 + 134217728;
constexpr size_t WS_X = WS_W2 + 67108864;
constexpr size_t WS_X1 = WS_X + 142606336;
constexpr size_t WS_U = WS_X1 + 142606336;
constexpr size_t WS_MIX = WS_U + 71303168;
constexpr size_t WS_RA = WS_MIX + 71303168;
constexpr size_t RA_PROJ = 0;
constexpr size_t RA_GM = RA_PROJ + 276299776;
constexpr size_t RA_GB = RA_GM + 71303168;
constexpr size_t RA_GQ = RA_GB + 71303168;
constexpr size_t RA_GO = RA_GQ + 35651584;
constexpr size_t RA_HB = RA_GO + 35651584;
constexpr size_t RA_HQ = RA_HB + 71303168;
constexpr size_t RA_HO = RA_HQ + 35651584;
constexpr size_t RA_HA = RA_HO + 35651584;
constexpr size_t RA_LB = RA_HA + 1114112;
constexpr size_t RA_LQ = RA_LB + 35651584;
constexpr size_t RA_LO = RA_LQ + 17825792;
constexpr size_t RA_LA = RA_LO + 35651584;
constexpr size_t RA_OB = RA_LA + 557056;
constexpr size_t RA_END = RA_OB + 106954752;
constexpr size_t RA_TBUF = 0;
constexpr size_t RA_XS = 142606336;
constexpr size_t RA_HID = RA_XS + 150994944;
constexpr size_t RA_YS = RA_HID + 75497472;
constexpr size_t WS_TOTAL = WS_RA + RA_END;
static_assert(RA_YS + 150994944 <= RA_END, "region A");

struct Ctx {
    const float* in[24]; float* out; unsigned char* ws;
    LDSP unsigned char* lds; int tid, lane, wave, G, bid;
};

__device__ __forceinline__ float bf2f(unsigned b) { return __uint_as_float(b << 16); }
__device__ __forceinline__ float bflo(unsigned u) { return __uint_as_float(u << 16); }
__device__ __forceinline__ float bfhi(unsigned u) { return __uint_as_float(u & 0xffff0000u); }
__device__ __forceinline__ unsigned pk2(float lo, float hi) { return pg8::cvt_pk_bf16(lo, hi); }
__device__ __forceinline__ bf16_t f2bf(float x) { return (bf16_t)(pk2(x, 0.f) & 0xffffu); }
__device__ __forceinline__ float sigmoidf_(float x) { return 1.f / (1.f + __expf(-x)); }
__device__ __forceinline__ float siluf_(float x) { return x / (1.f + __expf(-x)); }
__device__ __forceinline__ float softplusf_(float x) { return x > 20.f ? x : log1pf(__expf(x)); }
__device__ __forceinline__ float wsum(float v) {
#pragma unroll
    for (int m = 32; m >= 1; m >>= 1) v += __shfl_xor(v, m);
    return v;
}

template <int KS>
__device__ __forceinline__ f32x4 mma_tile(const LDSP bf16_t* a, int lda, const LDSP bf16_t* b, int ldb, f32x4 acc, int lane) {
    const int r = lane & 15, q = lane >> 4;
#pragma unroll
    for (int kk = 0; kk < KS; ++kk) {
        const bf16x8 af = *(const LDSP bf16x8*)(a + r * lda + kk * 32 + q * 8);
        const bf16x8 bf = *(const LDSP bf16x8*)(b + r * ldb + kk * 32 + q * 8);
        acc = __builtin_amdgcn_mfma_f32_16x16x32_bf16(af, bf, acc, 0, 0, 0);
    }
    return acc;
}
__device__ __forceinline__ u32x2 pack4(f32x4 v) { u32x2 o; o.x = pk2(v[0], v[1]); o.y = pk2(v[2], v[3]); return o; }

__device__ __forceinline__ int tok_of(int n, int dir, int i) { return n * 64 + (dir ? 63 - i : i); }

__device__ __forceinline__ void modv_fill_s(const Ctx& c) {
    LDSP float* s = (LDSP float*)c.lds;
    for (int i = c.tid; i < 5 * 2048; i += 512) {
        const int r = i >> 11, k = i & 2047;
        const float v = r < 4 ? c.in[I_C][r * 2048 + k] : c.in[I_CCTX][k];
        s[i] = siluf_(v);
    }
    __syncthreads();
}
__device__ __forceinline__ void modv_unit(const Ctx& c, int unit) {
    const int l = unit / 48, cb = unit % 48;
    LDSP float* s = (LDSP float*)c.lds;
    LDSP float* red = s + 5 * 2048;
    const float* W = c.in[I_WMOD] + (size_t)l * 2048 * 12288 + cb * 256 + c.lane * 4;
    const int k0 = c.wave * 256;
    f32x4 acc[5];
#pragma unroll
    for (int r = 0; r < 5; ++r) acc[r] = (f32x4){0.f, 0.f, 0.f, 0.f};
#pragma unroll 8
    for (int k = 0; k < 256; ++k) {
        const f32x4 w = *(const f32x4*)(W + (size_t)(k0 + k) * 12288);
#pragma unroll
        for (int r = 0; r < 5; ++r) { const float sv = s[r * 2048 + k0 + k]; acc[r] += w * sv; }
    }
#pragma unroll
    for (int r = 0; r < 5; ++r) *(LDSP f32x4*)(red + (c.wave * 5 + r) * 256 + c.lane * 4) = acc[r];
    __syncthreads();
    float* modv = (float*)(c.ws + WS_MODV);
    for (int o = c.tid; o < 5 * 256; o += 512) {
        const int r = o >> 8, col = o & 255;
        float sum = 0.f;
#pragma unroll
        for (int w = 0; w < 8; ++w) sum += red[(w * 5 + r) * 256 + col];
        modv[(size_t)(l * 5 + r) * 12288 + cb * 256 + col] = sum + c.in[I_BMOD][l * 12288 + cb * 256 + col];
    }
    __syncthreads();
}

__device__ __forceinline__ void convert_tile(const Ctx& c, const float* src, int ldsrc, int nvalid, bf16_t* dst, int lddst) {
    const int n4 = c.tid & 31, kq = c.tid >> 5;
    f32x4 v[8];
#pragma unroll
    for (int j = 0; j < 8; ++j) v[j] = (4 * n4 < nvalid) ? *(const f32x4*)(src + (size_t)(kq * 8 + j) * ldsrc + 4 * n4) : (f32x4){0.f, 0.f, 0.f, 0.f};
#pragma unroll
    for (int i = 0; i < 4; ++i) {
        const u32x4 o = (u32x4){pk2(v[0][i], v[1][i]), pk2(v[2][i], v[3][i]), pk2(v[4][i], v[5][i]), pk2(v[6][i], v[7][i])};
        *(u32x4*)(dst + (size_t)(4 * n4 + i) * lddst + kq * 8) = o;
    }
}
constexpr int CONV_JOBS = 992 + 256 + 3 * 2048;
__device__ __forceinline__ void convert_job(const Ctx& c, int l, int job) {
    if (job < 992) {
        const int kt = job & 15, nt = job >> 4;
        convert_tile(c, c.in[I_WIN] + (size_t)l * 2048 * NIN + (size_t)kt * 128 * NIN + nt * 128, NIN, NIN - nt * 128,
                     (bf16_t*)(c.ws + WS_WIN) + (size_t)nt * 128 * 2048 + kt * 128, 2048);
    } else if (job < 1248) {
        const int j = job - 992, kt = j & 15, nt = j >> 4;
        convert_tile(c, c.in[I_WOUT] + (size_t)l * 2048 * 2048 + (size_t)kt * 128 * 2048 + nt * 128, 2048, 128,
                     (bf16_t*)(c.ws + WS_WOUT) + (size_t)nt * 128 * 2048 + kt * 128, 2048);
    } else if (job < 1248 + 4096) {
        const int j = job - 1248, which = j >> 11, jj = j & 2047, e = jj >> 7, rem = jj & 127, kt = rem & 15, nt = rem >> 4;
        const float* src = c.in[which ? I_W3 : I_W1] + ((size_t)(l * 16 + e) * 2048 + (size_t)kt * 128) * 1024 + nt * 128;
        convert_tile(c, src, 1024, 128, (bf16_t*)(c.ws + WS_W13) + ((size_t)e * 2048 + nt * 256 + which * 128) * 2048 + kt * 128, 2048);
    } else {
        const int j = job - 1248 - 4096, e = j >> 7, rem = j & 127, kt = rem & 7, nt = rem >> 3;
        const float* src = c.in[I_W2] + ((size_t)(l * 16 + e) * 1024 + (size_t)kt * 128) * 2048 + nt * 128;
        convert_tile(c, src, 2048, 128, (bf16_t*)(c.ws + WS_W2) + ((size_t)e * 2048 + nt * 128) * 1024 + kt * 128, 1024);
    }
}
__device__ __forceinline__ void convert_phase(const Ctx& c, int l) {
    for (int job = c.bid; job < CONV_JOBS; job += c.G) convert_job(c, l, job);
}

__device__ __forceinline__ void row_stats(const f32x4 (&v)[8], float& mu, float& rstd) {
    float s = 0.f;
#pragma unroll
    for (int j = 0; j < 8; ++j) s += v[j][0] + v[j][1] + v[j][2] + v[j][3];
    mu = wsum(s) * (1.f / 2048.f);
    float q = 0.f;
#pragma unroll
    for (int j = 0; j < 8; ++j) { const f32x4 d = v[j] - mu; q += d[0] * d[0] + d[1] * d[1] + d[2] * d[2] + d[3] * d[3]; }
    rstd = rsqrtf(wsum(q) * (1.f / 2048.f) + LN_EPS);
}
__device__ __forceinline__ void modulate_store(const f32x4 (&v)[8], const float* shift, const float* scale, bf16_t* urow, int lane) {
    float mu, rstd; row_stats(v, mu, rstd);
#pragma unroll
    for (int j = 0; j < 8; ++j) {
        const int col = 256 * j + 4 * lane;
        const f32x4 sh = *(const f32x4*)(shift + col), sc = *(const f32x4*)(scale + col);
        const f32x4 y = (v[j] - mu) * rstd * (sc + 1.f) + sh;
        *(u32x2*)(urow + col) = pack4(y);
    }
}
__device__ __forceinline__ void phase_l0_modulate(const Ctx& c) {
    const float* modv = (const float*)(c.ws + WS_MODV);
    float* X = (float*)(c.ws + WS_X); bf16_t* U = (bf16_t*)(c.ws + WS_U);
    for (int row = c.bid * 8 + c.wave; row < MROWS; row += c.G * 8) {
        const int b = row / T, t = row % T;
        const float* src = t < CTX ? c.in[I_CTX] + ((size_t)b * CTX + t) * D : c.in[I_X] + ((size_t)b * SEQ + (t - CTX)) * D;
        const int r = t < CTX ? 4 : b;
        f32x4 v[8];
#pragma unroll
        for (int j = 0; j < 8; ++j) v[j] = *(const f32x4*)(src + 256 * j + 4 * c.lane);
#pragma unroll
        for (int j = 0; j < 8; ++j) *(f32x4*)(X + (size_t)row * D + 256 * j + 4 * c.lane) = v[j];
        modulate_store(v, modv + (size_t)(0 * 5 + r) * 12288, modv + (size_t)(0 * 5 + r) * 12288 + 2048, U + (size_t)row * D, c.lane);
    }
}

constexpr int GP_RAW = 0;
constexpr int GP_UT = 0;
constexpr int GP_WT = 18432;
constexpr int GP_A = 36864;
constexpr int GP_CW = 53312;
constexpr int GP_Q = GP_CW + 7680;
constexpr int GP_K = GP_Q + 17408;
constexpr int GP_V = GP_K + 17408;
constexpr int GP_KDT = GP_V + 17408;
constexpr int GP_P = GP_KDT + 18432;
constexpr int GP_SM = GP_P + 9216;
constexpr int GP_END = GP_SM + 1024;
static_assert(GP_END <= 160 * 1024, "gdn prep lds");

__device__ __forceinline__ void gdn_prep_unit(const Ctx& c, int l, int cc) {
    const int n = cc % NCH, dir = (cc / NCH) & 1, h = (cc / (NCH * 2)) & 3, b = cc / (NCH * 8);
    int tid_ = c.tid; asm volatile("" : "+v"(tid_));
    const int tid = tid_, lane = tid_ & 63, wave = c.wave;
    LDSP unsigned char* L = c.lds;
    LDSP bf16_t* raw = (LDSP bf16_t*)(L + GP_RAW);
    LDSP float* cw = (LDSP float*)(L + GP_CW);
    LDSP bf16_t* Qs = (LDSP bf16_t*)(L + GP_Q);
    LDSP bf16_t* Ks = (LDSP bf16_t*)(L + GP_K);
    LDSP bf16_t* Vs = (LDSP bf16_t*)(L + GP_V);
    LDSP bf16_t* KdT = (LDSP bf16_t*)(L + GP_KDT);
    LDSP bf16_t* Pm = (LDSP bf16_t*)(L + GP_P);
    LDSP bf16_t* UT = (LDSP bf16_t*)(L + GP_UT);
    LDSP bf16_t* WT = (LDSP bf16_t*)(L + GP_WT);
    LDSP float* Am = (LDSP float*)(L + GP_A);
    LDSP float* sm = (LDSP float*)(L + GP_SM);
    const bf16_t* proj = (const bf16_t*)(c.ws + WS_RA + RA_PROJ);
    const int seg0 = n < 4 ? 0 : CTX, seg1 = n < 4 ? CTX : T;
    const size_t rowb = (size_t)b * T;

    for (int ch = tid; ch < 68 * 48; ch += 512) {
        const int rr = ch / 48, c16 = ch % 48, part = c16 >> 4, d8 = c16 & 15;
        const int t = n * 64 - 2 + rr;
        u32x4 v = (u32x4){0u, 0u, 0u, 0u};
        if (t >= seg0 && t < seg1) v = *(const u32x4*)(proj + (rowb + t) * NINP + part * 512 + h * 128 + d8 * 8);
        *(LDSP u32x4*)(raw + rr * 392 + part * 128 + d8 * 8) = v;
    }
    for (int i = tid; i < 5 * 384; i += 512) {
        const int j = i / 384, cidx = i % 384, part = cidx >> 7, d = cidx & 127;
        cw[i] = c.in[I_CONV][(size_t)(l * 5 + j) * 1536 + part * 512 + h * 128 + d];
    }
    if (wave == 0) {
        const int t = tok_of(n, dir, lane);
        const bf16_t* pr = proj + (rowb + t) * NINP;
        const float beta = sigmoidf_(bf2f(pr[C_ABETA + dir * 4 + h]));
        const float la = -__expf(c.in[I_ALOG][l * 8 + dir * 4 + h]) * softplusf_(bf2f(pr[C_ADEC + dir * 4 + h]) + c.in[I_DTB][l * 8 + dir * 4 + h]);
        float g = la;
#pragma unroll
        for (int m = 1; m < 64; m <<= 1) { const float o = __shfl_up(g, m); if (lane >= m) g += o; }
        const float gend = __shfl(g, 63);
        sm[lane] = g; sm[64 + lane] = beta; sm[128 + lane] = __expf(g); sm[192 + lane] = __expf(gend - g);
    }
    __syncthreads();
    {
        const int i = tid >> 3, gq = tid & 7;
        const int rc = (dir ? 63 - i : i) + 2;
        float q[16], k[16], v[16];
#pragma unroll
        for (int e = 0; e < 16; ++e) { q[e] = 0.f; k[e] = 0.f; v[e] = 0.f; }
#pragma unroll
        for (int j = 0; j < 5; ++j) {
            const LDSP bf16_t* rp = raw + (rc - 2 + j) * 392 + gq * 16;
            const LDSP float* wp = cw + j * 384 + gq * 16;
#pragma unroll
            for (int hf = 0; hf < 2; ++hf) {
                const u32x4 rq4 = *(const LDSP u32x4*)(rp + hf * 8), rk4 = *(const LDSP u32x4*)(rp + 128 + hf * 8), rv4 = *(const LDSP u32x4*)(rp + 256 + hf * 8);
#pragma unroll
                for (int m = 0; m < 4; ++m) {
                    const int e = hf * 8 + m * 2;
                    q[e] += bflo(rq4[m]) * wp[e]; q[e + 1] += bfhi(rq4[m]) * wp[e + 1];
                    k[e] += bflo(rk4[m]) * wp[128 + e]; k[e + 1] += bfhi(rk4[m]) * wp[128 + e + 1];
                    v[e] += bflo(rv4[m]) * wp[256 + e]; v[e + 1] += bfhi(rv4[m]) * wp[256 + e + 1];
                }
            }
        }
        float sq = 0.f, sk = 0.f;
#pragma unroll
        for (int e = 0; e < 16; ++e) { q[e] = siluf_(q[e]); k[e] = siluf_(k[e]); v[e] = siluf_(v[e]); sq += q[e] * q[e]; sk += k[e] * k[e]; }
#pragma unroll
        for (int m = 1; m < 8; m <<= 1) { sq += __shfl_xor(sq, m); sk += __shfl_xor(sk, m); }
        const float rq = rsqrtf(sq + NORM_EPS) * 0.08838834764831845f, rk = rsqrtf(sk + NORM_EPS);
#pragma unroll
        for (int e = 0; e < 16; e += 2) {
            *(LDSP unsigned*)(Qs + i * 136 + gq * 16 + e) = pk2(q[e] * rq, q[e + 1] * rq);
            *(LDSP unsigned*)(Ks + i * 136 + gq * 16 + e) = pk2(k[e] * rk, k[e + 1] * rk);
            *(LDSP unsigned*)(Vs + i * 136 + gq * 16 + e) = pk2(v[e], v[e + 1]);
        }
    }
    __syncthreads();
#pragma unroll
    for (int p = 0; p < 2; ++p) {
        const int id = p * 512 + tid, d = id & 127, i0 = (id >> 7) * 8;
        unsigned w[4];
#pragma unroll
        for (int e = 0; e < 8; e += 2) w[e >> 1] = pk2(bf2f(Ks[(i0 + e) * 136 + d]) * sm[192 + i0 + e], bf2f(Ks[(i0 + e + 1) * 136 + d]) * sm[192 + i0 + e + 1]);
        *(LDSP u32x4*)(KdT + d * 72 + i0) = (u32x4){w[0], w[1], w[2], w[3]};
    }
#pragma unroll
    for (int tt = 0; tt < 4; ++tt) {
        const int id = wave * 4 + tt, which = id >> 4, ti = (id & 15) >> 2, tj = id & 3;
        const int r = lane & 15, q4 = lane >> 4;
        if (which == 0) {
            if (tj <= ti) {
                f32x4 a = mma_tile<4>(Ks + ti * 16 * 136, 136, Ks + tj * 16 * 136, 136, (f32x4){0.f, 0.f, 0.f, 0.f}, lane);
                const int j = tj * 16 + r; const float gj = sm[j];
#pragma unroll
                for (int e = 0; e < 4; ++e) { const int i = ti * 16 + q4 * 4 + e; Am[i * 64 + j] = (i > j) ? sm[64 + i] * a[e] * __expf(sm[i] - gj) : 0.f; }
            }
        } else {
            f32x4 o = (f32x4){0.f, 0.f, 0.f, 0.f};
            if (tj <= ti) {
                const f32x4 a = mma_tile<4>(Ks + tj * 16 * 136, 136, Qs + ti * 16 * 136, 136, (f32x4){0.f, 0.f, 0.f, 0.f}, lane);
                const int i = ti * 16 + r; const float gi = sm[i];
#pragma unroll
                for (int e = 0; e < 4; ++e) { const int j = tj * 16 + q4 * 4 + e; o[e] = (i >= j) ? a[e] * __expf(gi - sm[j]) : 0.f; }
            }
            *(LDSP u32x2*)(Pm + (ti * 16 + r) * 72 + tj * 16 + q4 * 4) = pack4(o);
        }
    }
    __syncthreads();
    if (tid < 256) {
        const int col = tid;
        const LDSP bf16_t* rp = col < 128 ? Vs + col : Ks + (col - 128);
        float X[64];
#pragma unroll
        for (int i = 0; i < 64; ++i) {
            float x = sm[64 + i] * bf2f(rp[i * 136]) * (col < 128 ? 1.f : sm[128 + i]);
#pragma unroll
            for (int j4 = 0; j4 < (i + 3) / 4; ++j4) {
                const f32x4 a = *(const LDSP f32x4*)(Am + i * 64 + j4 * 4);
#pragma unroll
                for (int e = 0; e < 4; ++e) if (j4 * 4 + e < i) x -= a[e] * X[j4 * 4 + e];
            }
            asm volatile("" : "+v"(x) :: "memory");
            X[i] = x;
        }
        LDSP bf16_t* dstp = col < 128 ? UT + col * 72 : WT + (col - 128) * 72;
#pragma unroll
        for (int i = 0; i < 64; i += 8)
            *(LDSP u32x4*)(dstp + i) = (u32x4){pk2(X[i], X[i + 1]), pk2(X[i + 2], X[i + 3]), pk2(X[i + 4], X[i + 5]), pk2(X[i + 6], X[i + 7])};
    }
    __syncthreads();
    {
        bf16_t* Mg = (bf16_t*)(c.ws + WS_RA + RA_GM) + (size_t)cc * 16384;
        bf16_t* Bg = (bf16_t*)(c.ws + WS_RA + RA_GB) + (size_t)cc * 16384;
        bf16_t* Qg = (bf16_t*)(c.ws + WS_RA + RA_GQ) + (size_t)cc * 8192;
        bf16_t* Og = (bf16_t*)(c.ws + WS_RA + RA_GO) + (size_t)cc * 8192;
        const float ge = sm[128 + 63];
        const int r = lane & 15, q4 = lane >> 4;
        const f32x4 z = (f32x4){0.f, 0.f, 0.f, 0.f};
        for (int id = wave; id < 192; id += 8) {
            if (id < 32) {
                const int td = id >> 2, ti = id & 3;
                const f32x4 a = mma_tile<2>(WT + td * 16 * 72, 72, Pm + ti * 16 * 72, 72, z, lane);
                const int i = ti * 16 + r, d0 = td * 16 + q4 * 4; const float egi = sm[128 + i];
                f32x4 o;
#pragma unroll
                for (int e = 0; e < 4; ++e) o[e] = bf2f(Qs[i * 136 + d0 + e]) * egi - a[e];
                *(u32x2*)(Qg + i * 128 + d0) = pack4(o);
            } else if (id < 64) {
                const int td = (id - 32) >> 2, ti = id & 3;
                const f32x4 a = mma_tile<2>(UT + td * 16 * 72, 72, Pm + ti * 16 * 72, 72, z, lane);
                *(u32x2*)(Og + (ti * 16 + r) * 128 + td * 16 + q4 * 4) = pack4(a);
            } else if (id < 128) {
                const int tc = (id - 64) >> 3, tr = id & 7;
                const f32x4 a = mma_tile<2>(WT + tc * 16 * 72, 72, KdT + tr * 16 * 72, 72, z, lane);
                const int dk = tr * 16 + r, d0 = tc * 16 + q4 * 4;
                f32x4 o;
#pragma unroll
                for (int e = 0; e < 4; ++e) o[e] = ((dk == d0 + e) ? ge : 0.f) - a[e];
                *(u32x2*)(Mg + dk * 128 + d0) = pack4(o);
            } else {
                const int tr = (id - 128) >> 3, tc = id & 7;
                const f32x4 a = mma_tile<2>(KdT + tr * 16 * 72, 72, UT + tc * 16 * 72, 72, z, lane);
                *(u32x2*)(Bg + (tc * 16 + r) * 128 + tr * 16 + q4 * 4) = pack4(a);
            }
        }
    }
    __syncthreads();
}

constexpr int DP_QS = 0;
constexpr int DP_KSELF = 17408;
constexpr int DP_KSC = 34816;
constexpr int DP_KDT = 60928;
constexpr int DP_VT = 79360;
constexpr int DP_P = 97792;
constexpr int DP_TOT = 107008;
constexpr int DP_CODE = 109056;
constexpr int DP_END = 113152;

template <int MIX>
__device__ __forceinline__ void diag_prep_unit(const Ctx& c, int l, int cc) {
    constexpr int DK = (MIX == 1) ? 128 : 64;
    constexpr int PQ = DK + 8;
    const int n = cc % NCH, dir = (cc / NCH) & 1, h = (cc / (NCH * 2)) & 3, b = cc / (NCH * 8);
    const int tid = c.tid, lane = c.lane, wave = c.wave;
    LDSP unsigned char* L = c.lds;
    LDSP bf16_t* Qs = (LDSP bf16_t*)(L + DP_QS);
    LDSP bf16_t* Kself = (LDSP bf16_t*)(L + DP_KSELF);
    LDSP bf16_t* Ksc = (LDSP bf16_t*)(L + DP_KSC);
    LDSP bf16_t* KdT = (LDSP bf16_t*)(L + DP_KDT);
    LDSP bf16_t* VT = (LDSP bf16_t*)(L + DP_VT);
    LDSP bf16_t* Pm = (LDSP bf16_t*)(L + DP_P);
    LDSP float* tot = (LDSP float*)(L + DP_TOT);
    LDSP float* code = (LDSP float*)(L + DP_CODE);
    const bf16_t* proj = (const bf16_t*)(c.ws + WS_RA + RA_PROJ);
    const size_t rowb = (size_t)b * T;
    bf16_t* Bg; bf16_t* Qg; bf16_t* Og; float* Ag;
    if (MIX == 1) { Bg = (bf16_t*)(c.ws + WS_RA + RA_HB) + (size_t)cc * 16384; Qg = (bf16_t*)(c.ws + WS_RA + RA_HQ) + (size_t)cc * 8192;
                    Og = (bf16_t*)(c.ws + WS_RA + RA_HO) + (size_t)cc * 8192; Ag = (float*)(c.ws + WS_RA + RA_HA) + (size_t)cc * 128; }
    else          { Bg = (bf16_t*)(c.ws + WS_RA + RA_LB) + (size_t)cc * 8192; Qg = (bf16_t*)(c.ws + WS_RA + RA_LQ) + (size_t)cc * 4096;
                    Og = (bf16_t*)(c.ws + WS_RA + RA_LO) + (size_t)cc * 8192; Ag = (float*)(c.ws + WS_RA + RA_LA) + (size_t)cc * 64; }

    const int vcol = (MIX == 1 ? C_CI : C_BV) + h * 128;
#pragma unroll
    for (int p = 0; p < 2; ++p) {
        const int id = p * 512 + tid, i = id & 63, c8 = id >> 6;
        const u32x4 v = *(const u32x4*)(proj + (rowb + tok_of(n, dir, i)) * NINP + vcol + c8 * 8);
#pragma unroll
        for (int m = 0; m < 4; ++m) { VT[(c8 * 8 + 2 * m) * 72 + i] = (bf16_t)(v[m] & 0xffffu); VT[(c8 * 8 + 2 * m + 1) * 72 + i] = (bf16_t)(v[m] >> 16); }
    }
    for (int i = tid; i < 64 * 36; i += 512) ((LDSP unsigned*)Pm)[i] = 0u;
    if (MIX == 2) {
        for (int i = tid; i < 64 * 16; i += 512) code[i] = bf2f(proj[(rowb + tok_of(n, dir, i >> 4)) * NINP + C_BCODE + dir * 16 + (i & 15)]);
        __syncthreads();
    }
    const int d = tid % DK, I = tid / DK;
    const bool act = (MIX == 1) || (tid < 256);
    float qv[16], kv[16], bl[16];
    if (act) {
        float lb = 0.f, wg[16], bg = 0.f;
        if (MIX == 1) {
            const float* gam = c.in[I_HGAM] + (size_t)dir * DEPTH * 512 + h * 128 + d;
            float mx = gam[0];
#pragma unroll
            for (int i = 1; i < DEPTH; ++i) mx = fmaxf(mx, gam[i * 512]);
            float den = 0.f, num = 0.f;
#pragma unroll
            for (int i = 0; i < DEPTH; ++i) { const float e = __expf(gam[i * 512] - mx); den += e; if (i >= 1 && i <= l) num += e; }
            lb = num / den;
        } else {
#pragma unroll
            for (int r = 0; r < 16; ++r) wg[r] = c.in[I_GLAW][((size_t)(l * 2 + dir) * 16 + r) * 256 + h * 64 + d];
            bg = c.in[I_GLAB][(l * 2 + dir) * 256 + h * 64 + d];
        }
        float run = 0.f;
#pragma unroll
        for (int s = 0; s < 16; ++s) {
            const int i = I * 16 + s, t = tok_of(n, dir, i);
            const bf16_t* pr = proj + (rowb + t) * NINP;
            float la;
            if (MIX == 1) {
                qv[s] = bf2f(pr[C_CQ + h * 128 + d]);
                const float f = lb + (1.f - lb) * sigmoidf_(bf2f(pr[C_CF + dir * 512 + h * 128 + d]));
                la = __logf(f); kv[s] = 1.f - f;
            } else {
                float q0 = bf2f(pr[C_BQ + h * 64 + d]) * 0.125f, k0 = bf2f(pr[C_BK + h * 64 + d]);
                if (n >= 4) {
                    const int pos = t - CTX, hf = d >> 5, idx = d & 31, fi = idx & 15;
                    const float p = (float)(hf ? (pos & 63) : (pos >> 6));
                    const float inv = __expf(-(float)fi * (9.210340371976184f / 16.f));
                    float ang = p * inv;
                    const float kk = rintf(ang * 0.15915494309189535f);
                    ang = fmaf(-kk, 6.2831855f, ang); ang = fmaf(-kk, -1.7484555e-7f, ang);
                    const float cs = __cosf(ang), sn = __sinf(ang);
                    const int dp = idx < 16 ? d + 16 : d - 16;
                    const float q1 = bf2f(pr[C_BQ + h * 64 + dp]) * 0.125f, k1 = bf2f(pr[C_BK + h * 64 + dp]);
                    if (idx < 16) { q0 = q0 * cs - q1 * sn; k0 = k0 * cs - k1 * sn; }
                    else          { q0 = q1 * sn + q0 * cs; k0 = k1 * sn + k0 * cs; }
                }
                qv[s] = q0; kv[s] = k0;
                float gt = bg;
#pragma unroll
                for (int r = 0; r < 16; ++r) gt += code[i * 16 + r] * wg[r];
                la = -softplusf_(-gt) * (1.f / 16.f);
            }
            run += la; bl[s] = run;
        }
        tot[I * 128 + d] = run;
    }
    __syncthreads();
    if (act) {
        float pre = 0.f, bend = 0.f, tI[4];
#pragma unroll
        for (int m = 0; m < 4; ++m) { tI[m] = tot[m * 128 + d]; bend += tI[m]; if (m < I) pre += tI[m]; }
        unsigned kd[8];
#pragma unroll
        for (int s = 0; s < 16; ++s) {
            const int i = I * 16 + s;
            Qs[i * PQ + d] = f2bf(qv[s] * __expf(bl[s]));
            Kself[i * PQ + d] = f2bf(kv[s] * __expf(-bl[s]));
            Qg[i * DK + d] = f2bf(qv[s] * __expf(pre + bl[s]));
            const float kdv = kv[s] * __expf(bend - pre - bl[s]);
            if (s & 1) kd[s >> 1] = (kd[s >> 1] & 0xffffu) | ((unsigned)f2bf(kdv) << 16); else kd[s >> 1] = f2bf(kdv);
            float off = 0.f;
#pragma unroll
            for (int Ip = 1; Ip < 4; ++Ip) {
                if (Ip > I) { off += tI[Ip - 1]; Ksc[((Ip * (Ip - 1) / 2 + I) * 16 + s) * PQ + d] = f2bf(kv[s] * __expf(off - bl[s])); }
            }
        }
        *(LDSP u32x4*)(KdT + d * 72 + I * 16) = (u32x4){kd[0], kd[1], kd[2], kd[3]};
        *(LDSP u32x4*)(KdT + d * 72 + I * 16 + 8) = (u32x4){kd[4], kd[5], kd[6], kd[7]};
        if (I == 0) Ag[d] = __expf(bend);
    }
    __syncthreads();
    for (int blk = wave; blk < 10; blk += 8) {
        int Ib, Jb;
        if (blk < 4) { Ib = blk; Jb = blk; } else { const int s = blk - 4; Ib = s < 1 ? 1 : (s < 3 ? 2 : 3); Jb = s - (Ib * (Ib - 1) / 2); }
        const LDSP bf16_t* kp = (Ib == Jb) ? Kself + Jb * 16 * PQ : Ksc + (Ib * (Ib - 1) / 2 + Jb) * 16 * PQ;
        const f32x4 a = mma_tile<DK / 32>(kp, PQ, Qs + Ib * 16 * PQ, PQ, (f32x4){0.f, 0.f, 0.f, 0.f}, lane);
        const int r = lane & 15, q4 = lane >> 4;
        f32x4 o;
#pragma unroll
        for (int e = 0; e < 4; ++e) o[e] = (Ib > Jb || r >= q4 * 4 + e) ? a[e] : 0.f;
        *(LDSP u32x2*)(Pm + (Ib * 16 + r) * 72 + Jb * 16 + q4 * 4) = pack4(o);
    }
    __syncthreads();
    {
        const int r = lane & 15, q4 = lane >> 4;
        const f32x4 z = (f32x4){0.f, 0.f, 0.f, 0.f};
        constexpr int NT2 = (DK / 16) * 8;
        for (int id = wave; id < 32 + NT2; id += 8) {
            if (id < 32) {
                const int td = id >> 2, ti = id & 3;
                const f32x4 a = mma_tile<2>(VT + td * 16 * 72, 72, Pm + ti * 16 * 72, 72, z, lane);
                *(u32x2*)(Og + (ti * 16 + r) * 128 + td * 16 + q4 * 4) = pack4(a);
            } else {
                const int j = id - 32, tk = j >> 3, tv = j & 7;
                const f32x4 a = mma_tile<2>(KdT + tk * 16 * 72, 72, VT + tv * 16 * 72, 72, z, lane);
                *(u32x2*)(Bg + (tv * 16 + r) * DK + tk * 16 + q4 * 4) = pack4(a);
            }
        }
    }
    __syncthreads();
}

template <int MIX>
__device__ __forceinline__ void scan_unit(const Ctx& c, int chain, int slice) {
    constexpr int DK = (MIX == 2) ? 64 : 128;
    constexpr int DVS = (MIX == 0) ? 32 : 64;
    constexpr int PS = DK + 8;
    constexpr int NS = (MIX == 1) ? 4 : 2;
    constexpr int NO = (MIX == 0) ? 1 : 2;
    constexpr int KS = DK / 32;
    const int lane = c.lane, wave = c.wave, r = lane & 15, q4 = lane >> 4;
    const int dir = chain & 1, h = (chain >> 1) & 3, b = chain >> 3;
    LDSP bf16_t* ST = (LDSP bf16_t*)c.lds;
    for (int i = c.tid; i < DVS * PS / 2; i += 512) ((LDSP unsigned*)ST)[i] = 0u;
    const int dkt = (MIX == 2) ? (wave & 3) : wave;
    const int dvt0 = (MIX == 2) ? 2 * (wave >> 2) : 0;
    const int ott = wave >> 1;
    const int odv0 = (MIX == 0) ? (wave & 1) : 2 * (wave & 1);
    const size_t ccb = (size_t)chain * NCH;
    const bf16_t* Mg = (const bf16_t*)(c.ws + WS_RA + RA_GM);
    const bf16_t* Bg = (const bf16_t*)(c.ws + WS_RA + (MIX == 0 ? RA_GB : MIX == 1 ? RA_HB : RA_LB));
    const bf16_t* Qg = (const bf16_t*)(c.ws + WS_RA + (MIX == 0 ? RA_GQ : MIX == 1 ? RA_HQ : RA_LQ));
    const bf16_t* Og = (const bf16_t*)(c.ws + WS_RA + (MIX == 0 ? RA_GO : MIX == 1 ? RA_HO : RA_LO));
    const float* Ag = (const float*)(c.ws + WS_RA + (MIX == 1 ? RA_HA : RA_LA));
    bf16_t* OB = (bf16_t*)(c.ws + WS_RA + RA_OB) + ((size_t)(MIX * 2 + dir) * MROWS) * 512;
    f32x4 S[NS];
#pragma unroll
    for (int t = 0; t < NS; ++t) S[t] = (f32x4){0.f, 0.f, 0.f, 0.f};
    struct Ld { bf16x8 mf[KS]; u32x2 bt[NS]; f32x4 ae; bf16x8 qf[KS]; u32x2 ot[NO]; };
    Ld cur, nxt;
    auto load = [&](Ld& d, int s) {
        const int n = dir ? (s < 4 ? 3 - s : 71 - s) : s;
        const size_t cc = ccb + n;
        if (MIX == 0) {
#pragma unroll
            for (int kk = 0; kk < KS; ++kk) d.mf[kk] = *(const bf16x8*)(Mg + cc * 16384 + (size_t)(dkt * 16 + r) * 128 + kk * 32 + q4 * 8);
        } else {
            d.ae = *(const f32x4*)(Ag + cc * DK + dkt * 16 + q4 * 4);
        }
#pragma unroll
        for (int t = 0; t < NS; ++t) d.bt[t] = *(const u32x2*)(Bg + cc * (128 * DK) + (size_t)(slice * DVS + (dvt0 + t) * 16 + r) * DK + dkt * 16 + q4 * 4);
#pragma unroll
        for (int kk = 0; kk < KS; ++kk) d.qf[kk] = *(const bf16x8*)(Qg + cc * (64 * DK) + (size_t)(ott * 16 + r) * DK + kk * 32 + q4 * 8);
#pragma unroll
        for (int t = 0; t < NO; ++t) d.ot[t] = *(const u32x2*)(Og + cc * 8192 + (size_t)(ott * 16 + r) * 128 + slice * DVS + (odv0 + t) * 16 + q4 * 4);
    };
    load(cur, 0);
    __syncthreads();
    for (int s = 0; s < NCH; ++s) {
        if (s + 1 < NCH) load(nxt, s + 1);
        const int n = dir ? (s < 4 ? 3 - s : 71 - s) : s;
#pragma unroll
        for (int t = 0; t < NO; ++t) {
            f32x4 a = (f32x4){bflo(cur.ot[t].x), bfhi(cur.ot[t].x), bflo(cur.ot[t].y), bfhi(cur.ot[t].y)};
#pragma unroll
            for (int kk = 0; kk < KS; ++kk) {
                const bf16x8 sf = *(const LDSP bf16x8*)(ST + ((odv0 + t) * 16 + r) * PS + kk * 32 + q4 * 8);
                a = __builtin_amdgcn_mfma_f32_16x16x32_bf16(sf, cur.qf[kk], a, 0, 0, 0);
            }
            const int tok = tok_of(n, dir, ott * 16 + r);
            *(u32x2*)(OB + ((size_t)b * T + tok) * 512 + h * 128 + slice * DVS + (odv0 + t) * 16 + q4 * 4) = pack4(a);
        }
        f32x4 Sn[NS];
#pragma unroll
        for (int t = 0; t < NS; ++t) {
            const f32x4 bm = (f32x4){bflo(cur.bt[t].x), bfhi(cur.bt[t].x), bflo(cur.bt[t].y), bfhi(cur.bt[t].y)};
            if (MIX == 0) {
                f32x4 a = bm;
#pragma unroll
                for (int kk = 0; kk < KS; ++kk) {
                    const bf16x8 sf = *(const LDSP bf16x8*)(ST + ((dvt0 + t) * 16 + r) * PS + kk * 32 + q4 * 8);
                    a = __builtin_amdgcn_mfma_f32_16x16x32_bf16(cur.mf[kk], sf, a, 0, 0, 0);
                }
                Sn[t] = a;
            } else {
                Sn[t] = cur.ae * S[t] + bm;
            }
        }
        __syncthreads();
#pragma unroll
        for (int t = 0; t < NS; ++t) { S[t] = Sn[t]; *(LDSP u32x2*)(ST + ((dvt0 + t) * 16 + r) * PS + dkt * 16 + q4 * 4) = pack4(Sn[t]); }
        __syncthreads();
        cur = nxt;
    }
}

constexpr int NA_Q = 0, NA_K = 17408, NA_VT = 34816, NA_P = 53248, NA_GRP = 62464;
constexpr int NA_RPB = 2 * NA_GRP;
__device__ __forceinline__ void na_pair(const Ctx& c, int l, int pair) {
    const int tid = c.tid, lane = c.lane, wave = c.wave, grp = wave >> 2, gw = wave & 3, gt = tid & 255;
    const int r = lane & 15, q4 = lane >> 4;
    const bool is_lat = pair < 512;
    int b, h, gr = 0, qb = 0;
    if (is_lat) { const int u = pair * 2 + grp; b = u >> 8; h = (u >> 6) & 3; gr = u & 63; }
    else { const int u = (pair - 512) * 2 + grp; b = u >> 4; h = (u >> 2) & 3; qb = u & 3; }
    const int NT = is_lat ? 12 : 4;
    const int rs = gr - 4 < 0 ? 0 : (gr - 4 > 56 ? 56 : gr - 4);
    LDSP unsigned char* L = c.lds + grp * NA_GRP;
    LDSP bf16_t* Qs = (LDSP bf16_t*)(L + NA_Q);
    LDSP bf16_t* Kt = (LDSP bf16_t*)(L + NA_K);
    LDSP bf16_t* VT = (LDSP bf16_t*)(L + NA_VT);
    LDSP bf16_t* Pm = (LDSP bf16_t*)(L + NA_P);
    LDSP float* rpb = (LDSP float*)(c.lds + NA_RPB);
    const bf16_t* proj = (const bf16_t*)(c.ws + WS_RA + RA_PROJ);
    const size_t rowb = (size_t)b * T;
    const int qtok0 = is_lat ? CTX + gr * 64 : qb * 64;
#pragma unroll
    for (int p = 0; p < 4; ++p) {
        const int id = p * 256 + gt, qi = id >> 4, c8 = id & 15;
        *(LDSP u32x4*)(Qs + qi * 136 + c8 * 8) = *(const u32x4*)(proj + (rowb + qtok0 + qi) * NINP + C_DQ + h * 128 + c8 * 8);
    }
    if (tid < 465) rpb[tid] = c.in[I_RPB][(size_t)(l * 4 + h) * 465 + tid];
    float m_run = -1e30f, l_run = 0.f;
    f32x4 acc[8];
#pragma unroll
    for (int dt = 0; dt < 8; ++dt) acc[dt] = (f32x4){0.f, 0.f, 0.f, 0.f};
    const float SC = 0.08838834764831845f * 1.4426950408889634f;
    const int cq = gw * 16 + r;
    const int cs = cq - 8 < 0 ? 0 : (cq - 8 > 48 ? 48 : cq - 8);
    for (int kt = 0; kt < NT; ++kt) {
        const bool loc = is_lat && kt < 8;
        const int ktok0 = is_lat ? (kt < 8 ? CTX + (rs + kt) * 64 : (kt - 8) * 64) : kt * 64;
        __syncthreads();
#pragma unroll
        for (int p = 0; p < 4; ++p) {
            const int id = p * 256 + gt, j = id >> 4, c8 = id & 15;
            *(LDSP u32x4*)(Kt + j * 136 + c8 * 8) = *(const u32x4*)(proj + (rowb + ktok0 + j) * NINP + C_DK + h * 128 + c8 * 8);
        }
#pragma unroll
        for (int p = 0; p < 4; ++p) {
            const int id = p * 256 + gt, j = id & 63, c8 = id >> 6;
            const u32x4 v = *(const u32x4*)(proj + (rowb + ktok0 + j) * NINP + C_DV + h * 128 + c8 * 8);
#pragma unroll
            for (int m = 0; m < 4; ++m) { VT[(c8 * 8 + 2 * m) * 72 + j] = (bf16_t)(v[m] & 0xffffu); VT[(c8 * 8 + 2 * m + 1) * 72 + j] = (bf16_t)(v[m] >> 16); }
        }
        __syncthreads();
        f32x4 sc[4];
        float tmax = -1e30f;
#pragma unroll
        for (int ct = 0; ct < 4; ++ct) {
            sc[ct] = mma_tile<4>(Kt + ct * 16 * 136, 136, Qs + gw * 16 * 136, 136, (f32x4){0.f, 0.f, 0.f, 0.f}, lane);
#pragma unroll
            for (int e = 0; e < 4; ++e) {
                float s = sc[ct][e] * SC;
                if (loc) {
                    const int ck = ct * 16 + q4 * 4 + e;
                    int dc = ck - cq; dc = dc < -15 ? -15 : (dc > 15 ? 15 : dc);
                    const int dr = rs + kt - gr + 7;
                    s += rpb[dr * 31 + dc + 15] * 1.4426950408889634f;
                    if (ck < cs || ck >= cs + 16) s = -INFINITY;
                }
                sc[ct][e] = s; tmax = fmaxf(tmax, s);
            }
        }
        tmax = fmaxf(tmax, __shfl_xor(tmax, 16)); tmax = fmaxf(tmax, __shfl_xor(tmax, 32));
        const float m_new = fmaxf(m_run, tmax);
        const float alpha = __builtin_amdgcn_exp2f(m_run - m_new);
        float psum = 0.f;
#pragma unroll
        for (int ct = 0; ct < 4; ++ct) {
            f32x4 p;
#pragma unroll
            for (int e = 0; e < 4; ++e) { p[e] = __builtin_amdgcn_exp2f(sc[ct][e] - m_new); psum += p[e]; }
            *(LDSP u32x2*)(Pm + (gw * 16 + r) * 72 + ct * 16 + q4 * 4) = pack4(p);
        }
        psum += __shfl_xor(psum, 16); psum += __shfl_xor(psum, 32);
        l_run = l_run * alpha + psum; m_run = m_new;
#pragma unroll
        for (int dt = 0; dt < 8; ++dt) {
            acc[dt] = acc[dt] * alpha;
            acc[dt] = mma_tile<2>(VT + dt * 16 * 72, 72, Pm + gw * 16 * 72, 72, acc[dt], lane);
        }
    }
    const float inv = 1.f / l_run;
    bf16_t* mix = (bf16_t*)(c.ws + WS_MIX) + (rowb + qtok0 + gw * 16 + r) * D + 1536 + h * 128;
#pragma unroll
    for (int dt = 0; dt < 8; ++dt) *(u32x2*)(mix + dt * 16 + q4 * 4) = pack4(acc[dt] * inv);
    __syncthreads();
}

__device__ __forceinline__ void phase_combine(const Ctx& c, int l) {
    const bf16_t* proj = (const bf16_t*)(c.ws + WS_RA + RA_PROJ);
    const bf16_t* OB = (const bf16_t*)(c.ws + WS_RA + RA_OB);
    bf16_t* mix = (bf16_t*)(c.ws + WS_MIX);
    const int lane = c.lane, d0 = (lane & 15) * 8;
    for (int row = c.bid * 8 + c.wave; row < MROWS; row += c.G * 8) {
#pragma unroll
        for (int mx = 0; mx < 3; ++mx) {
            const int om = mx == 0 ? 0 : 3 - mx;
            const u32x4 a = *(const u32x4*)(OB + ((size_t)(om * 2 + 0) * MROWS + row) * 512 + lane * 8);
            const u32x4 bq = *(const u32x4*)(OB + ((size_t)(om * 2 + 1) * MROWS + row) * 512 + lane * 8);
            const u32x4 g = *(const u32x4*)(proj + (size_t)row * NINP + (mx == 0 ? C_AZ : mx == 1 ? C_BR : C_CG) + lane * 8);
            const float* nw = c.in[mx == 0 ? I_GDNN : mx == 1 ? I_GLAN : I_HGN] + l * 128 + d0;
            float o[8]; float ss = 0.f;
#pragma unroll
            for (int m = 0; m < 4; ++m) { o[2 * m] = bflo(a[m]) + bflo(bq[m]); o[2 * m + 1] = bfhi(a[m]) + bfhi(bq[m]); ss += o[2 * m] * o[2 * m] + o[2 * m + 1] * o[2 * m + 1]; }
#pragma unroll
            for (int m = 1; m < 16; m <<= 1) ss += __shfl_xor(ss, m);
            const float rn = rsqrtf(ss * (1.f / 128.f) + NORM_EPS);
            float y[8];
#pragma unroll
            for (int m = 0; m < 4; ++m) {
                const float g0 = bflo(g[m]), g1 = bfhi(g[m]);
                const float a0 = (mx == 2) ? sigmoidf_(g0) : siluf_(g0), a1 = (mx == 2) ? sigmoidf_(g1) : siluf_(g1);
                y[2 * m] = o[2 * m] * rn * nw[2 * m] * a0; y[2 * m + 1] = o[2 * m + 1] * rn * nw[2 * m + 1] * a1;
            }
            *(u32x4*)(mix + (size_t)row * D + mx * 512 + lane * 8) = (u32x4){pk2(y[0], y[1]), pk2(y[2], y[3]), pk2(y[4], y[5]), pk2(y[6], y[7])};
        }
    }
}

__device__ __forceinline__ void phase_ln_router(const Ctx& c, int l) {
    LDSP float* wr = (LDSP float*)c.lds;
    for (int i = c.tid; i < 2048 * 16; i += 512) { const int k = i >> 4, e = i & 15; wr[e * 2048 + k] = c.in[I_ROUT][(size_t)l * 2048 * 16 + i]; }
    __syncthreads();
    const float* modv = (const float*)(c.ws + WS_MODV);
    const float* tb = (const float*)(c.ws + WS_RA + RA_TBUF);
    float* X1 = (float*)(c.ws + WS_X1); bf16_t* U = (bf16_t*)(c.ws + WS_U); float* aff = (float*)(c.ws + WS_AFF);
    const float* lg = c.in[I_LNG] + (size_t)(l * 2 + 0) * D; const float* lbp = c.in[I_LNB] + (size_t)(l * 2 + 0) * D;
    const int lane = c.lane;
    for (int row = c.bid * 8 + c.wave; row < MROWS; row += c.G * 8) {
        const int b = row / T, t = row % T;
        if (l == DEPTH - 1 && t < CTX) continue;
        const int r = t < CTX ? 4 : b;
        f32x4 v[8];
#pragma unroll
        for (int j = 0; j < 8; ++j) v[j] = *(const f32x4*)(tb + (size_t)row * D + 256 * j + 4 * lane);
        float mu, rstd; row_stats(v, mu, rstd);
#pragma unroll
        for (int j = 0; j < 8; ++j) {
            const int col = 256 * j + 4 * lane;
            v[j] = (v[j] - mu) * rstd * *(const f32x4*)(lg + col) + *(const f32x4*)(lbp + col);
            *(f32x4*)(X1 + (size_t)row * D + col) = v[j];
        }
        row_stats(v, mu, rstd);
        const float* sh = modv + (size_t)(l * 5 + r) * 12288 + 3 * 2048; const float* scp = sh + 2048;
        float lg16[16];
#pragma unroll
        for (int e = 0; e < 16; ++e) lg16[e] = 0.f;
#pragma unroll
        for (int j = 0; j < 8; ++j) {
            const int col = 256 * j + 4 * lane;
            const f32x4 y = (v[j] - mu) * rstd * (*(const f32x4*)(scp + col) + 1.f) + *(const f32x4*)(sh + col);
            *(u32x2*)(U + (size_t)row * D + col) = pack4(y);
#pragma unroll
            for (int e = 0; e < 16; ++e) { const f32x4 w = *(const LDSP f32x4*)(wr + e * 2048 + col); lg16[e] += y[0] * w[0] + y[1] * w[1] + y[2] * w[2] + y[3] * w[3]; }
        }
        float mxv = -1e30f;
#pragma unroll
        for (int e = 0; e < 16; ++e) { lg16[e] = wsum(lg16[e]); mxv = fmaxf(mxv, lg16[e]); }
        float den = 0.f;
#pragma unroll
        for (int e = 0; e < 16; ++e) { lg16[e] = expf(lg16[e] - mxv); den += lg16[e]; }
        const float rd = 1.f / den;
        float mine = 0.f;
#pragma unroll
        for (int e = 0; e < 16; ++e) if (lane == e) mine = lg16[e] * rd;
        if (lane < 16) aff[(size_t)row * 16 + lane] = mine;
    }
    __syncthreads();
}

__device__ __forceinline__ void topk_unit(const Ctx& c, int prob) {
    const bool lat = prob < 64; const int pe = lat ? prob : prob - 64, b = pe >> 4, e = pe & 15;
    const int n = lat ? 4096 : 256, kcap = lat ? 512 : 32, tok0 = lat ? CTX : 0;
    LDSP unsigned* keys = (LDSP unsigned*)c.lds;
    LDSP unsigned* hist = keys + 4096;
    LDSP unsigned* bc = hist + 256;
    LDSP unsigned* wsum_ = bc + 4;
    const float* aff = (const float*)(c.ws + WS_AFF);
    const int tid = c.tid, lane = c.lane, wave = c.wave;
    const size_t rowb = (size_t)b * T + tok0;
    for (int i = tid; i < n; i += 512) keys[i] = __float_as_uint(aff[(rowb + i) * 16 + e]);
    unsigned prefix = 0u, mask = 0u, krem = (unsigned)kcap;
    for (int pass = 0; pass < 4; ++pass) {
        const int shift = 24 - 8 * pass;
        if (tid < 256) hist[tid] = 0u;
        __syncthreads();
        for (int i = tid; i < n; i += 512) { const unsigned k = keys[i]; if ((k & mask) == prefix) __hip_atomic_fetch_add(&hist[(k >> shift) & 255u], 1u, __ATOMIC_RELAXED, __HIP_MEMORY_SCOPE_WORKGROUP); }
        __syncthreads();
        if (tid == 0) {
            unsigned cum = 0u; int bin = 255;
            for (; bin > 0; --bin) { const unsigned hcount = hist[bin]; if (cum + hcount >= krem) break; cum += hcount; }
            bc[0] = prefix | ((unsigned)bin << shift); bc[1] = krem - cum;
        }
        __syncthreads();
        prefix = bc[0]; krem = bc[1]; mask |= 255u << shift;
        __syncthreads();
    }
    const int per = n / 512 > 0 ? n / 512 : 1;
    const int i0 = tid * per;
    unsigned cnt = 0u;
    if (i0 < n) for (int j = 0; j < per; ++j) { const unsigned k = keys[i0 + j]; cnt += (k > prefix) ? 1u : 0u; cnt += (k == prefix) ? 0x10000u : 0u; }
    unsigned inc = cnt;
#pragma unroll
    for (int m = 1; m < 64; m <<= 1) { const unsigned o = __shfl_up(inc, m); if (lane >= m) inc += o; }
    if (lane == 63) wsum_[wave] = inc;
    __syncthreads();
    unsigned base = 0u;
    for (int w = 0; w < wave; ++w) base += wsum_[w];
    unsigned excl = base + inc - cnt;
    int* idx = (int*)(c.ws + WS_IDX); float* gate = (float*)(c.ws + WS_GATE); int* inv = (int*)(c.ws + WS_INV);
    const int slot0 = lat ? b * 512 : 2048 + b * 32;
    if (i0 < n) for (int j = 0; j < per; ++j) {
        const unsigned k = keys[i0 + j];
        const unsigned gtb = excl & 0xffffu, eqb = excl >> 16;
        const bool sel = (k > prefix) || (k == prefix && eqb < krem);
        int srow = -1;
        if (sel) {
            srow = slot0 + (int)(gtb + (eqb < krem ? eqb : krem));
            idx[e * EROWS + srow] = (int)(rowb + i0 + j);
            gate[e * EROWS + srow] = __uint_as_float(k);
        }
        inv[(rowb + i0 + j) * 16 + e] = srow;
        excl += (k > prefix) ? 1u : 0u; excl += (k == prefix) ? 0x10000u : 0u;
    }
    __syncthreads();
}

__device__ __forceinline__ void phase_gather(const Ctx& c, int l) {
    const int* idx = (const int*)(c.ws + WS_IDX);
    const bf16_t* U = (const bf16_t*)(c.ws + WS_U); bf16_t* XS = (bf16_t*)(c.ws + WS_RA + RA_XS);
    const int nrow = (l == DEPTH - 1) ? 2048 : EROWS, nreal = (l == DEPTH - 1) ? 2048 : 2176;
    for (int g = c.bid * 8 + c.wave; g < NEXP * nrow; g += c.G * 8) {
        const int e = g / nrow, s = g % nrow;
        u32x4 v[4];
        if (s < nreal) {
            const int src = idx[e * EROWS + s];
#pragma unroll
            for (int j = 0; j < 4; ++j) v[j] = *(const u32x4*)(U + (size_t)src * D + j * 512 + c.lane * 8);
        } else {
#pragma unroll
            for (int j = 0; j < 4; ++j) v[j] = (u32x4){0u, 0u, 0u, 0u};
            if (c.lane == 0) ((float*)(c.ws + WS_GATE))[e * EROWS + s] = 0.f;
        }
#pragma unroll
        for (int j = 0; j < 4; ++j) *(u32x4*)(XS + ((size_t)e * EROWS + s) * D + j * 512 + c.lane * 8) = v[j];
    }
}

__device__ __forceinline__ void phase_final(const Ctx& c, int l) {
    const float* modv = (const float*)(c.ws + WS_MODV);
    const float* X1 = (const float*)(c.ws + WS_X1); float* X = (float*)(c.ws + WS_X); bf16_t* U = (bf16_t*)(c.ws + WS_U);
    const bf16_t* YS = (const bf16_t*)(c.ws + WS_RA + RA_YS); const int* inv = (const int*)(c.ws + WS_INV);
    const float* lg = c.in[I_LNG] + (size_t)(l * 2 + 1) * D; const float* lbp = c.in[I_LNB] + (size_t)(l * 2 + 1) * D;
    const int lane = c.lane;
    for (int row = c.bid * 8 + c.wave; row < MROWS; row += c.G * 8) {
        const int b = row / T, t = row % T;
        if (l == DEPTH - 1 && t < CTX) continue;
        const int r = t < CTX ? 4 : b;
        f32x4 y[8];
#pragma unroll
        for (int j = 0; j < 8; ++j) y[j] = (f32x4){0.f, 0.f, 0.f, 0.f};
        const int myinv = inv[(size_t)row * 16 + (lane & 15)];
        for (int e = 0; e < 16; ++e) {
            const int s = __shfl(myinv, e);
            if (s >= 0) {
                const bf16_t* yr = YS + ((size_t)e * EROWS + s) * D;
#pragma unroll
                for (int j = 0; j < 8; ++j) { const u32x2 w = *(const u32x2*)(yr + 256 * j + 4 * lane); y[j] += (f32x4){bflo(w.x), bfhi(w.x), bflo(w.y), bfhi(w.y)}; }
            }
        }
        const float* m5 = modv + (size_t)(l * 5 + r) * 12288 + 5 * 2048;
        f32x4 v[8];
#pragma unroll
        for (int j = 0; j < 8; ++j) { const int col = 256 * j + 4 * lane; v[j] = *(const f32x4*)(X1 + (size_t)row * D + col) * ALPHA + *(const f32x4*)(m5 + col) * y[j]; }
        float mu, rstd; row_stats(v, mu, rstd);
#pragma unroll
        for (int j = 0; j < 8; ++j) { const int col = 256 * j + 4 * lane; v[j] = (v[j] - mu) * rstd * *(const f32x4*)(lg + col) + *(const f32x4*)(lbp + col); }
        if (l == DEPTH - 1) {
            float* o = c.out + ((size_t)b * SEQ + (t - CTX)) * D;
#pragma unroll
            for (int j = 0; j < 8; ++j) *(f32x4*)(o + 256 * j + 4 * lane) = v[j];
        } else {
#pragma unroll
            for (int j = 0; j < 8; ++j) *(f32x4*)(X + (size_t)row * D + 256 * j + 4 * lane) = v[j];
            const float* sh = modv + (size_t)((l + 1) * 5 + r) * 12288;
            modulate_store(v, sh, sh + 2048, U + (size_t)row * D, lane);
        }
    }
}

struct EpiOut {
    static constexpr bool PERM = false, AFTER_DRAIN = false;
    const float* X; const float* modv_l; float* Tb;
    __device__ __forceinline__ void operator()(const pg8::f32x4 (&acc)[2][2][4][2], const pg8::Unit& u, int wr, int wc, int fr, int fq) const {
        const int row0 = u.pm * 256 + wr * 64 + fr, col0 = u.pn * 256 + wc * 32 + 4 * fq;
        const int r = (u.pm % 17 == 0) ? 4 : u.pm / 17;
        const float* m2 = modv_l + (size_t)r * 12288 + 2 * 2048 + col0;
        pg8::f32x4 mv[2][2];
#pragma unroll
        for (int bj = 0; bj < 2; ++bj)
#pragma unroll
            for (int n = 0; n < 2; ++n) mv[bj][n] = *(const pg8::f32x4*)(m2 + bj * 128 + n * 16);
#pragma unroll
        for (int ai = 0; ai < 2; ++ai)
#pragma unroll
            for (int m = 0; m < 4; ++m) {
                const size_t off = (size_t)(row0 + ai * 128 + m * 16) * D + col0;
#pragma unroll
                for (int bj = 0; bj < 2; ++bj)
#pragma unroll
                    for (int n = 0; n < 2; ++n)
                        *(pg8::f32x4*)(Tb + off + bj * 128 + n * 16) = *(const pg8::f32x4*)(X + off + bj * 128 + n * 16) * ALPHA + mv[bj][n] * acc[ai][bj][m][n];
            }
    }
};
struct EpiHid {
    static constexpr bool PERM = true, AFTER_DRAIN = false;
    bf16_t* H;
    __device__ __forceinline__ void operator()(const pg8::f32x4 (&acc)[2][2][4][2], const pg8::Unit& u, int wr, int wc, int fr, int fq) const {
        const int row0 = u.pm * 256 + wr * 64 + fr, col0 = (u.pn & 7) * 128 + wc * 32 + 8 * fq;
#pragma unroll
        for (int ai = 0; ai < 2; ++ai)
#pragma unroll
            for (int m = 0; m < 4; ++m) {
                float hv[8];
#pragma unroll
                for (int n = 0; n < 2; ++n)
#pragma unroll
                    for (int j = 0; j < 4; ++j) hv[n * 4 + j] = siluf_(acc[ai][0][m][n][j]) * acc[ai][1][m][n][j];
                *(u32x4*)(H + (size_t)(row0 + ai * 128 + m * 16) * 1024 + col0) = (u32x4){pk2(hv[0], hv[1]), pk2(hv[2], hv[3]), pk2(hv[4], hv[5]), pk2(hv[6], hv[7])};
            }
    }
};
struct EpiY {
    static constexpr bool PERM = true, AFTER_DRAIN = false;
    bf16_t* Y; const float* gate;
    __device__ __forceinline__ void operator()(const pg8::f32x4 (&acc)[2][2][4][2], const pg8::Unit& u, int wr, int wc, int fr, int fq) const {
        const int row0 = u.pm * 256 + wr * 64 + fr, col0 = (u.pn & 7) * 256 + wc * 32 + 8 * fq;
#pragma unroll
        for (int ai = 0; ai < 2; ++ai)
#pragma unroll
            for (int m = 0; m < 4; ++m) {
                const int row = row0 + ai * 128 + m * 16; const float g = gate[row];
#pragma unroll
                for (int bj = 0; bj < 2; ++bj) {
                    const pg8::f32x4 v0 = acc[ai][bj][m][0] * g, v1 = acc[ai][bj][m][1] * g;
                    *(u32x4*)(Y + (size_t)row * D + col0 + bj * 128) = (u32x4){pk2(v0[0], v0[1]), pk2(v0[2], v0[3]), pk2(v1[0], v1[1]), pk2(v1[2], v1[3])};
                }
            }
    }
};
struct SchedLin {
    int G, c, nUnits, nPn, skip_ctx;
    __device__ __forceinline__ bool next(int i, pg8::Unit& u) const {
        const int L = i * G + c; if (L >= nUnits) return false;
        const int pml = L / nPn; u.pn = L % nPn; u.pm = skip_ctx ? (pml >> 4) * 17 + 1 + (pml & 15) : pml; return true;
    }
    __device__ __forceinline__ void a_ready(const pg8::Unit&) const {}
    __device__ __forceinline__ void done(const pg8::Unit&) const {}
};
struct SchedMoe {
    int G, c, nPm, nUnits;
    __device__ __forceinline__ bool next(int i, pg8::Unit& u) const {
        const int L = i * G + c; if (L >= nUnits) return false;
        const int per = nPm * 8, e = L / per, rem = L % per; u.pm = e * 9 + (rem >> 3); u.pn = e * 8 + (rem & 7); return true;
    }
    __device__ __forceinline__ void a_ready(const pg8::Unit&) const {}
    __device__ __forceinline__ void done(const pg8::Unit&) const {}
};
}

struct Args { const float* in[24]; float* out; unsigned char* ws; int ph_lo, ph_hi; };
constexpr int LDS_BYTES = 147456;
constexpr int N_PHASES = 2 + 11 * mk::DEPTH;

__global__ __launch_bounds__(512, 2) void mega_fwd(Args a) {
    using namespace mk;
    extern __shared__ __attribute__((aligned(16))) unsigned char lds_raw[];
    Ctx c0;
#pragma unroll
    for (int i = 0; i < 24; ++i) c0.in[i] = a.in[i];
    c0.out = a.out; c0.ws = a.ws; c0.lds = (LDSP unsigned char*)lds_raw;
    const int wave_s = __builtin_amdgcn_readfirstlane((int)threadIdx.x >> 6);
    c0.tid = threadIdx.x; c0.lane = c0.tid & 63; c0.wave = wave_s; c0.G = gridDim.x; c0.bid = blockIdx.x;
    const int lo = a.ph_lo, hi = a.ph_hi;
    volatile LAS unsigned* st = (volatile LAS unsigned*)(lds_raw + LDS_BYTES - 16);
    if (c0.tid == 0) { st[0] = 0u; st[1] = 0u; st[2] = 0u; st[3] = 0u; }
    __syncthreads();
    XcdBarrier bar; bar.bar = (unsigned*)(a.ws + WS_BAR); bar.x = 0; bar.st = st;
    if (hi - lo > 1) bar = xcd_barrier_post((unsigned*)(a.ws + WS_BAR), st);
    int ph = 0;
#define PH_CTX Ctx c = c0; { int wz = wave_s; asm volatile("" : "+s"(wz)); unsigned zz = 0u; asm volatile("" : "+v"(zz)); const int lz = (int)__builtin_amdgcn_mbcnt_hi(~0u, __builtin_amdgcn_mbcnt_lo(~0u, zz)); c.wave = wz; c.lane = lz; c.tid = wz * 64 + lz; }
#define PH_ON (ph >= lo && ph < hi)
#define PH_END do { if (PH_ON && ph + 1 < hi) xcd_barrier(bar); ++ph; } while (0)

    if (PH_ON) { PH_CTX
        if (c.bid < 192) { modv_fill_s(c); for (int u = c.bid; u < 192; u += c.G) modv_unit(c, u); }
        convert_phase(c, 0);
    }
    PH_END;
    if (PH_ON) { PH_CTX phase_l0_modulate(c); }
    PH_END;

    for (int l = 0; l < DEPTH; ++l) {
        const bool last = (l == DEPTH - 1);
        if (PH_ON) { PH_CTX
            pg8::Gemm g{(const pg8::bf16_t*)(c.ws + WS_U), (const pg8::bf16_t*)(c.ws + WS_WIN), MROWS, NINP, D};
            pg8::StaticOrder S; S.init(MROWS, NINP, c.G, c.bid);
            pg8::EpiBf16<0> E{(pg8::bf16_t*)(c.ws + WS_RA + RA_PROJ), NINP, nullptr, 0, 0};
            pg8::gemm_phase<pg8::EpiBf16<0>, pg8::StaticOrder, false>((PG8_LAS unsigned char*)c.lds, g, S, E, nullptr, c.tid);
        }
        PH_END;
        if (PH_ON) { PH_CTX
            for (int cc = c.bid; cc < NCC; cc += c.G) gdn_prep_unit(c, l, cc);
        }
        if (PH_ON) { PH_CTX
            for (int cc = c.bid; cc < NCC; cc += c.G) diag_prep_unit<1>(c, l, cc);
        }
        if (PH_ON) { PH_CTX
            for (int cc = c.bid; cc < NCC; cc += c.G) diag_prep_unit<2>(c, l, cc);
        }
        PH_END;
        if (PH_ON) { PH_CTX
            for (int u = c.bid; u < 256; u += c.G) if (u < 128) { scan_unit<0>(c, u >> 2, u & 3); __syncthreads(); }
        }
        if (PH_ON) { PH_CTX
            for (int u = c.bid; u < 256; u += c.G) if (u >= 128 && u < 192) { scan_unit<1>(c, (u - 128) >> 1, (u - 128) & 1); __syncthreads(); }
        }
        if (PH_ON) { PH_CTX
            for (int u = c.bid; u < 256; u += c.G) if (u >= 192) { scan_unit<2>(c, (u - 192) >> 1, (u - 192) & 1); __syncthreads(); }
        }
        if (PH_ON) { PH_CTX
            const int npair = last ? 512 : 544;
            for (int p = c.bid; p < npair; p += c.G) na_pair(c, l, p);
        }
        PH_END;
        if (PH_ON) { PH_CTX phase_combine(c, l); }
        PH_END;
        if (PH_ON) { PH_CTX
            pg8::Gemm g{(const pg8::bf16_t*)(c.ws + WS_MIX), (const pg8::bf16_t*)(c.ws + WS_WOUT), MROWS, D, D};
            SchedLin S{c.G, c.bid, (last ? 64 : 68) * 8, 8, last ? 1 : 0};
            EpiOut E{(const float*)(c.ws + WS_X), (const float*)(c.ws + WS_MODV) + (size_t)l * 5 * 12288, (float*)(c.ws + WS_RA + RA_TBUF)};
            pg8::gemm_phase<EpiOut, SchedLin, false>((PG8_LAS unsigned char*)c.lds, g, S, E, nullptr, c.tid);
        }
        PH_END;
        if (PH_ON) { PH_CTX phase_ln_router(c, l); }
        PH_END;
        if (PH_ON) { PH_CTX const int nprob = last ? 64 : 128; for (int p = c.bid; p < nprob; p += c.G) topk_unit(c, p); }
        PH_END;
        if (PH_ON) { PH_CTX phase_gather(c, l); }
        PH_END;
        if (PH_ON) { PH_CTX
            pg8::Gemm g{(const pg8::bf16_t*)(c.ws + WS_RA + RA_XS), (const pg8::bf16_t*)(c.ws + WS_W13), NEXP * EROWS, NEXP * 2048, D};
            SchedMoe S{c.G, c.bid, last ? 8 : 9, NEXP * (last ? 8 : 9) * 8};
            EpiHid E{(bf16_t*)(c.ws + WS_RA + RA_HID)};
            pg8::gemm_phase<EpiHid, SchedMoe, false>((PG8_LAS unsigned char*)c.lds, g, S, E, nullptr, c.tid);
        }
        PH_END;
        if (PH_ON) { PH_CTX
            pg8::Gemm g{(const pg8::bf16_t*)(c.ws + WS_RA + RA_HID), (const pg8::bf16_t*)(c.ws + WS_W2), NEXP * EROWS, NEXP * 2048, 1024};
            SchedMoe S{c.G, c.bid, last ? 8 : 9, NEXP * (last ? 8 : 9) * 8};
            EpiY E{(bf16_t*)(c.ws + WS_RA + RA_YS), (const float*)(c.ws + WS_GATE)};
            pg8::gemm_phase<EpiY, SchedMoe, false>((PG8_LAS unsigned char*)c.lds, g, S, E, nullptr, c.tid);
        }
        PH_END;
        if (PH_ON) { PH_CTX phase_final(c, l); if (!last) convert_phase(c, l + 1); }
        PH_END;
    }
}

#ifdef MK_STOP
__global__ void digest_k(const unsigned* w0, size_t n0, const unsigned* w1, size_t n1, float* out, size_t nout) {
    for (size_t i = (size_t)blockIdx.x * blockDim.x + threadIdx.x; i < nout; i += (size_t)gridDim.x * blockDim.x) {
        unsigned h = 0u;
        for (size_t j = i; j < n0 + n1; j += nout) {
#ifdef MK_RW0
            const size_t rw = j < n0 ? (size_t)(MK_RW0) : (size_t)(MK_RW1); const size_t row = (j < n0 ? j : j - n0) / rw;
            if (row % 4352 < 256) continue;
#endif
#ifdef MK_NANCOUNT
            { const unsigned wv = (j < n0 ? w0[j] : w1[j - n0]);
#ifdef MK_BF16
              if ((wv & 0x7F800000u) == 0x7F800000u || (wv & 0x7F80u) == 0x7F80u) h += 1u; }
#else
              if ((wv & 0x7F800000u) == 0x7F800000u) h += 1u; }
#endif
#else
            h = h * 31u + (j < n0 ? w0[j] : w1[j - n0]);
#endif
        }
#ifdef MK_NANCOUNT
        out[i] = 1000.f * (float)h;
#else
        out[i] = (float)(h & 0xFFFFFu);
#endif
    }
}
#endif
extern "C" void kernel_launch(void* const* d_in, const int* in_sizes, int n_in, void* d_out, int out_size, void* d_ws, size_t ws_size, hipStream_t stream) {
    static int grid = 0;
    if (grid == 0) {
        if (n_in != 24 || ws_size < mk::WS_TOTAL) { fprintf(stderr, "kernel_launch: n_in %d ws %zu (need %zu)\n", n_in, ws_size, (size_t)mk::WS_TOTAL); grid = -1; return; }
        int dev = 0, cus = 0, per_cu = 0;
        if (hipGetDevice(&dev) != hipSuccess || hipDeviceGetAttribute(&cus, hipDeviceAttributeMultiprocessorCount, dev) != hipSuccess) { grid = -1; return; }
        if (hipFuncSetAttribute((const void*)mega_fwd, hipFuncAttributeMaxDynamicSharedMemorySize, LDS_BYTES) != hipSuccess) { fprintf(stderr, "kernel_launch: hipFuncSetAttribute failed\n"); grid = -1; return; }
        if (hipOccupancyMaxActiveBlocksPerMultiprocessor(&per_cu, (const void*)mega_fwd, 512, LDS_BYTES) != hipSuccess || per_cu < 1) fprintf(stderr, "kernel_launch: occupancy query says %d\n", per_cu);
        (void)hipGetLastError();
        grid = cus;
    }
    if (grid < 0) return;
    (void)hipMemsetAsync((char*)d_ws + mk::WS_BAR, 0, 16384, stream);
    Args a{};
    for (int i = 0; i < 24; ++i) a.in[i] = (const float*)d_in[i];
    a.out = (float*)d_out; a.ws = (unsigned char*)d_ws;
#if MK_N_LAUNCHES == 1
    a.ph_lo = 0; a.ph_hi = N_PHASES;
    hipLaunchKernelGGL(mega_fwd, dim3(grid), dim3(512), LDS_BYTES, stream, a);
#else
#ifdef MK_STOP
    for (int p = 0; p < MK_STOP; ++p) { a.ph_lo = p; a.ph_hi = p + 1; hipLaunchKernelGGL(mega_fwd, dim3(grid), dim3(512), LDS_BYTES, stream, a); }
    hipLaunchKernelGGL(digest_k, dim3(2048), dim3(256), 0, stream, (const unsigned*)((char*)d_ws + (size_t)(MK_D0)), (size_t)(MK_N0) / 4, (const unsigned*)((char*)d_ws + (size_t)(MK_D1)), (size_t)(MK_N1) / 4, (float*)d_out, (size_t)out_size);
#else
    for (int p = 0; p < N_PHASES; ++p) { a.ph_lo = p; a.ph_hi = p + 1; hipLaunchKernelGGL(mega_fwd, dim3(grid), dim3(512), LDS_BYTES, stream, a); }
#endif
#endif
}
```

```cpp
#include <hip/hip_runtime.h>
#include <cstdio>
#include <cstdint>
#ifndef MK_N_LAUNCHES
#define MK_N_LAUNCHES 1
#endif
namespace pg8 {
#define PG8_LAS __attribute__((address_space(3)))
typedef unsigned short bf16_t;
typedef short bf16x8 __attribute__((ext_vector_type(8)));
typedef float f32x4 __attribute__((ext_vector_type(4)));
typedef unsigned u32x4 __attribute__((ext_vector_type(4)));
constexpr int BM = 256, BK = 64, HALF = 128, HTB = HALF * BK * 2  , STAGE_BYTES = 8 * HTB, NXCD = 8, WGM = 8;

__host__ __device__ __forceinline__ int lds_byte(int r, int c) { const int st = (r >> 4) * 2 + (c >> 5), rr = r & 15, cc = c & 31, ob = rr * 64 + cc * 2; return st * 1024 + (ob ^ (((ob >> 9) & 1) << 5)); }
__host__ __device__ __forceinline__ void stage_rc(int b, int& R, int& C) { const int st = b / 1024, sb = b % 1024, swz = sb ^ (((sb >> 9) & 1) << 5); R = (st >> 1) * 16 + swz / 64; C = (st & 1) * 32 + (swz % 64) / 2; }
__host__ __device__ __forceinline__ int perm32(int rho) { const int n = rho >> 4, i = rho & 15; return 8 * (i >> 2) + 4 * n + (i & 3); }

struct Unit { int pm, pn; };
struct Gemm { const bf16_t* A; const bf16_t* Bt; int M, N, K; };

struct StaticOrder {
    int nM, nN, nwg, G, c;
    __host__ __device__ void init(int M, int N, int G_, int c_) { nM = M / BM; nN = N / BM; nwg = nM * nN; G = G_; c = c_; }
    __host__ __device__ bool next(int i, Unit& u) const {
        const long L = (long)i * G + c; if (L >= nwg) return false;
        int wgid = (int)L; { const int q = nwg / NXCD, r = nwg % NXCD, xcd = wgid % NXCD, off = wgid / NXCD; wgid = (xcd < r ? xcd * (q + 1) : r * (q + 1) + (xcd - r) * q) + off; }
        const int nig = WGM * nN, gid = wgid / nig, fm = gid * WGM, gsz = (nM - fm) < WGM ? (nM - fm) : WGM;
        u.pm = fm + ((wgid % nig) % gsz); u.pn = (wgid % nig) / gsz; return true;
    }
    __device__ __forceinline__ void a_ready(const Unit&) const {}
    __device__ __forceinline__ void done(const Unit&) const {}
};
struct CountedOrder : StaticOrder {
    const unsigned* ready; unsigned need; unsigned* tmo;
    __device__ __forceinline__ void a_ready(const Unit& u) const {
        if (threadIdx.x < 64) {
            const unsigned long long t0 = __builtin_amdgcn_s_memrealtime(); unsigned polls = 0;
            while ((unsigned)__builtin_amdgcn_readfirstlane(__hip_atomic_load(ready + 64 * u.pm, __ATOMIC_RELAXED, __HIP_MEMORY_SCOPE_AGENT)) < need) {
                if ((++polls & 255u) == 0u && __builtin_amdgcn_readfirstlane(__hip_atomic_load(tmo, __ATOMIC_RELAXED, __HIP_MEMORY_SCOPE_AGENT)) != 0u) break;
                if (__builtin_amdgcn_s_memrealtime() - t0 > 2000000ull) {
                    if (threadIdx.x == 0) { unsigned expect = 0u; __hip_atomic_compare_exchange_strong(tmo + 1, &expect, 0x600u | (unsigned)(u.pm & 0xff), __ATOMIC_RELAXED, __ATOMIC_RELAXED, __HIP_MEMORY_SCOPE_AGENT); __hip_atomic_store(tmo, 1u, __ATOMIC_RELAXED, __HIP_MEMORY_SCOPE_AGENT); }
                    break; }
                __builtin_amdgcn_s_sleep(2); }
            __builtin_amdgcn_fence(__ATOMIC_ACQUIRE, "agent");
            asm volatile("s_waitcnt vmcnt(0)" ::: "memory");
        }
#if !defined(BROKEN_HOOK_NO_BARRIER)
        asm volatile("" ::: "memory"); __builtin_amdgcn_s_barrier(); asm volatile("" ::: "memory");
#endif
    }
};

typedef float f32x2_cv __attribute__((ext_vector_type(2)));
typedef __bf16 bf16x2_cv __attribute__((ext_vector_type(2)));
__device__ __forceinline__ unsigned cvt_pk_bf16(float lo, float hi) { const bf16x2_cv v = __builtin_convertvector((f32x2_cv){lo, hi}, bf16x2_cv); return __builtin_bit_cast(unsigned, v); }
typedef float f32x2 __attribute__((ext_vector_type(2)));
__device__ __forceinline__ f32x2 gelu_pk(f32x2 v) {
    const f32x2 av = __builtin_elementwise_abs(v), d = av * 0.2316418882f + 1.0f;
    f32x2 t; t.x = __builtin_amdgcn_rcpf(d.x); t.y = __builtin_amdgcn_rcpf(d.y);
    f32x2 q = t * 0.5307027145f + (-0.7265760135f); q = q * t + 0.7107068705f; q = q * t + (-0.142248368f); q = q * t + 0.127414796f; q = q * t;
    const f32x2 s = (v * v) * (-0.72134752044f);
    f32x2 e; e.x = __builtin_amdgcn_exp2f(s.x); e.y = __builtin_amdgcn_exp2f(s.y);
    const f32x2 m = v * (q * e), r = v - m;
    f32x2 o; o.x = v.x < 0.f ? m.x : r.x; o.y = v.y < 0.f ? m.y : r.y; return o;
}

struct EpiF32 {
    static constexpr bool PERM = false, AFTER_DRAIN = false;
    float* C; int ldc; const float* bias;
    __device__ __forceinline__ void operator()(const f32x4 (&acc)[2][2][4][2], const Unit& u, int wr, int wc, int fr, int fq) const {
        const int row0 = u.pm * BM + wr * 64 + fr, col0 = u.pn * BM + wc * 32 + 4 * fq;
        f32x4 bv[2][2];
#pragma unroll
        for (int bj = 0; bj < 2; ++bj)
#pragma unroll
            for (int n = 0; n < 2; ++n) bv[bj][n] = bias ? *(const f32x4*)(bias + col0 + bj * HALF + n * 16) : (f32x4){0.f, 0.f, 0.f, 0.f};
#pragma unroll
        for (int ai = 0; ai < 2; ++ai)
#pragma unroll
            for (int m = 0; m < 4; ++m) { float* rowp = C + (size_t)(row0 + ai * HALF + m * 16) * ldc + col0;
#pragma unroll
                for (int bj = 0; bj < 2; ++bj)
#pragma unroll
                    for (int n = 0; n < 2; ++n) *(f32x4*)(rowp + bj * HALF + n * 16) = acc[ai][bj][m][n] + bv[bj][n]; }
    }
};
template <int ACT  > struct EpiBf16 {
    static constexpr bool PERM = true, AFTER_DRAIN = false;
    bf16_t* O; int ldc; const float* bias; int split_cols; size_t split_stride;
    __device__ __forceinline__ void operator()(const f32x4 (&acc)[2][2][4][2], const Unit& u, int wr, int wc, int fr, int fq) const {
        const int row0 = u.pm * BM + wr * 64 + fr; int colt = u.pn * BM; bf16_t* base = O;
        if (split_cols) { const int t = colt / split_cols; base += (size_t)t * split_stride; colt -= t * split_cols; }
        const int col0 = colt + wc * 32 + 8 * fq, bcol0 = u.pn * BM + wc * 32 + 8 * fq;
        f32x4 bv[2][2];
#pragma unroll
        for (int bj = 0; bj < 2; ++bj)
#pragma unroll
            for (int n = 0; n < 2; ++n) bv[bj][n] = bias ? *(const f32x4*)(bias + bcol0 + bj * HALF + 4 * n) : (f32x4){0.f, 0.f, 0.f, 0.f};
#pragma unroll
        for (int ai = 0; ai < 2; ++ai)
#pragma unroll
            for (int m = 0; m < 4; ++m) { bf16_t* rowp = base + (size_t)(row0 + ai * HALF + m * 16) * ldc + col0;
#pragma unroll
                for (int bj = 0; bj < 2; ++bj) { f32x4 v0 = acc[ai][bj][m][0] + bv[bj][0], v1 = acc[ai][bj][m][1] + bv[bj][1];
                    if (ACT == 1) { f32x2 a = gelu_pk((f32x2){v0[0], v0[1]}), b = gelu_pk((f32x2){v0[2], v0[3]}), c = gelu_pk((f32x2){v1[0], v1[1]}), d = gelu_pk((f32x2){v1[2], v1[3]});
                        v0 = (f32x4){a.x, a.y, b.x, b.y}; v1 = (f32x4){c.x, c.y, d.x, d.y}; }
                    if (ACT == 2) {
#pragma unroll
                        for (int j = 0; j < 4; ++j) { v0[j] = 0.5f * v0[j] * (1.0f + erff(v0[j] * 0.70710678f)); v1[j] = 0.5f * v1[j] * (1.0f + erff(v1[j] * 0.70710678f)); } }
                    u32x4 w; w.x = cvt_pk_bf16(v0[0], v0[1]); w.y = cvt_pk_bf16(v0[2], v0[3]); w.z = cvt_pk_bf16(v1[0], v1[1]); w.w = cvt_pk_bf16(v1[2], v1[3]);
                    *(u32x4*)(rowp + bj * HALF) = w; } }
    }
};

struct PanelStats {
    unsigned* xbuf;
    unsigned* cnt;
    unsigned* tmo;
    int ntn; float eps;
    unsigned code;
    __device__ __forceinline__ bool run(const f32x4 (&v)[2][2][4][2], const Unit& u, int wr, int wc, int fr, int fq, PG8_LAS unsigned char* lds, int wid, int lane) const {
        typedef float f32x2v __attribute__((ext_vector_type(2)));
        PG8_LAS f32x2v* P = (PG8_LAS f32x2v*)lds;
        PG8_LAS f32x2v* S = (PG8_LAS f32x2v*)(lds + 8192);
        PG8_LAS unsigned* flag = (PG8_LAS unsigned*)(lds + 8192 + 2048);
#pragma unroll
        for (int ai = 0; ai < 2; ++ai)
#pragma unroll
            for (int m = 0; m < 4; ++m) {
                float s = 0.f;
#pragma unroll
                for (int bj = 0; bj < 2; ++bj)
#pragma unroll
                    for (int n = 0; n < 2; ++n) { const f32x4 x = v[ai][bj][m][n]; s += (x[0] + x[1]) + (x[2] + x[3]); }
                s += __shfl_xor(s, 16); s += __shfl_xor(s, 32);
                const float mw = s * (1.0f / 64.0f); float q = 0.f;
#pragma unroll
                for (int bj = 0; bj < 2; ++bj)
#pragma unroll
                    for (int n = 0; n < 2; ++n) { const f32x4 d = v[ai][bj][m][n] - mw; q += (d[0] * d[0] + d[1] * d[1]) + (d[2] * d[2] + d[3] * d[3]); }
                q += __shfl_xor(q, 16); q += __shfl_xor(q, 32);
                if (fq == 0) P[(ai * HALF + wr * 64 + m * 16 + fr) * 4 + wc] = (f32x2v){mw, q};
            }
        asm volatile("s_waitcnt lgkmcnt(0)" ::: "memory"); __builtin_amdgcn_s_barrier(); asm volatile("" ::: "memory");
#if defined(BROKEN_NO_WAIT)
        if (blockIdx.x >= 64) { const long long t0 = clock64(); while (clock64() - t0 < 60000) __builtin_amdgcn_s_sleep(8); }
#endif
        const int row = wid * 32 + (lane & 31);
        if (lane < 32) {
            const f32x2v a = P[row * 4 + 0], b = P[row * 4 + 1], c = P[row * 4 + 2], d = P[row * 4 + 3];
            const float mt = (a.x + b.x + c.x + d.x) * 0.25f;
            const float da = a.x - mt, db = b.x - mt, dc = c.x - mt, dd = d.x - mt;
            const float m2 = (a.y + b.y) + (c.y + d.y) + 64.0f * ((da * da + db * db) + (dc * dc + dd * dd));
            unsigned long long* slot = (unsigned long long*)xbuf + ((size_t)(u.pm * BM + row) * 4 + u.pn);
            __hip_atomic_store(slot, ((unsigned long long)__float_as_uint(m2) << 32) | __float_as_uint(mt), __ATOMIC_RELAXED, __HIP_MEMORY_SCOPE_AGENT);
        }
        asm volatile("s_waitcnt vmcnt(0)" ::: "memory");
        if (lane == 0) __hip_atomic_fetch_add(cnt + 64 * u.pm, 1u, __ATOMIC_RELAXED, __HIP_MEMORY_SCOPE_AGENT);
        if (wid == 0) {
            bool dead = false; const unsigned long long t0 = __builtin_amdgcn_s_memrealtime(); const unsigned want = 8u * (unsigned)ntn;
            for (;;) {
#if defined(BROKEN_NO_WAIT)
                break;
#endif
                if ((unsigned)__builtin_amdgcn_readfirstlane(__hip_atomic_load(cnt + 64 * u.pm, __ATOMIC_RELAXED, __HIP_MEMORY_SCOPE_AGENT)) >= want) break;
                if (__builtin_amdgcn_s_memrealtime() - t0 > 2000000ull) {
                    if (lane == 0) { unsigned expect = 0u; __hip_atomic_compare_exchange_strong(tmo + 1, &expect, code | (unsigned)(u.pm & 0xff), __ATOMIC_RELAXED, __ATOMIC_RELAXED, __HIP_MEMORY_SCOPE_AGENT);
                                     __hip_atomic_store(tmo, 1u, __ATOMIC_RELAXED, __HIP_MEMORY_SCOPE_AGENT); }
                    dead = true; break; }
                __builtin_amdgcn_s_sleep(2);
            }
            __builtin_amdgcn_fence(__ATOMIC_ACQUIRE, "agent");
            if (lane == 0) flag[0] = dead ? 1u : 0u;
        }
        asm volatile("s_waitcnt vmcnt(0) lgkmcnt(0)" ::: "memory"); __builtin_amdgcn_s_barrier(); asm volatile("" ::: "memory");
        const bool bad = flag[0] != 0u;
        if (lane < 32) {
            const unsigned long long* slot = (const unsigned long long*)xbuf + (size_t)(u.pm * BM + row) * 4; float mt[4], m2[4]; float ms = 0.f;
#pragma unroll
            for (int t = 0; t < 4; ++t) { if (t < ntn) { const unsigned long long w = __hip_atomic_load(slot + t, __ATOMIC_RELAXED, __HIP_MEMORY_SCOPE_AGENT); mt[t] = __uint_as_float((unsigned)w); m2[t] = __uint_as_float((unsigned)(w >> 32)); } else { mt[t] = 0.f; m2[t] = 0.f; } ms += mt[t]; }
            const float mean = ms / (float)ntn; float q = 0.f;
#pragma unroll
            for (int t = 0; t < 4; ++t) if (t < ntn) { const float dm = mt[t] - mean; q += m2[t] + 256.0f * dm * dm; }
            S[row] = (f32x2v){mean, 1.0f / sqrtf(q / (256.0f * (float)ntn) + eps)};
        }
        asm volatile("s_waitcnt lgkmcnt(0)" ::: "memory"); __builtin_amdgcn_s_barrier(); asm volatile("" ::: "memory");
        return bad;
    }
};
struct EpiLnRes {
    static constexpr bool PERM = false, AFTER_DRAIN = true;
    const float* base; float* out; int ldc; const float* bias; PanelStats st; unsigned poison;
    __device__ __forceinline__ void refuse(size_t i0, size_t stride, int M, int N) const { const float q = __builtin_nanf(""); for (size_t i = i0; i < (size_t)M * N; i += stride) out[(i / N) * ldc + i % N] = q;
        if (i0 == 0) { unsigned expect = 0u; __hip_atomic_compare_exchange_strong(st.tmo + 1, &expect, 0x7f0u, __ATOMIC_RELAXED, __ATOMIC_RELAXED, __HIP_MEMORY_SCOPE_AGENT); __hip_atomic_store(st.tmo, 1u, __ATOMIC_RELAXED, __HIP_MEMORY_SCOPE_AGENT); } }
    __device__ __forceinline__ void fused(f32x4 (&acc)[2][2][4][2], const Unit& u, int wr, int wc, int fr, int fq, PG8_LAS unsigned char* lds, int wid, int lane) const {
        typedef float f32x2v __attribute__((ext_vector_type(2)));
        const PG8_LAS f32x2v* S = (const PG8_LAS f32x2v*)(lds + 8192);
        const int col0 = u.pn * BM + wc * 32 + 4 * fq;
#pragma unroll
        for (int bj = 0; bj < 2; ++bj)
#pragma unroll
            for (int n = 0; n < 2; ++n) { const f32x4 bv = bias ? *(const f32x4*)(bias + col0 + bj * HALF + n * 16) : (f32x4){0.f, 0.f, 0.f, 0.f};
#pragma unroll
                for (int ai = 0; ai < 2; ++ai)
#pragma unroll
                    for (int m = 0; m < 4; ++m) acc[ai][bj][m][n] += bv; }
        const bool bad = st.run(acc, u, wr, wc, fr, fq, lds, wid, lane) || poison != 0u;
        const float qnan = __builtin_nanf("");
#pragma unroll
        for (int ai = 0; ai < 2; ++ai)
#pragma unroll
            for (int m = 0; m < 4; ++m) { const int r = ai * HALF + wr * 64 + m * 16 + fr; const f32x2v sr = S[r]; const size_t off = (size_t)(u.pm * BM + r) * ldc + col0;
#pragma unroll
                for (int bj = 0; bj < 2; ++bj)
#pragma unroll
                    for (int n = 0; n < 2; ++n) { const f32x4 bs = *(const f32x4*)(base + off + bj * HALF + n * 16); f32x4 o = bs + (acc[ai][bj][m][n] - sr.x) * sr.y;
                        if (bad) o = (f32x4){qnan, qnan, qnan, qnan}; *(f32x4*)(out + off + bj * HALF + n * 16) = o; }
                asm volatile("" ::: "memory"); }
    }
};
struct EpiLnResLn {
    static constexpr bool PERM = false, AFTER_DRAIN = true;
    const float* base; float* out; bf16_t* xn; int ldc; const float* bias; PanelStats st1, st2; unsigned poison;
    __device__ __forceinline__ void refuse(size_t i0, size_t stride, int M, int N) const { const float q = __builtin_nanf(""); for (size_t i = i0; i < (size_t)M * N; i += stride) { const size_t o = (i / N) * ldc + i % N; out[o] = q; xn[o] = (bf16_t)0x7fc0u; }
        if (i0 == 0) { unsigned expect = 0u; __hip_atomic_compare_exchange_strong(st1.tmo + 1, &expect, 0x7f0u, __ATOMIC_RELAXED, __ATOMIC_RELAXED, __HIP_MEMORY_SCOPE_AGENT); __hip_atomic_store(st1.tmo, 1u, __ATOMIC_RELAXED, __HIP_MEMORY_SCOPE_AGENT); } }
    __device__ __forceinline__ void fused(f32x4 (&acc)[2][2][4][2], const Unit& u, int wr, int wc, int fr, int fq, PG8_LAS unsigned char* lds, int wid, int lane) const {
        typedef float f32x2v __attribute__((ext_vector_type(2))); typedef unsigned u32x2v __attribute__((ext_vector_type(2)));
        const PG8_LAS f32x2v* S = (const PG8_LAS f32x2v*)(lds + 8192);
        const int col0 = u.pn * BM + wc * 32 + 4 * fq;
#pragma unroll
        for (int bj = 0; bj < 2; ++bj)
#pragma unroll
            for (int n = 0; n < 2; ++n) { const f32x4 bv = bias ? *(const f32x4*)(bias + col0 + bj * HALF + n * 16) : (f32x4){0.f, 0.f, 0.f, 0.f};
#pragma unroll
                for (int ai = 0; ai < 2; ++ai)
#pragma unroll
                    for (int m = 0; m < 4; ++m) acc[ai][bj][m][n] += bv; }
        bool bad = st1.run(acc, u, wr, wc, fr, fq, lds, wid, lane) || poison != 0u;
        const float qnan = __builtin_nanf("");
#pragma unroll
        for (int ai = 0; ai < 2; ++ai)
#pragma unroll
            for (int m = 0; m < 4; ++m) { const int r = ai * HALF + wr * 64 + m * 16 + fr; const f32x2v sr = S[r]; const size_t off = (size_t)(u.pm * BM + r) * ldc + col0;
#pragma unroll
                for (int bj = 0; bj < 2; ++bj)
#pragma unroll
                    for (int n = 0; n < 2; ++n) { const f32x4 bs = *(const f32x4*)(base + off + bj * HALF + n * 16); acc[ai][bj][m][n] = bs + (acc[ai][bj][m][n] - sr.x) * sr.y; }
                asm volatile("" : "+v"(acc[ai][0][m][0]), "+v"(acc[ai][0][m][1]), "+v"(acc[ai][1][m][0]), "+v"(acc[ai][1][m][1]));
                if (m & 1) asm volatile("" ::: "memory"); }
        const bool bad1 = bad;
        bad = st2.run(acc, u, wr, wc, fr, fq, lds, wid, lane) || bad;
#pragma unroll
        for (int ai = 0; ai < 2; ++ai)
#pragma unroll
            for (int m = 0; m < 4; ++m) { const int r = ai * HALF + wr * 64 + m * 16 + fr; const f32x2v sr = S[r]; const size_t off = (size_t)(u.pm * BM + r) * ldc + col0;
#pragma unroll
                for (int bj = 0; bj < 2; ++bj)
#pragma unroll
                    for (int n = 0; n < 2; ++n) { const f32x4 x1 = acc[ai][bj][m][n]; *(f32x4*)(out + off + bj * HALF + n * 16) = bad1 ? (f32x4){qnan, qnan, qnan, qnan} : x1;
                        const f32x4 o = (x1 - sr.x) * sr.y; u32x2v w; w.x = cvt_pk_bf16(o[0], o[1]); w.y = cvt_pk_bf16(o[2], o[3]);
                        if (bad) { w.x = 0x7fc07fc0u; w.y = 0x7fc07fc0u; } *(u32x2v*)(xn + off + bj * HALF + n * 16) = w; }
                asm volatile("" ::: "memory"); }
    }
};

template <class Epi, class Sched, bool STAMP = false>
__device__ __forceinline__ void gemm_phase(PG8_LAS unsigned char* lds, const Gemm g, const Sched& S, const Epi& E, unsigned long long* stamps, int tid_in) {
    int tid_ = tid_in; asm volatile("" : "+v"(tid_));
    const int tid = tid_, wid = __builtin_amdgcn_readfirstlane(tid >> 6), lane = tid & 63, wr = wid >> 2, wc = wid & 3, fr = lane & 15, fq = lane >> 4;
    const int K = g.K, nt = K / BK;
    int ts_lo = 0, ts_hi = 0, nts = 0; const unsigned long long rt_entry = STAMP ? (unsigned long long)wall_clock64() : 0ull;
#define PG8_STAMP() do { if (STAMP && wid == 0 && nts < 64) { const unsigned long long _c = (unsigned long long)clock64(); \
        ts_lo = (lane == nts) ? (int)(unsigned)_c : ts_lo; ts_hi = (lane == nts) ? (int)(unsigned)(_c >> 32) : ts_hi; ++nts; } } while (0)
    PG8_STAMP();
    unsigned voffA[2], voffB[2];
#pragma unroll
    for (int i = 0; i < 2; ++i) { int R, C; stage_rc(tid * 16 + i * 8192, R, C); const int Rb = Epi::PERM ? ((R & ~31) + perm32(R & 31)) : R;
        voffA[i] = (unsigned)(R * K + C) * 2u; voffB[i] = (unsigned)(Rb * K + C) * 2u; }
    const size_t kstep = (size_t)(BK * 2);
    const size_t hstep = (size_t)HALF * K * 2;
    const size_t tstep = 2 * hstep;
    const unsigned ldsw = (unsigned)wid * 1024u;
    const int aoff = lds_byte(wr * 64 + fr, fq * 8), boff = lds_byte(wc * 32 + fr, fq * 8);
#define PG8_SA(b, h) (((b) * 2 + (h)) * HTB)
#define PG8_SB(b, h) ((4 + (b) * 2 + (h)) * HTB)
#define PG8_STAGE(bufoff, gbase, voff) do { _Pragma("unroll") for (int _i = 0; _i < 2; ++_i) \
        __builtin_amdgcn_global_load_lds((const unsigned*)((const char*)(gbase) + (voff)[_i]), (PG8_LAS unsigned*)(lds + (bufoff) + ldsw + _i * 8192), 16, 0, 0); } while (0)
#define PG8_LDA(dst, b, h) do { _Pragma("unroll") for (int m = 0; m < 4; ++m) _Pragma("unroll") for (int k = 0; k < 2; ++k) dst[m][k] = *(const PG8_LAS bf16x8*)(lds + PG8_SA(b, h) + aoff + m * 2048 + k * 1024); } while (0)
#define PG8_LDB(dst, b, h) do { _Pragma("unroll") for (int n = 0; n < 2; ++n) _Pragma("unroll") for (int k = 0; k < 2; ++k) dst[n][k] = *(const PG8_LAS bf16x8*)(lds + PG8_SB(b, h) + boff + n * 2048 + k * 1024); } while (0)
#define PG8_MMA(ai, bj, At, Bt) do { __builtin_amdgcn_s_setprio(1); _Pragma("unroll") for (int m = 0; m < 4; ++m) _Pragma("unroll") for (int n = 0; n < 2; ++n) _Pragma("unroll") for (int k = 0; k < 2; ++k) \
        acc[ai][bj][m][n] = __builtin_amdgcn_mfma_f32_16x16x32_bf16(Bt[n][k], At[m][k], acc[ai][bj][m][n], 0, 0, 0); __builtin_amdgcn_s_setprio(0); } while (0)
#define PG8_WAIT_V(n) asm volatile("s_waitcnt vmcnt(" #n ")" ::: "memory")
#define PG8_WAIT_L(n) asm volatile("s_waitcnt lgkmcnt(" #n ")" ::: "memory")
#define PG8_BAR __builtin_amdgcn_s_barrier()
#define PG8_SCHED __builtin_amdgcn_sched_barrier(0)
    Unit cur, nxt; int ui = 0;
    if (!S.next(0, cur)) return;
    f32x4 acc[2][2][4][2];
#pragma unroll
    for (int a = 0; a < 2; ++a)
#pragma unroll
        for (int b = 0; b < 2; ++b)
#pragma unroll
            for (int m = 0; m < 4; ++m)
#pragma unroll
                for (int n = 0; n < 2; ++n) acc[a][b][m][n] = (f32x4){0.f, 0.f, 0.f, 0.f};
    bf16x8 At[4][2], B0[2][2], B1[2][2];
    const char* cA = (const char*)g.A + (size_t)cur.pm * tstep; const char* cB = (const char*)g.Bt + (size_t)cur.pn * tstep;
    S.a_ready(cur);
    PG8_STAGE(PG8_SB(0, 0), cB, voffB); PG8_STAGE(PG8_SA(0, 0), cA, voffA); PG8_STAGE(PG8_SB(0, 1), cB + hstep, voffB); PG8_STAGE(PG8_SA(0, 1), cA + hstep, voffA);
    if (wr == 1) PG8_BAR;
    PG8_WAIT_V(4); PG8_BAR;
    PG8_STAGE(PG8_SB(1, 0), cB + kstep, voffB); PG8_STAGE(PG8_SA(1, 0), cA + kstep, voffA); PG8_STAGE(PG8_SB(1, 1), cB + hstep + kstep, voffB);
    PG8_WAIT_V(6); PG8_BAR;
    PG8_STAMP();
    for (;;) {
        const bool has_next = S.next(ui + 1, nxt);
        const char* nA = has_next ? (const char*)g.A + (size_t)nxt.pm * tstep : cA; const char* nB = has_next ? (const char*)g.Bt + (size_t)nxt.pn * tstep : cB;
        for (int t = 0; t < nt; t += 2) {
            const bool last = (t == nt - 2);
            const char* a1 = cA + (size_t)(t + 1) * kstep;
            const char* a2 = last ? nA : cA + (size_t)(t + 2) * kstep; const char* b2 = last ? nB : cB + (size_t)(t + 2) * kstep;
            const char* a3 = a2 + kstep; const char* b3 = b2 + kstep;
            if (last && has_next) S.a_ready(nxt);
            PG8_LDB(B0, 0, 0); PG8_SCHED; PG8_LDA(At, 0, 0); PG8_STAGE(PG8_SA(1, 1), a1 + hstep, voffA);
            PG8_WAIT_L(8); PG8_BAR; PG8_WAIT_L(0); PG8_MMA(0, 0, At, B0); PG8_BAR; PG8_SCHED;
            PG8_LDB(B1, 0, 1); PG8_STAGE(PG8_SB(0, 0), b2, voffB);
            PG8_BAR; PG8_WAIT_L(0); PG8_MMA(0, 1, At, B1); PG8_BAR;
            PG8_LDA(At, 0, 1); PG8_STAGE(PG8_SA(0, 0), a2, voffA);
            PG8_BAR; PG8_WAIT_L(0); PG8_MMA(1, 0, At, B0); PG8_BAR; PG8_SCHED;
            PG8_STAGE(PG8_SB(0, 1), b2 + hstep, voffB);
            PG8_WAIT_V(6); PG8_BAR; PG8_MMA(1, 1, At, B1); PG8_BAR;
            PG8_LDB(B0, 1, 0); PG8_SCHED; PG8_LDA(At, 1, 0); PG8_STAGE(PG8_SA(0, 1), a2 + hstep, voffA);
            PG8_WAIT_L(8); PG8_BAR; PG8_WAIT_L(0); PG8_MMA(0, 0, At, B0); PG8_BAR; PG8_SCHED;
            PG8_LDB(B1, 1, 1); PG8_STAGE(PG8_SB(1, 0), b3, voffB);
            PG8_BAR; PG8_WAIT_L(0); PG8_MMA(0, 1, At, B1); PG8_BAR;
            PG8_LDA(At, 1, 1); PG8_STAGE(PG8_SA(1, 0), a3, voffA);
            PG8_BAR; PG8_WAIT_L(0); PG8_MMA(1, 0, At, B0); PG8_BAR; PG8_SCHED;
            PG8_STAGE(PG8_SB(1, 1), b3 + hstep, voffB);
            PG8_WAIT_V(6); PG8_BAR; PG8_MMA(1, 1, At, B1); PG8_BAR;
        }
        PG8_STAMP();
        if constexpr (!Epi::AFTER_DRAIN) { E(acc, cur, wr, wc, fr, fq); S.done(cur); }
        PG8_STAMP();
        if (!has_next) break;
#pragma unroll
        for (int a = 0; a < 2; ++a)
#pragma unroll
            for (int b = 0; b < 2; ++b)
#pragma unroll
                for (int m = 0; m < 4; ++m)
#pragma unroll
                    for (int n = 0; n < 2; ++n) acc[a][b][m][n] = (f32x4){0.f, 0.f, 0.f, 0.f};
        cur = nxt; cA = nA; cB = nB; ++ui;
    }
    PG8_WAIT_V(0);
    if (wr == 0) PG8_BAR;
    PG8_BAR;
    if constexpr (Epi::AFTER_DRAIN) { E.fused(acc, cur, wr, wc, fr, fq, lds, wid, lane); S.done(cur); }
    PG8_STAMP();
    if (STAMP && wid == 0) { stamps[lane] = lane < nts ? (((unsigned long long)(unsigned)ts_hi << 32) | (unsigned)ts_lo) : 0ull;
        if (lane == 62) stamps[62] = rt_entry; if (lane == 63) stamps[63] = (unsigned long long)wall_clock64(); }
#undef PG8_STAMP
#undef PG8_SA
#undef PG8_SB
#undef PG8_STAGE
#undef PG8_LDA
#undef PG8_LDB
#undef PG8_MMA
#undef PG8_WAIT_V
#undef PG8_WAIT_L
#undef PG8_BAR
#undef PG8_SCHED
}
}
#define XB_TMO      128
#define XB_XCNT(j)  (256  + 64 * (j))
#define XB_XSUB(j)  (1280 + 64 * (j))
#define XB_XGEN(j)  (2304 + 64 * (j))
#define XB_TOP      3328
#define XB_TOPGEN   3392
#define XCD_BAR_WORDS 3456
#define XB_SPIN_CAP (1u << 18)
#define LAS __attribute__((address_space(3)))

__device__ __forceinline__ unsigned xb_ld(unsigned* p)              { return __hip_atomic_load(p, __ATOMIC_RELAXED, __HIP_MEMORY_SCOPE_AGENT); }
__device__ __forceinline__ unsigned xb_add(unsigned* p, unsigned v) { return __hip_atomic_fetch_add(p, v, __ATOMIC_RELAXED, __HIP_MEMORY_SCOPE_AGENT); }
__device__ __forceinline__ unsigned xb_xcc_id() { return (unsigned)__builtin_amdgcn_s_getreg((3 << 11) | 20) & 0xFu; }
#define XB_SPIN(cond, bar) do { unsigned _sp = 0; while (cond) { __builtin_amdgcn_s_sleep(1); \
    if ((++_sp & 255u) == 0u) { if (xb_ld(&(bar)[XB_TMO])) break; if (_sp > XB_SPIN_CAP) { atomicAdd(&(bar)[XB_TMO], 1u); break; } } } } while (0)

struct XcdBarrier {
    unsigned* bar; unsigned x;
    volatile LAS unsigned* st;
};

__device__ __forceinline__ XcdBarrier xcd_barrier_post(unsigned* bar, volatile LAS unsigned* st) {
    XcdBarrier b; b.bar = bar; b.x = xb_xcc_id(); b.st = st;
    if (threadIdx.x == 0) (void)xb_add(&bar[XB_XCNT(b.x)], 1u);
    return b;
}
__device__ __forceinline__ void xcd_barrier_complete(unsigned* bar, unsigned x, unsigned& nloc, unsigned& nx) {
    const unsigned G = gridDim.x * gridDim.y * gridDim.z;
    unsigned sum, cnt, mine, sp = 0u;
    for (;;) {
        sum = 0u; cnt = 0u; mine = 0u;
#pragma unroll
        for (unsigned j = 0; j < 16; ++j) { const unsigned c = xb_ld(&bar[XB_XCNT(j)]); sum += c; cnt += (c > 0u) ? 1u : 0u; mine = (j == x) ? c : mine; }
        if (sum == G) break;
        __builtin_amdgcn_s_sleep(1);
        if ((++sp & 255u) == 0u) { if (xb_ld(&bar[XB_TMO])) break; if (sp > XB_SPIN_CAP) { atomicAdd(&bar[XB_TMO], 1u); break; } }
    }
    nloc = mine > 0u ? mine : 1u; nx = cnt > 0u ? cnt : 1u;
}

__device__ __forceinline__ void xcd_barrier(const XcdBarrier& b) {
    asm volatile("s_waitcnt vmcnt(0)" ::: "memory");
    __syncthreads();
    if (threadIdx.x == 0) {
        unsigned* bar = b.bar;
        __builtin_amdgcn_s_waitcnt(0);
        unsigned nloc = b.st[0], nx = b.st[1];
        if (nloc == 0u) { xcd_barrier_complete(bar, b.x, nloc, nx); b.st[0] = nloc; b.st[1] = nx; }
        const unsigned old = xb_add(&bar[XB_XSUB(b.x)], 1u);
        const unsigned gen = old / nloc;
        if (old + 1u == (gen + 1u) * nloc) {
            __builtin_amdgcn_fence(__ATOMIC_RELEASE, "agent");
            asm volatile("s_waitcnt vmcnt(0)" ::: "memory");
            const unsigned og = xb_add(&bar[XB_TOP], 1u);
            const unsigned tg = og / nx;
            if (og + 1u == (tg + 1u) * nx) xb_add(&bar[XB_TOPGEN], 1u);
            else XB_SPIN(xb_ld(&bar[XB_TOPGEN]) == tg, bar);
            __builtin_amdgcn_fence(__ATOMIC_ACQUIRE, "agent");
            xb_add(&bar[XB_XGEN(b.x)], 1u);
            asm volatile("s_waitcnt vmcnt(0)" ::: "memory");
        } else {
            XB_SPIN(xb_ld(&bar[XB_XGEN(b.x)]) == gen, bar);
            __builtin_amdgcn_fence(__ATOMIC_ACQUIRE, "agent");
            asm volatile("s_waitcnt vmcnt(0)" ::: "memory");
        }
    }
    __syncthreads();
}

namespace mk {
typedef unsigned short bf16_t;
typedef short bf16x8 __attribute__((ext_vector_type(8)));
typedef float f32x4 __attribute__((ext_vector_type(4)));
typedef unsigned u32x2 __attribute__((ext_vector_type(2)));
typedef unsigned u32x4 __attribute__((ext_vector_type(4)));
#define LDSP __attribute__((address_space(3)))

constexpr int D = 2048, NB = 4, SEQ = 4096, DEPTH = 4, CTX = 256, T = CTX + SEQ, MROWS = NB * T;
constexpr int NIN = 7728, NINP = 7936, NCH = T / 64;
constexpr int C_AQ = 0, C_AK = 512, C_AV = 1024, C_AZ = 1536, C_ABETA = 2048, C_ADEC = 2056,
              C_BQ = 2064, C_BK = 2320, C_BV = 2576, C_BR = 3088, C_BCODE = 3600,
              C_CQ = 3632, C_CI = 4144, C_CG = 4656, C_CF = 5168, C_DQ = 6192, C_DK = 6704, C_DV = 7216;
constexpr int NEXP = 16, EROWS = 2304;
constexpr float ALPHA = 1.681792830507429f;
constexpr float LN_EPS = 1e-5f, NORM_EPS = 1e-6f;
constexpr int NCC = NB * 4 * 2 * NCH;

enum { I_X = 0, I_C, I_CTX, I_CCTX, I_WMOD, I_BMOD, I_WIN, I_WOUT, I_LNG, I_LNB, I_CONV, I_ALOG, I_DTB, I_GDNN, I_GLAW, I_GLAB, I_GLAN, I_HGAM, I_HGN, I_RPB, I_ROUT, I_W1, I_W3, I_W2 };

constexpr size_t WS_BAR = 0;
constexpr size_t WS_MODV = 16384;
constexpr size_t WS_AFF = WS_MODV + 983040;
constexpr size_t WS_INV = WS_AFF + 1114112;
constexpr size_t WS_IDX = WS_INV + 1114112;
constexpr size_t WS_GATE = WS_IDX + 147456;
constexpr size_t WS_WIN = WS_GATE + 147456;
constexpr size_t WS_WOUT = WS_WIN + 32505856;
constexpr size_t WS_W13 = WS_WOUT + 8388608;
constexpr size_t WS_W2 = WS_W13 + 134217728;
constexpr size_t WS_X = WS_W2 + 67108864;
constexpr size_t WS_X1 = WS_X + 142606336;
constexpr size_t WS_U = WS_X1 + 142606336;
constexpr size_t WS_MIX = WS_U + 71303168;
constexpr size_t WS_RA = WS_MIX + 71303168;
constexpr size_t RA_PROJ = 0;
constexpr size_t RA_GM = RA_PROJ + 276299776;
constexpr size_t RA_GB = RA_GM + 71303168;
constexpr size_t RA_GQ = RA_GB + 71303168;
constexpr size_t RA_GO = RA_GQ + 35651584;
constexpr size_t RA_HB = RA_GO + 35651584;
constexpr size_t RA_HQ = RA_HB + 71303168;
constexpr size_t RA_HO = RA_HQ + 35651584;
constexpr size_t RA_HA = RA_HO + 35651584;
constexpr size_t RA_LB = RA_HA + 1114112;
constexpr size_t RA_LQ = RA_LB + 35651584;
constexpr size_t RA_LO = RA_LQ + 17825792;
constexpr size_t RA_LA = RA_LO + 35651584;
constexpr size_t RA_OB = RA_LA + 557056;
constexpr size_t RA_END = RA_OB + 106954752;
constexpr size_t RA_TBUF = 0;
constexpr size_t RA_XS = 142606336;
constexpr size_t RA_HID = RA_XS + 150994944;
constexpr size_t RA_YS = RA_HID + 75497472;
constexpr size_t WS_TOTAL = WS_RA + RA_END;
static_assert(RA_YS + 150994944 <= RA_END, "region A");

struct Ctx {
    const float* in[24]; float* out; unsigned char* ws;
    LDSP unsigned char* lds; int tid, lane, wave, G, bid;
};

__device__ __forceinline__ float bf2f(unsigned b) { return __uint_as_float(b << 16); }
__device__ __forceinline__ float bflo(unsigned u) { return __uint_as_float(u << 16); }
__device__ __forceinline__ float bfhi(unsigned u) { return __uint_as_float(u & 0xffff0000u); }
__device__ __forceinline__ unsigned pk2(float lo, float hi) { return pg8::cvt_pk_bf16(lo, hi); }
__device__ __forceinline__ bf16_t f2bf(float x) { return (bf16_t)(pk2(x, 0.f) & 0xffffu); }
__device__ __forceinline__ float sigmoidf_(float x) { return 1.f / (1.f + __expf(-x)); }
__device__ __forceinline__ float siluf_(float x) { return x / (1.f + __expf(-x)); }
__device__ __forceinline__ float softplusf_(float x) { return x > 20.f ? x : log1pf(__expf(x)); }
__device__ __forceinline__ float wsum(float v) {
#pragma unroll
    for (int m = 32; m >= 1; m >>= 1) v += __shfl_xor(v, m);
    return v;
}

template <int KS>
__device__ __forceinline__ f32x4 mma_tile(const LDSP bf16_t* a, int lda, const LDSP bf16_t* b, int ldb, f32x4 acc, int lane) {
    const int r = lane & 15, q = lane >> 4;
#pragma unroll
    for (int kk = 0; kk < KS; ++kk) {
        const bf16x8 af = *(const LDSP bf16x8*)(a + r * lda + kk * 32 + q * 8);
        const bf16x8 bf = *(const LDSP bf16x8*)(b + r * ldb + kk * 32 + q * 8);
        acc = __builtin_amdgcn_mfma_f32_16x16x32_bf16(af, bf, acc, 0, 0, 0);
    }
    return acc;
}
typedef short s16x4 __attribute__((ext_vector_type(4)));
__device__ __forceinline__ bf16x8 frag_tr16(const LDSP bf16_t* base, int ld, int lane) {
    const int g = lane >> 4, i = lane & 15;
    const LDSP bf16_t* p = base + (8 * g + (i >> 2)) * ld + 4 * (i & 3);
    const s16x4 lo = __builtin_amdgcn_ds_read_tr16_b64_v4i16((LDSP s16x4*)p);
    const s16x4 hi = __builtin_amdgcn_ds_read_tr16_b64_v4i16((LDSP s16x4*)(p + 4 * ld));
    return (bf16x8){lo[0], lo[1], lo[2], lo[3], hi[0], hi[1], hi[2], hi[3]};
}
__device__ __forceinline__ u32x2 pack4(f32x4 v) { u32x2 o; o.x = pk2(v[0], v[1]); o.y = pk2(v[2], v[3]); return o; }

__device__ __forceinline__ int tok_of(int n, int dir, int i) { return n * 64 + (dir ? 63 - i : i); }

__device__ __forceinline__ void modv_fill_s(const Ctx& c) {
    LDSP float* s = (LDSP float*)c.lds;
    for (int i = c.tid; i < 5 * 2048; i += 512) {
        const int r = i >> 11, k = i & 2047;
        const float v = r < 4 ? c.in[I_C][r * 2048 + k] : c.in[I_CCTX][k];
        s[i] = siluf_(v);
    }
    __syncthreads();
}
__device__ __forceinline__ void modv_unit(const Ctx& c, int unit) {
    const int l = unit / 48, cb = unit % 48;
    LDSP float* s = (LDSP float*)c.lds;
    LDSP float* red = s + 5 * 2048;
    const float* W = c.in[I_WMOD] + (size_t)l * 2048 * 12288 + cb * 256 + c.lane * 4;
    const int k0 = c.wave * 256;
    f32x4 acc[5];
#pragma unroll
    for (int r = 0; r < 5; ++r) acc[r] = (f32x4){0.f, 0.f, 0.f, 0.f};
#pragma unroll 8
    for (int k = 0; k < 256; ++k) {
        const f32x4 w = *(const f32x4*)(W + (size_t)(k0 + k) * 12288);
#pragma unroll
        for (int r = 0; r < 5; ++r) { const float sv = s[r * 2048 + k0 + k]; acc[r] += w * sv; }
    }
#pragma unroll
    for (int r = 0; r < 5; ++r) *(LDSP f32x4*)(red + (c.wave * 5 + r) * 256 + c.lane * 4) = acc[r];
    __syncthreads();
    float* modv = (float*)(c.ws + WS_MODV);
    for (int o = c.tid; o < 5 * 256; o += 512) {
        const int r = o >> 8, col = o & 255;
        float sum = 0.f;
#pragma unroll
        for (int w = 0; w < 8; ++w) sum += red[(w * 5 + r) * 256 + col];
        modv[(size_t)(l * 5 + r) * 12288 + cb * 256 + col] = sum + c.in[I_BMOD][l * 12288 + cb * 256 + col];
    }
    __syncthreads();
}

struct CJob { const float* src; bf16_t* dst; int ldsrc, lddst, nvalid; };
constexpr int CONV_JOBS = 992 + 256 + 3 * 2048;
__device__ __forceinline__ CJob conv_desc(const Ctx& c, int l, int job) {
    CJob d;
    if (job < 992) {
        const int kt = job & 15, nt = job >> 4;
        d.src = c.in[I_WIN] + (size_t)l * 2048 * NIN + (size_t)kt * 128 * NIN + nt * 128; d.ldsrc = NIN; d.nvalid = NIN - nt * 128;
        d.dst = (bf16_t*)(c.ws + WS_WIN) + (size_t)nt * 128 * 2048 + kt * 128; d.lddst = 2048;
    } else if (job < 1248) {
        const int j = job - 992, kt = j & 15, nt = j >> 4;
        d.src = c.in[I_WOUT] + (size_t)l * 2048 * 2048 + (size_t)kt * 128 * 2048 + nt * 128; d.ldsrc = 2048; d.nvalid = 128;
        d.dst = (bf16_t*)(c.ws + WS_WOUT) + (size_t)nt * 128 * 2048 + kt * 128; d.lddst = 2048;
    } else if (job < 1248 + 4096) {
        const int j = job - 1248, which = j >> 11, jj = j & 2047, e = jj >> 7, rem = jj & 127, kt = rem & 15, nt = rem >> 4;
        d.src = c.in[which ? I_W3 : I_W1] + ((size_t)(l * 16 + e) * 2048 + (size_t)kt * 128) * 1024 + nt * 128; d.ldsrc = 1024; d.nvalid = 128;
        d.dst = (bf16_t*)(c.ws + WS_W13) + ((size_t)e * 2048 + nt * 256 + which * 128) * 2048 + kt * 128; d.lddst = 2048;
    } else {
        const int j = job - 1248 - 4096, e = j >> 7, rem = j & 127, kt = rem & 7, nt = rem >> 3;
        d.src = c.in[I_W2] + ((size_t)(l * 16 + e) * 1024 + (size_t)kt * 128) * 2048 + nt * 128; d.ldsrc = 2048; d.nvalid = 128;
        d.dst = (bf16_t*)(c.ws + WS_W2) + ((size_t)e * 2048 + nt * 128) * 1024 + kt * 128; d.lddst = 1024;
    }
    return d;
}
__device__ __forceinline__ void convert_phase(const Ctx& c, int l) {
    LDSP unsigned* Tb = (LDSP unsigned*)c.lds;
    const int n4 = c.tid & 31, kr = c.tid >> 5;
    int job = c.bid, buf = 0;
    if (job >= CONV_JOBS) return;
    CJob cur = conv_desc(c, l, job), nxt = cur;
    f32x4 v[8];
#pragma unroll
    for (int p = 0; p < 4; ++p)
#pragma unroll
        for (int hh = 0; hh < 2; ++hh) v[2 * p + hh] = (4 * n4 < cur.nvalid) ? *(const f32x4*)(cur.src + (size_t)(32 * p + 2 * kr + hh) * cur.ldsrc + 4 * n4) : (f32x4){0.f, 0.f, 0.f, 0.f};
    for (; job < CONV_JOBS; job += c.G) {
        LDSP unsigned* Tt = Tb + buf * (128 * 65);
#pragma unroll
        for (int p = 0; p < 4; ++p)
#pragma unroll
            for (int i = 0; i < 4; ++i) Tt[(4 * n4 + i) * 65 + 16 * p + kr] = pk2(v[2 * p][i], v[2 * p + 1][i]);
        const int nj = job + c.G;
        if (nj < CONV_JOBS) {
            nxt = conv_desc(c, l, nj);
#pragma unroll
            for (int p = 0; p < 4; ++p)
#pragma unroll
                for (int hh = 0; hh < 2; ++hh) v[2 * p + hh] = (4 * n4 < nxt.nvalid) ? *(const f32x4*)(nxt.src + (size_t)(32 * p + 2 * kr + hh) * nxt.ldsrc + 4 * n4) : (f32x4){0.f, 0.f, 0.f, 0.f};
        }
        __syncthreads();
#pragma unroll
        for (int q = 0; q < 4; ++q) {
            const int id = q * 512 + c.tid, n = id >> 4, kq = id & 15;
            const u32x4 o = (u32x4){Tt[n * 65 + 4 * kq], Tt[n * 65 + 4 * kq + 1], Tt[n * 65 + 4 * kq + 2], Tt[n * 65 + 4 * kq + 3]};
            *(u32x4*)(cur.dst + (size_t)n * cur.lddst + kq * 8) = o;
        }
        cur = nxt; buf ^= 1;
    }
    __syncthreads();
}

__device__ __forceinline__ void row_stats(const f32x4 (&v)[8], float& mu, float& rstd) {
    float s = 0.f;
#pragma unroll
    for (int j = 0; j < 8; ++j) s += v[j][0] + v[j][1] + v[j][2] + v[j][3];
    mu = wsum(s) * (1.f / 2048.f);
    float q = 0.f;
#pragma unroll
    for (int j = 0; j < 8; ++j) { const f32x4 d = v[j] - mu; q += d[0] * d[0] + d[1] * d[1] + d[2] * d[2] + d[3] * d[3]; }
    rstd = rsqrtf(wsum(q) * (1.f / 2048.f) + LN_EPS);
}
__device__ __forceinline__ void modulate_store(const f32x4 (&v)[8], const float* shift, const float* scale, bf16_t* urow, int lane) {
    float mu, rstd; row_stats(v, mu, rstd);
#pragma unroll
    for (int j = 0; j < 8; ++j) {
        const int col = 256 * j + 4 * lane;
        const f32x4 sh = *(const f32x4*)(shift + col), sc = *(const f32x4*)(scale + col);
        const f32x4 y = (v[j] - mu) * rstd * (sc + 1.f) + sh;
        *(u32x2*)(urow + col) = pack4(y);
    }
}
__device__ __forceinline__ void phase_l0_modulate(const Ctx& c) {
    const float* modv = (const float*)(c.ws + WS_MODV);
    float* X = (float*)(c.ws + WS_X); bf16_t* U = (bf16_t*)(c.ws + WS_U);
    for (int row = c.bid * 8 + c.wave; row < MROWS; row += c.G * 8) {
        const int b = row / T, t = row % T;
        const float* src = t < CTX ? c.in[I_CTX] + ((size_t)b * CTX + t) * D : c.in[I_X] + ((size_t)b * SEQ + (t - CTX)) * D;
        const int r = t < CTX ? 4 : b;
        f32x4 v[8];
#pragma unroll
        for (int j = 0; j < 8; ++j) v[j] = *(const f32x4*)(src + 256 * j + 4 * c.lane);
#pragma unroll
        for (int j = 0; j < 8; ++j) *(f32x4*)(X + (size_t)row * D + 256 * j + 4 * c.lane) = v[j];
        modulate_store(v, modv + (size_t)(0 * 5 + r) * 12288, modv + (size_t)(0 * 5 + r) * 12288 + 2048, U + (size_t)row * D, c.lane);
    }
}

constexpr int GP_RAW = 0;
constexpr int GP_UT = 0;
constexpr int GP_WT = 18432;
constexpr int GP_A = 36864;
constexpr int GP_AP = 65;
constexpr int GP_TB = 53504;
constexpr int GP_CW = 53312;
constexpr int GP_Q = GP_CW + 7680;
constexpr int GP_K = GP_Q + 17408;
constexpr int GP_V = GP_K + 17408;
constexpr int GP_KDT = GP_V + 17408;
constexpr int GP_P = GP_KDT + 18432;
constexpr int GP_SM = GP_P + 9216;
constexpr int GP_END = GP_SM + 1024;
static_assert(GP_END <= 160 * 1024, "gdn prep lds");

#ifdef MK_GSTAMP
#define GST(k) do { if (c.bid == 0 && tid == 0) { const unsigned long long t_ = __builtin_amdgcn_s_memrealtime(); gst[k] += t_ - gst[8]; gst[8] = t_; } } while (0)
#else
#define GST(k)
#endif
__device__ __forceinline__ void gdn_prep_unit(const Ctx& c, int l, int cc) {
    const int n = cc % NCH, dir = (cc / NCH) & 1, h = (cc / (NCH * 2)) & 3, b = cc / (NCH * 8);
    int tid_ = c.tid; asm volatile("" : "+v"(tid_));
    const int tid = tid_, lane = tid_ & 63, wave = c.wave;
    LDSP unsigned char* L = c.lds;
    LDSP bf16_t* raw = (LDSP bf16_t*)(L + GP_RAW);
    LDSP float* cw = (LDSP float*)(L + GP_CW);
    LDSP bf16_t* Qs = (LDSP bf16_t*)(L + GP_Q);
    LDSP bf16_t* Ks = (LDSP bf16_t*)(L + GP_K);
    LDSP bf16_t* Vs = (LDSP bf16_t*)(L + GP_V);
    LDSP bf16_t* KdT = (LDSP bf16_t*)(L + GP_KDT);
    LDSP bf16_t* Pm = (LDSP bf16_t*)(L + GP_P);
    LDSP bf16_t* UT = (LDSP bf16_t*)(L + GP_UT);
    LDSP bf16_t* WT = (LDSP bf16_t*)(L + GP_WT);
    LDSP float* Am = (LDSP float*)(L + GP_A);
    LDSP float* sm = (LDSP float*)(L + GP_SM);
    const bf16_t* proj = (const bf16_t*)(c.ws + WS_RA + RA_PROJ);
    const int seg0 = n < 4 ? 0 : CTX, seg1 = n < 4 ? CTX : T;
    const size_t rowb = (size_t)b * T;
#ifdef MK_GSTAMP
    volatile LDSP unsigned long long* gst = (volatile LDSP unsigned long long*)(c.lds + 147456 - 48 - 80);
    if (c.bid == 0 && tid == 0) gst[8] = __builtin_amdgcn_s_memrealtime();
#endif

    for (int ch = tid; ch < 68 * 48; ch += 512) {
        const int rr = ch / 48, c16 = ch % 48, part = c16 >> 4, d8 = c16 & 15;
        const int t = n * 64 - 2 + rr;
        u32x4 v = (u32x4){0u, 0u, 0u, 0u};
        if (t >= seg0 && t < seg1) v = *(const u32x4*)(proj + (rowb + t) * NINP + part * 512 + h * 128 + d8 * 8);
        *(LDSP u32x4*)(raw + rr * 392 + part * 128 + d8 * 8) = v;
    }
    for (int i = tid; i < 5 * 384; i += 512) {
        const int j = i / 384, cidx = i % 384, part = cidx >> 7, d = cidx & 127;
        cw[i] = c.in[I_CONV][(size_t)(l * 5 + j) * 1536 + part * 512 + h * 128 + d];
    }
    if (wave == 0) {
        const int t = tok_of(n, dir, lane);
        const bf16_t* pr = proj + (rowb + t) * NINP;
        const float beta = sigmoidf_(bf2f(pr[C_ABETA + dir * 4 + h]));
        const float la = -__expf(c.in[I_ALOG][l * 8 + dir * 4 + h]) * softplusf_(bf2f(pr[C_ADEC + dir * 4 + h]) + c.in[I_DTB][l * 8 + dir * 4 + h]);
        float g = la;
#pragma unroll
        for (int m = 1; m < 64; m <<= 1) { const float o = __shfl_up(g, m); if (lane >= m) g += o; }
        const float gend = __shfl(g, 63);
        sm[lane] = g; sm[64 + lane] = beta; sm[128 + lane] = __expf(g); sm[192 + lane] = __expf(gend - g);
    }
    __syncthreads();
    GST(0);
    {
        const int i = tid >> 3, gq = tid & 7;
        const int rc = (dir ? 63 - i : i) + 2;
#pragma unroll
        for (int part = 0; part < 3; ++part) {
            float a[16];
#pragma unroll
            for (int e = 0; e < 16; ++e) a[e] = 0.f;
#pragma unroll
            for (int j = 0; j < 5; ++j) {
                const LDSP bf16_t* rp = raw + (rc - 2 + j) * 392 + part * 128 + gq * 16;
                const LDSP float* wp = cw + j * 384 + part * 128 + gq * 16;
#pragma unroll
                for (int hf = 0; hf < 2; ++hf) {
                    const u32x4 r4 = *(const LDSP u32x4*)(rp + hf * 8);
                    const f32x4 w0 = *(const LDSP f32x4*)(wp + hf * 8), w1 = *(const LDSP f32x4*)(wp + hf * 8 + 4);
                    a[hf * 8 + 0] += bflo(r4[0]) * w0[0]; a[hf * 8 + 1] += bfhi(r4[0]) * w0[1]; a[hf * 8 + 2] += bflo(r4[1]) * w0[2]; a[hf * 8 + 3] += bfhi(r4[1]) * w0[3];
                    a[hf * 8 + 4] += bflo(r4[2]) * w1[0]; a[hf * 8 + 5] += bfhi(r4[2]) * w1[1]; a[hf * 8 + 6] += bflo(r4[3]) * w1[2]; a[hf * 8 + 7] += bfhi(r4[3]) * w1[3];
                }
            }
            float ss = 0.f;
#pragma unroll
            for (int e = 0; e < 16; ++e) { a[e] = siluf_(a[e]); ss += a[e] * a[e]; }
            float sc = 1.f;
            if (part < 2) {
#pragma unroll
                for (int m = 1; m < 8; m <<= 1) ss += __shfl_xor(ss, m);
                sc = rsqrtf(ss + NORM_EPS) * (part == 0 ? 0.08838834764831845f : 1.f);
            }
            LDSP bf16_t* dq = (part == 0 ? Qs : part == 1 ? Ks : Vs) + i * 136 + gq * 16;
            *(LDSP u32x4*)dq = (u32x4){pk2(a[0] * sc, a[1] * sc), pk2(a[2] * sc, a[3] * sc), pk2(a[4] * sc, a[5] * sc), pk2(a[6] * sc, a[7] * sc)};
            *(LDSP u32x4*)(dq + 8) = (u32x4){pk2(a[8] * sc, a[9] * sc), pk2(a[10] * sc, a[11] * sc), pk2(a[12] * sc, a[13] * sc), pk2(a[14] * sc, a[15] * sc)};
            asm volatile("" ::: "memory");
        }
    }
    __syncthreads();
    GST(1);
#pragma unroll
    for (int p = 0; p < 2; ++p) {
        const int id = p * 512 + tid, d = id & 127, i0 = (id >> 7) * 8;
        unsigned w[4];
#pragma unroll
        for (int e = 0; e < 8; e += 2) w[e >> 1] = pk2(bf2f(Ks[(i0 + e) * 136 + d]) * sm[192 + i0 + e], bf2f(Ks[(i0 + e + 1) * 136 + d]) * sm[192 + i0 + e + 1]);
        *(LDSP u32x4*)(KdT + d * 72 + i0) = (u32x4){w[0], w[1], w[2], w[3]};
    }
#pragma unroll
    for (int tt = 0; tt < 4; ++tt) {
        const int id = wave * 4 + tt, which = id >> 4, ti = (id & 15) >> 2, tj = id & 3;
        const int r = lane & 15, q4 = lane >> 4;
        if (which == 0) {
            if (tj <= ti) {
                f32x4 a = mma_tile<4>(Ks + ti * 16 * 136, 136, Ks + tj * 16 * 136, 136, (f32x4){0.f, 0.f, 0.f, 0.f}, lane);
                const int j = tj * 16 + r; const float gj = sm[j];
#pragma unroll
                for (int e = 0; e < 4; ++e) { const int i = ti * 16 + q4 * 4 + e; Am[i * GP_AP + j] = (i > j) ? sm[64 + i] * a[e] * __expf(sm[i] - gj) : 0.f; }
            }
        } else {
            f32x4 o = (f32x4){0.f, 0.f, 0.f, 0.f};
            if (tj <= ti) {
                const f32x4 a = mma_tile<4>(Ks + tj * 16 * 136, 136, Qs + ti * 16 * 136, 136, (f32x4){0.f, 0.f, 0.f, 0.f}, lane);
                const int i = ti * 16 + r; const float gi = sm[i];
#pragma unroll
                for (int e = 0; e < 4; ++e) { const int j = tj * 16 + q4 * 4 + e; o[e] = (i >= j) ? a[e] * __expf(gi - sm[j]) : 0.f; }
            }
            *(LDSP u32x2*)(Pm + (ti * 16 + r) * 72 + tj * 16 + q4 * 4) = pack4(o);
        }
    }
    __syncthreads();
    GST(2);
    {
        LDSP float* TB = (LDSP float*)(L + GP_TB);
        const int r = lane & 15, q4 = lane >> 4;
        if (wave == 0) {
            const int I = lane >> 4, cidx = lane & 15;
            float x[16];
#pragma unroll
            for (int i = 0; i < 16; ++i) {
                float v = (i == cidx) ? 1.f : 0.f;
#pragma unroll
                for (int j = 0; j < i; ++j) v -= Am[(16 * I + i) * GP_AP + 16 * I + j] * x[j];
                x[i] = v;
            }
#pragma unroll
            for (int i = 0; i < 16; ++i) TB[(I * 16 + i) * 16 + cidx] = x[i];
        }
        f32x4 acc[4][2];
        const LDSP bf16_t* src = wave < 4 ? Vs : Ks;
        const int cb = (wave & 3) * 32;
#pragma unroll
        for (int I = 0; I < 4; ++I)
#pragma unroll
            for (int t = 0; t < 2; ++t)
#pragma unroll
                for (int e = 0; e < 4; ++e) {
                    const int row = 16 * I + 4 * q4 + e;
                    acc[I][t][e] = sm[64 + row] * bf2f(src[row * 136 + cb + 16 * t + r]) * (wave < 4 ? 1.f : sm[128 + row]);
                }
        __syncthreads();
        LDSP bf16_t* dstp = wave < 4 ? UT : WT;
#pragma unroll
        for (int I = 0; I < 4; ++I) {
            f32x4 x[2] = {(f32x4){0.f, 0.f, 0.f, 0.f}, (f32x4){0.f, 0.f, 0.f, 0.f}};
#pragma unroll
            for (int s4 = 0; s4 < 4; ++s4) {
                const float a = TB[(I * 16 + r) * 16 + 4 * q4 + s4];
#pragma unroll
                for (int t = 0; t < 2; ++t) x[t] = __builtin_amdgcn_mfma_f32_16x16x4f32(a, acc[I][t][s4], x[t], 0, 0, 0);
            }
#pragma unroll
            for (int Ip = I + 1; Ip < 4; ++Ip)
#pragma unroll
                for (int s4 = 0; s4 < 4; ++s4) {
                    const float a = -Am[(16 * Ip + r) * GP_AP + 16 * I + 4 * q4 + s4];
#pragma unroll
                    for (int t = 0; t < 2; ++t) acc[Ip][t] = __builtin_amdgcn_mfma_f32_16x16x4f32(a, x[t][s4], acc[Ip][t], 0, 0, 0);
                }
#pragma unroll
            for (int t = 0; t < 2; ++t) *(LDSP u32x2*)(dstp + (cb + 16 * t + r) * 72 + 16 * I + 4 * q4) = pack4(x[t]);
        }
    }
    __syncthreads();
    GST(3);
    {
        const size_t cs = (size_t)n * 32 + cc / NCH;
        bf16_t* Mg = (bf16_t*)(c.ws + WS_RA + RA_GM) + cs * 16384;
        bf16_t* Bg = (bf16_t*)(c.ws + WS_RA + RA_GB) + cs * 16384;
        bf16_t* Qg = (bf16_t*)(c.ws + WS_RA + RA_GQ) + cs * 8192;
        bf16_t* Og = (bf16_t*)(c.ws + WS_RA + RA_GO) + cs * 8192;
        LDSP bf16_t* SB = Ks;
        const float ge = sm[128 + 63];
        const int r = lane & 15, q4 = lane >> 4;
        const f32x4 z = (f32x4){0.f, 0.f, 0.f, 0.f};
        for (int id = wave; id < 64; id += 8) {
            if (id < 32) {
                const int td = id >> 2, ti = id & 3;
                const f32x4 a = mma_tile<2>(WT + td * 16 * 72, 72, Pm + ti * 16 * 72, 72, z, lane);
                const int i = ti * 16 + r, d0 = td * 16 + q4 * 4; const float egi = sm[128 + i];
                f32x4 o;
#pragma unroll
                for (int e = 0; e < 4; ++e) o[e] = bf2f(Qs[i * 136 + d0 + e]) * egi - a[e];
                *(LDSP u32x2*)(SB + i * 136 + d0) = pack4(o);
            } else {
                const int td = (id - 32) >> 2, ti = id & 3;
                const f32x4 a = mma_tile<2>(UT + td * 16 * 72, 72, Pm + ti * 16 * 72, 72, z, lane);
                *(LDSP u32x2*)(SB + (64 + ti * 16 + r) * 136 + td * 16 + q4 * 4) = pack4(a);
            }
        }
        __syncthreads();
#pragma unroll
        for (int q = 0; q < 4; ++q) {
            const int id = q * 512 + tid, row = id >> 4, ch = id & 15;
            bf16_t* dst = row < 64 ? Qg + row * 128 + ch * 8 : Og + (row - 64) * 128 + ch * 8;
            *(u32x4*)dst = *(const LDSP u32x4*)(SB + row * 136 + ch * 8);
        }
        __syncthreads();
        for (int id = wave; id < 64; id += 8) {
            const int tc = id >> 3, tr = id & 7;
            const f32x4 a = mma_tile<2>(WT + tc * 16 * 72, 72, KdT + tr * 16 * 72, 72, z, lane);
            const int dk = tr * 16 + r, d0 = tc * 16 + q4 * 4;
            f32x4 o;
#pragma unroll
            for (int e = 0; e < 4; ++e) o[e] = ((dk == d0 + e) ? ge : 0.f) - a[e];
            *(LDSP u32x2*)(SB + dk * 136 + d0) = pack4(o);
        }
        __syncthreads();
#pragma unroll
        for (int q = 0; q < 4; ++q) {
            const int id = q * 512 + tid, row = id >> 4, ch = id & 15;
            *(u32x4*)(Mg + row * 128 + ch * 8) = *(const LDSP u32x4*)(SB + row * 136 + ch * 8);
        }
        __syncthreads();
        for (int id = wave; id < 64; id += 8) {
            const int tr = id >> 3, tc = id & 7;
            const f32x4 a = mma_tile<2>(KdT + tr * 16 * 72, 72, UT + tc * 16 * 72, 72, z, lane);
            *(LDSP u32x2*)(SB + (tc * 16 + r) * 136 + tr * 16 + q4 * 4) = pack4(a);
        }
        __syncthreads();
#pragma unroll
        for (int q = 0; q < 4; ++q) {
            const int id = q * 512 + tid, row = id >> 4, ch = id & 15;
            *(u32x4*)(Bg + row * 128 + ch * 8) = *(const LDSP u32x4*)(SB + row * 136 + ch * 8);
        }
    }
    __syncthreads();
    GST(4);
}

constexpr int DP_QS = 0;
constexpr int DP_KSELF = 17408;
constexpr int DP_KSC = 34816;
constexpr int DP_KDT = 60928;
constexpr int DP_VT = 79360;
constexpr int DP_P = 97792;
constexpr int DP_TOT = 107008;
constexpr int DP_CODE = 109056;
constexpr int DP_END = 113152;

template <int MIX>
__device__ __forceinline__ void diag_prep_unit(const Ctx& c, int l, int cc) {
    constexpr int DK = (MIX == 1) ? 128 : 64;
    constexpr int PQ = DK + 8;
    const int n = cc % NCH, dir = (cc / NCH) & 1, h = (cc / (NCH * 2)) & 3, b = cc / (NCH * 8);
    const int tid = c.tid, lane = c.lane, wave = c.wave;
    LDSP unsigned char* L = c.lds;
    LDSP bf16_t* Qs = (LDSP bf16_t*)(L + DP_QS);
    LDSP bf16_t* Kself = (LDSP bf16_t*)(L + DP_KSELF);
    LDSP bf16_t* Ksc = (LDSP bf16_t*)(L + DP_KSC);
    LDSP bf16_t* KdT = (LDSP bf16_t*)(L + DP_KDT);
    LDSP bf16_t* VT = (LDSP bf16_t*)(L + DP_VT);
    LDSP bf16_t* Pm = (LDSP bf16_t*)(L + DP_P);
    LDSP float* tot = (LDSP float*)(L + DP_TOT);
    LDSP float* code = (LDSP float*)(L + DP_CODE);
    const bf16_t* proj = (const bf16_t*)(c.ws + WS_RA + RA_PROJ);
    const size_t rowb = (size_t)b * T;
    bf16_t* Bg; bf16_t* Qg; bf16_t* Og; float* Ag;
    const size_t cs = (size_t)n * 32 + cc / NCH;
    if (MIX == 1) { Bg = (bf16_t*)(c.ws + WS_RA + RA_HB) + cs * 16384; Qg = (bf16_t*)(c.ws + WS_RA + RA_HQ) + cs * 8192;
                    Og = (bf16_t*)(c.ws + WS_RA + RA_HO) + cs * 8192; Ag = (float*)(c.ws + WS_RA + RA_HA) + cs * 128; }
    else          { Bg = (bf16_t*)(c.ws + WS_RA + RA_LB) + cs * 8192; Qg = (bf16_t*)(c.ws + WS_RA + RA_LQ) + cs * 4096;
                    Og = (bf16_t*)(c.ws + WS_RA + RA_LO) + cs * 8192; Ag = (float*)(c.ws + WS_RA + RA_LA) + cs * 64; }

    const int vcol = (MIX == 1 ? C_CI : C_BV) + h * 128;
#pragma unroll
    for (int p = 0; p < 2; ++p) {
        const int id = p * 512 + tid, i = id & 63, c8 = id >> 6;
        const u32x4 v = *(const u32x4*)(proj + (rowb + tok_of(n, dir, i)) * NINP + vcol + c8 * 8);
#pragma unroll
        for (int m = 0; m < 4; ++m) { VT[(c8 * 8 + 2 * m) * 72 + i] = (bf16_t)(v[m] & 0xffffu); VT[(c8 * 8 + 2 * m + 1) * 72 + i] = (bf16_t)(v[m] >> 16); }
    }
    for (int i = tid; i < 64 * 36; i += 512) ((LDSP unsigned*)Pm)[i] = 0u;
    if (MIX == 2) {
        for (int i = tid; i < 64 * 16; i += 512) code[i] = bf2f(proj[(rowb + tok_of(n, dir, i >> 4)) * NINP + C_BCODE + dir * 16 + (i & 15)]);
        __syncthreads();
    }
    const int d = tid % DK, I = tid / DK;
    const bool act = (MIX == 1) || (tid < 256);
    float qv[16], kv[16], bl[16];
    if (act) {
        float lb = 0.f, wg[16], bg = 0.f;
        if (MIX == 1) {
            const float* gam = c.in[I_HGAM] + (size_t)dir * DEPTH * 512 + h * 128 + d;
            float mx = gam[0];
#pragma unroll
            for (int i = 1; i < DEPTH; ++i) mx = fmaxf(mx, gam[i * 512]);
            float den = 0.f, num = 0.f;
#pragma unroll
            for (int i = 0; i < DEPTH; ++i) { const float e = __expf(gam[i * 512] - mx); den += e; if (i >= 1 && i <= l) num += e; }
            lb = num / den;
        } else {
#pragma unroll
            for (int r = 0; r < 16; ++r) wg[r] = c.in[I_GLAW][((size_t)(l * 2 + dir) * 16 + r) * 256 + h * 64 + d];
            bg = c.in[I_GLAB][(l * 2 + dir) * 256 + h * 64 + d];
        }
        float run = 0.f;
#pragma unroll
        for (int s = 0; s < 16; ++s) {
            const int i = I * 16 + s, t = tok_of(n, dir, i);
            const bf16_t* pr = proj + (rowb + t) * NINP;
            float la;
            if (MIX == 1) {
                qv[s] = bf2f(pr[C_CQ + h * 128 + d]);
                const float f = lb + (1.f - lb) * sigmoidf_(bf2f(pr[C_CF + dir * 512 + h * 128 + d]));
                la = __logf(f); kv[s] = 1.f - f;
            } else {
                float q0 = bf2f(pr[C_BQ + h * 64 + d]) * 0.125f, k0 = bf2f(pr[C_BK + h * 64 + d]);
                if (n >= 4) {
                    const int pos = t - CTX, hf = d >> 5, idx = d & 31, fi = idx & 15;
                    const float p = (float)(hf ? (pos & 63) : (pos >> 6));
                    const float inv = __expf(-(float)fi * (9.210340371976184f / 16.f));
                    float ang = p * inv;
                    const float kk = rintf(ang * 0.15915494309189535f);
                    ang = fmaf(-kk, 6.2831855f, ang); ang = fmaf(-kk, -1.7484555e-7f, ang);
                    const float cs = __cosf(ang), sn = __sinf(ang);
                    const int dp = idx < 16 ? d + 16 : d - 16;
                    const float q1 = bf2f(pr[C_BQ + h * 64 + dp]) * 0.125f, k1 = bf2f(pr[C_BK + h * 64 + dp]);
                    if (idx < 16) { q0 = q0 * cs - q1 * sn; k0 = k0 * cs - k1 * sn; }
                    else          { q0 = q1 * sn + q0 * cs; k0 = k1 * sn + k0 * cs; }
                }
                qv[s] = q0; kv[s] = k0;
                float gt = bg;
#pragma unroll
                for (int r = 0; r < 16; ++r) gt += code[i * 16 + r] * wg[r];
                la = -softplusf_(-gt) * (1.f / 16.f);
            }
            run += la; bl[s] = run;
        }
        tot[I * 128 + d] = run;
    }
    __syncthreads();
    if (act) {
        float pre = 0.f, bend = 0.f, tI[4];
#pragma unroll
        for (int m = 0; m < 4; ++m) { tI[m] = tot[m * 128 + d]; bend += tI[m]; if (m < I) pre += tI[m]; }
        unsigned kd[8];
#pragma unroll
        for (int s = 0; s < 16; ++s) {
            const int i = I * 16 + s;
            Qs[i * PQ + d] = f2bf(qv[s] * __expf(bl[s]));
            Kself[i * PQ + d] = f2bf(kv[s] * __expf(-bl[s]));
            Qg[i * DK + d] = f2bf(qv[s] * __expf(pre + bl[s]));
            const float kdv = kv[s] * __expf(bend - pre - bl[s]);
            if (s & 1) kd[s >> 1] = (kd[s >> 1] & 0xffffu) | ((unsigned)f2bf(kdv) << 16); else kd[s >> 1] = f2bf(kdv);
            float off = 0.f;
#pragma unroll
            for (int Ip = 1; Ip < 4; ++Ip) {
                if (Ip > I) { off += tI[Ip - 1]; Ksc[((Ip * (Ip - 1) / 2 + I) * 16 + s) * PQ + d] = f2bf(kv[s] * __expf(off - bl[s])); }
            }
        }
        *(LDSP u32x4*)(KdT + d * 72 + I * 16) = (u32x4){kd[0], kd[1], kd[2], kd[3]};
        *(LDSP u32x4*)(KdT + d * 72 + I * 16 + 8) = (u32x4){kd[4], kd[5], kd[6], kd[7]};
        if (I == 0) Ag[d] = __expf(bend);
    }
    __syncthreads();
    for (int blk = wave; blk < 10; blk += 8) {
        int Ib, Jb;
        if (blk < 4) { Ib = blk; Jb = blk; } else { const int s = blk - 4; Ib = s < 1 ? 1 : (s < 3 ? 2 : 3); Jb = s - (Ib * (Ib - 1) / 2); }
        const LDSP bf16_t* kp = (Ib == Jb) ? Kself + Jb * 16 * PQ : Ksc + (Ib * (Ib - 1) / 2 + Jb) * 16 * PQ;
        const f32x4 a = mma_tile<DK / 32>(kp, PQ, Qs + Ib * 16 * PQ, PQ, (f32x4){0.f, 0.f, 0.f, 0.f}, lane);
        const int r = lane & 15, q4 = lane >> 4;
        f32x4 o;
#pragma unroll
        for (int e = 0; e < 4; ++e) o[e] = (Ib > Jb || r >= q4 * 4 + e) ? a[e] : 0.f;
        *(LDSP u32x2*)(Pm + (Ib * 16 + r) * 72 + Jb * 16 + q4 * 4) = pack4(o);
    }
    __syncthreads();
    {
        const int r = lane & 15, q4 = lane >> 4;
        const f32x4 z = (f32x4){0.f, 0.f, 0.f, 0.f};
        constexpr int NT2 = (DK / 16) * 8;
        for (int id = wave; id < 32 + NT2; id += 8) {
            if (id < 32) {
                const int td = id >> 2, ti = id & 3;
                const f32x4 a = mma_tile<2>(VT + td * 16 * 72, 72, Pm + ti * 16 * 72, 72, z, lane);
                *(u32x2*)(Og + (ti * 16 + r) * 128 + td * 16 + q4 * 4) = pack4(a);
            } else {
                const int j = id - 32, tk = j >> 3, tv = j & 7;
                const f32x4 a = mma_tile<2>(KdT + tk * 16 * 72, 72, VT + tv * 16 * 72, 72, z, lane);
                *(u32x2*)(Bg + (tv * 16 + r) * DK + tk * 16 + q4 * 4) = pack4(a);
            }
        }
    }
    __syncthreads();
}

template <int MIX, int DVS, int RING>
__device__ __forceinline__ void scan_unit(const Ctx& c, int chain, int slice) {
    constexpr int DK = (MIX == 2) ? 64 : 128;
    constexpr int PS = DK + 8;
    constexpr int NDK = DK / 16, NG = 8 / NDK;
    constexpr int NS = (DVS / 16) / NG;
    constexpr int NO = (DVS / 16) / 2;
    constexpr int KS = DK / 32;
    const int lane = c.lane, wave = c.wave, r = lane & 15, q4 = lane >> 4;
    const int dir = chain & 1, h = (chain >> 1) & 3, b = chain >> 3;
    LDSP bf16_t* ST = (LDSP bf16_t*)c.lds;
    constexpr int PO = DVS + 8;
    LDSP bf16_t* OS = ST + DVS * PS;
    for (int i = c.tid; i < DVS * PS / 2; i += 512) ((LDSP unsigned*)ST)[i] = 0u;
    const int dkt = wave % NDK;
    const int dvt0 = (wave / NDK) * NS;
    const int ott = wave >> 1;
    const int odv0 = (wave & 1) * NO;
    const bf16_t* Mg = (const bf16_t*)(c.ws + WS_RA + RA_GM);
    const bf16_t* Bg = (const bf16_t*)(c.ws + WS_RA + (MIX == 0 ? RA_GB : MIX == 1 ? RA_HB : RA_LB));
    const bf16_t* Qg = (const bf16_t*)(c.ws + WS_RA + (MIX == 0 ? RA_GQ : MIX == 1 ? RA_HQ : RA_LQ));
    const bf16_t* Og = (const bf16_t*)(c.ws + WS_RA + (MIX == 0 ? RA_GO : MIX == 1 ? RA_HO : RA_LO));
    const float* Ag = (const float*)(c.ws + WS_RA + (MIX == 1 ? RA_HA : RA_LA));
    bf16_t* OB = (bf16_t*)(c.ws + WS_RA + RA_OB) + ((size_t)(MIX * 2 + dir) * MROWS) * 512;
    f32x4 S[NS];
#pragma unroll
    for (int t = 0; t < NS; ++t) S[t] = (f32x4){0.f, 0.f, 0.f, 0.f};
    struct Ld { bf16x8 mf[KS]; u32x2 bt[NS]; f32x4 ae; bf16x8 qf[KS]; u32x2 ot[NO]; };
    Ld ring[RING];
    auto load = [&](Ld& d, int s) {
        const int n = dir ? (s < 4 ? 3 - s : 71 - s) : s;
        const size_t cc = (size_t)n * 32 + chain;
        if (MIX == 0) {
#pragma unroll
            for (int kk = 0; kk < KS; ++kk) d.mf[kk] = *(const bf16x8*)(Mg + cc * 16384 + (size_t)(dkt * 16 + r) * 128 + kk * 32 + q4 * 8);
        } else {
            d.ae = *(const f32x4*)(Ag + cc * DK + dkt * 16 + q4 * 4);
        }
#pragma unroll
        for (int t = 0; t < NS; ++t) d.bt[t] = *(const u32x2*)(Bg + cc * (128 * DK) + (size_t)(slice * DVS + (dvt0 + t) * 16 + r) * DK + dkt * 16 + q4 * 4);
#pragma unroll
        for (int kk = 0; kk < KS; ++kk) d.qf[kk] = *(const bf16x8*)(Qg + cc * (64 * DK) + (size_t)(ott * 16 + r) * DK + kk * 32 + q4 * 8);
#pragma unroll
        for (int t = 0; t < NO; ++t) d.ot[t] = *(const u32x2*)(Og + cc * 8192 + (size_t)(ott * 16 + r) * 128 + slice * DVS + (odv0 + t) * 16 + q4 * 4);
    };
#pragma unroll
    for (int k = 0; k < RING; ++k) load(ring[k], k);
    __syncthreads();
    for (int s0 = 0; s0 < NCH; s0 += RING) {
#pragma unroll
      for (int k = 0; k < RING; ++k) {
        const int s = s0 + k;
        if (s >= NCH) break;
        Ld& cur = ring[k];
        const int n = dir ? (s < 4 ? 3 - s : 71 - s) : s;
#pragma unroll
        for (int t = 0; t < NO; ++t) {
            f32x4 a = (f32x4){bflo(cur.ot[t].x), bfhi(cur.ot[t].x), bflo(cur.ot[t].y), bfhi(cur.ot[t].y)};
#pragma unroll
            for (int kk = 0; kk < KS; ++kk) {
                const bf16x8 sf = *(const LDSP bf16x8*)(ST + ((odv0 + t) * 16 + r) * PS + kk * 32 + q4 * 8);
                a = __builtin_amdgcn_mfma_f32_16x16x32_bf16(sf, cur.qf[kk], a, 0, 0, 0);
            }
            *(LDSP u32x2*)(OS + (s & 1) * 64 * PO + (ott * 16 + r) * PO + (odv0 + t) * 16 + q4 * 4) = pack4(a);
        }
        f32x4 Sn[NS];
#pragma unroll
        for (int t = 0; t < NS; ++t) {
            const f32x4 bm = (f32x4){bflo(cur.bt[t].x), bfhi(cur.bt[t].x), bflo(cur.bt[t].y), bfhi(cur.bt[t].y)};
            if (MIX == 0) {
                f32x4 a = bm;
#pragma unroll
                for (int kk = 0; kk < KS; ++kk) {
                    const bf16x8 sf = *(const LDSP bf16x8*)(ST + ((dvt0 + t) * 16 + r) * PS + kk * 32 + q4 * 8);
                    a = __builtin_amdgcn_mfma_f32_16x16x32_bf16(cur.mf[kk], sf, a, 0, 0, 0);
                }
                Sn[t] = a;
            } else {
                Sn[t] = cur.ae * S[t] + bm;
            }
        }
        if (s + RING < NCH) load(cur, s + RING);
        __syncthreads();
#pragma unroll
        for (int t = 0; t < NS; ++t) { S[t] = Sn[t]; *(LDSP u32x2*)(ST + ((dvt0 + t) * 16 + r) * PS + dkt * 16 + q4 * 4) = pack4(Sn[t]); }
#pragma unroll
        for (int id = c.tid; id < 64 * (DVS / 8); id += 512) {
            const int i = id / (DVS / 8), ch = id % (DVS / 8);
            *(u32x4*)(OB + ((size_t)b * T + tok_of(n, dir, i)) * 512 + h * 128 + slice * DVS + ch * 8) = *(const LDSP u32x4*)(OS + (s & 1) * 64 * PO + i * PO + ch * 8);
        }
        __syncthreads();
      }
    }
}

constexpr int NA_Q = 0, NA_K = 17408, NA_VT = 34816, NA_P = 53248, NA_GRP = 62464;
constexpr int NA_RPB = 2 * NA_GRP;
__device__ __forceinline__ void na_pair(const Ctx& c, int l, int pair) {
    const int tid = c.tid, lane = c.lane, wave = c.wave, grp = wave >> 2, gw = wave & 3, gt = tid & 255;
    const int r = lane & 15, q4 = lane >> 4;
    const bool is_lat = pair < 512;
    int b, h, gr = 0, qb = 0;
    if (is_lat) { const int u = pair * 2 + grp; b = u >> 8; h = (u >> 6) & 3; gr = u & 63; }
    else { const int u = (pair - 512) * 2 + grp; b = u >> 4; h = (u >> 2) & 3; qb = u & 3; }
    const int NT = is_lat ? 12 : 4;
    const int rs = gr - 4 < 0 ? 0 : (gr - 4 > 56 ? 56 : gr - 4);
    LDSP unsigned char* L = c.lds + grp * NA_GRP;
    LDSP bf16_t* Qs = (LDSP bf16_t*)(L + NA_Q);
    LDSP bf16_t* Kt = (LDSP bf16_t*)(L + NA_K);
    LDSP bf16_t* VT = (LDSP bf16_t*)(L + NA_VT);
    LDSP bf16_t* Pm = (LDSP bf16_t*)(L + NA_P);
    LDSP float* rpb = (LDSP float*)(c.lds + NA_RPB);
    const bf16_t* proj = (const bf16_t*)(c.ws + WS_RA + RA_PROJ);
    const size_t rowb = (size_t)b * T;
    const int qtok0 = is_lat ? CTX + gr * 64 : qb * 64;
#pragma unroll
    for (int p = 0; p < 4; ++p) {
        const int id = p * 256 + gt, qi = id >> 4, c8 = id & 15;
        *(LDSP u32x4*)(Qs + qi * 136 + c8 * 8) = *(const u32x4*)(proj + (rowb + qtok0 + qi) * NINP + C_DQ + h * 128 + c8 * 8);
    }
    if (tid < 465) rpb[tid] = c.in[I_RPB][(size_t)(l * 4 + h) * 465 + tid];
    float m_run = -1e30f, l_run = 0.f;
    f32x4 acc[8];
#pragma unroll
    for (int dt = 0; dt < 8; ++dt) acc[dt] = (f32x4){0.f, 0.f, 0.f, 0.f};
    const float SC = 0.08838834764831845f * 1.4426950408889634f;
    const int cq = gw * 16 + r;
    const int cs = cq - 8 < 0 ? 0 : (cq - 8 > 48 ? 48 : cq - 8);
    u32x4 kreg[4], vreg[4];
#define NA_KTOK0(kt_) (is_lat ? ((kt_) < 8 ? CTX + (rs + (kt_)) * 64 : ((kt_) - 8) * 64) : (kt_) * 64)
#define NA_PREFETCH(kt_) do { const int kb_ = NA_KTOK0(kt_); _Pragma("unroll") for (int p = 0; p < 4; ++p) { \
        const int id = p * 256 + gt; kreg[p] = *(const u32x4*)(proj + (rowb + kb_ + (id >> 4)) * NINP + C_DK + h * 128 + (id & 15) * 8); \
        vreg[p] = *(const u32x4*)(proj + (rowb + kb_ + (id >> 4)) * NINP + C_DV + h * 128 + (id & 15) * 8); } } while (0)
    NA_PREFETCH(0);
    for (int kt = 0; kt < NT; ++kt) {
        const bool loc = is_lat && kt < 8;
        __syncthreads();
#pragma unroll
        for (int p = 0; p < 4; ++p) {
            const int id = p * 256 + gt, j = id >> 4, c8 = id & 15;
            *(LDSP u32x4*)(Kt + j * 136 + c8 * 8) = kreg[p];
            *(LDSP u32x4*)(VT + j * 136 + c8 * 8) = vreg[p];
        }
        if (kt + 1 < NT) NA_PREFETCH(kt + 1);
        __syncthreads();
        f32x4 sc[4];
        float tmax = -1e30f;
#pragma unroll
        for (int ct = 0; ct < 4; ++ct) {
            sc[ct] = mma_tile<4>(Kt + ct * 16 * 136, 136, Qs + gw * 16 * 136, 136, (f32x4){0.f, 0.f, 0.f, 0.f}, lane);
#pragma unroll
            for (int e = 0; e < 4; ++e) {
                float s = sc[ct][e] * SC;
                if (loc) {
                    const int ck = ct * 16 + q4 * 4 + e;
                    int dc = ck - cq; dc = dc < -15 ? -15 : (dc > 15 ? 15 : dc);
                    const int dr = rs + kt - gr + 7;
                    s += rpb[dr * 31 + dc + 15] * 1.4426950408889634f;
                    if (ck < cs || ck >= cs + 16) s = -INFINITY;
                }
                sc[ct][e] = s; tmax = fmaxf(tmax, s);
            }
        }
        tmax = fmaxf(tmax, __shfl_xor(tmax, 16)); tmax = fmaxf(tmax, __shfl_xor(tmax, 32));
        const float m_new = fmaxf(m_run, tmax);
        const float alpha = __builtin_amdgcn_exp2f(m_run - m_new);
        float psum = 0.f;
#pragma unroll
        for (int ct = 0; ct < 4; ++ct) {
            f32x4 p;
#pragma unroll
            for (int e = 0; e < 4; ++e) { p[e] = __builtin_amdgcn_exp2f(sc[ct][e] - m_new); psum += p[e]; }
            *(LDSP u32x2*)(Pm + (gw * 16 + r) * 72 + ct * 16 + q4 * 4) = pack4(p);
        }
        psum += __shfl_xor(psum, 16); psum += __shfl_xor(psum, 32);
        l_run = l_run * alpha + psum; m_run = m_new;
#pragma unroll
        for (int dt = 0; dt < 8; ++dt) {
            acc[dt] = acc[dt] * alpha;
#pragma unroll
            for (int kk = 0; kk < 2; ++kk) {
                const bf16x8 vf = frag_tr16(VT + kk * 32 * 136 + dt * 16, 136, lane);
                const bf16x8 pf = *(const LDSP bf16x8*)(Pm + (gw * 16 + r) * 72 + kk * 32 + q4 * 8);
                acc[dt] = __builtin_amdgcn_mfma_f32_16x16x32_bf16(vf, pf, acc[dt], 0, 0, 0);
            }
        }
    }
    const float inv = 1.f / l_run;
    bf16_t* mix = (bf16_t*)(c.ws + WS_MIX) + (rowb + qtok0 + gw * 16 + r) * D + 1536 + h * 128;
#pragma unroll
    for (int dt = 0; dt < 8; ++dt) *(u32x2*)(mix + dt * 16 + q4 * 4) = pack4(acc[dt] * inv);
    __syncthreads();
}

__device__ __forceinline__ void phase_combine(const Ctx& c, int l) {
    const bf16_t* proj = (const bf16_t*)(c.ws + WS_RA + RA_PROJ);
    const bf16_t* OB = (const bf16_t*)(c.ws + WS_RA + RA_OB);
    bf16_t* mix = (bf16_t*)(c.ws + WS_MIX);
    const int lane = c.lane, d0 = (lane & 15) * 8;
    for (int row = c.bid * 8 + c.wave; row < MROWS; row += c.G * 8) {
#pragma unroll
        for (int mx = 0; mx < 3; ++mx) {
            const int om = mx == 0 ? 0 : 3 - mx;
            const u32x4 a = *(const u32x4*)(OB + ((size_t)(om * 2 + 0) * MROWS + row) * 512 + lane * 8);
            const u32x4 bq = *(const u32x4*)(OB + ((size_t)(om * 2 + 1) * MROWS + row) * 512 + lane * 8);
            const u32x4 g = *(const u32x4*)(proj + (size_t)row * NINP + (mx == 0 ? C_AZ : mx == 1 ? C_BR : C_CG) + lane * 8);
            const float* nw = c.in[mx == 0 ? I_GDNN : mx == 1 ? I_GLAN : I_HGN] + l * 128 + d0;
            float o[8]; float ss = 0.f;
#pragma unroll
            for (int m = 0; m < 4; ++m) { o[2 * m] = bflo(a[m]) + bflo(bq[m]); o[2 * m + 1] = bfhi(a[m]) + bfhi(bq[m]); ss += o[2 * m] * o[2 * m] + o[2 * m + 1] * o[2 * m + 1]; }
#pragma unroll
            for (int m = 1; m < 16; m <<= 1) ss += __shfl_xor(ss, m);
            const float rn = rsqrtf(ss * (1.f / 128.f) + NORM_EPS);
            float y[8];
#pragma unroll
            for (int m = 0; m < 4; ++m) {
                const float g0 = bflo(g[m]), g1 = bfhi(g[m]);
                const float a0 = (mx == 2) ? sigmoidf_(g0) : siluf_(g0), a1 = (mx == 2) ? sigmoidf_(g1) : siluf_(g1);
                y[2 * m] = o[2 * m] * rn * nw[2 * m] * a0; y[2 * m + 1] = o[2 * m + 1] * rn * nw[2 * m + 1] * a1;
            }
            *(u32x4*)(mix + (size_t)row * D + mx * 512 + lane * 8) = (u32x4){pk2(y[0], y[1]), pk2(y[2], y[3]), pk2(y[4], y[5]), pk2(y[6], y[7])};
        }
    }
}

__device__ __forceinline__ void phase_ln_router(const Ctx& c, int l) {
    LDSP float* wr = (LDSP float*)c.lds;
    for (int i = c.tid; i < 2048 * 16; i += 512) { const int k = i >> 4, e = i & 15; wr[e * 2048 + k] = c.in[I_ROUT][(size_t)l * 2048 * 16 + i]; }
    __syncthreads();
    const float* modv = (const float*)(c.ws + WS_MODV);
    const float* tb = (const float*)(c.ws + WS_RA + RA_TBUF);
    float* X1 = (float*)(c.ws + WS_X1); bf16_t* U = (bf16_t*)(c.ws + WS_U); float* aff = (float*)(c.ws + WS_AFF);
    const float* lg = c.in[I_LNG] + (size_t)(l * 2 + 0) * D; const float* lbp = c.in[I_LNB] + (size_t)(l * 2 + 0) * D;
    const int lane = c.lane;
    for (int row = c.bid * 8 + c.wave; row < MROWS; row += c.G * 8) {
        const int b = row / T, t = row % T;
        if (l == DEPTH - 1 && t < CTX) continue;
        const int r = t < CTX ? 4 : b;
        f32x4 v[8];
#pragma unroll
        for (int j = 0; j < 8; ++j) v[j] = *(const f32x4*)(tb + (size_t)row * D + 256 * j + 4 * lane);
        float mu, rstd; row_stats(v, mu, rstd);
#pragma unroll
        for (int j = 0; j < 8; ++j) {
            const int col = 256 * j + 4 * lane;
            v[j] = (v[j] - mu) * rstd * *(const f32x4*)(lg + col) + *(const f32x4*)(lbp + col);
            *(f32x4*)(X1 + (size_t)row * D + col) = v[j];
        }
        row_stats(v, mu, rstd);
        const float* sh = modv + (size_t)(l * 5 + r) * 12288 + 3 * 2048; const float* scp = sh + 2048;
        float lg16[16];
#pragma unroll
        for (int e = 0; e < 16; ++e) lg16[e] = 0.f;
#pragma unroll
        for (int j = 0; j < 8; ++j) {
            const int col = 256 * j + 4 * lane;
            const f32x4 y = (v[j] - mu) * rstd * (*(const f32x4*)(scp + col) + 1.f) + *(const f32x4*)(sh + col);
            *(u32x2*)(U + (size_t)row * D + col) = pack4(y);
#pragma unroll
            for (int e = 0; e < 16; ++e) { const f32x4 w = *(const LDSP f32x4*)(wr + e * 2048 + col); lg16[e] += y[0] * w[0] + y[1] * w[1] + y[2] * w[2] + y[3] * w[3]; }
        }
        float mxv = -1e30f;
#pragma unroll
        for (int e = 0; e < 16; ++e) { lg16[e] = wsum(lg16[e]); mxv = fmaxf(mxv, lg16[e]); }
        float den = 0.f;
#pragma unroll
        for (int e = 0; e < 16; ++e) { lg16[e] = expf(lg16[e] - mxv); den += lg16[e]; }
        const float rd = 1.f / den;
        float mine = 0.f;
#pragma unroll
        for (int e = 0; e < 16; ++e) if (lane == e) mine = lg16[e] * rd;
        if (lane < 16) aff[(size_t)row * 16 + lane] = mine;
    }
    __syncthreads();
}

__device__ __forceinline__ void topk_unit(const Ctx& c, int prob) {
    const bool lat = prob < 64; const int pe = lat ? prob : prob - 64, b = pe >> 4, e = pe & 15;
    const int n = lat ? 4096 : 256, kcap = lat ? 512 : 32, tok0 = lat ? CTX : 0;
    LDSP unsigned* keys = (LDSP unsigned*)c.lds;
    LDSP unsigned* hist = keys + 4096;
    LDSP unsigned* bc = hist + 256;
    LDSP unsigned* wsum_ = bc + 4;
    const float* aff = (const float*)(c.ws + WS_AFF);
    const int tid = c.tid, lane = c.lane, wave = c.wave;
    const size_t rowb = (size_t)b * T + tok0;
    for (int i = tid; i < n; i += 512) keys[i] = __float_as_uint(aff[(rowb + i) * 16 + e]);
    unsigned prefix = 0u, mask = 0u, krem = (unsigned)kcap;
    for (int pass = 0; pass < 4; ++pass) {
        const int shift = 24 - 8 * pass;
        if (tid < 256) hist[tid] = 0u;
        __syncthreads();
        for (int i = tid; i < n; i += 512) { const unsigned k = keys[i]; if ((k & mask) == prefix) __hip_atomic_fetch_add(&hist[(k >> shift) & 255u], 1u, __ATOMIC_RELAXED, __HIP_MEMORY_SCOPE_WORKGROUP); }
        __syncthreads();
        if (tid == 0) {
            unsigned cum = 0u; int bin = 255;
            for (; bin > 0; --bin) { const unsigned hcount = hist[bin]; if (cum + hcount >= krem) break; cum += hcount; }
            bc[0] = prefix | ((unsigned)bin << shift); bc[1] = krem - cum;
        }
        __syncthreads();
        prefix = bc[0]; krem = bc[1]; mask |= 255u << shift;
        __syncthreads();
    }
    const int per = n / 512 > 0 ? n / 512 : 1;
    const int i0 = tid * per;
    unsigned cnt = 0u;
    if (i0 < n) for (int j = 0; j < per; ++j) { const unsigned k = keys[i0 + j]; cnt += (k > prefix) ? 1u : 0u; cnt += (k == prefix) ? 0x10000u : 0u; }
    unsigned inc = cnt;
#pragma unroll
    for (int m = 1; m < 64; m <<= 1) { const unsigned o = __shfl_up(inc, m); if (lane >= m) inc += o; }
    if (lane == 63) wsum_[wave] = inc;
    __syncthreads();
    unsigned base = 0u;
    for (int w = 0; w < wave; ++w) base += wsum_[w];
    unsigned excl = base + inc - cnt;
    int* idx = (int*)(c.ws + WS_IDX); float* gate = (float*)(c.ws + WS_GATE); int* inv = (int*)(c.ws + WS_INV);
    const int slot0 = lat ? b * 512 : 2048 + b * 32;
    if (i0 < n) for (int j = 0; j < per; ++j) {
        const unsigned k = keys[i0 + j];
        const unsigned gtb = excl & 0xffffu, eqb = excl >> 16;
        const bool sel = (k > prefix) || (k == prefix && eqb < krem);
        int srow = -1;
        if (sel) {
            srow = slot0 + (int)(gtb + (eqb < krem ? eqb : krem));
            idx[e * EROWS + srow] = (int)(rowb + i0 + j);
            gate[e * EROWS + srow] = __uint_as_float(k);
        }
        inv[(rowb + i0 + j) * 16 + e] = srow;
        excl += (k > prefix) ? 1u : 0u; excl += (k == prefix) ? 0x10000u : 0u;
    }
    __syncthreads();
}

__device__ __forceinline__ void phase_gather(const Ctx& c, int l) {
    const int* idx = (const int*)(c.ws + WS_IDX);
    const bf16_t* U = (const bf16_t*)(c.ws + WS_U); bf16_t* XS = (bf16_t*)(c.ws + WS_RA + RA_XS);
    const int nrow = (l == DEPTH - 1) ? 2048 : EROWS, nreal = (l == DEPTH - 1) ? 2048 : 2176;
    for (int g = c.bid * 8 + c.wave; g < NEXP * nrow; g += c.G * 8) {
        const int e = g / nrow, s = g % nrow;
        u32x4 v[4];
        if (s < nreal) {
            const int src = idx[e * EROWS + s];
#pragma unroll
            for (int j = 0; j < 4; ++j) v[j] = *(const u32x4*)(U + (size_t)src * D + j * 512 + c.lane * 8);
        } else {
#pragma unroll
            for (int j = 0; j < 4; ++j) v[j] = (u32x4){0u, 0u, 0u, 0u};
            if (c.lane == 0) ((float*)(c.ws + WS_GATE))[e * EROWS + s] = 0.f;
        }
#pragma unroll
        for (int j = 0; j < 4; ++j) *(u32x4*)(XS + ((size_t)e * EROWS + s) * D + j * 512 + c.lane * 8) = v[j];
    }
}

__device__ __forceinline__ void phase_final(const Ctx& c, int l) {
    const float* modv = (const float*)(c.ws + WS_MODV);
    const float* X1 = (const float*)(c.ws + WS_X1); float* X = (float*)(c.ws + WS_X); bf16_t* U = (bf16_t*)(c.ws + WS_U);
    const bf16_t* YS = (const bf16_t*)(c.ws + WS_RA + RA_YS); const int* inv = (const int*)(c.ws + WS_INV);
    const float* lg = c.in[I_LNG] + (size_t)(l * 2 + 1) * D; const float* lbp = c.in[I_LNB] + (size_t)(l * 2 + 1) * D;
    const int lane = c.lane;
    for (int row = c.bid * 8 + c.wave; row < MROWS; row += c.G * 8) {
        const int b = row / T, t = row % T;
        if (l == DEPTH - 1 && t < CTX) continue;
        const int r = t < CTX ? 4 : b;
        f32x4 y[8];
#pragma unroll
        for (int j = 0; j < 8; ++j) y[j] = (f32x4){0.f, 0.f, 0.f, 0.f};
        const int myinv = inv[(size_t)row * 16 + (lane & 15)];
        for (int e = 0; e < 16; ++e) {
            const int s = __shfl(myinv, e);
            if (s >= 0) {
                const bf16_t* yr = YS + ((size_t)e * EROWS + s) * D;
#pragma unroll
                for (int j = 0; j < 8; ++j) { const u32x2 w = *(const u32x2*)(yr + 256 * j + 4 * lane); y[j] += (f32x4){bflo(w.x), bfhi(w.x), bflo(w.y), bfhi(w.y)}; }
            }
        }
        const float* m5 = modv + (size_t)(l * 5 + r) * 12288 + 5 * 2048;
        f32x4 v[8];
#pragma unroll
        for (int j = 0; j < 8; ++j) { const int col = 256 * j + 4 * lane; v[j] = *(const f32x4*)(X1 + (size_t)row * D + col) * ALPHA + *(const f32x4*)(m5 + col) * y[j]; }
        float mu, rstd; row_stats(v, mu, rstd);
#pragma unroll
        for (int j = 0; j < 8; ++j) { const int col = 256 * j + 4 * lane; v[j] = (v[j] - mu) * rstd * *(const f32x4*)(lg + col) + *(const f32x4*)(lbp + col); }
        if (l == DEPTH - 1) {
            float* o = c.out + ((size_t)b * SEQ + (t - CTX)) * D;
#pragma unroll
            for (int j = 0; j < 8; ++j) *(f32x4*)(o + 256 * j + 4 * lane) = v[j];
        } else {
#pragma unroll
            for (int j = 0; j < 8; ++j) *(f32x4*)(X + (size_t)row * D + 256 * j + 4 * lane) = v[j];
            const float* sh = modv + (size_t)((l + 1) * 5 + r) * 12288;
            modulate_store(v, sh, sh + 2048, U + (size_t)row * D, lane);
        }
    }
}

struct EpiOut {
    static constexpr bool PERM = false, AFTER_DRAIN = false;
    const float* X; const float* modv_l; float* Tb;
    __device__ __forceinline__ void operator()(const pg8::f32x4 (&acc)[2][2][4][2], const pg8::Unit& u, int wr, int wc, int fr, int fq) const {
        const int row0 = u.pm * 256 + wr * 64 + fr, col0 = u.pn * 256 + wc * 32 + 4 * fq;
        const int r = (u.pm % 17 == 0) ? 4 : u.pm / 17;
        const float* m2 = modv_l + (size_t)r * 12288 + 2 * 2048 + col0;
        pg8::f32x4 mv[2][2];
#pragma unroll
        for (int bj = 0; bj < 2; ++bj)
#pragma unroll
            for (int n = 0; n < 2; ++n) mv[bj][n] = *(const pg8::f32x4*)(m2 + bj * 128 + n * 16);
#pragma unroll
        for (int ai = 0; ai < 2; ++ai)
#pragma unroll
            for (int m = 0; m < 4; ++m) {
                const size_t off = (size_t)(row0 + ai * 128 + m * 16) * D + col0;
#pragma unroll
                for (int bj = 0; bj < 2; ++bj)
#pragma unroll
                    for (int n = 0; n < 2; ++n)
                        *(pg8::f32x4*)(Tb + off + bj * 128 + n * 16) = *(const pg8::f32x4*)(X + off + bj * 128 + n * 16) * ALPHA + mv[bj][n] * acc[ai][bj][m][n];
            }
    }
};
struct EpiHid {
    static constexpr bool PERM = true, AFTER_DRAIN = false;
    bf16_t* H;
    __device__ __forceinline__ void operator()(const pg8::f32x4 (&acc)[2][2][4][2], const pg8::Unit& u, int wr, int wc, int fr, int fq) const {
        const int row0 = u.pm * 256 + wr * 64 + fr, col0 = (u.pn & 7) * 128 + wc * 32 + 8 * fq;
#pragma unroll
        for (int ai = 0; ai < 2; ++ai)
#pragma unroll
            for (int m = 0; m < 4; ++m) {
                float hv[8];
#pragma unroll
                for (int n = 0; n < 2; ++n)
#pragma unroll
                    for (int j = 0; j < 4; ++j) hv[n * 4 + j] = siluf_(acc[ai][0][m][n][j]) * acc[ai][1][m][n][j];
                *(u32x4*)(H + (size_t)(row0 + ai * 128 + m * 16) * 1024 + col0) = (u32x4){pk2(hv[0], hv[1]), pk2(hv[2], hv[3]), pk2(hv[4], hv[5]), pk2(hv[6], hv[7])};
            }
    }
};
struct EpiY {
    static constexpr bool PERM = true, AFTER_DRAIN = false;
    bf16_t* Y; const float* gate;
    __device__ __forceinline__ void operator()(const pg8::f32x4 (&acc)[2][2][4][2], const pg8::Unit& u, int wr, int wc, int fr, int fq) const {
        const int row0 = u.pm * 256 + wr * 64 + fr, col0 = (u.pn & 7) * 256 + wc * 32 + 8 * fq;
#pragma unroll
        for (int ai = 0; ai < 2; ++ai)
#pragma unroll
            for (int m = 0; m < 4; ++m) {
                const int row = row0 + ai * 128 + m * 16; const float g = gate[row];
#pragma unroll
                for (int bj = 0; bj < 2; ++bj) {
                    const pg8::f32x4 v0 = acc[ai][bj][m][0] * g, v1 = acc[ai][bj][m][1] * g;
                    *(u32x4*)(Y + (size_t)row * D + col0 + bj * 128) = (u32x4){pk2(v0[0], v0[1]), pk2(v0[2], v0[3]), pk2(v1[0], v1[1]), pk2(v1[2], v1[3])};
                }
            }
    }
};
struct SchedLin {
    int G, c, nUnits, nPn, skip_ctx;
    __device__ __forceinline__ bool next(int i, pg8::Unit& u) const {
        const int L = i * G + c; if (L >= nUnits) return false;
        const int pml = L / nPn; u.pn = L % nPn; u.pm = skip_ctx ? (pml >> 4) * 17 + 1 + (pml & 15) : pml; return true;
    }
    __device__ __forceinline__ void a_ready(const pg8::Unit&) const {}
    __device__ __forceinline__ void done(const pg8::Unit&) const {}
};
struct SchedMoe {
    int G, c, nPm, nUnits;
    __device__ __forceinline__ bool next(int i, pg8::Unit& u) const {
        const int L = i * G + c; if (L >= nUnits) return false;
        const int per = nPm * 8, e = L / per, rem = L % per; u.pm = e * 9 + (rem >> 3); u.pn = e * 8 + (rem & 7); return true;
    }
    __device__ __forceinline__ void a_ready(const pg8::Unit&) const {}
    __device__ __forceinline__ void done(const pg8::Unit&) const {}
};
}

struct Args { const float* in[24]; float* out; unsigned char* ws; int ph_lo, ph_hi; };
constexpr int LDS_BYTES = 147456;
#ifndef MK_NG
#define MK_NG 128
#define MK_NH 48
#endif
constexpr int N_PHASES = 2 + 11 * mk::DEPTH;

__global__ __launch_bounds__(512, 2) void mega_fwd(Args a) {
    using namespace mk;
    extern __shared__ __attribute__((aligned(16))) unsigned char lds_raw[];
    Ctx c0;
#pragma unroll
    for (int i = 0; i < 24; ++i) c0.in[i] = a.in[i];
    c0.out = a.out; c0.ws = a.ws; c0.lds = (LDSP unsigned char*)lds_raw;
    const int wave_s = __builtin_amdgcn_readfirstlane((int)threadIdx.x >> 6);
    c0.tid = threadIdx.x; c0.lane = c0.tid & 63; c0.wave = wave_s; c0.G = gridDim.x; c0.bid = blockIdx.x;
    const int lo = a.ph_lo, hi = a.ph_hi;
    volatile LAS unsigned* st = (volatile LAS unsigned*)(lds_raw + LDS_BYTES - 16);
    if (c0.tid == 0) { st[0] = 0u; st[1] = 0u; st[2] = 0u; st[3] = 0u; }
    __syncthreads();
    XcdBarrier bar; bar.bar = (unsigned*)(a.ws + WS_BAR); bar.x = 0; bar.st = st;
    if (hi - lo > 1) bar = xcd_barrier_post((unsigned*)(a.ws + WS_BAR), st);
    int ph = 0;
#define PH_CTX Ctx c = c0; { int wz = wave_s; asm volatile("" : "+s"(wz)); unsigned zz = 0u; asm volatile("" : "+v"(zz)); const int lz = (int)__builtin_amdgcn_mbcnt_hi(~0u, __builtin_amdgcn_mbcnt_lo(~0u, zz)); int bz = c0.bid; asm volatile("" : "+s"(bz)); c.bid = bz; c.wave = wz; c.lane = lz; c.tid = wz * 64 + lz; }
#define PH_ON (ph >= lo && ph < hi)
#ifdef MK_DBL
#define REP(id) for (int rep_ = 0; rep_ < 1 + (((MK_DBL) >> (id)) & 1); ++rep_, __syncthreads())
#else
#define REP(id)
#endif
#ifdef MK_TPROBE_A
    volatile LAS unsigned long long* tp = (volatile LAS unsigned long long*)(lds_raw + LDS_BYTES - 48);
    if (c0.bid == (MK_TPROBE_WG) && c0.tid == 0) { tp[0] = __builtin_amdgcn_s_memrealtime(); tp[1] = 0ull; tp[2] = 0ull; tp[3] = 0ull; }
#ifdef MK_GSTAMP
    if (c0.tid == 0) { volatile LAS unsigned long long* g0 = (volatile LAS unsigned long long*)(lds_raw + LDS_BYTES - 48 - 80); for (int i = 0; i < 9; ++i) g0[i] = 0ull; }
    __syncthreads();
#endif
#define PH_END do { if (PH_ON && ph + 1 < hi) xcd_barrier(bar); \
        if (c0.bid == (MK_TPROBE_WG) && threadIdx.x == 0) { const unsigned long long now_ = __builtin_amdgcn_s_memrealtime(); const int kind_ = ph < 2 ? ph : 2 + (ph - 2) % 11; \
            if (kind_ >= (MK_TPROBE_A) && kind_ <= (MK_TPROBE_B)) tp[1] += now_ - tp[0]; tp[0] = now_; } ++ph; } while (0)
#else
#define PH_END do { if (PH_ON && ph + 1 < hi) xcd_barrier(bar); ++ph; } while (0)
#endif

    if (PH_ON) REP(0) { PH_CTX
        if (c.bid < 192) { modv_fill_s(c); for (int u = c.bid; u < 192; u += c.G) modv_unit(c, u); }
        convert_phase(c, 0);
    }
    PH_END;
    if (PH_ON) REP(1) { PH_CTX phase_l0_modulate(c); }
    PH_END;

    for (int l = 0; l < DEPTH; ++l) {
        const bool last = (l == DEPTH - 1);
        if (PH_ON) REP(2) { PH_CTX
            pg8::Gemm g{(const pg8::bf16_t*)(c.ws + WS_U), (const pg8::bf16_t*)(c.ws + WS_WIN), MROWS, NINP, D};
            pg8::StaticOrder S; S.init(MROWS, NINP, c.G, c.bid);
            pg8::EpiBf16<0> E{(pg8::bf16_t*)(c.ws + WS_RA + RA_PROJ), NINP, nullptr, 0, 0};
            pg8::gemm_phase<pg8::EpiBf16<0>, pg8::StaticOrder, false>((PG8_LAS unsigned char*)c.lds, g, S, E, nullptr, c.tid);
        }
        PH_END;
        if (PH_ON) REP(3) { PH_CTX
            const bool split = false;
            for (int cc = c.bid; cc < NCC; cc += c.G) gdn_prep_unit(c, l, cc);
        }
        if (PH_ON) REP(4) { PH_CTX
            const bool split = false;
            for (int cc = split ? c.bid - MK_NG : c.bid; cc < NCC && (!split || (c.bid >= MK_NG && c.bid < MK_NG + MK_NH)); cc += split ? MK_NH : c.G) diag_prep_unit<1>(c, l, cc);
        }
        if (PH_ON) REP(5) { PH_CTX
            const bool split = false;
            for (int cc = split ? c.bid - MK_NG - MK_NH : c.bid; cc < NCC && (!split || c.bid >= MK_NG + MK_NH); cc += split ? (256 - MK_NG - MK_NH) : c.G) diag_prep_unit<2>(c, l, cc);
        }
        PH_END;
        if (PH_ON) REP(6) { PH_CTX
            for (int u = c.bid; u < 128; u += c.G) if (u < 64) { scan_unit<0, 64, 3>(c, u & 31, u >> 5); __syncthreads(); }
        }
        if (PH_ON) REP(7) { PH_CTX
            for (int u = c.bid; u < 128; u += c.G) if (u >= 64 && u < 96) { scan_unit<1, 128, 2>(c, u - 64, 0); __syncthreads(); }
        }
        if (PH_ON) REP(8) { PH_CTX
            for (int u = c.bid; u < 128; u += c.G) if (u >= 96) { scan_unit<2, 128, 4>(c, u - 96, 0); __syncthreads(); }
        }
#ifdef MK_TPROBE_A
        if (PH_ON && c0.bid == (MK_TPROBE_WG) && threadIdx.x == 0) { tp[2] += __builtin_amdgcn_s_memrealtime() - tp[0]; }
#endif
        if (PH_ON) REP(9) { PH_CTX
            const int nq = last ? 64 : 68, qx = c.bid & 7;
            unsigned* qhead = (unsigned*)(c.ws + WS_BAR) + 3584 + 8 * (l * 8 + qx);
            volatile LAS unsigned* tk = (volatile LAS unsigned*)(lds_raw + LDS_BYTES - 64);
            for (;;) {
                if (c.tid == 0) tk[0] = __hip_atomic_fetch_add(qhead, 1u, __ATOMIC_RELAXED, __HIP_MEMORY_SCOPE_AGENT);
                __syncthreads();
                const int t = (int)tk[0];
                if (t >= nq) break;
                na_pair(c, l, t < 64 ? 64 * qx + t : 512 + 4 * qx + (t - 64));
            }
        }
#ifdef MK_TPROBE_A
        if (PH_ON && c0.bid == (MK_TPROBE_WG) && threadIdx.x == 0) { tp[3] += __builtin_amdgcn_s_memrealtime() - tp[0]; }
#endif
        PH_END;
        if (PH_ON) REP(10) { PH_CTX phase_combine(c, l); }
        PH_END;
        if (PH_ON) REP(11) { PH_CTX
            pg8::Gemm g{(const pg8::bf16_t*)(c.ws + WS_MIX), (const pg8::bf16_t*)(c.ws + WS_WOUT), MROWS, D, D};
            SchedLin S{c.G, c.bid, (last ? 64 : 68) * 8, 8, last ? 1 : 0};
            EpiOut E{(const float*)(c.ws + WS_X), (const float*)(c.ws + WS_MODV) + (size_t)l * 5 * 12288, (float*)(c.ws + WS_RA + RA_TBUF)};
            pg8::gemm_phase<EpiOut, SchedLin, false>((PG8_LAS unsigned char*)c.lds, g, S, E, nullptr, c.tid);
        }
        PH_END;
        if (PH_ON) REP(12) { PH_CTX phase_ln_router(c, l); }
        PH_END;
        if (PH_ON) REP(13) { PH_CTX const int nprob = last ? 64 : 128; for (int p = c.bid; p < nprob; p += c.G) topk_unit(c, p); }
        PH_END;
        if (PH_ON) REP(14) { PH_CTX phase_gather(c, l); }
        PH_END;
        if (PH_ON) REP(15) { PH_CTX
            pg8::Gemm g{(const pg8::bf16_t*)(c.ws + WS_RA + RA_XS), (const pg8::bf16_t*)(c.ws + WS_W13), NEXP * EROWS, NEXP * 2048, D};
            SchedMoe S{c.G, c.bid, last ? 8 : 9, NEXP * (last ? 8 : 9) * 8};
            EpiHid E{(bf16_t*)(c.ws + WS_RA + RA_HID)};
            pg8::gemm_phase<EpiHid, SchedMoe, false>((PG8_LAS unsigned char*)c.lds, g, S, E, nullptr, c.tid);
        }
        PH_END;
        if (PH_ON) REP(16) { PH_CTX
            pg8::Gemm g{(const pg8::bf16_t*)(c.ws + WS_RA + RA_HID), (const pg8::bf16_t*)(c.ws + WS_W2), NEXP * EROWS, NEXP * 2048, 1024};
            SchedMoe S{c.G, c.bid, last ? 8 : 9, NEXP * (last ? 8 : 9) * 8};
            EpiY E{(bf16_t*)(c.ws + WS_RA + RA_YS), (const float*)(c.ws + WS_GATE)};
            pg8::gemm_phase<EpiY, SchedMoe, false>((PG8_LAS unsigned char*)c.lds, g, S, E, nullptr, c.tid);
        }
        PH_END;
        if (PH_ON) REP(17) { PH_CTX phase_final(c, l); }
        if (PH_ON) REP(18) { PH_CTX if (!last) convert_phase(c, l + 1); }
        PH_END;
    }
#ifdef MK_TPROBE_A
    if (c0.bid == (MK_TPROBE_WG) && threadIdx.x == 0) { const unsigned long long t0_ = __builtin_amdgcn_s_memrealtime(), w_ =
#ifdef MK_GSTAMP
        ((volatile LAS unsigned long long*)(lds_raw + LDS_BYTES - 48 - 80))[MK_GSTAMP] * (unsigned long long)(MK_TPROBE_MULT);
#else
        tp[MK_TPROBE_SEL] * (unsigned long long)(MK_TPROBE_MULT);
#endif
        while (__builtin_amdgcn_s_memrealtime() - t0_ < w_) __builtin_amdgcn_s_sleep(32); }
#endif
}

#ifdef MK_STOP
__global__ void digest_k(const unsigned* w0, size_t n0, const unsigned* w1, size_t n1, float* out, size_t nout) {
    for (size_t i = (size_t)blockIdx.x * blockDim.x + threadIdx.x; i < nout; i += (size_t)gridDim.x * blockDim.x) {
        unsigned h = 0u;
        for (size_t j = i; j < n0 + n1; j += nout) {
#ifdef MK_RW0
            const size_t rw = j < n0 ? (size_t)(MK_RW0) : (size_t)(MK_RW1); const size_t row = (j < n0 ? j : j - n0) / rw;
            if (row % 4352 < 256) continue;
#endif
#ifdef MK_NANCOUNT
            { const unsigned wv = (j < n0 ? w0[j] : w1[j - n0]);
#ifdef MK_BF16
              if ((wv & 0x7F800000u) == 0x7F800000u || (wv & 0x7F80u) == 0x7F80u) h += 1u; }
#else
              if ((wv & 0x7F800000u) == 0x7F800000u) h += 1u; }
#endif
#else
            h = h * 31u + (j < n0 ? w0[j] : w1[j - n0]);
#endif
        }
#ifdef MK_NANCOUNT
        out[i] = 1000.f * (float)h;
#else
        out[i] = (float)(h & 0xFFFFFu);
#endif
    }
}
#endif
extern "C" void kernel_launch(void* const* d_in, const int* in_sizes, int n_in, void* d_out, int out_size, void* d_ws, size_t ws_size, hipStream_t stream) {
    static int grid = 0;
    if (grid == 0) {
        if (n_in != 24 || ws_size < mk::WS_TOTAL) { fprintf(stderr, "kernel_launch: n_in %d ws %zu (need %zu)\n", n_in, ws_size, (size_t)mk::WS_TOTAL); grid = -1; return; }
        int dev = 0, cus = 0, per_cu = 0;
        if (hipGetDevice(&dev) != hipSuccess || hipDeviceGetAttribute(&cus, hipDeviceAttributeMultiprocessorCount, dev) != hipSuccess) { grid = -1; return; }
        if (hipFuncSetAttribute((const void*)mega_fwd, hipFuncAttributeMaxDynamicSharedMemorySize, LDS_BYTES) != hipSuccess) { fprintf(stderr, "kernel_launch: hipFuncSetAttribute failed\n"); grid = -1; return; }
        if (hipOccupancyMaxActiveBlocksPerMultiprocessor(&per_cu, (const void*)mega_fwd, 512, LDS_BYTES) != hipSuccess || per_cu < 1) fprintf(stderr, "kernel_launch: occupancy query says %d\n", per_cu);
        (void)hipGetLastError();
        grid = cus;
    }
    if (grid < 0) return;
    (void)hipMemsetAsync((char*)d_ws + mk::WS_BAR, 0, 16384, stream);
    Args a{};
    for (int i = 0; i < 24; ++i) a.in[i] = (const float*)d_in[i];
    a.out = (float*)d_out; a.ws = (unsigned char*)d_ws;
#if MK_N_LAUNCHES == 1
    a.ph_lo = 0; a.ph_hi = N_PHASES;
    hipLaunchKernelGGL(mega_fwd, dim3(grid), dim3(512), LDS_BYTES, stream, a);
#else
#ifdef MK_STOP
    for (int p = 0; p < MK_STOP; ++p) { a.ph_lo = p; a.ph_hi = p + 1; hipLaunchKernelGGL(mega_fwd, dim3(grid), dim3(512), LDS_BYTES, stream, a); }
    hipLaunchKernelGGL(digest_k, dim3(2048), dim3(256), 0, stream, (const unsigned*)((char*)d_ws + (size_t)(MK_D0)), (size_t)(MK_N0) / 4, (const unsigned*)((char*)d_ws + (size_t)(MK_D1)), (size_t)(MK_N1) / 4, (float*)d_out, (size_t)out_size);
#else
    for (int p = 0; p < N_PHASES; ++p) { a.ph_lo = p; a.ph_hi = p + 1; hipLaunchKernelGGL(mega_fwd, dim3(grid), dim3(512), LDS_BYTES, stream, a); }
#endif
#endif
}
```

```cpp
#include <hip/hip_runtime.h>
#include <cstdio>
#include <cstdint>
#ifndef MK_N_LAUNCHES
#define MK_N_LAUNCHES 1
#endif
namespace pg8 {
#define PG8_LAS __attribute__((address_space(3)))
typedef unsigned short bf16_t;
typedef short bf16x8 __attribute__((ext_vector_type(8)));
typedef float f32x4 __attribute__((ext_vector_type(4)));
typedef unsigned u32x4 __attribute__((ext_vector_type(4)));
constexpr int BM = 256, BK = 64, HALF = 128, HTB = HALF * BK * 2  , STAGE_BYTES = 8 * HTB, NXCD = 8, WGM = 8;

__host__ __device__ __forceinline__ int lds_byte(int r, int c) { const int st = (r >> 4) * 2 + (c >> 5), rr = r & 15, cc = c & 31, ob = rr * 64 + cc * 2; return st * 1024 + (ob ^ (((ob >> 9) & 1) << 5)); }
__host__ __device__ __forceinline__ void stage_rc(int b, int& R, int& C) { const int st = b / 1024, sb = b % 1024, swz = sb ^ (((sb >> 9) & 1) << 5); R = (st >> 1) * 16 + swz / 64; C = (st & 1) * 32 + (swz % 64) / 2; }
__host__ __device__ __forceinline__ int perm32(int rho) { const int n = rho >> 4, i = rho & 15; return 8 * (i >> 2) + 4 * n + (i & 3); }

struct Unit { int pm, pn; };
struct Gemm { const bf16_t* A; const bf16_t* Bt; int M, N, K; };

struct StaticOrder {
    int nM, nN, nwg, G, c;
    __host__ __device__ void init(int M, int N, int G_, int c_) { nM = M / BM; nN = N / BM; nwg = nM * nN; G = G_; c = c_; }
    __host__ __device__ bool next(int i, Unit& u) const {
        const long L = (long)i * G + c; if (L >= nwg) return false;
        int wgid = (int)L; { const int q = nwg / NXCD, r = nwg % NXCD, xcd = wgid % NXCD, off = wgid / NXCD; wgid = (xcd < r ? xcd * (q + 1) : r * (q + 1) + (xcd - r) * q) + off; }
        const int nig = WGM * nN, gid = wgid / nig, fm = gid * WGM, gsz = (nM - fm) < WGM ? (nM - fm) : WGM;
        u.pm = fm + ((wgid % nig) % gsz); u.pn = (wgid % nig) / gsz; return true;
    }
    __device__ __forceinline__ void a_ready(const Unit&) const {}
    __device__ __forceinline__ void done(const Unit&) const {}
};
struct CountedOrder : StaticOrder {
    const unsigned* ready; unsigned need; unsigned* tmo;
    __device__ __forceinline__ void a_ready(const Unit& u) const {
        if (threadIdx.x < 64) {
            const unsigned long long t0 = __builtin_amdgcn_s_memrealtime(); unsigned polls = 0;
            while ((unsigned)__builtin_amdgcn_readfirstlane(__hip_atomic_load(ready + 64 * u.pm, __ATOMIC_RELAXED, __HIP_MEMORY_SCOPE_AGENT)) < need) {
                if ((++polls & 255u) == 0u && __builtin_amdgcn_readfirstlane(__hip_atomic_load(tmo, __ATOMIC_RELAXED, __HIP_MEMORY_SCOPE_AGENT)) != 0u) break;
                if (__builtin_amdgcn_s_memrealtime() - t0 > 2000000ull) {
                    if (threadIdx.x == 0) { unsigned expect = 0u; __hip_atomic_compare_exchange_strong(tmo + 1, &expect, 0x600u | (unsigned)(u.pm & 0xff), __ATOMIC_RELAXED, __ATOMIC_RELAXED, __HIP_MEMORY_SCOPE_AGENT); __hip_atomic_store(tmo, 1u, __ATOMIC_RELAXED, __HIP_MEMORY_SCOPE_AGENT); }
                    break; }
                __builtin_amdgcn_s_sleep(2); }
            __builtin_amdgcn_fence(__ATOMIC_ACQUIRE, "agent");
            asm volatile("s_waitcnt vmcnt(0)" ::: "memory");
        }
#if !defined(BROKEN_HOOK_NO_BARRIER)
        asm volatile("" ::: "memory"); __builtin_amdgcn_s_barrier(); asm volatile("" ::: "memory");
#endif
    }
};

typedef float f32x2_cv __attribute__((ext_vector_type(2)));
typedef __bf16 bf16x2_cv __attribute__((ext_vector_type(2)));
__device__ __forceinline__ unsigned cvt_pk_bf16(float lo, float hi) { const bf16x2_cv v = __builtin_convertvector((f32x2_cv){lo, hi}, bf16x2_cv); return __builtin_bit_cast(unsigned, v); }
typedef float f32x2 __attribute__((ext_vector_type(2)));
__device__ __forceinline__ f32x2 gelu_pk(f32x2 v) {
    const f32x2 av = __builtin_elementwise_abs(v), d = av * 0.2316418882f + 1.0f;
    f32x2 t; t.x = __builtin_amdgcn_rcpf(d.x); t.y = __builtin_amdgcn_rcpf(d.y);
    f32x2 q = t * 0.5307027145f + (-0.7265760135f); q = q * t + 0.7107068705f; q = q * t + (-0.142248368f); q = q * t + 0.127414796f; q = q * t;
    const f32x2 s = (v * v) * (-0.72134752044f);
    f32x2 e; e.x = __builtin_amdgcn_exp2f(s.x); e.y = __builtin_amdgcn_exp2f(s.y);
    const f32x2 m = v * (q * e), r = v - m;
    f32x2 o; o.x = v.x < 0.f ? m.x : r.x; o.y = v.y < 0.f ? m.y : r.y; return o;
}

struct EpiF32 {
    static constexpr bool PERM = false, AFTER_DRAIN = false;
    float* C; int ldc; const float* bias;
    __device__ __forceinline__ void operator()(const f32x4 (&acc)[2][2][4][2], const Unit& u, int wr, int wc, int fr, int fq) const {
        const int row0 = u.pm * BM + wr * 64 + fr, col0 = u.pn * BM + wc * 32 + 4 * fq;
        f32x4 bv[2][2];
#pragma unroll
        for (int bj = 0; bj < 2; ++bj)
#pragma unroll
            for (int n = 0; n < 2; ++n) bv[bj][n] = bias ? *(const f32x4*)(bias + col0 + bj * HALF + n * 16) : (f32x4){0.f, 0.f, 0.f, 0.f};
#pragma unroll
        for (int ai = 0; ai < 2; ++ai)
#pragma unroll
            for (int m = 0; m < 4; ++m) { float* rowp = C + (size_t)(row0 + ai * HALF + m * 16) * ldc + col0;
#pragma unroll
                for (int bj = 0; bj < 2; ++bj)
#pragma unroll
                    for (int n = 0; n < 2; ++n) *(f32x4*)(rowp + bj * HALF + n * 16) = acc[ai][bj][m][n] + bv[bj][n]; }
    }
};
template <int ACT  > struct EpiBf16 {
    static constexpr bool PERM = true, AFTER_DRAIN = false;
    bf16_t* O; int ldc; const float* bias; int split_cols; size_t split_stride;
    __device__ __forceinline__ void operator()(const f32x4 (&acc)[2][2][4][2], const Unit& u, int wr, int wc, int fr, int fq) const {
        const int row0 = u.pm * BM + wr * 64 + fr; int colt = u.pn * BM; bf16_t* base = O;
        if (split_cols) { const int t = colt / split_cols; base += (size_t)t * split_stride; colt -= t * split_cols; }
        const int col0 = colt + wc * 32 + 8 * fq, bcol0 = u.pn * BM + wc * 32 + 8 * fq;
        f32x4 bv[2][2];
#pragma unroll
        for (int bj = 0; bj < 2; ++bj)
#pragma unroll
            for (int n = 0; n < 2; ++n) bv[bj][n] = bias ? *(const f32x4*)(bias + bcol0 + bj * HALF + 4 * n) : (f32x4){0.f, 0.f, 0.f, 0.f};
#pragma unroll
        for (int ai = 0; ai < 2; ++ai)
#pragma unroll
            for (int m = 0; m < 4; ++m) { bf16_t* rowp = base + (size_t)(row0 + ai * HALF + m * 16) * ldc + col0;
#pragma unroll
                for (int bj = 0; bj < 2; ++bj) { f32x4 v0 = acc[ai][bj][m][0] + bv[bj][0], v1 = acc[ai][bj][m][1] + bv[bj][1];
                    if (ACT == 1) { f32x2 a = gelu_pk((f32x2){v0[0], v0[1]}), b = gelu_pk((f32x2){v0[2], v0[3]}), c = gelu_pk((f32x2){v1[0], v1[1]}), d = gelu_pk((f32x2){v1[2], v1[3]});
                        v0 = (f32x4){a.x, a.y, b.x, b.y}; v1 = (f32x4){c.x, c.y, d.x, d.y}; }
                    if (ACT == 2) {
#pragma unroll
                        for (int j = 0; j < 4; ++j) { v0[j] = 0.5f * v0[j] * (1.0f + erff(v0[j] * 0.70710678f)); v1[j] = 0.5f * v1[j] * (1.0f + erff(v1[j] * 0.70710678f)); } }
                    u32x4 w; w.x = cvt_pk_bf16(v0[0], v0[1]); w.y = cvt_pk_bf16(v0[2], v0[3]); w.z = cvt_pk_bf16(v1[0], v1[1]); w.w = cvt_pk_bf16(v1[2], v1[3]);
                    *(u32x4*)(rowp + bj * HALF) = w; } }
    }
};

struct PanelStats {
    unsigned* xbuf;
    unsigned* cnt;
    unsigned* tmo;
    int ntn; float eps;
    unsigned code;
    __device__ __forceinline__ bool run(const f32x4 (&v)[2][2][4][2], const Unit& u, int wr, int wc, int fr, int fq, PG8_LAS unsigned char* lds, int wid, int lane) const {
        typedef float f32x2v __attribute__((ext_vector_type(2)));
        PG8_LAS f32x2v* P = (PG8_LAS f32x2v*)lds;
        PG8_LAS f32x2v* S = (PG8_LAS f32x2v*)(lds + 8192);
        PG8_LAS unsigned* flag = (PG8_LAS unsigned*)(lds + 8192 + 2048);
#pragma unroll
        for (int ai = 0; ai < 2; ++ai)
#pragma unroll
            for (int m = 0; m < 4; ++m) {
                float s = 0.f;
#pragma unroll
                for (int bj = 0; bj < 2; ++bj)
#pragma unroll
                    for (int n = 0; n < 2; ++n) { const f32x4 x = v[ai][bj][m][n]; s += (x[0] + x[1]) + (x[2] + x[3]); }
                s += __shfl_xor(s, 16); s += __shfl_xor(s, 32);
                const float mw = s * (1.0f / 64.0f); float q = 0.f;
#pragma unroll
                for (int bj = 0; bj < 2; ++bj)
#pragma unroll
                    for (int n = 0; n < 2; ++n) { const f32x4 d = v[ai][bj][m][n] - mw; q += (d[0] * d[0] + d[1] * d[1]) + (d[2] * d[2] + d[3] * d[3]); }
                q += __shfl_xor(q, 16); q += __shfl_xor(q, 32);
                if (fq == 0) P[(ai * HALF + wr * 64 + m * 16 + fr) * 4 + wc] = (f32x2v){mw, q};
            }
        asm volatile("s_waitcnt lgkmcnt(0)" ::: "memory"); __builtin_amdgcn_s_barrier(); asm volatile("" ::: "memory");
#if defined(BROKEN_NO_WAIT)
        if (blockIdx.x >= 64) { const long long t0 = clock64(); while (clock64() - t0 < 60000) __builtin_amdgcn_s_sleep(8); }
#endif
        const int row = wid * 32 + (lane & 31);
        if (lane < 32) {
            const f32x2v a = P[row * 4 + 0], b = P[row * 4 + 1], c = P[row * 4 + 2], d = P[row * 4 + 3];
            const float mt = (a.x + b.x + c.x + d.x) * 0.25f;
            const float da = a.x - mt, db = b.x - mt, dc = c.x - mt, dd = d.x - mt;
            const float m2 = (a.y + b.y) + (c.y + d.y) + 64.0f * ((da * da + db * db) + (dc * dc + dd * dd));
            unsigned long long* slot = (unsigned long long*)xbuf + ((size_t)(u.pm * BM + row) * 4 + u.pn);
            __hip_atomic_store(slot, ((unsigned long long)__float_as_uint(m2) << 32) | __float_as_uint(mt), __ATOMIC_RELAXED, __HIP_MEMORY_SCOPE_AGENT);
        }
        asm volatile("s_waitcnt vmcnt(0)" ::: "memory");
        if (lane == 0) __hip_atomic_fetch_add(cnt + 64 * u.pm, 1u, __ATOMIC_RELAXED, __HIP_MEMORY_SCOPE_AGENT);
        if (wid == 0) {
            bool dead = false; const unsigned long long t0 = __builtin_amdgcn_s_memrealtime(); const unsigned want = 8u * (unsigned)ntn;
            for (;;) {
#if defined(BROKEN_NO_WAIT)
                break;
#endif
                if ((unsigned)__builtin_amdgcn_readfirstlane(__hip_atomic_load(cnt + 64 * u.pm, __ATOMIC_RELAXED, __HIP_MEMORY_SCOPE_AGENT)) >= want) break;
                if (__builtin_amdgcn_s_memrealtime() - t0 > 2000000ull) {
                    if (lane == 0) { unsigned expect = 0u; __hip_atomic_compare_exchange_strong(tmo + 1, &expect, code | (unsigned)(u.pm & 0xff), __ATOMIC_RELAXED, __ATOMIC_RELAXED, __HIP_MEMORY_SCOPE_AGENT);
                                     __hip_atomic_store(tmo, 1u, __ATOMIC_RELAXED, __HIP_MEMORY_SCOPE_AGENT); }
                    dead = true; break; }
                __builtin_amdgcn_s_sleep(2);
            }
            __builtin_amdgcn_fence(__ATOMIC_ACQUIRE, "agent");
            if (lane == 0) flag[0] = dead ? 1u : 0u;
        }
        asm volatile("s_waitcnt vmcnt(0) lgkmcnt(0)" ::: "memory"); __builtin_amdgcn_s_barrier(); asm volatile("" ::: "memory");
        const bool bad = flag[0] != 0u;
        if (lane < 32) {
            const unsigned long long* slot = (const unsigned long long*)xbuf + (size_t)(u.pm * BM + row) * 4; float mt[4], m2[4]; float ms = 0.f;
#pragma unroll
            for (int t = 0; t < 4; ++t) { if (t < ntn) { const unsigned long long w = __hip_atomic_load(slot + t, __ATOMIC_RELAXED, __HIP_MEMORY_SCOPE_AGENT); mt[t] = __uint_as_float((unsigned)w); m2[t] = __uint_as_float((unsigned)(w >> 32)); } else { mt[t] = 0.f; m2[t] = 0.f; } ms += mt[t]; }
            const float mean = ms / (float)ntn; float q = 0.f;
#pragma unroll
            for (int t = 0; t < 4; ++t) if (t < ntn) { const float dm = mt[t] - mean; q += m2[t] + 256.0f * dm * dm; }
            S[row] = (f32x2v){mean, 1.0f / sqrtf(q / (256.0f * (float)ntn) + eps)};
        }
        asm volatile("s_waitcnt lgkmcnt(0)" ::: "memory"); __builtin_amdgcn_s_barrier(); asm volatile("" ::: "memory");
        return bad;
    }
};
struct EpiLnRes {
    static constexpr bool PERM = false, AFTER_DRAIN = true;
    const float* base; float* out; int ldc; const float* bias; PanelStats st; unsigned poison;
    __device__ __forceinline__ void refuse(size_t i0, size_t stride, int M, int N) const { const float q = __builtin_nanf(""); for (size_t i = i0; i < (size_t)M * N; i += stride) out[(i / N) * ldc + i % N] = q;
        if (i0 == 0) { unsigned expect = 0u; __hip_atomic_compare_exchange_strong(st.tmo + 1, &expect, 0x7f0u, __ATOMIC_RELAXED, __ATOMIC_RELAXED, __HIP_MEMORY_SCOPE_AGENT); __hip_atomic_store(st.tmo, 1u, __ATOMIC_RELAXED, __HIP_MEMORY_SCOPE_AGENT); } }
    __device__ __forceinline__ void fused(f32x4 (&acc)[2][2][4][2], const Unit& u, int wr, int wc, int fr, int fq, PG8_LAS unsigned char* lds, int wid, int lane) const {
        typedef float f32x2v __attribute__((ext_vector_type(2)));
        const PG8_LAS f32x2v* S = (const PG8_LAS f32x2v*)(lds + 8192);
        const int col0 = u.pn * BM + wc * 32 + 4 * fq;
#pragma unroll
        for (int bj = 0; bj < 2; ++bj)
#pragma unroll
            for (int n = 0; n < 2; ++n) { const f32x4 bv = bias ? *(const f32x4*)(bias + col0 + bj * HALF + n * 16) : (f32x4){0.f, 0.f, 0.f, 0.f};
#pragma unroll
                for (int ai = 0; ai < 2; ++ai)
#pragma unroll
                    for (int m = 0; m < 4; ++m) acc[ai][bj][m][n] += bv; }
        const bool bad = st.run(acc, u, wr, wc, fr, fq, lds, wid, lane) || poison != 0u;
        const float qnan = __builtin_nanf("");
#pragma unroll
        for (int ai = 0; ai < 2; ++ai)
#pragma unroll
            for (int m = 0; m < 4; ++m) { const int r = ai * HALF + wr * 64 + m * 16 + fr; const f32x2v sr = S[r]; const size_t off = (size_t)(u.pm * BM + r) * ldc + col0;
#pragma unroll
                for (int bj = 0; bj < 2; ++bj)
#pragma unroll
                    for (int n = 0; n < 2; ++n) { const f32x4 bs = *(const f32x4*)(base + off + bj * HALF + n * 16); f32x4 o = bs + (acc[ai][bj][m][n] - sr.x) * sr.y;
                        if (bad) o = (f32x4){qnan, qnan, qnan, qnan}; *(f32x4*)(out + off + bj * HALF + n * 16) = o; }
                asm volatile("" ::: "memory"); }
    }
};
struct EpiLnResLn {
    static constexpr bool PERM = false, AFTER_DRAIN = true;
    const float* base; float* out; bf16_t* xn; int ldc; const float* bias; PanelStats st1, st2; unsigned poison;
    __device__ __forceinline__ void refuse(size_t i0, size_t stride, int M, int N) const { const float q = __builtin_nanf(""); for (size_t i = i0; i < (size_t)M * N; i += stride) { const size_t o = (i / N) * ldc + i % N; out[o] = q; xn[o] = (bf16_t)0x7fc0u; }
        if (i0 == 0) { unsigned expect = 0u; __hip_atomic_compare_exchange_strong(st1.tmo + 1, &expect, 0x7f0u, __ATOMIC_RELAXED, __ATOMIC_RELAXED, __HIP_MEMORY_SCOPE_AGENT); __hip_atomic_store(st1.tmo, 1u, __ATOMIC_RELAXED, __HIP_MEMORY_SCOPE_AGENT); } }
    __device__ __forceinline__ void fused(f32x4 (&acc)[2][2][4][2], const Unit& u, int wr, int wc, int fr, int fq, PG8_LAS unsigned char* lds, int wid, int lane) const {
        typedef float f32x2v __attribute__((ext_vector_type(2))); typedef unsigned u32x2v __attribute__((ext_vector_type(2)));
        const PG8_LAS f32x2v* S = (const PG8_LAS f32x2v*)(lds + 8192);
        const int col0 = u.pn * BM + wc * 32 + 4 * fq;
#pragma unroll
        for (int bj = 0; bj < 2; ++bj)
#pragma unroll
            for (int n = 0; n < 2; ++n) { const f32x4 bv = bias ? *(const f32x4*)(bias + col0 + bj * HALF + n * 16) : (f32x4){0.f, 0.f, 0.f, 0.f};
#pragma unroll
                for (int ai = 0; ai < 2; ++ai)
#pragma unroll
                    for (int m = 0; m < 4; ++m) acc[ai][bj][m][n] += bv; }
        bool bad = st1.run(acc, u, wr, wc, fr, fq, lds, wid, lane) || poison != 0u;
        const float qnan = __builtin_nanf("");
#pragma unroll
        for (int ai = 0; ai < 2; ++ai)
#pragma unroll
            for (int m = 0; m < 4; ++m) { const int r = ai * HALF + wr * 64 + m * 16 + fr; const f32x2v sr = S[r]; const size_t off = (size_t)(u.pm * BM + r) * ldc + col0;
#pragma unroll
                for (int bj = 0; bj < 2; ++bj)
#pragma unroll
                    for (int n = 0; n < 2; ++n) { const f32x4 bs = *(const f32x4*)(base + off + bj * HALF + n * 16); acc[ai][bj][m][n] = bs + (acc[ai][bj][m][n] - sr.x) * sr.y; }
                asm volatile("" : "+v"(acc[ai][0][m][0]), "+v"(acc[ai][0][m][1]), "+v"(acc[ai][1][m][0]), "+v"(acc[ai][1][m][1]));
                if (m & 1) asm volatile("" ::: "memory"); }
        const bool bad1 = bad;
        bad = st2.run(acc, u, wr, wc, fr, fq, lds, wid, lane) || bad;
#pragma unroll
        for (int ai = 0; ai < 2; ++ai)
#pragma unroll
            for (int m = 0; m < 4; ++m) { const int r = ai * HALF + wr * 64 + m * 16 + fr; const f32x2v sr = S[r]; const size_t off = (size_t)(u.pm * BM + r) * ldc + col0;
#pragma unroll
                for (int bj = 0; bj < 2; ++bj)
#pragma unroll
                    for (int n = 0; n < 2; ++n) { const f32x4 x1 = acc[ai][bj][m][n]; *(f32x4*)(out + off + bj * HALF + n * 16) = bad1 ? (f32x4){qnan, qnan, qnan, qnan} : x1;
                        const f32x4 o = (x1 - sr.x) * sr.y; u32x2v w; w.x = cvt_pk_bf16(o[0], o[1]); w.y = cvt_pk_bf16(o[2], o[3]);
                        if (bad) { w.x = 0x7fc07fc0u; w.y = 0x7fc07fc0u; } *(u32x2v*)(xn + off + bj * HALF + n * 16) = w; }
                asm volatile("" ::: "memory"); }
    }
};

template <class Epi, class Sched, bool STAMP = false>
__device__ __forceinline__ void gemm_phase(PG8_LAS unsigned char* lds, const Gemm g, const Sched& S, const Epi& E, unsigned long long* stamps, int tid_in) {
    int tid_ = tid_in; asm volatile("" : "+v"(tid_));
    const int tid = tid_, wid = __builtin_amdgcn_readfirstlane(tid >> 6), lane = tid & 63, wr = wid >> 2, wc = wid & 3, fr = lane & 15, fq = lane >> 4;
    const int K = g.K, nt = K / BK;
    int ts_lo = 0, ts_hi = 0, nts = 0; const unsigned long long rt_entry = STAMP ? (unsigned long long)wall_clock64() : 0ull;
#define PG8_STAMP() do { if (STAMP && wid == 0 && nts < 64) { const unsigned long long _c = (unsigned long long)clock64(); \
        ts_lo = (lane == nts) ? (int)(unsigned)_c : ts_lo; ts_hi = (lane == nts) ? (int)(unsigned)(_c >> 32) : ts_hi; ++nts; } } while (0)
    PG8_STAMP();
    unsigned voffA[2], voffB[2];
#pragma unroll
    for (int i = 0; i < 2; ++i) { int R, C; stage_rc(tid * 16 + i * 8192, R, C); const int Rb = Epi::PERM ? ((R & ~31) + perm32(R & 31)) : R;
        voffA[i] = (unsigned)(R * K + C) * 2u; voffB[i] = (unsigned)(Rb * K + C) * 2u; }
    const size_t kstep = (size_t)(BK * 2);
    const size_t hstep = (size_t)HALF * K * 2;
    const size_t tstep = 2 * hstep;
    const unsigned ldsw = (unsigned)wid * 1024u;
    const int aoff = lds_byte(wr * 64 + fr, fq * 8), boff = lds_byte(wc * 32 + fr, fq * 8);
#define PG8_SA(b, h) (((b) * 2 + (h)) * HTB)
#define PG8_SB(b, h) ((4 + (b) * 2 + (h)) * HTB)
#define PG8_STAGE(bufoff, gbase, voff) do { _Pragma("unroll") for (int _i = 0; _i < 2; ++_i) \
        __builtin_amdgcn_global_load_lds((const unsigned*)((const char*)(gbase) + (voff)[_i]), (PG8_LAS unsigned*)(lds + (bufoff) + ldsw + _i * 8192), 16, 0, 0); } while (0)
#define PG8_LDA(dst, b, h) do { _Pragma("unroll") for (int m = 0; m < 4; ++m) _Pragma("unroll") for (int k = 0; k < 2; ++k) dst[m][k] = *(const PG8_LAS bf16x8*)(lds + PG8_SA(b, h) + aoff + m * 2048 + k * 1024); } while (0)
#define PG8_LDB(dst, b, h) do { _Pragma("unroll") for (int n = 0; n < 2; ++n) _Pragma("unroll") for (int k = 0; k < 2; ++k) dst[n][k] = *(const PG8_LAS bf16x8*)(lds + PG8_SB(b, h) + boff + n * 2048 + k * 1024); } while (0)
#define PG8_MMA(ai, bj, At, Bt) do { __builtin_amdgcn_s_setprio(1); _Pragma("unroll") for (int m = 0; m < 4; ++m) _Pragma("unroll") for (int n = 0; n < 2; ++n) _Pragma("unroll") for (int k = 0; k < 2; ++k) \
        acc[ai][bj][m][n] = __builtin_amdgcn_mfma_f32_16x16x32_bf16(Bt[n][k], At[m][k], acc[ai][bj][m][n], 0, 0, 0); __builtin_amdgcn_s_setprio(0); } while (0)
#define PG8_WAIT_V(n) asm volatile("s_waitcnt vmcnt(" #n ")" ::: "memory")
#define PG8_WAIT_L(n) asm volatile("s_waitcnt lgkmcnt(" #n ")" ::: "memory")
#define PG8_BAR __builtin_amdgcn_s_barrier()
#define PG8_SCHED __builtin_amdgcn_sched_barrier(0)
    Unit cur, nxt; int ui = 0;
    if (!S.next(0, cur)) return;
    f32x4 acc[2][2][4][2];
#pragma unroll
    for (int a = 0; a < 2; ++a)
#pragma unroll
        for (int b = 0; b < 2; ++b)
#pragma unroll
            for (int m = 0; m < 4; ++m)
#pragma unroll
                for (int n = 0; n < 2; ++n) acc[a][b][m][n] = (f32x4){0.f, 0.f, 0.f, 0.f};
    bf16x8 At[4][2], B0[2][2], B1[2][2];
    const char* cA = (const char*)g.A + (size_t)cur.pm * tstep; const char* cB = (const char*)g.Bt + (size_t)cur.pn * tstep;
    S.a_ready(cur);
    PG8_STAGE(PG8_SB(0, 0), cB, voffB); PG8_STAGE(PG8_SA(0, 0), cA, voffA); PG8_STAGE(PG8_SB(0, 1), cB + hstep, voffB); PG8_STAGE(PG8_SA(0, 1), cA + hstep, voffA);
    if (wr == 1) PG8_BAR;
    PG8_WAIT_V(4); PG8_BAR;
    PG8_STAGE(PG8_SB(1, 0), cB + kstep, voffB); PG8_STAGE(PG8_SA(1, 0), cA + kstep, voffA); PG8_STAGE(PG8_SB(1, 1), cB + hstep + kstep, voffB);
    PG8_WAIT_V(6); PG8_BAR;
    PG8_STAMP();
    for (;;) {
        const bool has_next = S.next(ui + 1, nxt);
        const char* nA = has_next ? (const char*)g.A + (size_t)nxt.pm * tstep : cA; const char* nB = has_next ? (const char*)g.Bt + (size_t)nxt.pn * tstep : cB;
        for (int t = 0; t < nt; t += 2) {
            const bool last = (t == nt - 2);
            const char* a1 = cA + (size_t)(t + 1) * kstep;
            const char* a2 = last ? nA : cA + (size_t)(t + 2) * kstep; const char* b2 = last ? nB : cB + (size_t)(t + 2) * kstep;
            const char* a3 = a2 + kstep; const char* b3 = b2 + kstep;
            if (last && has_next) S.a_ready(nxt);
            PG8_LDB(B0, 0, 0); PG8_SCHED; PG8_LDA(At, 0, 0); PG8_STAGE(PG8_SA(1, 1), a1 + hstep, voffA);
            PG8_WAIT_L(8); PG8_BAR; PG8_WAIT_L(0); PG8_MMA(0, 0, At, B0); PG8_BAR; PG8_SCHED;
            PG8_LDB(B1, 0, 1); PG8_STAGE(PG8_SB(0, 0), b2, voffB);
            PG8_BAR; PG8_WAIT_L(0); PG8_MMA(0, 1, At, B1); PG8_BAR;
            PG8_LDA(At, 0, 1); PG8_STAGE(PG8_SA(0, 0), a2, voffA);
            PG8_BAR; PG8_WAIT_L(0); PG8_MMA(1, 0, At, B0); PG8_BAR; PG8_SCHED;
            PG8_STAGE(PG8_SB(0, 1), b2 + hstep, voffB);
            PG8_WAIT_V(6); PG8_BAR; PG8_MMA(1, 1, At, B1); PG8_BAR;
            PG8_LDB(B0, 1, 0); PG8_SCHED; PG8_LDA(At, 1, 0); PG8_STAGE(PG8_SA(0, 1), a2 + hstep, voffA);
            PG8_WAIT_L(8); PG8_BAR; PG8_WAIT_L(0); PG8_MMA(0, 0, At, B0); PG8_BAR; PG8_SCHED;
            PG8_LDB(B1, 1, 1); PG8_STAGE(PG8_SB(1, 0), b3, voffB);
            PG8_BAR; PG8_WAIT_L(0); PG8_MMA(0, 1, At, B1); PG8_BAR;
            PG8_LDA(At, 1, 1); PG8_STAGE(PG8_SA(1, 0), a3, voffA);
            PG8_BAR; PG8_WAIT_L(0); PG8_MMA(1, 0, At, B0); PG8_BAR; PG8_SCHED;
            PG8_STAGE(PG8_SB(1, 1), b3 + hstep, voffB);
            PG8_WAIT_V(6); PG8_BAR; PG8_MMA(1, 1, At, B1); PG8_BAR;
        }
        PG8_STAMP();
        if constexpr (!Epi::AFTER_DRAIN) { E(acc, cur, wr, wc, fr, fq); S.done(cur); }
        PG8_STAMP();
        if (!has_next) break;
#pragma unroll
        for (int a = 0; a < 2; ++a)
#pragma unroll
            for (int b = 0; b < 2; ++b)
#pragma unroll
                for (int m = 0; m < 4; ++m)
#pragma unroll
                    for (int n = 0; n < 2; ++n) acc[a][b][m][n] = (f32x4){0.f, 0.f, 0.f, 0.f};
        cur = nxt; cA = nA; cB = nB; ++ui;
    }
    PG8_WAIT_V(0);
    if (wr == 0) PG8_BAR;
    PG8_BAR;
    if constexpr (Epi::AFTER_DRAIN) { E.fused(acc, cur, wr, wc, fr, fq, lds, wid, lane); S.done(cur); }
    PG8_STAMP();
    if (STAMP && wid == 0) { stamps[lane] = lane < nts ? (((unsigned long long)(unsigned)ts_hi << 32) | (unsigned)ts_lo) : 0ull;
        if (lane == 62) stamps[62] = rt_entry; if (lane == 63) stamps[63] = (unsigned long long)wall_clock64(); }
#undef PG8_STAMP
#undef PG8_SA
#undef PG8_SB
#undef PG8_STAGE
#undef PG8_LDA
#undef PG8_LDB
#undef PG8_MMA
#undef PG8_WAIT_V
#undef PG8_WAIT_L
#undef PG8_BAR
#undef PG8_SCHED
}
}
#define XB_TMO      128
#define XB_XCNT(j)  (256  + 64 * (j))
#define XB_XSUB(j)  (1280 + 64 * (j))
#define XB_XGEN(j)  (2304 + 64 * (j))
#define XB_TOP      3328
#define XB_TOPGEN   3392
#define XCD_BAR_WORDS 3456
#define XB_SPIN_CAP (1u << 18)
#define LAS __attribute__((address_space(3)))

__device__ __forceinline__ unsigned xb_ld(unsigned* p)              { return __hip_atomic_load(p, __ATOMIC_RELAXED, __HIP_MEMORY_SCOPE_AGENT); }
__device__ __forceinline__ unsigned xb_add(unsigned* p, unsigned v) { return __hip_atomic_fetch_add(p, v, __ATOMIC_RELAXED, __HIP_MEMORY_SCOPE_AGENT); }
__device__ __forceinline__ unsigned xb_xcc_id() { return (unsigned)__builtin_amdgcn_s_getreg((3 << 11) | 20) & 0xFu; }
#define XB_SPIN(cond, bar) do { unsigned _sp = 0; while (cond) { __builtin_amdgcn_s_sleep(1); \
    if ((++_sp & 255u) == 0u) { if (xb_ld(&(bar)[XB_TMO])) break; if (_sp > XB_SPIN_CAP) { atomicAdd(&(bar)[XB_TMO], 1u); break; } } } } while (0)

struct XcdBarrier {
    unsigned* bar; unsigned x;
    volatile LAS unsigned* st;
};

__device__ __forceinline__ XcdBarrier xcd_barrier_post(unsigned* bar, volatile LAS unsigned* st) {
    XcdBarrier b; b.bar = bar; b.x = xb_xcc_id(); b.st = st;
    if (threadIdx.x == 0) (void)xb_add(&bar[XB_XCNT(b.x)], 1u);
    return b;
}
__device__ __forceinline__ void xcd_barrier_complete(unsigned* bar, unsigned x, unsigned& nloc, unsigned& nx) {
    const unsigned G = gridDim.x * gridDim.y * gridDim.z;
    unsigned sum, cnt, mine, sp = 0u;
    for (;;) {
        sum = 0u; cnt = 0u; mine = 0u;
#pragma unroll
        for (unsigned j = 0; j < 16; ++j) { const unsigned c = xb_ld(&bar[XB_XCNT(j)]); sum += c; cnt += (c > 0u) ? 1u : 0u; mine = (j == x) ? c : mine; }
        if (sum == G) break;
        __builtin_amdgcn_s_sleep(1);
        if ((++sp & 255u) == 0u) { if (xb_ld(&bar[XB_TMO])) break; if (sp > XB_SPIN_CAP) { atomicAdd(&bar[XB_TMO], 1u); break; } }
    }
    nloc = mine > 0u ? mine : 1u; nx = cnt > 0u ? cnt : 1u;
}

__device__ __forceinline__ void xcd_barrier(const XcdBarrier& b) {
    asm volatile("s_waitcnt vmcnt(0)" ::: "memory");
    __syncthreads();
    if (threadIdx.x == 0) {
        unsigned* bar = b.bar;
        __builtin_amdgcn_s_waitcnt(0);
        unsigned nloc = b.st[0], nx = b.st[1];
        if (nloc == 0u) { xcd_barrier_complete(bar, b.x, nloc, nx); b.st[0] = nloc; b.st[1] = nx; }
        const unsigned old = xb_add(&bar[XB_XSUB(b.x)], 1u);
        const unsigned gen = old / nloc;
        if (old + 1u == (gen + 1u) * nloc) {
            __builtin_amdgcn_fence(__ATOMIC_RELEASE, "agent");
            asm volatile("s_waitcnt vmcnt(0)" ::: "memory");
            const unsigned og = xb_add(&bar[XB_TOP], 1u);
            const unsigned tg = og / nx;
            if (og + 1u == (tg + 1u) * nx) xb_add(&bar[XB_TOPGEN], 1u);
            else XB_SPIN(xb_ld(&bar[XB_TOPGEN]) == tg, bar);
            __builtin_amdgcn_fence(__ATOMIC_ACQUIRE, "agent");
            xb_add(&bar[XB_XGEN(b.x)], 1u);
            asm volatile("s_waitcnt vmcnt(0)" ::: "memory");
        } else {
            XB_SPIN(xb_ld(&bar[XB_XGEN(b.x)]) == gen, bar);
            __builtin_amdgcn_fence(__ATOMIC_ACQUIRE, "agent");
            asm volatile("s_waitcnt vmcnt(0)" ::: "memory");
        }
    }
    __syncthreads();
}

namespace mk {
typedef unsigned short bf16_t;
typedef short bf16x8 __attribute__((ext_vector_type(8)));
typedef float f32x4 __attribute__((ext_vector_type(4)));
typedef unsigned u32x2 __attribute__((ext_vector_type(2)));
typedef unsigned u32x4 __attribute__((ext_vector_type(4)));
#define LDSP __attribute__((address_space(3)))

constexpr int D = 2048, NB = 4, SEQ = 4096, DEPTH = 4, CTX = 256, T = CTX + SEQ, MROWS = NB * T;
constexpr int NIN = 7728, NINP = 7936, NCH = T / 64;
constexpr int C_AQ = 0, C_AK = 512, C_AV = 1024, C_AZ = 1536, C_ABETA = 2048, C_ADEC = 2056,
              C_BQ = 2064, C_BK = 2320, C_BV = 2576, C_BR = 3088, C_BCODE = 3600,
              C_CQ = 3632, C_CI = 4144, C_CG = 4656, C_CF = 5168, C_DQ = 6192, C_DK = 6704, C_DV = 7216;
constexpr int NEXP = 16, EROWS = 2304;
constexpr float ALPHA = 1.681792830507429f;
constexpr float LN_EPS = 1e-5f, NORM_EPS = 1e-6f;
constexpr int NCC = NB * 4 * 2 * NCH;

enum { I_X = 0, I_C, I_CTX, I_CCTX, I_WMOD, I_BMOD, I_WIN, I_WOUT, I_LNG, I_LNB, I_CONV, I_ALOG, I_DTB, I_GDNN, I_GLAW, I_GLAB, I_GLAN, I_HGAM, I_HGN, I_RPB, I_ROUT, I_W1, I_W3, I_W2 };

constexpr size_t WS_BAR = 0;
constexpr size_t WS_MODV = 16384;
constexpr size_t WS_AFF = WS_MODV + 983040;
constexpr size_t WS_INV = WS_AFF + 1114112;
constexpr size_t WS_IDX = WS_INV + 1114112;
constexpr size_t WS_GATE = WS_IDX + 147456;
constexpr size_t WS_WIN = WS_GATE + 147456;
constexpr size_t WS_WOUT = WS_WIN + 32505856;
constexpr size_t WS_W13 = WS_WOUT + 8388608;
constexpr size_t WS_W2 = WS_W13 + 134217728;
constexpr size_t WS_X = WS_W2 + 67108864;
constexpr size_t WS_X1 = WS_X + 142606336;
constexpr size_t WS_U = WS_X1 + 142606336;
constexpr size_t WS_MIX = WS_U + 71303168;
constexpr size_t WS_RA = WS_MIX + 71303168;
constexpr size_t RA_PROJ = 0;
constexpr size_t RA_GM = RA_PROJ + 276299776;
constexpr size_t RA_GB = RA_GM + 71303168;
constexpr size_t RA_GQ = RA_GB + 71303168;
constexpr size_t RA_GO = RA_GQ + 35651584;
constexpr size_t RA_HB = RA_GO + 35651584;
constexpr size_t RA_HQ = RA_HB + 71303168;
constexpr size_t RA_HO = RA_HQ + 35651584;
constexpr size_t RA_HA = RA_HO + 35651584;
constexpr size_t RA_LB = RA_HA + 1114112;
constexpr size_t RA_LQ = RA_LB + 35651584;
constexpr size_t RA_LO = RA_LQ + 17825792;
constexpr size_t RA_LA = RA_LO + 35651584;
constexpr size_t RA_OB = RA_LA + 557056;
constexpr size_t RA_END = RA_OB + 106954752;
constexpr size_t RA_TBUF = 0;
constexpr size_t RA_XS = 142606336;
constexpr size_t RA_HID = RA_XS + 150994944;
constexpr size_t RA_YS = RA_HID + 75497472;
constexpr size_t WS_TOTAL = WS_RA + RA_END;
static_assert(RA_YS + 150994944 <= RA_END, "region A");

struct Ctx {
    const float* in[24]; float* out; unsigned char* ws;
    LDSP unsigned char* lds; int tid, lane, wave, G, bid;
};

__device__ __forceinline__ float bf2f(unsigned b) { return __uint_as_float(b << 16); }
__device__ __forceinline__ float bflo(unsigned u) { return __uint_as_float(u << 16); }
__device__ __forceinline__ float bfhi(unsigned u) { return __uint_as_float(u & 0xffff0000u); }
__device__ __forceinline__ unsigned pk2(float lo, float hi) { return pg8::cvt_pk_bf16(lo, hi); }
__device__ __forceinline__ bf16_t f2bf(float x) { return (bf16_t)(pk2(x, 0.f) & 0xffffu); }
__device__ __forceinline__ float sigmoidf_(float x) { return 1.f / (1.f + __expf(-x)); }
__device__ __forceinline__ float siluf_(float x) { return x / (1.f + __expf(-x)); }
__device__ __forceinline__ float softplusf_(float x) { return x > 20.f ? x : log1pf(__expf(x)); }
__device__ __forceinline__ float wsum(float v) {
#pragma unroll
    for (int m = 32; m >= 1; m >>= 1) v += __shfl_xor(v, m);
    return v;
}

template <int KS>
__device__ __forceinline__ f32x4 mma_tile(const LDSP bf16_t* a, int lda, const LDSP bf16_t* b, int ldb, f32x4 acc, int lane) {
    const int r = lane & 15, q = lane >> 4;
#pragma unroll
    for (int kk = 0; kk < KS; ++kk) {
        const bf16x8 af = *(const LDSP bf16x8*)(a + r * lda + kk * 32 + q * 8);
        const bf16x8 bf = *(const LDSP bf16x8*)(b + r * ldb + kk * 32 + q * 8);
        acc = __builtin_amdgcn_mfma_f32_16x16x32_bf16(af, bf, acc, 0, 0, 0);
    }
    return acc;
}
typedef short s16x4 __attribute__((ext_vector_type(4)));
__device__ __forceinline__ bf16x8 frag_tr16(const LDSP bf16_t* base, int ld, int lane) {
    const int g = lane >> 4, i = lane & 15;
    const LDSP bf16_t* p = base + (8 * g + (i >> 2)) * ld + 4 * (i & 3);
    const s16x4 lo = __builtin_amdgcn_ds_read_tr16_b64_v4i16((LDSP s16x4*)p);
    const s16x4 hi = __builtin_amdgcn_ds_read_tr16_b64_v4i16((LDSP s16x4*)(p + 4 * ld));
    return (bf16x8){lo[0], lo[1], lo[2], lo[3], hi[0], hi[1], hi[2], hi[3]};
}
__device__ __forceinline__ u32x2 pack4(f32x4 v) { u32x2 o; o.x = pk2(v[0], v[1]); o.y = pk2(v[2], v[3]); return o; }

__device__ __forceinline__ int tok_of(int n, int dir, int i) { return n * 64 + (dir ? 63 - i : i); }

__device__ __forceinline__ void modv_fill_s(const Ctx& c) {
    LDSP float* s = (LDSP float*)c.lds;
    for (int i = c.tid; i < 5 * 2048; i += 512) {
        const int r = i >> 11, k = i & 2047;
        const float v = r < 4 ? c.in[I_C][r * 2048 + k] : c.in[I_CCTX][k];
        s[i] = siluf_(v);
    }
    __syncthreads();
}
__device__ __forceinline__ void modv_unit(const Ctx& c, int unit) {
    const int l = unit / 48, cb = unit % 48;
    LDSP float* s = (LDSP float*)c.lds;
    LDSP float* red = s + 5 * 2048;
    const float* W = c.in[I_WMOD] + (size_t)l * 2048 * 12288 + cb * 256 + c.lane * 4;
    const int k0 = c.wave * 256;
    f32x4 acc[5];
#pragma unroll
    for (int r = 0; r < 5; ++r) acc[r] = (f32x4){0.f, 0.f, 0.f, 0.f};
#pragma unroll 8
    for (int k = 0; k < 256; ++k) {
        const f32x4 w = *(const f32x4*)(W + (size_t)(k0 + k) * 12288);
#pragma unroll
        for (int r = 0; r < 5; ++r) { const float sv = s[r * 2048 + k0 + k]; acc[r] += w * sv; }
    }
#pragma unroll
    for (int r = 0; r < 5; ++r) *(LDSP f32x4*)(red + (c.wave * 5 + r) * 256 + c.lane * 4) = acc[r];
    __syncthreads();
    float* modv = (float*)(c.ws + WS_MODV);
    for (int o = c.tid; o < 5 * 256; o += 512) {
        const int r = o >> 8, col = o & 255;
        float sum = 0.f;
#pragma unroll
        for (int w = 0; w < 8; ++w) sum += red[(w * 5 + r) * 256 + col];
        modv[(size_t)(l * 5 + r) * 12288 + cb * 256 + col] = sum + c.in[I_BMOD][l * 12288 + cb * 256 + col];
    }
    __syncthreads();
}

struct CJob { const float* src; bf16_t* dst; int ldsrc, lddst, nvalid; };
constexpr int CONV_JOBS = 992 + 256 + 3 * 2048;
__device__ __forceinline__ CJob conv_desc(const Ctx& c, int l, int job) {
    CJob d;
    if (job < 992) {
        const int kt = job & 15, nt = job >> 4;
        d.src = c.in[I_WIN] + (size_t)l * 2048 * NIN + (size_t)kt * 128 * NIN + nt * 128; d.ldsrc = NIN; d.nvalid = NIN - nt * 128;
        d.dst = (bf16_t*)(c.ws + WS_WIN) + (size_t)nt * 128 * 2048 + kt * 128; d.lddst = 2048;
    } else if (job < 1248) {
        const int j = job - 992, kt = j & 15, nt = j >> 4;
        d.src = c.in[I_WOUT] + (size_t)l * 2048 * 2048 + (size_t)kt * 128 * 2048 + nt * 128; d.ldsrc = 2048; d.nvalid = 128;
        d.dst = (bf16_t*)(c.ws + WS_WOUT) + (size_t)nt * 128 * 2048 + kt * 128; d.lddst = 2048;
    } else if (job < 1248 + 4096) {
        const int j = job - 1248, which = j >> 11, jj = j & 2047, e = jj >> 7, rem = jj & 127, kt = rem & 15, nt = rem >> 4;
        d.src = c.in[which ? I_W3 : I_W1] + ((size_t)(l * 16 + e) * 2048 + (size_t)kt * 128) * 1024 + nt * 128; d.ldsrc = 1024; d.nvalid = 128;
        d.dst = (bf16_t*)(c.ws + WS_W13) + ((size_t)e * 2048 + nt * 256 + which * 128) * 2048 + kt * 128; d.lddst = 2048;
    } else {
        const int j = job - 1248 - 4096, e = j >> 7, rem = j & 127, kt = rem & 7, nt = rem >> 3;
        d.src = c.in[I_W2] + ((size_t)(l * 16 + e) * 1024 + (size_t)kt * 128) * 2048 + nt * 128; d.ldsrc = 2048; d.nvalid = 128;
        d.dst = (bf16_t*)(c.ws + WS_W2) + ((size_t)e * 2048 + nt * 128) * 1024 + kt * 128; d.lddst = 1024;
    }
    return d;
}
__device__ __forceinline__ void convert_phase(const Ctx& c, int l) {
    LDSP unsigned* Tb = (LDSP unsigned*)c.lds;
    const int n4 = c.tid & 31, kr = c.tid >> 5;
    int job = c.bid, buf = 0;
    if (job >= CONV_JOBS) return;
    CJob cur = conv_desc(c, l, job), nxt = cur;
    f32x4 v[8];
#pragma unroll
    for (int p = 0; p < 4; ++p)
#pragma unroll
        for (int hh = 0; hh < 2; ++hh) v[2 * p + hh] = (4 * n4 < cur.nvalid) ? *(const f32x4*)(cur.src + (size_t)(32 * p + 2 * kr + hh) * cur.ldsrc + 4 * n4) : (f32x4){0.f, 0.f, 0.f, 0.f};
    for (; job < CONV_JOBS; job += c.G) {
        LDSP unsigned* Tt = Tb + buf * (128 * 65);
#pragma unroll
        for (int p = 0; p < 4; ++p)
#pragma unroll
            for (int i = 0; i < 4; ++i) Tt[(4 * n4 + i) * 65 + 16 * p + kr] = pk2(v[2 * p][i], v[2 * p + 1][i]);
        const int nj = job + c.G;
        if (nj < CONV_JOBS) {
            nxt = conv_desc(c, l, nj);
#pragma unroll
            for (int p = 0; p < 4; ++p)
#pragma unroll
                for (int hh = 0; hh < 2; ++hh) v[2 * p + hh] = (4 * n4 < nxt.nvalid) ? *(const f32x4*)(nxt.src + (size_t)(32 * p + 2 * kr + hh) * nxt.ldsrc + 4 * n4) : (f32x4){0.f, 0.f, 0.f, 0.f};
        }
        __syncthreads();
#pragma unroll
        for (int q = 0; q < 4; ++q) {
            const int id = q * 512 + c.tid, n = id >> 4, kq = id & 15;
            const u32x4 o = (u32x4){Tt[n * 65 + 4 * kq], Tt[n * 65 + 4 * kq + 1], Tt[n * 65 + 4 * kq + 2], Tt[n * 65 + 4 * kq + 3]};
            *(u32x4*)(cur.dst + (size_t)n * cur.lddst + kq * 8) = o;
        }
        cur = nxt; buf ^= 1;
    }
    __syncthreads();
}

__device__ __forceinline__ void row_stats(const f32x4 (&v)[8], float& mu, float& rstd) {
    float s = 0.f;
#pragma unroll
    for (int j = 0; j < 8; ++j) s += v[j][0] + v[j][1] + v[j][2] + v[j][3];
    mu = wsum(s) * (1.f / 2048.f);
    float q = 0.f;
#pragma unroll
    for (int j = 0; j < 8; ++j) { const f32x4 d = v[j] - mu; q += d[0] * d[0] + d[1] * d[1] + d[2] * d[2] + d[3] * d[3]; }
    rstd = rsqrtf(wsum(q) * (1.f / 2048.f) + LN_EPS);
}
__device__ __forceinline__ void modulate_store(const f32x4 (&v)[8], const float* shift, const float* scale, bf16_t* urow, int lane) {
    float mu, rstd; row_stats(v, mu, rstd);
#pragma unroll
    for (int j = 0; j < 8; ++j) {
        const int col = 256 * j + 4 * lane;
        const f32x4 sh = *(const f32x4*)(shift + col), sc = *(const f32x4*)(scale + col);
        const f32x4 y = (v[j] - mu) * rstd * (sc + 1.f) + sh;
        *(u32x2*)(urow + col) = pack4(y);
    }
}
__device__ __forceinline__ void phase_l0_modulate(const Ctx& c) {
    const float* modv = (const float*)(c.ws + WS_MODV);
    float* X = (float*)(c.ws + WS_X); bf16_t* U = (bf16_t*)(c.ws + WS_U);
    for (int row = c.bid * 8 + c.wave; row < MROWS; row += c.G * 8) {
        const int b = row / T, t = row % T;
        const float* src = t < CTX ? c.in[I_CTX] + ((size_t)b * CTX + t) * D : c.in[I_X] + ((size_t)b * SEQ + (t - CTX)) * D;
        const int r = t < CTX ? 4 : b;
        f32x4 v[8];
#pragma unroll
        for (int j = 0; j < 8; ++j) v[j] = *(const f32x4*)(src + 256 * j + 4 * c.lane);
#pragma unroll
        for (int j = 0; j < 8; ++j) *(f32x4*)(X + (size_t)row * D + 256 * j + 4 * c.lane) = v[j];
        modulate_store(v, modv + (size_t)(0 * 5 + r) * 12288, modv + (size_t)(0 * 5 + r) * 12288 + 2048, U + (size_t)row * D, c.lane);
    }
}

constexpr int GP_RAW = 0;
constexpr int GP_UT = 0;
constexpr int GP_WT = 18432;
constexpr int GP_A = 36864;
constexpr int GP_AP = 65;
constexpr int GP_TB = 53504;
constexpr int GP_CW = 53312;
constexpr int GP_Q = GP_CW + 7680;
constexpr int GP_K = GP_Q + 17408;
constexpr int GP_V = GP_K + 17408;
constexpr int GP_KDT = GP_V + 17408;
constexpr int GP_P = GP_KDT + 18432;
constexpr int GP_SM = GP_P + 9216;
constexpr int GP_END = GP_SM + 1024;
static_assert(GP_END <= 160 * 1024, "gdn prep lds");

#ifdef MK_GSTAMP
#define GST(k) do { if (c.bid == 0 && tid == 0) { const unsigned long long t_ = __builtin_amdgcn_s_memrealtime(); gst[k] += t_ - gst[8]; gst[8] = t_; } } while (0)
#else
#define GST(k)
#endif
__device__ __forceinline__ void gdn_prep_unit(const Ctx& c, int l, int cc) {
    const int n = cc % NCH, dir = (cc / NCH) & 1, h = (cc / (NCH * 2)) & 3, b = cc / (NCH * 8);
    int tid_ = c.tid; asm volatile("" : "+v"(tid_));
    const int tid = tid_, lane = tid_ & 63, wave = c.wave;
    LDSP unsigned char* L = c.lds;
    LDSP bf16_t* raw = (LDSP bf16_t*)(L + GP_RAW);
    LDSP float* cw = (LDSP float*)(L + GP_CW);
    LDSP bf16_t* Qs = (LDSP bf16_t*)(L + GP_Q);
    LDSP bf16_t* Ks = (LDSP bf16_t*)(L + GP_K);
    LDSP bf16_t* Vs = (LDSP bf16_t*)(L + GP_V);
    LDSP bf16_t* KdT = (LDSP bf16_t*)(L + GP_KDT);
    LDSP bf16_t* Pm = (LDSP bf16_t*)(L + GP_P);
    LDSP bf16_t* UT = (LDSP bf16_t*)(L + GP_UT);
    LDSP bf16_t* WT = (LDSP bf16_t*)(L + GP_WT);
    LDSP float* Am = (LDSP float*)(L + GP_A);
    LDSP float* sm = (LDSP float*)(L + GP_SM);
    const bf16_t* proj = (const bf16_t*)(c.ws + WS_RA + RA_PROJ);
    const int seg0 = n < 4 ? 0 : CTX, seg1 = n < 4 ? CTX : T;
    const size_t rowb = (size_t)b * T;
#ifdef MK_GSTAMP
    volatile LDSP unsigned long long* gst = (volatile LDSP unsigned long long*)(c.lds + 147456 - 48 - 80);
    if (c.bid == 0 && tid == 0) gst[8] = __builtin_amdgcn_s_memrealtime();
#endif

    for (int ch = tid; ch < 68 * 48; ch += 512) {
        const int rr = ch / 48, c16 = ch % 48, part = c16 >> 4, d8 = c16 & 15;
        const int t = n * 64 - 2 + rr;
        u32x4 v = (u32x4){0u, 0u, 0u, 0u};
        if (t >= seg0 && t < seg1) v = *(const u32x4*)(proj + (rowb + t) * NINP + part * 512 + h * 128 + d8 * 8);
        *(LDSP u32x4*)(raw + rr * 392 + part * 128 + d8 * 8) = v;
    }
    for (int i = tid; i < 5 * 384; i += 512) {
        const int j = i / 384, cidx = i % 384, part = cidx >> 7, d = cidx & 127;
        cw[i] = c.in[I_CONV][(size_t)(l * 5 + j) * 1536 + part * 512 + h * 128 + d];
    }
    if (wave == 0) {
        const int t = tok_of(n, dir, lane);
        const bf16_t* pr = proj + (rowb + t) * NINP;
        const float beta = sigmoidf_(bf2f(pr[C_ABETA + dir * 4 + h]));
        const float la = -__expf(c.in[I_ALOG][l * 8 + dir * 4 + h]) * softplusf_(bf2f(pr[C_ADEC + dir * 4 + h]) + c.in[I_DTB][l * 8 + dir * 4 + h]);
        float g = la;
#pragma unroll
        for (int m = 1; m < 64; m <<= 1) { const float o = __shfl_up(g, m); if (lane >= m) g += o; }
        const float gend = __shfl(g, 63);
        sm[lane] = g; sm[64 + lane] = beta; sm[128 + lane] = __expf(g); sm[192 + lane] = __expf(gend - g);
    }
    __syncthreads();
    GST(0);
    {
        const int i = tid >> 3, gq = tid & 7;
        const int rc = (dir ? 63 - i : i) + 2;
#pragma unroll
        for (int part = 0; part < 3; ++part) {
            float a[16];
#pragma unroll
            for (int e = 0; e < 16; ++e) a[e] = 0.f;
#pragma unroll
            for (int j = 0; j < 5; ++j) {
                const LDSP bf16_t* rp = raw + (rc - 2 + j) * 392 + part * 128 + gq * 16;
                const LDSP float* wp = cw + j * 384 + part * 128 + gq * 16;
#pragma unroll
                for (int hf = 0; hf < 2; ++hf) {
                    const u32x4 r4 = *(const LDSP u32x4*)(rp + hf * 8);
                    const f32x4 w0 = *(const LDSP f32x4*)(wp + hf * 8), w1 = *(const LDSP f32x4*)(wp + hf * 8 + 4);
                    a[hf * 8 + 0] += bflo(r4[0]) * w0[0]; a[hf * 8 + 1] += bfhi(r4[0]) * w0[1]; a[hf * 8 + 2] += bflo(r4[1]) * w0[2]; a[hf * 8 + 3] += bfhi(r4[1]) * w0[3];
                    a[hf * 8 + 4] += bflo(r4[2]) * w1[0]; a[hf * 8 + 5] += bfhi(r4[2]) * w1[1]; a[hf * 8 + 6] += bflo(r4[3]) * w1[2]; a[hf * 8 + 7] += bfhi(r4[3]) * w1[3];
                }
            }
            float ss = 0.f;
#pragma unroll
            for (int e = 0; e < 16; ++e) { a[e] = siluf_(a[e]); ss += a[e] * a[e]; }
            float sc = 1.f;
            if (part < 2) {
#pragma unroll
                for (int m = 1; m < 8; m <<= 1) ss += __shfl_xor(ss, m);
                sc = rsqrtf(ss + NORM_EPS) * (part == 0 ? 0.08838834764831845f : 1.f);
            }
            LDSP bf16_t* dq = (part == 0 ? Qs : part == 1 ? Ks : Vs) + i * 136 + gq * 16;
            *(LDSP u32x4*)dq = (u32x4){pk2(a[0] * sc, a[1] * sc), pk2(a[2] * sc, a[3] * sc), pk2(a[4] * sc, a[5] * sc), pk2(a[6] * sc, a[7] * sc)};
            *(LDSP u32x4*)(dq + 8) = (u32x4){pk2(a[8] * sc, a[9] * sc), pk2(a[10] * sc, a[11] * sc), pk2(a[12] * sc, a[13] * sc), pk2(a[14] * sc, a[15] * sc)};
            asm volatile("" ::: "memory");
        }
    }
    __syncthreads();
    GST(1);
#pragma unroll
    for (int p = 0; p < 2; ++p) {
        const int id = p * 512 + tid, d = id & 127, i0 = (id >> 7) * 8;
        unsigned w[4];
#pragma unroll
        for (int e = 0; e < 8; e += 2) w[e >> 1] = pk2(bf2f(Ks[(i0 + e) * 136 + d]) * sm[192 + i0 + e], bf2f(Ks[(i0 + e + 1) * 136 + d]) * sm[192 + i0 + e + 1]);
        *(LDSP u32x4*)(KdT + d * 72 + i0) = (u32x4){w[0], w[1], w[2], w[3]};
    }
#pragma unroll
    for (int tt = 0; tt < 4; ++tt) {
        const int id = wave * 4 + tt, which = id >> 4, ti = (id & 15) >> 2, tj = id & 3;
        const int r = lane & 15, q4 = lane >> 4;
        if (which == 0) {
            if (tj <= ti) {
                f32x4 a = mma_tile<4>(Ks + ti * 16 * 136, 136, Ks + tj * 16 * 136, 136, (f32x4){0.f, 0.f, 0.f, 0.f}, lane);
                const int j = tj * 16 + r; const float gj = sm[j];
#pragma unroll
                for (int e = 0; e < 4; ++e) { const int i = ti * 16 + q4 * 4 + e; Am[i * GP_AP + j] = (i > j) ? sm[64 + i] * a[e] * __expf(sm[i] - gj) : 0.f; }
            }
        } else {
            f32x4 o = (f32x4){0.f, 0.f, 0.f, 0.f};
            if (tj <= ti) {
                const f32x4 a = mma_tile<4>(Ks + tj * 16 * 136, 136, Qs + ti * 16 * 136, 136, (f32x4){0.f, 0.f, 0.f, 0.f}, lane);
                const int i = ti * 16 + r; const float gi = sm[i];
#pragma unroll
                for (int e = 0; e < 4; ++e) { const int j = tj * 16 + q4 * 4 + e; o[e] = (i >= j) ? a[e] * __expf(gi - sm[j]) : 0.f; }
            }
            *(LDSP u32x2*)(Pm + (ti * 16 + r) * 72 + tj * 16 + q4 * 4) = pack4(o);
        }
    }
    __syncthreads();
    GST(2);
    {
        LDSP float* TB = (LDSP float*)(L + GP_TB);
        const int r = lane & 15, q4 = lane >> 4;
        if (wave == 0) {
            const int I = lane >> 4, cidx = lane & 15;
            float x[16];
#pragma unroll
            for (int i = 0; i < 16; ++i) {
                float v = (i == cidx) ? 1.f : 0.f;
#pragma unroll
                for (int j = 0; j < i; ++j) v -= Am[(16 * I + i) * GP_AP + 16 * I + j] * x[j];
                x[i] = v;
            }
#pragma unroll
            for (int i = 0; i < 16; ++i) TB[(I * 16 + i) * 16 + cidx] = x[i];
        }
        f32x4 acc[4][2];
        const LDSP bf16_t* src = wave < 4 ? Vs : Ks;
        const int cb = (wave & 3) * 32;
#pragma unroll
        for (int I = 0; I < 4; ++I)
#pragma unroll
            for (int t = 0; t < 2; ++t)
#pragma unroll
                for (int e = 0; e < 4; ++e) {
                    const int row = 16 * I + 4 * q4 + e;
                    acc[I][t][e] = sm[64 + row] * bf2f(src[row * 136 + cb + 16 * t + r]) * (wave < 4 ? 1.f : sm[128 + row]);
                }
        __syncthreads();
        LDSP bf16_t* dstp = wave < 4 ? UT : WT;
#pragma unroll
        for (int I = 0; I < 4; ++I) {
            f32x4 x[2] = {(f32x4){0.f, 0.f, 0.f, 0.f}, (f32x4){0.f, 0.f, 0.f, 0.f}};
#pragma unroll
            for (int s4 = 0; s4 < 4; ++s4) {
                const float a = TB[(I * 16 + r) * 16 + 4 * q4 + s4];
#pragma unroll
                for (int t = 0; t < 2; ++t) x[t] = __builtin_amdgcn_mfma_f32_16x16x4f32(a, acc[I][t][s4], x[t], 0, 0, 0);
            }
#pragma unroll
            for (int Ip = I + 1; Ip < 4; ++Ip)
#pragma unroll
                for (int s4 = 0; s4 < 4; ++s4) {
                    const float a = -Am[(16 * Ip + r) * GP_AP + 16 * I + 4 * q4 + s4];
#pragma unroll
                    for (int t = 0; t < 2; ++t) acc[Ip][t] = __builtin_amdgcn_mfma_f32_16x16x4f32(a, x[t][s4], acc[Ip][t], 0, 0, 0);
                }
#pragma unroll
            for (int t = 0; t < 2; ++t) *(LDSP u32x2*)(dstp + (cb + 16 * t + r) * 72 + 16 * I + 4 * q4) = pack4(x[t]);
        }
    }
    __syncthreads();
    GST(3);
    {
        const size_t cs = (size_t)n * 32 + cc / NCH;
        bf16_t* Mg = (bf16_t*)(c.ws + WS_RA + RA_GM) + cs * 16384;
        bf16_t* Bg = (bf16_t*)(c.ws + WS_RA + RA_GB) + cs * 16384;
        bf16_t* Qg = (bf16_t*)(c.ws + WS_RA + RA_GQ) + cs * 8192;
        bf16_t* Og = (bf16_t*)(c.ws + WS_RA + RA_GO) + cs * 8192;
        const float ge = sm[128 + 63];
        const int r = lane & 15, q4 = lane >> 4;
        const f32x4 z = (f32x4){0.f, 0.f, 0.f, 0.f};
        for (int id = wave; id < 192; id += 8) {
            if (id < 32) {
                const int td = id >> 2, ti = id & 3;
                const f32x4 a = mma_tile<2>(WT + td * 16 * 72, 72, Pm + ti * 16 * 72, 72, z, lane);
                const int i = ti * 16 + r, d0 = td * 16 + q4 * 4; const float egi = sm[128 + i];
                f32x4 o;
#pragma unroll
                for (int e = 0; e < 4; ++e) o[e] = bf2f(Qs[i * 136 + d0 + e]) * egi - a[e];
                *(u32x2*)(Qg + (((ti * 4 + (td >> 1)) * 4 + ((2 * td + (q4 >> 1)) & 3)) * 16 + r) * 8 + 4 * (q4 & 1)) = pack4(o);
            } else if (id < 64) {
                const int td = (id - 32) >> 2, ti = id & 3;
                const f32x4 a = mma_tile<2>(UT + td * 16 * 72, 72, Pm + ti * 16 * 72, 72, z, lane);
                *(u32x2*)(Og + ((ti * 8 + td) * 64 + lane) * 4) = pack4(a);
            } else if (id < 128) {
                const int tc = (id - 64) >> 3, tr = id & 7;
                const f32x4 a = mma_tile<2>(WT + tc * 16 * 72, 72, KdT + tr * 16 * 72, 72, z, lane);
                const int dk = tr * 16 + r, d0 = tc * 16 + q4 * 4;
                f32x4 o;
#pragma unroll
                for (int e = 0; e < 4; ++e) o[e] = ((dk == d0 + e) ? ge : 0.f) - a[e];
                *(u32x2*)(Mg + (((tr * 4 + (tc >> 1)) * 4 + ((2 * tc + (q4 >> 1)) & 3)) * 16 + r) * 8 + 4 * (q4 & 1)) = pack4(o);
            } else {
                const int tr = (id - 128) >> 3, tc = id & 7;
                const f32x4 a = mma_tile<2>(KdT + tr * 16 * 72, 72, UT + tc * 16 * 72, 72, z, lane);
                *(u32x2*)(Bg + ((tc * 8 + tr) * 64 + lane) * 4) = pack4(a);
            }
        }
    }
    __syncthreads();
    GST(4);
}

constexpr int DP_QS = 0;
constexpr int DP_KSELF = 17408;
constexpr int DP_KSC = 34816;
constexpr int DP_KDT = 60928;
constexpr int DP_VT = 79360;
constexpr int DP_P = 97792;
constexpr int DP_TOT = 107008;
constexpr int DP_CODE = 111104;
constexpr int DP_QG = 115200;
constexpr int DP_END = 132608;

template <int MIX>
__device__ __forceinline__ void diag_prep_unit(const Ctx& c, int l, int cc) {
    constexpr int DK = (MIX == 1) ? 128 : 64;
    constexpr int PQ = DK + 8;
    const int n = cc % NCH, dir = (cc / NCH) & 1, h = (cc / (NCH * 2)) & 3, b = cc / (NCH * 8);
    const int tid = c.tid, lane = c.lane, wave = c.wave;
    LDSP unsigned char* L = c.lds;
    LDSP bf16_t* Qs = (LDSP bf16_t*)(L + DP_QS);
    LDSP bf16_t* Kself = (LDSP bf16_t*)(L + DP_KSELF);
    LDSP bf16_t* Ksc = (LDSP bf16_t*)(L + DP_KSC);
    LDSP bf16_t* KdT = (LDSP bf16_t*)(L + DP_KDT);
    LDSP bf16_t* VT = (LDSP bf16_t*)(L + DP_VT);
    LDSP bf16_t* Pm = (LDSP bf16_t*)(L + DP_P);
    LDSP float* tot = (LDSP float*)(L + DP_TOT);
    LDSP float* code = (LDSP float*)(L + DP_CODE);
    LDSP bf16_t* Qt = (LDSP bf16_t*)(L + DP_QG);
    const bf16_t* proj = (const bf16_t*)(c.ws + WS_RA + RA_PROJ);
    const size_t rowb = (size_t)b * T;
    bf16_t* Bg; bf16_t* Qg; bf16_t* Og; float* Ag;
    const size_t cs = (size_t)n * 32 + cc / NCH;
    if (MIX == 1) { Bg = (bf16_t*)(c.ws + WS_RA + RA_HB) + cs * 16384; Qg = (bf16_t*)(c.ws + WS_RA + RA_HQ) + cs * 8192;
                    Og = (bf16_t*)(c.ws + WS_RA + RA_HO) + cs * 8192; Ag = (float*)(c.ws + WS_RA + RA_HA) + cs * 128; }
    else          { Bg = (bf16_t*)(c.ws + WS_RA + RA_LB) + cs * 8192; Qg = (bf16_t*)(c.ws + WS_RA + RA_LQ) + cs * 4096;
                    Og = (bf16_t*)(c.ws + WS_RA + RA_LO) + cs * 8192; Ag = (float*)(c.ws + WS_RA + RA_LA) + cs * 64; }

    const int vcol = (MIX == 1 ? C_CI : C_BV) + h * 128;
#pragma unroll
    for (int p = 0; p < 2; ++p) {
        const int id = p * 512 + tid, i = id >> 4, c8 = id & 15;
        *(LDSP u32x4*)(VT + i * 136 + c8 * 8) = *(const u32x4*)(proj + (rowb + tok_of(n, dir, i)) * NINP + vcol + c8 * 8);
    }
    for (int i = tid; i < 64 * 36; i += 512) ((LDSP unsigned*)Pm)[i] = 0u;
    {
        constexpr int CPR = DK / 8;
        const int qcol = (MIX == 1 ? C_CQ + h * 128 : C_BQ + h * 64), kcol = (MIX == 1 ? C_CF + dir * 512 + h * 128 : C_BK + h * 64);
#pragma unroll
        for (int p = 0; p < (64 * CPR) / 512; ++p) {
            const int id = p * 512 + tid, i = id / CPR, c8 = id % CPR;
            const bf16_t* pr = proj + (rowb + tok_of(n, dir, i)) * NINP;
            *(LDSP u32x4*)(Qs + i * PQ + c8 * 8) = *(const u32x4*)(pr + qcol + c8 * 8);
            *(LDSP u32x4*)(Kself + i * PQ + c8 * 8) = *(const u32x4*)(pr + kcol + c8 * 8);
        }
        if (MIX == 2) for (int i = tid; i < 64 * 16; i += 512) code[i] = bf2f(proj[(rowb + tok_of(n, dir, i >> 4)) * NINP + C_BCODE + dir * 16 + (i & 15)]);
    }
    __syncthreads();
    constexpr int TPT = DK / 8, NSUB = 64 / TPT;
    const int d = tid % DK, J = tid / DK, I = (J * TPT) >> 4;
    float qv[TPT], kv[TPT], bl[TPT];
    {
        float lb = 0.f, wg[16], bg = 0.f;
        if (MIX == 1) {
            const float* gam = c.in[I_HGAM] + (size_t)dir * DEPTH * 512 + h * 128 + d;
            float mx = gam[0];
#pragma unroll
            for (int i = 1; i < DEPTH; ++i) mx = fmaxf(mx, gam[i * 512]);
            float den = 0.f, num = 0.f;
#pragma unroll
            for (int i = 0; i < DEPTH; ++i) { const float e = __expf(gam[i * 512] - mx); den += e; if (i >= 1 && i <= l) num += e; }
            lb = num / den;
        } else {
#pragma unroll
            for (int r = 0; r < 16; ++r) wg[r] = c.in[I_GLAW][((size_t)(l * 2 + dir) * 16 + r) * 256 + h * 64 + d];
            bg = c.in[I_GLAB][(l * 2 + dir) * 256 + h * 64 + d];
        }
        float run = 0.f;
#pragma unroll
        for (int s = 0; s < TPT; ++s) {
            const int i = J * TPT + s, t = tok_of(n, dir, i);
            float la;
            if (MIX == 1) {
                qv[s] = bf2f(Qs[i * PQ + d]);
                const float f = lb + (1.f - lb) * sigmoidf_(bf2f(Kself[i * PQ + d]));
                la = __logf(f); kv[s] = 1.f - f;
            } else {
                float q0 = bf2f(Qs[i * PQ + d]) * 0.125f, k0 = bf2f(Kself[i * PQ + d]);
                if (n >= 4) {
                    const int pos = t - CTX, hf = d >> 5, idx = d & 31, fi = idx & 15;
                    const float p = (float)(hf ? (pos & 63) : (pos >> 6));
                    const float inv = __expf(-(float)fi * (9.210340371976184f / 16.f));
                    float ang = p * inv;
                    const float kk = rintf(ang * 0.15915494309189535f);
                    ang = fmaf(-kk, 6.2831855f, ang); ang = fmaf(-kk, -1.7484555e-7f, ang);
                    const float cs = __cosf(ang), sn = __sinf(ang);
                    const int dp = idx < 16 ? d + 16 : d - 16;
                    const float q1 = bf2f(Qs[i * PQ + dp]) * 0.125f, k1 = bf2f(Kself[i * PQ + dp]);
                    if (idx < 16) { q0 = q0 * cs - q1 * sn; k0 = k0 * cs - k1 * sn; }
                    else          { q0 = q1 * sn + q0 * cs; k0 = k1 * sn + k0 * cs; }
                }
                qv[s] = q0; kv[s] = k0;
                float gt = bg;
#pragma unroll
                for (int r = 0; r < 16; ++r) gt += code[i * 16 + r] * wg[r];
                la = -softplusf_(-gt) * (1.f / 16.f);
            }
            run += la; bl[s] = run;
        }
        tot[J * 128 + d] = run;
    }
    __syncthreads();
    {
        float pre = 0.f, bend = 0.f, hb = 0.f, tI[4] = {0.f, 0.f, 0.f, 0.f};
#pragma unroll
        for (int m = 0; m < NSUB; ++m) {
            const float tm = tot[m * 128 + d]; const int Im = (m * TPT) >> 4;
            bend += tm; tI[Im] += tm;
            if (Im < I) pre += tm; else if (Im == I && m < J) hb += tm;
        }
        unsigned kd[TPT / 2];
#pragma unroll
        for (int s = 0; s < TPT; ++s) {
            const int i = J * TPT + s, s16 = i & 15;
            const float b16 = hb + bl[s];
            Qs[i * PQ + d] = f2bf(qv[s] * __expf(b16));
            Kself[i * PQ + d] = f2bf(kv[s] * __expf(-b16));
            Qt[i * PQ + d] = f2bf(qv[s] * __expf(pre + b16));
            const float kdv = kv[s] * __expf(bend - pre - b16);
            if (s & 1) kd[s >> 1] = (kd[s >> 1] & 0xffffu) | ((unsigned)f2bf(kdv) << 16); else kd[s >> 1] = f2bf(kdv);
            float off = 0.f;
#pragma unroll
            for (int Ip = 1; Ip < 4; ++Ip) {
                if (Ip > I) { off += tI[Ip - 1]; Ksc[((Ip * (Ip - 1) / 2 + I) * 16 + s16) * PQ + d] = f2bf(kv[s] * __expf(off - b16)); }
            }
        }
#pragma unroll
        for (int w8 = 0; w8 < TPT / 8; ++w8)
            *(LDSP u32x4*)(KdT + d * 72 + J * TPT + w8 * 8) = (u32x4){kd[w8 * 4], kd[w8 * 4 + 1], kd[w8 * 4 + 2], kd[w8 * 4 + 3]};
        if (J == 0) Ag[d] = __expf(bend);
    }
    __syncthreads();
#pragma unroll
    for (int p = 0; p < (64 * DK / 8) / 512; ++p) {
        const int id = p * 512 + tid, fl = id & 63, fr = id >> 6;
        const int ott_ = fr / (DK / 32), kk_ = fr % (DK / 32);
        *(u32x4*)(Qg + (size_t)id * 8) = *(const LDSP u32x4*)(Qt + (ott_ * 16 + (fl & 15)) * PQ + kk_ * 32 + (fl >> 4) * 8);
    }
    for (int blk = wave; blk < 10; blk += 8) {
        int Ib, Jb;
        if (blk < 4) { Ib = blk; Jb = blk; } else { const int s = blk - 4; Ib = s < 1 ? 1 : (s < 3 ? 2 : 3); Jb = s - (Ib * (Ib - 1) / 2); }
        const LDSP bf16_t* kp = (Ib == Jb) ? Kself + Jb * 16 * PQ : Ksc + (Ib * (Ib - 1) / 2 + Jb) * 16 * PQ;
        const f32x4 a = mma_tile<DK / 32>(kp, PQ, Qs + Ib * 16 * PQ, PQ, (f32x4){0.f, 0.f, 0.f, 0.f}, lane);
        const int r = lane & 15, q4 = lane >> 4;
        f32x4 o;
#pragma unroll
        for (int e = 0; e < 4; ++e) o[e] = (Ib > Jb || r >= q4 * 4 + e) ? a[e] : 0.f;
        *(LDSP u32x2*)(Pm + (Ib * 16 + r) * 72 + Jb * 16 + q4 * 4) = pack4(o);
    }
    __syncthreads();
    {
        const int r = lane & 15, q4 = lane >> 4;
        const f32x4 z = (f32x4){0.f, 0.f, 0.f, 0.f};
        constexpr int NT2 = (DK / 16) * 8;
        for (int id = wave; id < 32 + NT2; id += 8) {
            if (id < 32) {
                const int td = id >> 2, ti = id & 3;
                f32x4 a = z;
#pragma unroll
                for (int kk = 0; kk < 2; ++kk)
                    a = __builtin_amdgcn_mfma_f32_16x16x32_bf16(frag_tr16(VT + kk * 32 * 136 + td * 16, 136, lane), *(const LDSP bf16x8*)(Pm + (ti * 16 + r) * 72 + kk * 32 + q4 * 8), a, 0, 0, 0);
                *(u32x2*)(Og + ((ti * 8 + td) * 64 + lane) * 4) = pack4(a);
            } else {
                const int j = id - 32, tk = j >> 3, tv = j & 7;
                f32x4 a = z;
#pragma unroll
                for (int kk = 0; kk < 2; ++kk)
                    a = __builtin_amdgcn_mfma_f32_16x16x32_bf16(*(const LDSP bf16x8*)(KdT + (tk * 16 + r) * 72 + kk * 32 + q4 * 8), frag_tr16(VT + kk * 32 * 136 + tv * 16, 136, lane), a, 0, 0, 0);
                *(u32x2*)(Bg + ((tv * (DK / 16) + tk) * 64 + lane) * 4) = pack4(a);
            }
        }
    }
    __syncthreads();
}

template <int MIX, int DVS, int RING>
__device__ __forceinline__ void scan_unit(const Ctx& c, int chain, int slice) {
    constexpr int DK = (MIX == 2) ? 64 : 128;
    constexpr int PS = DK + 8;
    constexpr int NDK = DK / 16, NG = 8 / NDK;
    constexpr int NS = (DVS / 16) / NG;
    constexpr int NO = (DVS / 16) / 2;
    constexpr int KS = DK / 32;
    const int lane = c.lane, wave = c.wave, r = lane & 15, q4 = lane >> 4;
    const int dir = chain & 1, h = (chain >> 1) & 3, b = chain >> 3;
    LDSP bf16_t* ST = (LDSP bf16_t*)c.lds;
    constexpr int PO = DVS + 8;
    LDSP bf16_t* OS = ST + DVS * PS;
    for (int i = c.tid; i < DVS * PS / 2; i += 512) ((LDSP unsigned*)ST)[i] = 0u;
    const int dkt = wave % NDK;
    const int dvt0 = (wave / NDK) * NS;
    const int ott = wave >> 1;
    const int odv0 = (wave & 1) * NO;
    const bf16_t* Mg = (const bf16_t*)(c.ws + WS_RA + RA_GM);
    const bf16_t* Bg = (const bf16_t*)(c.ws + WS_RA + (MIX == 0 ? RA_GB : MIX == 1 ? RA_HB : RA_LB));
    const bf16_t* Qg = (const bf16_t*)(c.ws + WS_RA + (MIX == 0 ? RA_GQ : MIX == 1 ? RA_HQ : RA_LQ));
    const bf16_t* Og = (const bf16_t*)(c.ws + WS_RA + (MIX == 0 ? RA_GO : MIX == 1 ? RA_HO : RA_LO));
    const float* Ag = (const float*)(c.ws + WS_RA + (MIX == 1 ? RA_HA : RA_LA));
    bf16_t* OB = (bf16_t*)(c.ws + WS_RA + RA_OB) + ((size_t)(MIX * 2 + dir) * MROWS) * 512;
    f32x4 S[NS];
#pragma unroll
    for (int t = 0; t < NS; ++t) S[t] = (f32x4){0.f, 0.f, 0.f, 0.f};
    struct Ld { bf16x8 mf[KS]; u32x2 bt[NS]; f32x4 ae; bf16x8 qf[KS]; u32x2 ot[NO]; };
    Ld ring[RING];
    auto load = [&](Ld& d, int s) {
        const int n = dir ? (s < 4 ? 3 - s : 71 - s) : s;
        const size_t cc = (size_t)n * 32 + chain;
        if (MIX == 0) {
#pragma unroll
            for (int kk = 0; kk < KS; ++kk) d.mf[kk] = *(const bf16x8*)(Mg + cc * 16384 + ((dkt * 4 + kk) * 64 + lane) * 8);
        } else {
            d.ae = *(const f32x4*)(Ag + cc * DK + dkt * 16 + q4 * 4);
        }
#pragma unroll
        for (int t = 0; t < NS; ++t) d.bt[t] = *(const u32x2*)(Bg + cc * (128 * DK) + (((slice * (DVS / 16) + dvt0 + t) * NDK + dkt) * 64 + lane) * 4);
#pragma unroll
        for (int kk = 0; kk < KS; ++kk) d.qf[kk] = *(const bf16x8*)(Qg + cc * (64 * DK) + ((ott * KS + kk) * 64 + lane) * 8);
#pragma unroll
        for (int t = 0; t < NO; ++t) d.ot[t] = *(const u32x2*)(Og + cc * 8192 + ((ott * 8 + slice * (DVS / 16) + odv0 + t) * 64 + lane) * 4);
    };
#pragma unroll
    for (int k = 0; k < RING; ++k) load(ring[k], k);
    __syncthreads();
    for (int s0 = 0; s0 < NCH; s0 += RING) {
#pragma unroll
      for (int k = 0; k < RING; ++k) {
        const int s = s0 + k;
        if (s >= NCH) break;
        Ld& cur = ring[k];
        const int n = dir ? (s < 4 ? 3 - s : 71 - s) : s;
#pragma unroll
        for (int t = 0; t < NO; ++t) {
            f32x4 a = (f32x4){bflo(cur.ot[t].x), bfhi(cur.ot[t].x), bflo(cur.ot[t].y), bfhi(cur.ot[t].y)};
#pragma unroll
            for (int kk = 0; kk < KS; ++kk) {
                const bf16x8 sf = *(const LDSP bf16x8*)(ST + ((odv0 + t) * 16 + r) * PS + kk * 32 + q4 * 8);
                a = __builtin_amdgcn_mfma_f32_16x16x32_bf16(sf, cur.qf[kk], a, 0, 0, 0);
            }
            *(LDSP u32x2*)(OS + (s & 1) * 64 * PO + (ott * 16 + r) * PO + (odv0 + t) * 16 + q4 * 4) = pack4(a);
        }
        f32x4 Sn[NS];
#pragma unroll
        for (int t = 0; t < NS; ++t) {
            const f32x4 bm = (f32x4){bflo(cur.bt[t].x), bfhi(cur.bt[t].x), bflo(cur.bt[t].y), bfhi(cur.bt[t].y)};
            if (MIX == 0) {
                f32x4 a = bm;
#pragma unroll
                for (int kk = 0; kk < KS; ++kk) {
                    const bf16x8 sf = *(const LDSP bf16x8*)(ST + ((dvt0 + t) * 16 + r) * PS + kk * 32 + q4 * 8);
                    a = __builtin_amdgcn_mfma_f32_16x16x32_bf16(cur.mf[kk], sf, a, 0, 0, 0);
                }
                Sn[t] = a;
            } else {
                Sn[t] = cur.ae * S[t] + bm;
            }
        }
        if (s + RING < NCH) load(cur, s + RING);
        __syncthreads();
#pragma unroll
        for (int t = 0; t < NS; ++t) { S[t] = Sn[t]; *(LDSP u32x2*)(ST + ((dvt0 + t) * 16 + r) * PS + dkt * 16 + q4 * 4) = pack4(Sn[t]); }
#pragma unroll
        for (int id = c.tid; id < 64 * (DVS / 8); id += 512) {
            const int i = id / (DVS / 8), ch = id % (DVS / 8);
            *(u32x4*)(OB + ((size_t)b * T + tok_of(n, dir, i)) * 512 + h * 128 + slice * DVS + ch * 8) = *(const LDSP u32x4*)(OS + (s & 1) * 64 * PO + i * PO + ch * 8);
        }
        __syncthreads();
      }
    }
}

constexpr int NA_Q = 0, NA_K = 17408, NA_VT = 34816, NA_P = 53248, NA_GRP = 62464;
constexpr int NA_RPB = 2 * NA_GRP;
__device__ __forceinline__ void na_pair(const Ctx& c, int l, int pair) {
    const int tid = c.tid, lane = c.lane, wave = c.wave, grp = wave >> 2, gw = wave & 3, gt = tid & 255;
    const int r = lane & 15, q4 = lane >> 4;
    const bool is_lat = pair < 512;
    int b, h, gr = 0, qb = 0;
    if (is_lat) { const int u = pair * 2 + grp; b = u >> 8; h = (u >> 6) & 3; gr = u & 63; }
    else { const int u = (pair - 512) * 2 + grp; b = u >> 4; h = (u >> 2) & 3; qb = u & 3; }
    const int NT = is_lat ? 12 : 4;
    const int rs = gr - 4 < 0 ? 0 : (gr - 4 > 56 ? 56 : gr - 4);
    LDSP unsigned char* L = c.lds + grp * NA_GRP;
    LDSP bf16_t* Qs = (LDSP bf16_t*)(L + NA_Q);
    LDSP bf16_t* Kt = (LDSP bf16_t*)(L + NA_K);
    LDSP bf16_t* VT = (LDSP bf16_t*)(L + NA_VT);
    LDSP bf16_t* Pm = (LDSP bf16_t*)(L + NA_P);
    LDSP float* rpb = (LDSP float*)(c.lds + NA_RPB);
    const bf16_t* proj = (const bf16_t*)(c.ws + WS_RA + RA_PROJ);
    const size_t rowb = (size_t)b * T;
    const int qtok0 = is_lat ? CTX + gr * 64 : qb * 64;
#pragma unroll
    for (int p = 0; p < 4; ++p) {
        const int id = p * 256 + gt, qi = id >> 4, c8 = id & 15;
        *(LDSP u32x4*)(Qs + qi * 136 + c8 * 8) = *(const u32x4*)(proj + (rowb + qtok0 + qi) * NINP + C_DQ + h * 128 + c8 * 8);
    }
    if (tid < 465) rpb[tid] = c.in[I_RPB][(size_t)(l * 4 + h) * 465 + tid];
    float m_run = -1e30f, l_run = 0.f;
    f32x4 acc[8];
#pragma unroll
    for (int dt = 0; dt < 8; ++dt) acc[dt] = (f32x4){0.f, 0.f, 0.f, 0.f};
    const float SC = 0.08838834764831845f * 1.4426950408889634f;
    const int cq = gw * 16 + r;
    const int cs = cq - 8 < 0 ? 0 : (cq - 8 > 48 ? 48 : cq - 8);
    u32x4 kreg[4], vreg[4];
#define NA_KTOK0(kt_) (is_lat ? ((kt_) < 8 ? CTX + (rs + (kt_)) * 64 : ((kt_) - 8) * 64) : (kt_) * 64)
#define NA_PREFETCH(kt_) do { const int kb_ = NA_KTOK0(kt_); _Pragma("unroll") for (int p = 0; p < 4; ++p) { \
        const int id = p * 256 + gt; kreg[p] = *(const u32x4*)(proj + (rowb + kb_ + (id >> 4)) * NINP + C_DK + h * 128 + (id & 15) * 8); \
        vreg[p] = *(const u32x4*)(proj + (rowb + kb_ + (id >> 4)) * NINP + C_DV + h * 128 + (id & 15) * 8); } } while (0)
    NA_PREFETCH(0);
    for (int kt = 0; kt < NT; ++kt) {
        const bool loc = is_lat && kt < 8;
        __syncthreads();
#pragma unroll
        for (int p = 0; p < 4; ++p) {
            const int id = p * 256 + gt, j = id >> 4, c8 = id & 15;
            *(LDSP u32x4*)(Kt + j * 136 + c8 * 8) = kreg[p];
            *(LDSP u32x4*)(VT + j * 136 + c8 * 8) = vreg[p];
        }
        if (kt + 1 < NT) NA_PREFETCH(kt + 1);
        __syncthreads();
        f32x4 sc[4];
        float tmax = -1e30f;
#pragma unroll
        for (int ct = 0; ct < 4; ++ct) {
            sc[ct] = mma_tile<4>(Kt + ct * 16 * 136, 136, Qs + gw * 16 * 136, 136, (f32x4){0.f, 0.f, 0.f, 0.f}, lane);
#pragma unroll
            for (int e = 0; e < 4; ++e) {
                float s = sc[ct][e] * SC;
                if (loc) {
                    const int ck = ct * 16 + q4 * 4 + e;
                    int dc = ck - cq; dc = dc < -15 ? -15 : (dc > 15 ? 15 : dc);
                    const int dr = rs + kt - gr + 7;
                    s += rpb[dr * 31 + dc + 15] * 1.4426950408889634f;
                    if (ck < cs || ck >= cs + 16) s = -INFINITY;
                }
                sc[ct][e] = s; tmax = fmaxf(tmax, s);
            }
        }
        tmax = fmaxf(tmax, __shfl_xor(tmax, 16)); tmax = fmaxf(tmax, __shfl_xor(tmax, 32));
        const float m_new = fmaxf(m_run, tmax);
        const float alpha = __builtin_amdgcn_exp2f(m_run - m_new);
        float psum = 0.f;
#pragma unroll
        for (int ct = 0; ct < 4; ++ct) {
            f32x4 p;
#pragma unroll
            for (int e = 0; e < 4; ++e) { p[e] = __builtin_amdgcn_exp2f(sc[ct][e] - m_new); psum += p[e]; }
            *(LDSP u32x2*)(Pm + (gw * 16 + r) * 72 + ct * 16 + q4 * 4) = pack4(p);
        }
        psum += __shfl_xor(psum, 16); psum += __shfl_xor(psum, 32);
        l_run = l_run * alpha + psum; m_run = m_new;
#pragma unroll
        for (int dt = 0; dt < 8; ++dt) {
            acc[dt] = acc[dt] * alpha;
#pragma unroll
            for (int kk = 0; kk < 2; ++kk) {
                const bf16x8 vf = frag_tr16(VT + kk * 32 * 136 + dt * 16, 136, lane);
                const bf16x8 pf = *(const LDSP bf16x8*)(Pm + (gw * 16 + r) * 72 + kk * 32 + q4 * 8);
                acc[dt] = __builtin_amdgcn_mfma_f32_16x16x32_bf16(vf, pf, acc[dt], 0, 0, 0);
            }
        }
    }
    const float inv = 1.f / l_run;
    bf16_t* mix = (bf16_t*)(c.ws + WS_MIX) + (rowb + qtok0 + gw * 16 + r) * D + 1536 + h * 128;
#pragma unroll
    for (int dt = 0; dt < 8; ++dt) *(u32x2*)(mix + dt * 16 + q4 * 4) = pack4(acc[dt] * inv);
    __syncthreads();
}

__device__ __forceinline__ void phase_combine(const Ctx& c, int l) {
    const bf16_t* proj = (const bf16_t*)(c.ws + WS_RA + RA_PROJ);
    const bf16_t* OB = (const bf16_t*)(c.ws + WS_RA + RA_OB);
    bf16_t* mix = (bf16_t*)(c.ws + WS_MIX);
    const int lane = c.lane, d0 = (lane & 15) * 8;
    for (int row = c.bid * 8 + c.wave; row < MROWS; row += c.G * 8) {
#pragma unroll
        for (int mx = 0; mx < 3; ++mx) {
            const int om = mx == 0 ? 0 : 3 - mx;
            const u32x4 a = *(const u32x4*)(OB + ((size_t)(om * 2 + 0) * MROWS + row) * 512 + lane * 8);
            const u32x4 bq = *(const u32x4*)(OB + ((size_t)(om * 2 + 1) * MROWS + row) * 512 + lane * 8);
            const u32x4 g = *(const u32x4*)(proj + (size_t)row * NINP + (mx == 0 ? C_AZ : mx == 1 ? C_BR : C_CG) + lane * 8);
            const float* nw = c.in[mx == 0 ? I_GDNN : mx == 1 ? I_GLAN : I_HGN] + l * 128 + d0;
            float o[8]; float ss = 0.f;
#pragma unroll
            for (int m = 0; m < 4; ++m) { o[2 * m] = bflo(a[m]) + bflo(bq[m]); o[2 * m + 1] = bfhi(a[m]) + bfhi(bq[m]); ss += o[2 * m] * o[2 * m] + o[2 * m + 1] * o[2 * m + 1]; }
#pragma unroll
            for (int m = 1; m < 16; m <<= 1) ss += __shfl_xor(ss, m);
            const float rn = rsqrtf(ss * (1.f / 128.f) + NORM_EPS);
            float y[8];
#pragma unroll
            for (int m = 0; m < 4; ++m) {
                const float g0 = bflo(g[m]), g1 = bfhi(g[m]);
                const float a0 = (mx == 2) ? sigmoidf_(g0) : siluf_(g0), a1 = (mx == 2) ? sigmoidf_(g1) : siluf_(g1);
                y[2 * m] = o[2 * m] * rn * nw[2 * m] * a0; y[2 * m + 1] = o[2 * m + 1] * rn * nw[2 * m + 1] * a1;
            }
            *(u32x4*)(mix + (size_t)row * D + mx * 512 + lane * 8) = (u32x4){pk2(y[0], y[1]), pk2(y[2], y[3]), pk2(y[4], y[5]), pk2(y[6], y[7])};
        }
    }
}

__device__ __forceinline__ void phase_ln_router(const Ctx& c, int l) {
    LDSP float* wr = (LDSP float*)c.lds;
    for (int i = c.tid; i < 2048 * 16; i += 512) { const int k = i >> 4, e = i & 15; wr[e * 2048 + k] = c.in[I_ROUT][(size_t)l * 2048 * 16 + i]; }
    __syncthreads();
    const float* modv = (const float*)(c.ws + WS_MODV);
    const float* tb = (const float*)(c.ws + WS_RA + RA_TBUF);
    float* X1 = (float*)(c.ws + WS_X1); bf16_t* U = (bf16_t*)(c.ws + WS_U); float* aff = (float*)(c.ws + WS_AFF);
    const float* lg = c.in[I_LNG] + (size_t)(l * 2 + 0) * D; const float* lbp = c.in[I_LNB] + (size_t)(l * 2 + 0) * D;
    const int lane = c.lane;
    for (int row = c.bid * 8 + c.wave; row < MROWS; row += c.G * 8) {
        const int b = row / T, t = row % T;
        if (l == DEPTH - 1 && t < CTX) continue;
        const int r = t < CTX ? 4 : b;
        f32x4 v[8];
#pragma unroll
        for (int j = 0; j < 8; ++j) v[j] = *(const f32x4*)(tb + (size_t)row * D + 256 * j + 4 * lane);
        float mu, rstd; row_stats(v, mu, rstd);
#pragma unroll
        for (int j = 0; j < 8; ++j) {
            const int col = 256 * j + 4 * lane;
            v[j] = (v[j] - mu) * rstd * *(const f32x4*)(lg + col) + *(const f32x4*)(lbp + col);
            *(f32x4*)(X1 + (size_t)row * D + col) = v[j];
        }
        row_stats(v, mu, rstd);
        const float* sh = modv + (size_t)(l * 5 + r) * 12288 + 3 * 2048; const float* scp = sh + 2048;
        float lg16[16];
#pragma unroll
        for (int e = 0; e < 16; ++e) lg16[e] = 0.f;
#pragma unroll
        for (int j = 0; j < 8; ++j) {
            const int col = 256 * j + 4 * lane;
            const f32x4 y = (v[j] - mu) * rstd * (*(const f32x4*)(scp + col) + 1.f) + *(const f32x4*)(sh + col);
            *(u32x2*)(U + (size_t)row * D + col) = pack4(y);
#pragma unroll
            for (int e = 0; e < 16; ++e) { const f32x4 w = *(const LDSP f32x4*)(wr + e * 2048 + col); lg16[e] += y[0] * w[0] + y[1] * w[1] + y[2] * w[2] + y[3] * w[3]; }
        }
        float mxv = -1e30f;
#pragma unroll
        for (int e = 0; e < 16; ++e) { lg16[e] = wsum(lg16[e]); mxv = fmaxf(mxv, lg16[e]); }
        float den = 0.f;
#pragma unroll
        for (int e = 0; e < 16; ++e) { lg16[e] = expf(lg16[e] - mxv); den += lg16[e]; }
        const float rd = 1.f / den;
        float mine = 0.f;
#pragma unroll
        for (int e = 0; e < 16; ++e) if (lane == e) mine = lg16[e] * rd;
        if (lane < 16) aff[((size_t)b * 16 + lane) * T + t] = mine;
    }
    __syncthreads();
}

__device__ __forceinline__ void topk_unit(const Ctx& c, int prob) {
    const bool lat = prob < 64; const int pe = lat ? prob : prob - 64, b = pe >> 4, e = pe & 15;
    const int n = lat ? 4096 : 256, kcap = lat ? 512 : 32, tok0 = lat ? CTX : 0;
    LDSP unsigned* keys = (LDSP unsigned*)c.lds;
    LDSP unsigned* hist = keys + 4096;
    LDSP unsigned* bc = hist + 256;
    LDSP unsigned* wsum_ = bc + 4;
    const float* aff = (const float*)(c.ws + WS_AFF);
    const int tid = c.tid, lane = c.lane, wave = c.wave;
    const size_t rowb = (size_t)b * T + tok0;
    for (int i = tid; i < n; i += 512) keys[i] = __float_as_uint(aff[((size_t)b * 16 + e) * T + tok0 + i]);
    unsigned prefix = 0u, mask = 0u, krem = (unsigned)kcap;
    for (int pass = 0; pass < 4; ++pass) {
        const int shift = 24 - 8 * pass;
        if (tid < 256) hist[tid] = 0u;
        __syncthreads();
        for (int i = tid; i < n; i += 512) { const unsigned k = keys[i]; if ((k & mask) == prefix) __hip_atomic_fetch_add(&hist[(k >> shift) & 255u], 1u, __ATOMIC_RELAXED, __HIP_MEMORY_SCOPE_WORKGROUP); }
        __syncthreads();
        if (tid == 0) {
            unsigned cum = 0u; int bin = 255;
            for (; bin > 0; --bin) { const unsigned hcount = hist[bin]; if (cum + hcount >= krem) break; cum += hcount; }
            bc[0] = prefix | ((unsigned)bin << shift); bc[1] = krem - cum;
        }
        __syncthreads();
        prefix = bc[0]; krem = bc[1]; mask |= 255u << shift;
        __syncthreads();
    }
    const int per = n / 512 > 0 ? n / 512 : 1;
    const int i0 = tid * per;
    unsigned cnt = 0u;
    if (i0 < n) for (int j = 0; j < per; ++j) { const unsigned k = keys[i0 + j]; cnt += (k > prefix) ? 1u : 0u; cnt += (k == prefix) ? 0x10000u : 0u; }
    unsigned inc = cnt;
#pragma unroll
    for (int m = 1; m < 64; m <<= 1) { const unsigned o = __shfl_up(inc, m); if (lane >= m) inc += o; }
    if (lane == 63) wsum_[wave] = inc;
    __syncthreads();
    unsigned base = 0u;
    for (int w = 0; w < wave; ++w) base += wsum_[w];
    unsigned excl = base + inc - cnt;
    int* idx = (int*)(c.ws + WS_IDX); float* gate = (float*)(c.ws + WS_GATE); int* inv = (int*)(c.ws + WS_INV);
    const int slot0 = lat ? b * 512 : 2048 + b * 32;
    if (i0 < n) for (int j = 0; j < per; ++j) {
        const unsigned k = keys[i0 + j];
        const unsigned gtb = excl & 0xffffu, eqb = excl >> 16;
        const bool sel = (k > prefix) || (k == prefix && eqb < krem);
        int srow = -1;
        if (sel) {
            srow = slot0 + (int)(gtb + (eqb < krem ? eqb : krem));
            idx[e * EROWS + srow] = (int)(rowb + i0 + j);
            gate[e * EROWS + srow] = __uint_as_float(k);
        }
        inv[(rowb + i0 + j) * 16 + e] = srow;
        excl += (k > prefix) ? 1u : 0u; excl += (k == prefix) ? 0x10000u : 0u;
    }
    __syncthreads();
}

__device__ __forceinline__ void phase_gather(const Ctx& c, int l) {
    const int* idx = (const int*)(c.ws + WS_IDX);
    const bf16_t* U = (const bf16_t*)(c.ws + WS_U); bf16_t* XS = (bf16_t*)(c.ws + WS_RA + RA_XS);
    const int nrow = (l == DEPTH - 1) ? 2048 : EROWS, nreal = (l == DEPTH - 1) ? 2048 : 2176;
    for (int g = c.bid * 8 + c.wave; g < NEXP * nrow; g += c.G * 8) {
        const int e = g / nrow, s = g % nrow;
        u32x4 v[4];
        if (s < nreal) {
            const int src = idx[e * EROWS + s];
#pragma unroll
            for (int j = 0; j < 4; ++j) v[j] = *(const u32x4*)(U + (size_t)src * D + j * 512 + c.lane * 8);
        } else {
#pragma unroll
            for (int j = 0; j < 4; ++j) v[j] = (u32x4){0u, 0u, 0u, 0u};
            if (c.lane == 0) ((float*)(c.ws + WS_GATE))[e * EROWS + s] = 0.f;
        }
#pragma unroll
        for (int j = 0; j < 4; ++j) *(u32x4*)(XS + ((size_t)e * EROWS + s) * D + j * 512 + c.lane * 8) = v[j];
    }
}

__device__ __forceinline__ void phase_final(const Ctx& c, int l) {
    const float* modv = (const float*)(c.ws + WS_MODV);
    const float* X1 = (const float*)(c.ws + WS_X1); float* X = (float*)(c.ws + WS_X); bf16_t* U = (bf16_t*)(c.ws + WS_U);
    const bf16_t* YS = (const bf16_t*)(c.ws + WS_RA + RA_YS); const int* inv = (const int*)(c.ws + WS_INV);
    const float* lg = c.in[I_LNG] + (size_t)(l * 2 + 1) * D; const float* lbp = c.in[I_LNB] + (size_t)(l * 2 + 1) * D;
    const int lane = c.lane;
    for (int row = c.bid * 8 + c.wave; row < MROWS; row += c.G * 8) {
        const int b = row / T, t = row % T;
        if (l == DEPTH - 1 && t < CTX) continue;
        const int r = t < CTX ? 4 : b;
        f32x4 y[8];
#pragma unroll
        for (int j = 0; j < 8; ++j) y[j] = (f32x4){0.f, 0.f, 0.f, 0.f};
        const int myinv = inv[(size_t)row * 16 + (lane & 15)];
        for (int e = 0; e < 16; ++e) {
            const int s = __shfl(myinv, e);
            if (s >= 0) {
                const bf16_t* yr = YS + ((size_t)e * EROWS + s) * D;
#pragma unroll
                for (int j = 0; j < 8; ++j) { const u32x2 w = *(const u32x2*)(yr + 256 * j + 4 * lane); y[j] += (f32x4){bflo(w.x), bfhi(w.x), bflo(w.y), bfhi(w.y)}; }
            }
        }
        const float* m5 = modv + (size_t)(l * 5 + r) * 12288 + 5 * 2048;
        f32x4 v[8];
#pragma unroll
        for (int j = 0; j < 8; ++j) { const int col = 256 * j + 4 * lane; v[j] = *(const f32x4*)(X1 + (size_t)row * D + col) * ALPHA + *(const f32x4*)(m5 + col) * y[j]; }
        float mu, rstd; row_stats(v, mu, rstd);
#pragma unroll
        for (int j = 0; j < 8; ++j) { const int col = 256 * j + 4 * lane; v[j] = (v[j] - mu) * rstd * *(const f32x4*)(lg + col) + *(const f32x4*)(lbp + col); }
        if (l == DEPTH - 1) {
            float* o = c.out + ((size_t)b * SEQ + (t - CTX)) * D;
#pragma unroll
            for (int j = 0; j < 8; ++j) *(f32x4*)(o + 256 * j + 4 * lane) = v[j];
        } else {
#pragma unroll
            for (int j = 0; j < 8; ++j) *(f32x4*)(X + (size_t)row * D + 256 * j + 4 * lane) = v[j];
            const float* sh = modv + (size_t)((l + 1) * 5 + r) * 12288;
            modulate_store(v, sh, sh + 2048, U + (size_t)row * D, lane);
        }
    }
}

struct EpiOut {
    static constexpr bool PERM = false, AFTER_DRAIN = false;
    const float* X; const float* modv_l; float* Tb;
    __device__ __forceinline__ void operator()(const pg8::f32x4 (&acc)[2][2][4][2], const pg8::Unit& u, int wr, int wc, int fr, int fq) const {
        const int row0 = u.pm * 256 + wr * 64 + fr, col0 = u.pn * 256 + wc * 32 + 4 * fq;
        const int r = (u.pm % 17 == 0) ? 4 : u.pm / 17;
        const float* m2 = modv_l + (size_t)r * 12288 + 2 * 2048 + col0;
        pg8::f32x4 mv[2][2];
#pragma unroll
        for (int bj = 0; bj < 2; ++bj)
#pragma unroll
            for (int n = 0; n < 2; ++n) mv[bj][n] = *(const pg8::f32x4*)(m2 + bj * 128 + n * 16);
#pragma unroll
        for (int ai = 0; ai < 2; ++ai)
#pragma unroll
            for (int m = 0; m < 4; ++m) {
                const size_t off = (size_t)(row0 + ai * 128 + m * 16) * D + col0;
#pragma unroll
                for (int bj = 0; bj < 2; ++bj)
#pragma unroll
                    for (int n = 0; n < 2; ++n)
                        *(pg8::f32x4*)(Tb + off + bj * 128 + n * 16) = *(const pg8::f32x4*)(X + off + bj * 128 + n * 16) * ALPHA + mv[bj][n] * acc[ai][bj][m][n];
            }
    }
};
struct EpiHid {
    static constexpr bool PERM = true, AFTER_DRAIN = false;
    bf16_t* H;
    __device__ __forceinline__ void operator()(const pg8::f32x4 (&acc)[2][2][4][2], const pg8::Unit& u, int wr, int wc, int fr, int fq) const {
        const int row0 = u.pm * 256 + wr * 64 + fr, col0 = (u.pn & 7) * 128 + wc * 32 + 8 * fq;
#pragma unroll
        for (int ai = 0; ai < 2; ++ai)
#pragma unroll
            for (int m = 0; m < 4; ++m) {
                float hv[8];
#pragma unroll
                for (int n = 0; n < 2; ++n)
#pragma unroll
                    for (int j = 0; j < 4; ++j) hv[n * 4 + j] = siluf_(acc[ai][0][m][n][j]) * acc[ai][1][m][n][j];
                *(u32x4*)(H + (size_t)(row0 + ai * 128 + m * 16) * 1024 + col0) = (u32x4){pk2(hv[0], hv[1]), pk2(hv[2], hv[3]), pk2(hv[4], hv[5]), pk2(hv[6], hv[7])};
            }
    }
};
struct EpiY {
    static constexpr bool PERM = true, AFTER_DRAIN = false;
    bf16_t* Y; const float* gate;
    __device__ __forceinline__ void operator()(const pg8::f32x4 (&acc)[2][2][4][2], const pg8::Unit& u, int wr, int wc, int fr, int fq) const {
        const int row0 = u.pm * 256 + wr * 64 + fr, col0 = (u.pn & 7) * 256 + wc * 32 + 8 * fq;
#pragma unroll
        for (int ai = 0; ai < 2; ++ai)
#pragma unroll
            for (int m = 0; m < 4; ++m) {
                const int row = row0 + ai * 128 + m * 16; const float g = gate[row];
#pragma unroll
                for (int bj = 0; bj < 2; ++bj) {
                    const pg8::f32x4 v0 = acc[ai][bj][m][0] * g, v1 = acc[ai][bj][m][1] * g;
                    *(u32x4*)(Y + (size_t)row * D + col0 + bj * 128) = (u32x4){pk2(v0[0], v0[1]), pk2(v0[2], v0[3]), pk2(v1[0], v1[1]), pk2(v1[2], v1[3])};
                }
            }
    }
};
struct SchedLin {
    int G, c, nUnits, nPn, skip_ctx;
    __device__ __forceinline__ bool next(int i, pg8::Unit& u) const {
        const int L = i * G + c; if (L >= nUnits) return false;
        const int pml = L / nPn; u.pn = L % nPn; u.pm = skip_ctx ? (pml >> 4) * 17 + 1 + (pml & 15) : pml; return true;
    }
    __device__ __forceinline__ void a_ready(const pg8::Unit&) const {}
    __device__ __forceinline__ void done(const pg8::Unit&) const {}
};
struct SchedMoe {
    int G, c, nPm, nUnits;
    __device__ __forceinline__ bool next(int i, pg8::Unit& u) const {
        const int L = i * G + c; if (L >= nUnits) return false;
        const int per = nPm * 8, e = L / per, rem = L % per; u.pm = e * 9 + (rem >> 3); u.pn = e * 8 + (rem & 7); return true;
    }
    __device__ __forceinline__ void a_ready(const pg8::Unit&) const {}
    __device__ __forceinline__ void done(const pg8::Unit&) const {}
};
}

struct Args { const float* in[24]; float* out; unsigned char* ws; int ph_lo, ph_hi; };
constexpr int LDS_BYTES = 147456;
#ifndef MK_NG
#define MK_NG 128
#define MK_NH 48
#endif
constexpr int N_PHASES = 2 + 11 * mk::DEPTH;

__global__ __launch_bounds__(512, 2) void mega_fwd(Args a) {
    using namespace mk;
    extern __shared__ __attribute__((aligned(16))) unsigned char lds_raw[];
    Ctx c0;
#pragma unroll
    for (int i = 0; i < 24; ++i) c0.in[i] = a.in[i];
    c0.out = a.out; c0.ws = a.ws; c0.lds = (LDSP unsigned char*)lds_raw;
    const int wave_s = __builtin_amdgcn_readfirstlane((int)threadIdx.x >> 6);
    c0.tid = threadIdx.x; c0.lane = c0.tid & 63; c0.wave = wave_s; c0.G = gridDim.x; c0.bid = blockIdx.x;
    const int lo = a.ph_lo, hi = a.ph_hi;
    volatile LAS unsigned* st = (volatile LAS unsigned*)(lds_raw + LDS_BYTES - 16);
    if (c0.tid == 0) { st[0] = 0u; st[1] = 0u; st[2] = 0u; st[3] = 0u; }
    __syncthreads();
    XcdBarrier bar; bar.bar = (unsigned*)(a.ws + WS_BAR); bar.x = 0; bar.st = st;
    if (hi - lo > 1) bar = xcd_barrier_post((unsigned*)(a.ws + WS_BAR), st);
    int ph = 0;
#define PH_CTX Ctx c = c0; { int wz = wave_s; asm volatile("" : "+s"(wz)); unsigned zz = 0u; asm volatile("" : "+v"(zz)); const int lz = (int)__builtin_amdgcn_mbcnt_hi(~0u, __builtin_amdgcn_mbcnt_lo(~0u, zz)); int bz = c0.bid; asm volatile("" : "+s"(bz)); c.bid = bz; c.wave = wz; c.lane = lz; c.tid = wz * 64 + lz; }
#define PH_ON (ph >= lo && ph < hi)
#ifdef MK_DBL
#define REP(id) for (int rep_ = 0; rep_ < 1 + (((MK_DBL) >> (id)) & 1); ++rep_, __syncthreads())
#else
#define REP(id)
#endif
#ifdef MK_TPROBE_A
    volatile LAS unsigned long long* tp = (volatile LAS unsigned long long*)(lds_raw + LDS_BYTES - 48);
    if (c0.bid == (MK_TPROBE_WG) && c0.tid == 0) { tp[0] = __builtin_amdgcn_s_memrealtime(); tp[1] = 0ull; tp[2] = 0ull; tp[3] = 0ull; }
#ifdef MK_GSTAMP
    if (c0.tid == 0) { volatile LAS unsigned long long* g0 = (volatile LAS unsigned long long*)(lds_raw + LDS_BYTES - 48 - 80); for (int i = 0; i < 9; ++i) g0[i] = 0ull; }
    __syncthreads();
#endif
#define PH_END do { if (PH_ON && ph + 1 < hi) xcd_barrier(bar); \
        if (c0.bid == (MK_TPROBE_WG) && threadIdx.x == 0) { const unsigned long long now_ = __builtin_amdgcn_s_memrealtime(); const int kind_ = ph < 2 ? ph : 2 + (ph - 2) % 11; \
            if (kind_ >= (MK_TPROBE_A) && kind_ <= (MK_TPROBE_B)) tp[1] += now_ - tp[0]; tp[0] = now_; } ++ph; } while (0)
#else
#define PH_END do { if (PH_ON && ph + 1 < hi) xcd_barrier(bar); ++ph; } while (0)
#endif

    if (PH_ON) REP(0) { PH_CTX
        if (c.bid < 192) { modv_fill_s(c); for (int u = c.bid; u < 192; u += c.G) modv_unit(c, u); }
        convert_phase(c, 0);
    }
    PH_END;
    if (PH_ON) REP(1) { PH_CTX phase_l0_modulate(c); }
    PH_END;

    for (int l = 0; l < DEPTH; ++l) {
        const bool last = (l == DEPTH - 1);
        if (PH_ON) REP(2) { PH_CTX
            pg8::Gemm g{(const pg8::bf16_t*)(c.ws + WS_U), (const pg8::bf16_t*)(c.ws + WS_WIN), MROWS, NINP, D};
            pg8::StaticOrder S; S.init(MROWS, NINP, c.G, c.bid);
            pg8::EpiBf16<0> E{(pg8::bf16_t*)(c.ws + WS_RA + RA_PROJ), NINP, nullptr, 0, 0};
            pg8::gemm_phase<pg8::EpiBf16<0>, pg8::StaticOrder, false>((PG8_LAS unsigned char*)c.lds, g, S, E, nullptr, c.tid);
        }
        PH_END;
        if (PH_ON) REP(3) { PH_CTX
            const bool split = false;
            for (int cc = c.bid; cc < NCC; cc += c.G) gdn_prep_unit(c, l, cc);
        }
        if (PH_ON) REP(4) { PH_CTX
            const bool split = false;
            for (int cc = split ? c.bid - MK_NG : c.bid; cc < NCC && (!split || (c.bid >= MK_NG && c.bid < MK_NG + MK_NH)); cc += split ? MK_NH : c.G) diag_prep_unit<1>(c, l, cc);
        }
        if (PH_ON) REP(5) { PH_CTX
            const bool split = false;
            for (int cc = split ? c.bid - MK_NG - MK_NH : c.bid; cc < NCC && (!split || c.bid >= MK_NG + MK_NH); cc += split ? (256 - MK_NG - MK_NH) : c.G) diag_prep_unit<2>(c, l, cc);
        }
        PH_END;
        if (PH_ON) REP(6) { PH_CTX
            for (int u = c.bid; u < 128; u += c.G) if (u < 64) { scan_unit<0, 64, 3>(c, u & 31, u >> 5); __syncthreads(); }
        }
        if (PH_ON) REP(7) { PH_CTX
            for (int u = c.bid; u < 128; u += c.G) if (u >= 64 && u < 96) { scan_unit<1, 128, 2>(c, u - 64, 0); __syncthreads(); }
        }
        if (PH_ON) REP(8) { PH_CTX
            for (int u = c.bid; u < 128; u += c.G) if (u >= 96) { scan_unit<2, 128, 4>(c, u - 96, 0); __syncthreads(); }
        }
#ifdef MK_TPROBE_A
        if (PH_ON && c0.bid == (MK_TPROBE_WG) && threadIdx.x == 0) { tp[2] += __builtin_amdgcn_s_memrealtime() - tp[0]; }
#endif
        if (PH_ON) REP(9) { PH_CTX
            const int nq = last ? 64 : 68, qx = c.bid & 7;
            unsigned* qhead = (unsigned*)(c.ws + WS_BAR) + 3584 + 8 * (l * 8 + qx);
            volatile LAS unsigned* tk = (volatile LAS unsigned*)(lds_raw + LDS_BYTES - 64);
            for (;;) {
                if (c.tid == 0) tk[0] = __hip_atomic_fetch_add(qhead, 1u, __ATOMIC_RELAXED, __HIP_MEMORY_SCOPE_AGENT);
                __syncthreads();
                const int t = (int)tk[0];
                if (t >= nq) break;
                na_pair(c, l, t < 64 ? 64 * qx + t : 512 + 4 * qx + (t - 64));
            }
        }
#ifdef MK_TPROBE_A
        if (PH_ON && c0.bid == (MK_TPROBE_WG) && threadIdx.x == 0) { tp[3] += __builtin_amdgcn_s_memrealtime() - tp[0]; }
#endif
        PH_END;
        if (PH_ON) REP(10) { PH_CTX phase_combine(c, l); }
        PH_END;
        if (PH_ON) REP(11) { PH_CTX
            pg8::Gemm g{(const pg8::bf16_t*)(c.ws + WS_MIX), (const pg8::bf16_t*)(c.ws + WS_WOUT), MROWS, D, D};
            SchedLin S{c.G, c.bid, (last ? 64 : 68) * 8, 8, last ? 1 : 0};
            EpiOut E{(const float*)(c.ws + WS_X), (const float*)(c.ws + WS_MODV) + (size_t)l * 5 * 12288, (float*)(c.ws + WS_RA + RA_TBUF)};
            pg8::gemm_phase<EpiOut, SchedLin, false>((PG8_LAS unsigned char*)c.lds, g, S, E, nullptr, c.tid);
        }
        PH_END;
        if (PH_ON) REP(12) { PH_CTX phase_ln_router(c, l); }
        PH_END;
        if (PH_ON) REP(13) { PH_CTX const int nprob = last ? 64 : 128; for (int p = c.bid; p < nprob; p += c.G) topk_unit(c, p); }
        PH_END;
        if (PH_ON) REP(14) { PH_CTX phase_gather(c, l); }
        PH_END;
        if (PH_ON) REP(15) { PH_CTX
            pg8::Gemm g{(const pg8::bf16_t*)(c.ws + WS_RA + RA_XS), (const pg8::bf16_t*)(c.ws + WS_W13), NEXP * EROWS, NEXP * 2048, D};
            SchedMoe S{c.G, c.bid, last ? 8 : 9, NEXP * (last ? 8 : 9) * 8};
            EpiHid E{(bf16_t*)(c.ws + WS_RA + RA_HID)};
            pg8::gemm_phase<EpiHid, SchedMoe, false>((PG8_LAS unsigned char*)c.lds, g, S, E, nullptr, c.tid);
        }
        PH_END;
        if (PH_ON) REP(16) { PH_CTX
            pg8::Gemm g{(const pg8::bf16_t*)(c.ws + WS_RA + RA_HID), (const pg8::bf16_t*)(c.ws + WS_W2), NEXP * EROWS, NEXP * 2048, 1024};
            SchedMoe S{c.G, c.bid, last ? 8 : 9, NEXP * (last ? 8 : 9) * 8};
            EpiY E{(bf16_t*)(c.ws + WS_RA + RA_YS), (const float*)(c.ws + WS_GATE)};
            pg8::gemm_phase<EpiY, SchedMoe, false>((PG8_LAS unsigned char*)c.lds, g, S, E, nullptr, c.tid);
        }
        PH_END;
        if (PH_ON) REP(17) { PH_CTX phase_final(c, l); }
        if (PH_ON) REP(18) { PH_CTX if (!last) convert_phase(c, l + 1); }
        PH_END;
    }
#ifdef MK_TPROBE_A
    if (c0.bid == (MK_TPROBE_WG) && threadIdx.x == 0) { const unsigned long long t0_ = __builtin_amdgcn_s_memrealtime(), w_ =
#ifdef MK_GSTAMP
        ((volatile LAS unsigned long long*)(lds_raw + LDS_BYTES - 48 - 80))[MK_GSTAMP] * (unsigned long long)(MK_TPROBE_MULT);
#else
        tp[MK_TPROBE_SEL] * (unsigned long long)(MK_TPROBE_MULT);
#endif
        while (__builtin_amdgcn_s_memrealtime() - t0_ < w_) __builtin_amdgcn_s_sleep(32); }
#endif
}

#ifdef MK_STOP
__global__ void digest_k(const unsigned* w0, size_t n0, const unsigned* w1, size_t n1, float* out, size_t nout) {
    for (size_t i = (size_t)blockIdx.x * blockDim.x + threadIdx.x; i < nout; i += (size_t)gridDim.x * blockDim.x) {
        unsigned h = 0u;
        for (size_t j = i; j < n0 + n1; j += nout) {
#ifdef MK_RW0
            const size_t rw = j < n0 ? (size_t)(MK_RW0) : (size_t)(MK_RW1); const size_t row = (j < n0 ? j : j - n0) / rw;
            if (row % 4352 < 256) continue;
#endif
#ifdef MK_NANCOUNT
            { const unsigned wv = (j < n0 ? w0[j] : w1[j - n0]);
#ifdef MK_BF16
              if ((wv & 0x7F800000u) == 0x7F800000u || (wv & 0x7F80u) == 0x7F80u) h += 1u; }
#else
              if ((wv & 0x7F800000u) == 0x7F800000u) h += 1u; }
#endif
#else
            h = h * 31u + (j < n0 ? w0[j] : w1[j - n0]);
#endif
        }
#ifdef MK_NANCOUNT
        out[i] = 1000.f * (float)h;
#else
        out[i] = (float)(h & 0xFFFFFu);
#endif
    }
}
#endif
extern "C" void kernel_launch(void* const* d_in, const int* in_sizes, int n_in, void* d_out, int out_size, void* d_ws, size_t ws_size, hipStream_t stream) {
    static int grid = 0;
    if (grid == 0) {
        if (n_in != 24 || ws_size < mk::WS_TOTAL) { fprintf(stderr, "kernel_launch: n_in %d ws %zu (need %zu)\n", n_in, ws_size, (size_t)mk::WS_TOTAL); grid = -1; return; }
        int dev = 0, cus = 0, per_cu = 0;
        if (hipGetDevice(&dev) != hipSuccess || hipDeviceGetAttribute(&cus, hipDeviceAttributeMultiprocessorCount, dev) != hipSuccess) { grid = -1; return; }
        if (hipFuncSetAttribute((const void*)mega_fwd, hipFuncAttributeMaxDynamicSharedMemorySize, LDS_BYTES) != hipSuccess) { fprintf(stderr, "kernel_launch: hipFuncSetAttribute failed\n"); grid = -1; return; }
        if (hipOccupancyMaxActiveBlocksPerMultiprocessor(&per_cu, (const void*)mega_fwd, 512, LDS_BYTES) != hipSuccess || per_cu < 1) fprintf(stderr, "kernel_launch: occupancy query says %d\n", per_cu);
        (void)hipGetLastError();
        grid = cus;
    }
    if (grid < 0) return;
    (void)hipMemsetAsync((char*)d_ws + mk::WS_BAR, 0, 16384, stream);
    Args a{};
    for (int i = 0; i < 24; ++i) a.in[i] = (const float*)d_in[i];
    a.out = (float*)d_out; a.ws = (unsigned char*)d_ws;
#if MK_N_LAUNCHES == 1
    a.ph_lo = 0; a.ph_hi = N_PHASES;
    hipLaunchKernelGGL(mega_fwd, dim3(grid), dim3(512), LDS_BYTES, stream, a);
#else
#ifdef MK_STOP
    for (int p = 0; p < MK_STOP; ++p) { a.ph_lo = p; a.ph_hi = p + 1; hipLaunchKernelGGL(mega_fwd, dim3(grid), dim3(512), LDS_BYTES, stream, a); }
    hipLaunchKernelGGL(digest_k, dim3(2048), dim3(256), 0, stream, (const unsigned*)((char*)d_ws + (size_t)(MK_D0)), (size_t)(MK_N0) / 4, (const unsigned*)((char*)d_ws + (size_t)(MK_D1)), (size_t)(MK_N1) / 4, (float*)d_out, (size_t)out_size);
#else
    for (int p = 0; p < N_PHASES; ++p) { a.ph_lo = p; a.ph_hi = p + 1; hipLaunchKernelGGL(mega_fwd, dim3(grid), dim3(512), LDS_BYTES, stream, a); }
#endif
#endif
}
```

```cpp
#include <hip/hip_runtime.h>
#include <cstdio>
#include <cstdint>
#ifndef MK_N_LAUNCHES
#define MK_N_LAUNCHES 1
#endif
namespace pg8 {
#define PG8_LAS __attribute__((address_space(3)))
typedef unsigned short bf16_t;
typedef short bf16x8 __attribute__((ext_vector_type(8)));
typedef float f32x4 __attribute__((ext_vector_type(4)));
typedef unsigned u32x4 __attribute__((ext_vector_type(4)));
constexpr int BM = 256, BK = 64, HALF = 128, HTB = HALF * BK * 2  , STAGE_BYTES = 8 * HTB, NXCD = 8, WGM = 8;

__host__ __device__ __forceinline__ int lds_byte(int r, int c) { const int st = (r >> 4) * 2 + (c >> 5), rr = r & 15, cc = c & 31, ob = rr * 64 + cc * 2; return st * 1024 + (ob ^ (((ob >> 9) & 1) << 5)); }
__host__ __device__ __forceinline__ void stage_rc(int b, int& R, int& C) { const int st = b / 1024, sb = b % 1024, swz = sb ^ (((sb >> 9) & 1) << 5); R = (st >> 1) * 16 + swz / 64; C = (st & 1) * 32 + (swz % 64) / 2; }
__host__ __device__ __forceinline__ int perm32(int rho) { const int n = rho >> 4, i = rho & 15; return 8 * (i >> 2) + 4 * n + (i & 3); }

struct Unit { int pm, pn; };
struct Gemm { const bf16_t* A; const bf16_t* Bt; int M, N, K; };

struct StaticOrder {
    int nM, nN, nwg, G, c;
    __host__ __device__ void init(int M, int N, int G_, int c_) { nM = M / BM; nN = N / BM; nwg = nM * nN; G = G_; c = c_; }
    __host__ __device__ bool next(int i, Unit& u) const {
        const long L = (long)i * G + c; if (L >= nwg) return false;
        int wgid = (int)L; { const int q = nwg / NXCD, r = nwg % NXCD, xcd = wgid % NXCD, off = wgid / NXCD; wgid = (xcd < r ? xcd * (q + 1) : r * (q + 1) + (xcd - r) * q) + off; }
        const int nig = WGM * nN, gid = wgid / nig, fm = gid * WGM, gsz = (nM - fm) < WGM ? (nM - fm) : WGM;
        u.pm = fm + ((wgid % nig) % gsz); u.pn = (wgid % nig) / gsz; return true;
    }
    __device__ __forceinline__ void a_ready(const Unit&) const {}
    __device__ __forceinline__ void done(const Unit&) const {}
};
struct CountedOrder : StaticOrder {
    const unsigned* ready; unsigned need; unsigned* tmo;
    __device__ __forceinline__ void a_ready(const Unit& u) const {
        if (threadIdx.x < 64) {
            const unsigned long long t0 = __builtin_amdgcn_s_memrealtime(); unsigned polls = 0;
            while ((unsigned)__builtin_amdgcn_readfirstlane(__hip_atomic_load(ready + 64 * u.pm, __ATOMIC_RELAXED, __HIP_MEMORY_SCOPE_AGENT)) < need) {
                if ((++polls & 255u) == 0u && __builtin_amdgcn_readfirstlane(__hip_atomic_load(tmo, __ATOMIC_RELAXED, __HIP_MEMORY_SCOPE_AGENT)) != 0u) break;
                if (__builtin_amdgcn_s_memrealtime() - t0 > 2000000ull) {
                    if (threadIdx.x == 0) { unsigned expect = 0u; __hip_atomic_compare_exchange_strong(tmo + 1, &expect, 0x600u | (unsigned)(u.pm & 0xff), __ATOMIC_RELAXED, __ATOMIC_RELAXED, __HIP_MEMORY_SCOPE_AGENT); __hip_atomic_store(tmo, 1u, __ATOMIC_RELAXED, __HIP_MEMORY_SCOPE_AGENT); }
                    break; }
                __builtin_amdgcn_s_sleep(2); }
            __builtin_amdgcn_fence(__ATOMIC_ACQUIRE, "agent");
            asm volatile("s_waitcnt vmcnt(0)" ::: "memory");
        }
#if !defined(BROKEN_HOOK_NO_BARRIER)
        asm volatile("" ::: "memory"); __builtin_amdgcn_s_barrier(); asm volatile("" ::: "memory");
#endif
    }
};

typedef float f32x2_cv __attribute__((ext_vector_type(2)));
typedef __bf16 bf16x2_cv __attribute__((ext_vector_type(2)));
__device__ __forceinline__ unsigned cvt_pk_bf16(float lo, float hi) { const bf16x2_cv v = __builtin_convertvector((f32x2_cv){lo, hi}, bf16x2_cv); return __builtin_bit_cast(unsigned, v); }
typedef float f32x2 __attribute__((ext_vector_type(2)));
__device__ __forceinline__ f32x2 gelu_pk(f32x2 v) {
    const f32x2 av = __builtin_elementwise_abs(v), d = av * 0.2316418882f + 1.0f;
    f32x2 t; t.x = __builtin_amdgcn_rcpf(d.x); t.y = __builtin_amdgcn_rcpf(d.y);
    f32x2 q = t * 0.5307027145f + (-0.7265760135f); q = q * t + 0.7107068705f; q = q * t + (-0.142248368f); q = q * t + 0.127414796f; q = q * t;
    const f32x2 s = (v * v) * (-0.72134752044f);
    f32x2 e; e.x = __builtin_amdgcn_exp2f(s.x); e.y = __builtin_amdgcn_exp2f(s.y);
    const f32x2 m = v * (q * e), r = v - m;
    f32x2 o; o.x = v.x < 0.f ? m.x : r.x; o.y = v.y < 0.f ? m.y : r.y; return o;
}

struct EpiF32 {
    static constexpr bool PERM = false, AFTER_DRAIN = false;
    float* C; int ldc; const float* bias;
    __device__ __forceinline__ void operator()(const f32x4 (&acc)[2][2][4][2], const Unit& u, int wr, int wc, int fr, int fq) const {
        const int row0 = u.pm * BM + wr * 64 + fr, col0 = u.pn * BM + wc * 32 + 4 * fq;
        f32x4 bv[2][2];
#pragma unroll
        for (int bj = 0; bj < 2; ++bj)
#pragma unroll
            for (int n = 0; n < 2; ++n) bv[bj][n] = bias ? *(const f32x4*)(bias + col0 + bj * HALF + n * 16) : (f32x4){0.f, 0.f, 0.f, 0.f};
#pragma unroll
        for (int ai = 0; ai < 2; ++ai)
#pragma unroll
            for (int m = 0; m < 4; ++m) { float* rowp = C + (size_t)(row0 + ai * HALF + m * 16) * ldc + col0;
#pragma unroll
                for (int bj = 0; bj < 2; ++bj)
#pragma unroll
                    for (int n = 0; n < 2; ++n) *(f32x4*)(rowp + bj * HALF + n * 16) = acc[ai][bj][m][n] + bv[bj][n]; }
    }
};
template <int ACT  > struct EpiBf16 {
    static constexpr bool PERM = true, AFTER_DRAIN = false;
    bf16_t* O; int ldc; const float* bias; int split_cols; size_t split_stride;
    __device__ __forceinline__ void operator()(const f32x4 (&acc)[2][2][4][2], const Unit& u, int wr, int wc, int fr, int fq) const {
        const int row0 = u.pm * BM + wr * 64 + fr; int colt = u.pn * BM; bf16_t* base = O;
        if (split_cols) { const int t = colt / split_cols; base += (size_t)t * split_stride; colt -= t * split_cols; }
        const int col0 = colt + wc * 32 + 8 * fq, bcol0 = u.pn * BM + wc * 32 + 8 * fq;
        f32x4 bv[2][2];
#pragma unroll
        for (int bj = 0; bj < 2; ++bj)
#pragma unroll
            for (int n = 0; n < 2; ++n) bv[bj][n] = bias ? *(const f32x4*)(bias + bcol0 + bj * HALF + 4 * n) : (f32x4){0.f, 0.f, 0.f, 0.f};
#pragma unroll
        for (int ai = 0; ai < 2; ++ai)
#pragma unroll
            for (int m = 0; m < 4; ++m) { bf16_t* rowp = base + (size_t)(row0 + ai * HALF + m * 16) * ldc + col0;
#pragma unroll
                for (int bj = 0; bj < 2; ++bj) { f32x4 v0 = acc[ai][bj][m][0] + bv[bj][0], v1 = acc[ai][bj][m][1] + bv[bj][1];
                    if (ACT == 1) { f32x2 a = gelu_pk((f32x2){v0[0], v0[1]}), b = gelu_pk((f32x2){v0[2], v0[3]}), c = gelu_pk((f32x2){v1[0], v1[1]}), d = gelu_pk((f32x2){v1[2], v1[3]});
                        v0 = (f32x4){a.x, a.y, b.x, b.y}; v1 = (f32x4){c.x, c.y, d.x, d.y}; }
                    if (ACT == 2) {
#pragma unroll
                        for (int j = 0; j < 4; ++j) { v0[j] = 0.5f * v0[j] * (1.0f + erff(v0[j] * 0.70710678f)); v1[j] = 0.5f * v1[j] * (1.0f + erff(v1[j] * 0.70710678f)); } }
                    u32x4 w; w.x = cvt_pk_bf16(v0[0], v0[1]); w.y = cvt_pk_bf16(v0[2], v0[3]); w.z = cvt_pk_bf16(v1[0], v1[1]); w.w = cvt_pk_bf16(v1[2], v1[3]);
                    *(u32x4*)(rowp + bj * HALF) = w; } }
    }
};

struct PanelStats {
    unsigned* xbuf;
    unsigned* cnt;
    unsigned* tmo;
    int ntn; float eps;
    unsigned code;
    __device__ __forceinline__ bool run(const f32x4 (&v)[2][2][4][2], const Unit& u, int wr, int wc, int fr, int fq, PG8_LAS unsigned char* lds, int wid, int lane) const {
        typedef float f32x2v __attribute__((ext_vector_type(2)));
        PG8_LAS f32x2v* P = (PG8_LAS f32x2v*)lds;
        PG8_LAS f32x2v* S = (PG8_LAS f32x2v*)(lds + 8192);
        PG8_LAS unsigned* flag = (PG8_LAS unsigned*)(lds + 8192 + 2048);
#pragma unroll
        for (int ai = 0; ai < 2; ++ai)
#pragma unroll
            for (int m = 0; m < 4; ++m) {
                float s = 0.f;
#pragma unroll
                for (int bj = 0; bj < 2; ++bj)
#pragma unroll
                    for (int n = 0; n < 2; ++n) { const f32x4 x = v[ai][bj][m][n]; s += (x[0] + x[1]) + (x[2] + x[3]); }
                s += __shfl_xor(s, 16); s += __shfl_xor(s, 32);
                const float mw = s * (1.0f / 64.0f); float q = 0.f;
#pragma unroll
                for (int bj = 0; bj < 2; ++bj)
#pragma unroll
                    for (int n = 0; n < 2; ++n) { const f32x4 d = v[ai][bj][m][n] - mw; q += (d[0] * d[0] + d[1] * d[1]) + (d[2] * d[2] + d[3] * d[3]); }
                q += __shfl_xor(q, 16); q += __shfl_xor(q, 32);
                if (fq == 0) P[(ai * HALF + wr * 64 + m * 16 + fr) * 4 + wc] = (f32x2v){mw, q};
            }
        asm volatile("s_waitcnt lgkmcnt(0)" ::: "memory"); __builtin_amdgcn_s_barrier(); asm volatile("" ::: "memory");
#if defined(BROKEN_NO_WAIT)
        if (blockIdx.x >= 64) { const long long t0 = clock64(); while (clock64() - t0 < 60000) __builtin_amdgcn_s_sleep(8); }
#endif
        const int row = wid * 32 + (lane & 31);
        if (lane < 32) {
            const f32x2v a = P[row * 4 + 0], b = P[row * 4 + 1], c = P[row * 4 + 2], d = P[row * 4 + 3];
            const float mt = (a.x + b.x + c.x + d.x) * 0.25f;
            const float da = a.x - mt, db = b.x - mt, dc = c.x - mt, dd = d.x - mt;
            const float m2 = (a.y + b.y) + (c.y + d.y) + 64.0f * ((da * da + db * db) + (dc * dc + dd * dd));
            unsigned long long* slot = (unsigned long long*)xbuf + ((size_t)(u.pm * BM + row) * 4 + u.pn);
            __hip_atomic_store(slot, ((unsigned long long)__float_as_uint(m2) << 32) | __float_as_uint(mt), __ATOMIC_RELAXED, __HIP_MEMORY_SCOPE_AGENT);
        }
        asm volatile("s_waitcnt vmcnt(0)" ::: "memory");
        if (lane == 0) __hip_atomic_fetch_add(cnt + 64 * u.pm, 1u, __ATOMIC_RELAXED, __HIP_MEMORY_SCOPE_AGENT);
        if (wid == 0) {
            bool dead = false; const unsigned long long t0 = __builtin_amdgcn_s_memrealtime(); const unsigned want = 8u * (unsigned)ntn;
            for (;;) {
#if defined(BROKEN_NO_WAIT)
                break;
#endif
                if ((unsigned)__builtin_amdgcn_readfirstlane(__hip_atomic_load(cnt + 64 * u.pm, __ATOMIC_RELAXED, __HIP_MEMORY_SCOPE_AGENT)) >= want) break;
                if (__builtin_amdgcn_s_memrealtime() - t0 > 2000000ull) {
                    if (lane == 0) { unsigned expect = 0u; __hip_atomic_compare_exchange_strong(tmo + 1, &expect, code | (unsigned)(u.pm & 0xff), __ATOMIC_RELAXED, __ATOMIC_RELAXED, __HIP_MEMORY_SCOPE_AGENT);
                                     __hip_atomic_store(tmo, 1u, __ATOMIC_RELAXED, __HIP_MEMORY_SCOPE_AGENT); }
                    dead = true; break; }
                __builtin_amdgcn_s_sleep(2);
            }
            __builtin_amdgcn_fence(__ATOMIC_ACQUIRE, "agent");
            if (lane == 0) flag[0] = dead ? 1u : 0u;
        }
        asm volatile("s_waitcnt vmcnt(0) lgkmcnt(0)" ::: "memory"); __builtin_amdgcn_s_barrier(); asm volatile("" ::: "memory");
        const bool bad = flag[0] != 0u;
        if (lane < 32) {
            const unsigned long long* slot = (const unsigned long long*)xbuf + (size_t)(u.pm * BM + row) * 4; float mt[4], m2[4]; float ms = 0.f;
#pragma unroll
            for (int t = 0; t < 4; ++t) { if (t < ntn) { const unsigned long long w = __hip_atomic_load(slot + t, __ATOMIC_RELAXED, __HIP_MEMORY_SCOPE_AGENT); mt[t] = __uint_as_float((unsigned)w); m2[t] = __uint_as_float((unsigned)(w >> 32)); } else { mt[t] = 0.f; m2[t] = 0.f; } ms += mt[t]; }
            const float mean = ms / (float)ntn; float q = 0.f;
#pragma unroll
            for (int t = 0; t < 4; ++t) if (t < ntn) { const float dm = mt[t] - mean; q += m2[t] + 256.0f * dm * dm; }
            S[row] = (f32x2v){mean, 1.0f / sqrtf(q / (256.0f * (float)ntn) + eps)};
        }
        asm volatile("s_waitcnt lgkmcnt(0)" ::: "memory"); __builtin_amdgcn_s_barrier(); asm volatile("" ::: "memory");
        return bad;
    }
};
struct EpiLnRes {
    static constexpr bool PERM = false, AFTER_DRAIN = true;
    const float* base; float* out; int ldc; const float* bias; PanelStats st; unsigned poison;
    __device__ __forceinline__ void refuse(size_t i0, size_t stride, int M, int N) const { const float q = __builtin_nanf(""); for (size_t i = i0; i < (size_t)M * N; i += stride) out[(i / N) * ldc + i % N] = q;
        if (i0 == 0) { unsigned expect = 0u; __hip_atomic_compare_exchange_strong(st.tmo + 1, &expect, 0x7f0u, __ATOMIC_RELAXED, __ATOMIC_RELAXED, __HIP_MEMORY_SCOPE_AGENT); __hip_atomic_store(st.tmo, 1u, __ATOMIC_RELAXED, __HIP_MEMORY_SCOPE_AGENT); } }
    __device__ __forceinline__ void fused(f32x4 (&acc)[2][2][4][2], const Unit& u, int wr, int wc, int fr, int fq, PG8_LAS unsigned char* lds, int wid, int lane) const {
        typedef float f32x2v __attribute__((ext_vector_type(2)));
        const PG8_LAS f32x2v* S = (const PG8_LAS f32x2v*)(lds + 8192);
        const int col0 = u.pn * BM + wc * 32 + 4 * fq;
#pragma unroll
        for (int bj = 0; bj < 2; ++bj)
#pragma unroll
            for (int n = 0; n < 2; ++n) { const f32x4 bv = bias ? *(const f32x4*)(bias + col0 + bj * HALF + n * 16) : (f32x4){0.f, 0.f, 0.f, 0.f};
#pragma unroll
                for (int ai = 0; ai < 2; ++ai)
#pragma unroll
                    for (int m = 0; m < 4; ++m) acc[ai][bj][m][n] += bv; }
        const bool bad = st.run(acc, u, wr, wc, fr, fq, lds, wid, lane) || poison != 0u;
        const float qnan = __builtin_nanf("");
#pragma unroll
        for (int ai = 0; ai < 2; ++ai)
#pragma unroll
            for (int m = 0; m < 4; ++m) { const int r = ai * HALF + wr * 64 + m * 16 + fr; const f32x2v sr = S[r]; const size_t off = (size_t)(u.pm * BM + r) * ldc + col0;
#pragma unroll
                for (int bj = 0; bj < 2; ++bj)
#pragma unroll
                    for (int n = 0; n < 2; ++n) { const f32x4 bs = *(const f32x4*)(base + off + bj * HALF + n * 16); f32x4 o = bs + (acc[ai][bj][m][n] - sr.x) * sr.y;
                        if (bad) o = (f32x4){qnan, qnan, qnan, qnan}; *(f32x4*)(out + off + bj * HALF + n * 16) = o; }
                asm volatile("" ::: "memory"); }
    }
};
struct EpiLnResLn {
    static constexpr bool PERM = false, AFTER_DRAIN = true;
    const float* base; float* out; bf16_t* xn; int ldc; const float* bias; PanelStats st1, st2; unsigned poison;
    __device__ __forceinline__ void refuse(size_t i0, size_t stride, int M, int N) const { const float q = __builtin_nanf(""); for (size_t i = i0; i < (size_t)M * N; i += stride) { const size_t o = (i / N) * ldc + i % N; out[o] = q; xn[o] = (bf16_t)0x7fc0u; }
        if (i0 == 0) { unsigned expect = 0u; __hip_atomic_compare_exchange_strong(st1.tmo + 1, &expect, 0x7f0u, __ATOMIC_RELAXED, __ATOMIC_RELAXED, __HIP_MEMORY_SCOPE_AGENT); __hip_atomic_store(st1.tmo, 1u, __ATOMIC_RELAXED, __HIP_MEMORY_SCOPE_AGENT); } }
    __device__ __forceinline__ void fused(f32x4 (&acc)[2][2][4][2], const Unit& u, int wr, int wc, int fr, int fq, PG8_LAS unsigned char* lds, int wid, int lane) const {
        typedef float f32x2v __attribute__((ext_vector_type(2))); typedef unsigned u32x2v __attribute__((ext_vector_type(2)));
        const PG8_LAS f32x2v* S = (const PG8_LAS f32x2v*)(lds + 8192);
        const int col0 = u.pn * BM + wc * 32 + 4 * fq;
#pragma unroll
        for (int bj = 0; bj < 2; ++bj)
#pragma unroll
            for (int n = 0; n < 2; ++n) { const f32x4 bv = bias ? *(const f32x4*)(bias + col0 + bj * HALF + n * 16) : (f32x4){0.f, 0.f, 0.f, 0.f};
#pragma unroll
                for (int ai = 0; ai < 2; ++ai)
#pragma unroll
                    for (int m = 0; m < 4; ++m) acc[ai][bj][m][n] += bv; }
        bool bad = st1.run(acc, u, wr, wc, fr, fq, lds, wid, lane) || poison != 0u;
        const float qnan = __builtin_nanf("");
#pragma unroll
        for (int ai = 0; ai < 2; ++ai)
#pragma unroll
            for (int m = 0; m < 4; ++m) { const int r = ai * HALF + wr * 64 + m * 16 + fr; const f32x2v sr = S[r]; const size_t off = (size_t)(u.pm * BM + r) * ldc + col0;
#pragma unroll
                for (int bj = 0; bj < 2; ++bj)
#pragma unroll
                    for (int n = 0; n < 2; ++n) { const f32x4 bs = *(const f32x4*)(base + off + bj * HALF + n * 16); acc[ai][bj][m][n] = bs + (acc[ai][bj][m][n] - sr.x) * sr.y; }
                asm volatile("" : "+v"(acc[ai][0][m][0]), "+v"(acc[ai][0][m][1]), "+v"(acc[ai][1][m][0]), "+v"(acc[ai][1][m][1]));
                if (m & 1) asm volatile("" ::: "memory"); }
        const bool bad1 = bad;
        bad = st2.run(acc, u, wr, wc, fr, fq, lds, wid, lane) || bad;
#pragma unroll
        for (int ai = 0; ai < 2; ++ai)
#pragma unroll
            for (int m = 0; m < 4; ++m) { const int r = ai * HALF + wr * 64 + m * 16 + fr; const f32x2v sr = S[r]; const size_t off = (size_t)(u.pm * BM + r) * ldc + col0;
#pragma unroll
                for (int bj = 0; bj < 2; ++bj)
#pragma unroll
                    for (int n = 0; n < 2; ++n) { const f32x4 x1 = acc[ai][bj][m][n]; *(f32x4*)(out + off + bj * HALF + n * 16) = bad1 ? (f32x4){qnan, qnan, qnan, qnan} : x1;
                        const f32x4 o = (x1 - sr.x) * sr.y; u32x2v w; w.x = cvt_pk_bf16(o[0], o[1]); w.y = cvt_pk_bf16(o[2], o[3]);
                        if (bad) { w.x = 0x7fc07fc0u; w.y = 0x7fc07fc0u; } *(u32x2v*)(xn + off + bj * HALF + n * 16) = w; }
                asm volatile("" ::: "memory"); }
    }
};

template <class Epi, class Sched, bool STAMP = false>
__device__ __forceinline__ void gemm_phase(PG8_LAS unsigned char* lds, const Gemm g, const Sched& S, const Epi& E, unsigned long long* stamps, int tid_in) {
    int tid_ = tid_in; asm volatile("" : "+v"(tid_));
    const int tid = tid_, wid = __builtin_amdgcn_readfirstlane(tid >> 6), lane = tid & 63, wr = wid >> 2, wc = wid & 3, fr = lane & 15, fq = lane >> 4;
    const int K = g.K, nt = K / BK;
    int ts_lo = 0, ts_hi = 0, nts = 0; const unsigned long long rt_entry = STAMP ? (unsigned long long)wall_clock64() : 0ull;
#define PG8_STAMP() do { if (STAMP && wid == 0 && nts < 64) { const unsigned long long _c = (unsigned long long)clock64(); \
        ts_lo = (lane == nts) ? (int)(unsigned)_c : ts_lo; ts_hi = (lane == nts) ? (int)(unsigned)(_c >> 32) : ts_hi; ++nts; } } while (0)
    PG8_STAMP();
    unsigned voffA[2], voffB[2];
#pragma unroll
    for (int i = 0; i < 2; ++i) { int R, C; stage_rc(tid * 16 + i * 8192, R, C); const int Rb = Epi::PERM ? ((R & ~31) + perm32(R & 31)) : R;
        voffA[i] = (unsigned)(R * K + C) * 2u; voffB[i] = (unsigned)(Rb * K + C) * 2u; }
    const size_t kstep = (size_t)(BK * 2);
    const size_t hstep = (size_t)HALF * K * 2;
    const size_t tstep = 2 * hstep;
    const unsigned ldsw = (unsigned)wid * 1024u;
    const int aoff = lds_byte(wr * 64 + fr, fq * 8), boff = lds_byte(wc * 32 + fr, fq * 8);
#define PG8_SA(b, h) (((b) * 2 + (h)) * HTB)
#define PG8_SB(b, h) ((4 + (b) * 2 + (h)) * HTB)
#define PG8_STAGE(bufoff, gbase, voff) do { _Pragma("unroll") for (int _i = 0; _i < 2; ++_i) \
        __builtin_amdgcn_global_load_lds((const unsigned*)((const char*)(gbase) + (voff)[_i]), (PG8_LAS unsigned*)(lds + (bufoff) + ldsw + _i * 8192), 16, 0, 0); } while (0)
#define PG8_LDA(dst, b, h) do { _Pragma("unroll") for (int m = 0; m < 4; ++m) _Pragma("unroll") for (int k = 0; k < 2; ++k) dst[m][k] = *(const PG8_LAS bf16x8*)(lds + PG8_SA(b, h) + aoff + m * 2048 + k * 1024); } while (0)
#define PG8_LDB(dst, b, h) do { _Pragma("unroll") for (int n = 0; n < 2; ++n) _Pragma("unroll") for (int k = 0; k < 2; ++k) dst[n][k] = *(const PG8_LAS bf16x8*)(lds + PG8_SB(b, h) + boff + n * 2048 + k * 1024); } while (0)
#define PG8_MMA(ai, bj, At, Bt) do { __builtin_amdgcn_s_setprio(1); _Pragma("unroll") for (int m = 0; m < 4; ++m) _Pragma("unroll") for (int n = 0; n < 2; ++n) _Pragma("unroll") for (int k = 0; k < 2; ++k) \
        acc[ai][bj][m][n] = __builtin_amdgcn_mfma_f32_16x16x32_bf16(Bt[n][k], At[m][k], acc[ai][bj][m][n], 0, 0, 0); __builtin_amdgcn_s_setprio(0); } while (0)
#define PG8_WAIT_V(n) asm volatile("s_waitcnt vmcnt(" #n ")" ::: "memory")
#define PG8_WAIT_L(n) asm volatile("s_waitcnt lgkmcnt(" #n ")" ::: "memory")
#define PG8_BAR __builtin_amdgcn_s_barrier()
#define PG8_SCHED __builtin_amdgcn_sched_barrier(0)
    Unit cur, nxt; int ui = 0;
    if (!S.next(0, cur)) return;
    f32x4 acc[2][2][4][2];
#pragma unroll
    for (int a = 0; a < 2; ++a)
#pragma unroll
        for (int b = 0; b < 2; ++b)
#pragma unroll
            for (int m = 0; m < 4; ++m)
#pragma unroll
                for (int n = 0; n < 2; ++n) acc[a][b][m][n] = (f32x4){0.f, 0.f, 0.f, 0.f};
    bf16x8 At[4][2], B0[2][2], B1[2][2];
    const char* cA = (const char*)g.A + (size_t)cur.pm * tstep; const char* cB = (const char*)g.Bt + (size_t)cur.pn * tstep;
    S.a_ready(cur);
    PG8_STAGE(PG8_SB(0, 0), cB, voffB); PG8_STAGE(PG8_SA(0, 0), cA, voffA); PG8_STAGE(PG8_SB(0, 1), cB + hstep, voffB); PG8_STAGE(PG8_SA(0, 1), cA + hstep, voffA);
    if (wr == 1) PG8_BAR;
    PG8_WAIT_V(4); PG8_BAR;
    PG8_STAGE(PG8_SB(1, 0), cB + kstep, voffB); PG8_STAGE(PG8_SA(1, 0), cA + kstep, voffA); PG8_STAGE(PG8_SB(1, 1), cB + hstep + kstep, voffB);
    PG8_WAIT_V(6); PG8_BAR;
    PG8_STAMP();
    for (;;) {
        const bool has_next = S.next(ui + 1, nxt);
        const char* nA = has_next ? (const char*)g.A + (size_t)nxt.pm * tstep : cA; const char* nB = has_next ? (const char*)g.Bt + (size_t)nxt.pn * tstep : cB;
        for (int t = 0; t < nt; t += 2) {
            const bool last = (t == nt - 2);
            const char* a1 = cA + (size_t)(t + 1) * kstep;
            const char* a2 = last ? nA : cA + (size_t)(t + 2) * kstep; const char* b2 = last ? nB : cB + (size_t)(t + 2) * kstep;
            const char* a3 = a2 + kstep; const char* b3 = b2 + kstep;
            if (last && has_next) S.a_ready(nxt);
            PG8_LDB(B0, 0, 0); PG8_SCHED; PG8_LDA(At, 0, 0); PG8_STAGE(PG8_SA(1, 1), a1 + hstep, voffA);
            PG8_WAIT_L(8); PG8_BAR; PG8_WAIT_L(0); PG8_MMA(0, 0, At, B0); PG8_BAR; PG8_SCHED;
            PG8_LDB(B1, 0, 1); PG8_STAGE(PG8_SB(0, 0), b2, voffB);
            PG8_BAR; PG8_WAIT_L(0); PG8_MMA(0, 1, At, B1); PG8_BAR;
            PG8_LDA(At, 0, 1); PG8_STAGE(PG8_SA(0, 0), a2, voffA);
            PG8_BAR; PG8_WAIT_L(0); PG8_MMA(1, 0, At, B0); PG8_BAR; PG8_SCHED;
            PG8_STAGE(PG8_SB(0, 1), b2 + hstep, voffB);
            PG8_WAIT_V(6); PG8_BAR; PG8_MMA(1, 1, At, B1); PG8_BAR;
            PG8_LDB(B0, 1, 0); PG8_SCHED; PG8_LDA(At, 1, 0); PG8_STAGE(PG8_SA(0, 1), a2 + hstep, voffA);
            PG8_WAIT_L(8); PG8_BAR; PG8_WAIT_L(0); PG8_MMA(0, 0, At, B0); PG8_BAR; PG8_SCHED;
            PG8_LDB(B1, 1, 1); PG8_STAGE(PG8_SB(1, 0), b3, voffB);
            PG8_BAR; PG8_WAIT_L(0); PG8_MMA(0, 1, At, B1); PG8_BAR;
            PG8_LDA(At, 1, 1); PG8_STAGE(PG8_SA(1, 0), a3, voffA);
            PG8_BAR; PG8_WAIT_L(0); PG8_MMA(1, 0, At, B0); PG8_BAR; PG8_SCHED;
            PG8_STAGE(PG8_SB(1, 1), b3 + hstep, voffB);
            PG8_WAIT_V(6); PG8_BAR; PG8_MMA(1, 1, At, B1); PG8_BAR;
        }
        PG8_STAMP();
        if constexpr (!Epi::AFTER_DRAIN) { E(acc, cur, wr, wc, fr, fq); S.done(cur); }
        PG8_STAMP();
        if (!has_next) break;
#pragma unroll
        for (int a = 0; a < 2; ++a)
#pragma unroll
            for (int b = 0; b < 2; ++b)
#pragma unroll
                for (int m = 0; m < 4; ++m)
#pragma unroll
                    for (int n = 0; n < 2; ++n) acc[a][b][m][n] = (f32x4){0.f, 0.f, 0.f, 0.f};
        cur = nxt; cA = nA; cB = nB; ++ui;
    }
    PG8_WAIT_V(0);
    if (wr == 0) PG8_BAR;
    PG8_BAR;
    if constexpr (Epi::AFTER_DRAIN) { E.fused(acc, cur, wr, wc, fr, fq, lds, wid, lane); S.done(cur); }
    PG8_STAMP();
    if (STAMP && wid == 0) { stamps[lane] = lane < nts ? (((unsigned long long)(unsigned)ts_hi << 32) | (unsigned)ts_lo) : 0ull;
        if (lane == 62) stamps[62] = rt_entry; if (lane == 63) stamps[63] = (unsigned long long)wall_clock64(); }
#undef PG8_STAMP
#undef PG8_SA
#undef PG8_SB
#undef PG8_STAGE
#undef PG8_LDA
#undef PG8_LDB
#undef PG8_MMA
#undef PG8_WAIT_V
#undef PG8_WAIT_L
#undef PG8_BAR
#undef PG8_SCHED
}
}
#define XB_TMO      128
#define XB_XCNT(j)  (256  + 64 * (j))
#define XB_XSUB(j)  (1280 + 64 * (j))
#define XB_XGEN(j)  (2304 + 64 * (j))
#define XB_TOP      3328
#define XB_TOPGEN   3392
#define XCD_BAR_WORDS 3456
#define XB_SPIN_CAP (1u << 18)
#define LAS __attribute__((address_space(3)))

__device__ __forceinline__ unsigned xb_ld(unsigned* p)              { return __hip_atomic_load(p, __ATOMIC_RELAXED, __HIP_MEMORY_SCOPE_AGENT); }
__device__ __forceinline__ unsigned xb_add(unsigned* p, unsigned v) { return __hip_atomic_fetch_add(p, v, __ATOMIC_RELAXED, __HIP_MEMORY_SCOPE_AGENT); }
__device__ __forceinline__ unsigned xb_xcc_id() { return (unsigned)__builtin_amdgcn_s_getreg((3 << 11) | 20) & 0xFu; }
#define XB_SPIN(cond, bar) do { unsigned _sp = 0; while (cond) { __builtin_amdgcn_s_sleep(1); \
    if ((++_sp & 255u) == 0u) { if (xb_ld(&(bar)[XB_TMO])) break; if (_sp > XB_SPIN_CAP) { atomicAdd(&(bar)[XB_TMO], 1u); break; } } } } while (0)

struct XcdBarrier {
    unsigned* bar; unsigned x;
    volatile LAS unsigned* st;
};

__device__ __forceinline__ XcdBarrier xcd_barrier_post(unsigned* bar, volatile LAS unsigned* st) {
    XcdBarrier b; b.bar = bar; b.x = xb_xcc_id(); b.st = st;
    if (threadIdx.x == 0) (void)xb_add(&bar[XB_XCNT(b.x)], 1u);
    return b;
}
__device__ __forceinline__ void xcd_barrier_complete(unsigned* bar, unsigned x, unsigned& nloc, unsigned& nx) {
    const unsigned G = gridDim.x * gridDim.y * gridDim.z;
    unsigned sum, cnt, mine, sp = 0u;
    for (;;) {
        sum = 0u; cnt = 0u; mine = 0u;
#pragma unroll
        for (unsigned j = 0; j < 16; ++j) { const unsigned c = xb_ld(&bar[XB_XCNT(j)]); sum += c; cnt += (c > 0u) ? 1u : 0u; mine = (j == x) ? c : mine; }
        if (sum == G) break;
        __builtin_amdgcn_s_sleep(1);
        if ((++sp & 255u) == 0u) { if (xb_ld(&bar[XB_TMO])) break; if (sp > XB_SPIN_CAP) { atomicAdd(&bar[XB_TMO], 1u); break; } }
    }
    nloc = mine > 0u ? mine : 1u; nx = cnt > 0u ? cnt : 1u;
}

__device__ __forceinline__ void xcd_barrier(const XcdBarrier& b) {
    asm volatile("s_waitcnt vmcnt(0)" ::: "memory");
    __syncthreads();
    if (threadIdx.x == 0) {
        unsigned* bar = b.bar;
        __builtin_amdgcn_s_waitcnt(0);
        unsigned nloc = b.st[0], nx = b.st[1];
        if (nloc == 0u) { xcd_barrier_complete(bar, b.x, nloc, nx); b.st[0] = nloc; b.st[1] = nx; }
        const unsigned old = xb_add(&bar[XB_XSUB(b.x)], 1u);
        const unsigned gen = old / nloc;
        if (old + 1u == (gen + 1u) * nloc) {
            __builtin_amdgcn_fence(__ATOMIC_RELEASE, "agent");
            asm volatile("s_waitcnt vmcnt(0)" ::: "memory");
            const unsigned og = xb_add(&bar[XB_TOP], 1u);
            const unsigned tg = og / nx;
            if (og + 1u == (tg + 1u) * nx) xb_add(&bar[XB_TOPGEN], 1u);
            else XB_SPIN(xb_ld(&bar[XB_TOPGEN]) == tg, bar);
            __builtin_amdgcn_fence(__ATOMIC_ACQUIRE, "agent");
            xb_add(&bar[XB_XGEN(b.x)], 1u);
            asm volatile("s_waitcnt vmcnt(0)" ::: "memory");
        } else {
            XB_SPIN(xb_ld(&bar[XB_XGEN(b.x)]) == gen, bar);
            __builtin_amdgcn_fence(__ATOMIC_ACQUIRE, "agent");
            asm volatile("s_waitcnt vmcnt(0)" ::: "memory");
        }
    }
    __syncthreads();
}

namespace mk {
typedef unsigned short bf16_t;
typedef short bf16x8 __attribute__((ext_vector_type(8)));
typedef float f32x4 __attribute__((ext_vector_type(4)));
typedef unsigned u32x2 __attribute__((ext_vector_type(2)));
typedef unsigned u32x4 __attribute__((ext_vector_type(4)));
#define LDSP __attribute__((address_space(3)))

constexpr int D = 2048, NB = 4, SEQ = 4096, DEPTH = 4, CTX = 256, T = CTX + SEQ, MROWS = NB * T;
constexpr int NIN = 7728, NINP = 7936, NCH = T / 64;
constexpr int C_AQ = 0, C_AK = 512, C_AV = 1024, C_AZ = 1536, C_ABETA = 2048, C_ADEC = 2056,
              C_BQ = 2064, C_BK = 2320, C_BV = 2576, C_BR = 3088, C_BCODE = 3600,
              C_CQ = 3632, C_CI = 4144, C_CG = 4656, C_CF = 5168, C_DQ = 6192, C_DK = 6704, C_DV = 7216;
constexpr int NEXP = 16, EROWS = 2304;
constexpr float ALPHA = 1.681792830507429f;
constexpr float LN_EPS = 1e-5f, NORM_EPS = 1e-6f;
constexpr int NCC = NB * 4 * 2 * NCH;

enum { I_X = 0, I_C, I_CTX, I_CCTX, I_WMOD, I_BMOD, I_WIN, I_WOUT, I_LNG, I_LNB, I_CONV, I_ALOG, I_DTB, I_GDNN, I_GLAW, I_GLAB, I_GLAN, I_HGAM, I_HGN, I_RPB, I_ROUT, I_W1, I_W3, I_W2 };

constexpr size_t WS_BAR = 0;
constexpr size_t WS_MODV = 16384;
constexpr size_t WS_AFF = WS_MODV + 983040;
constexpr size_t WS_INV = WS_AFF + 1114112;
constexpr size_t WS_IDX = WS_INV + 1114112;
constexpr size_t WS_GATE = WS_IDX + 147456;
constexpr size_t WS_WIN = WS_GATE + 147456;
constexpr size_t WS_WOUT = WS_WIN + 32505856;
constexpr size_t WS_W13 = WS_WOUT + 8388608;
constexpr size_t WS_W2 = WS_W13 + 134217728;
constexpr size_t WS_X = WS_W2 + 67108864;
constexpr size_t WS_X1 = WS_X + 142606336;
constexpr size_t WS_U = WS_X1 + 142606336;
constexpr size_t WS_MIX = WS_U + 71303168;
constexpr size_t WS_RA = WS_MIX + 71303168;
constexpr size_t RA_PROJ = 0;
constexpr size_t RA_GM = RA_PROJ + 276299776;
constexpr size_t RA_GB = RA_GM + 71303168;
constexpr size_t RA_GQ = RA_GB + 71303168;
constexpr size_t RA_GO = RA_GQ + 35651584;
constexpr size_t RA_HB = RA_GO + 35651584;
constexpr size_t RA_HQ = RA_HB + 71303168;
constexpr size_t RA_HO = RA_HQ + 35651584;
constexpr size_t RA_HA = RA_HO + 35651584;
constexpr size_t RA_LB = RA_HA + 1114112;
constexpr size_t RA_LQ = RA_LB + 35651584;
constexpr size_t RA_LO = RA_LQ + 17825792;
constexpr size_t RA_LA = RA_LO + 35651584;
constexpr size_t RA_OB = RA_LA + 557056;
constexpr size_t RA_END = RA_OB + 106954752;
constexpr size_t RA_TBUF = 0;
constexpr size_t RA_XS = 142606336;
constexpr size_t RA_HID = RA_XS + 150994944;
constexpr size_t RA_YS = RA_HID + 75497472;
constexpr size_t WS_TOTAL = WS_RA + RA_END;
static_assert(RA_YS + 150994944 <= RA_END, "region A");

struct Ctx {
    const float* in[24]; float* out; unsigned char* ws;
    LDSP unsigned char* lds; int tid, lane, wave, G, bid;
};

__device__ __forceinline__ float bf2f(unsigned b) { return __uint_as_float(b << 16); }
__device__ __forceinline__ float bflo(unsigned u) { return __uint_as_float(u << 16); }
__device__ __forceinline__ float bfhi(unsigned u) { return __uint_as_float(u & 0xffff0000u); }
__device__ __forceinline__ unsigned pk2(float lo, float hi) { return pg8::cvt_pk_bf16(lo, hi); }
__device__ __forceinline__ bf16_t f2bf(float x) { return (bf16_t)(pk2(x, 0.f) & 0xffffu); }
__device__ __forceinline__ float sigmoidf_(float x) { return __builtin_amdgcn_rcpf(1.f + __builtin_amdgcn_exp2f(-1.4426950408889634f * x)); }
__device__ __forceinline__ float siluf_(float x) { return x * __builtin_amdgcn_rcpf(1.f + __builtin_amdgcn_exp2f(-1.4426950408889634f * x)); }
__device__ __forceinline__ float softplusf_(float x) { return x > 20.f ? x : log1pf(__expf(x)); }
__device__ __forceinline__ float wsum(float v) {
#pragma unroll
    for (int m = 32; m >= 1; m >>= 1) v += __shfl_xor(v, m);
    return v;
}

template <int KS>
__device__ __forceinline__ f32x4 mma_tile(const LDSP bf16_t* a, int lda, const LDSP bf16_t* b, int ldb, f32x4 acc, int lane) {
    const int r = lane & 15, q = lane >> 4;
#pragma unroll
    for (int kk = 0; kk < KS; ++kk) {
        const bf16x8 af = *(const LDSP bf16x8*)(a + r * lda + kk * 32 + q * 8);
        const bf16x8 bf = *(const LDSP bf16x8*)(b + r * ldb + kk * 32 + q * 8);
        acc = __builtin_amdgcn_mfma_f32_16x16x32_bf16(af, bf, acc, 0, 0, 0);
    }
    return acc;
}
typedef short s16x4 __attribute__((ext_vector_type(4)));
__device__ __forceinline__ bf16x8 frag_tr16(const LDSP bf16_t* base, int ld, int lane) {
    const int g = lane >> 4, i = lane & 15;
    const LDSP bf16_t* p = base + (8 * g + (i >> 2)) * ld + 4 * (i & 3);
    const s16x4 lo = __builtin_amdgcn_ds_read_tr16_b64_v4i16((LDSP s16x4*)p);
    const s16x4 hi = __builtin_amdgcn_ds_read_tr16_b64_v4i16((LDSP s16x4*)(p + 4 * ld));
    return (bf16x8){lo[0], lo[1], lo[2], lo[3], hi[0], hi[1], hi[2], hi[3]};
}
__device__ __forceinline__ u32x2 pack4(f32x4 v) { u32x2 o; o.x = pk2(v[0], v[1]); o.y = pk2(v[2], v[3]); return o; }

__device__ __forceinline__ int tok_of(int n, int dir, int i) { return n * 64 + (dir ? 63 - i : i); }

__device__ __forceinline__ void modv_fill_s(const Ctx& c) {
    LDSP float* s = (LDSP float*)c.lds;
    for (int i = c.tid; i < 5 * 2048; i += 512) {
        const int r = i >> 11, k = i & 2047;
        const float v = r < 4 ? c.in[I_C][r * 2048 + k] : c.in[I_CCTX][k];
        s[i] = siluf_(v);
    }
    __syncthreads();
}
__device__ __forceinline__ void modv_unit(const Ctx& c, int unit) {
    const int l = unit / 48, cb = unit % 48;
    LDSP float* s = (LDSP float*)c.lds;
    LDSP float* red = s + 5 * 2048;
    const float* W = c.in[I_WMOD] + (size_t)l * 2048 * 12288 + cb * 256 + c.lane * 4;
    const int k0 = c.wave * 256;
    f32x4 acc[5];
#pragma unroll
    for (int r = 0; r < 5; ++r) acc[r] = (f32x4){0.f, 0.f, 0.f, 0.f};
#pragma unroll 8
    for (int k = 0; k < 256; ++k) {
        const f32x4 w = *(const f32x4*)(W + (size_t)(k0 + k) * 12288);
#pragma unroll
        for (int r = 0; r < 5; ++r) { const float sv = s[r * 2048 + k0 + k]; acc[r] += w * sv; }
    }
#pragma unroll
    for (int r = 0; r < 5; ++r) *(LDSP f32x4*)(red + (c.wave * 5 + r) * 256 + c.lane * 4) = acc[r];
    __syncthreads();
    float* modv = (float*)(c.ws + WS_MODV);
    for (int o = c.tid; o < 5 * 256; o += 512) {
        const int r = o >> 8, col = o & 255;
        float sum = 0.f;
#pragma unroll
        for (int w = 0; w < 8; ++w) sum += red[(w * 5 + r) * 256 + col];
        modv[(size_t)(l * 5 + r) * 12288 + cb * 256 + col] = sum + c.in[I_BMOD][l * 12288 + cb * 256 + col];
    }
    __syncthreads();
}

struct CJob { const float* src; bf16_t* dst; int ldsrc, lddst, nvalid; };
constexpr int CONV_JOBS = 992 + 256 + 3 * 2048;
__device__ __forceinline__ CJob conv_desc(const Ctx& c, int l, int job) {
    CJob d;
    if (job < 992) {
        const int kt = job & 15, nt = job >> 4;
        d.src = c.in[I_WIN] + (size_t)l * 2048 * NIN + (size_t)kt * 128 * NIN + nt * 128; d.ldsrc = NIN; d.nvalid = NIN - nt * 128;
        d.dst = (bf16_t*)(c.ws + WS_WIN) + (size_t)nt * 128 * 2048 + kt * 128; d.lddst = 2048;
    } else if (job < 1248) {
        const int j = job - 992, kt = j & 15, nt = j >> 4;
        d.src = c.in[I_WOUT] + (size_t)l * 2048 * 2048 + (size_t)kt * 128 * 2048 + nt * 128; d.ldsrc = 2048; d.nvalid = 128;
        d.dst = (bf16_t*)(c.ws + WS_WOUT) + (size_t)nt * 128 * 2048 + kt * 128; d.lddst = 2048;
    } else if (job < 1248 + 4096) {
        const int j = job - 1248, which = j >> 11, jj = j & 2047, e = jj >> 7, rem = jj & 127, kt = rem & 15, nt = rem >> 4;
        d.src = c.in[which ? I_W3 : I_W1] + ((size_t)(l * 16 + e) * 2048 + (size_t)kt * 128) * 1024 + nt * 128; d.ldsrc = 1024; d.nvalid = 128;
        d.dst = (bf16_t*)(c.ws + WS_W13) + ((size_t)e * 2048 + nt * 256 + which * 128) * 2048 + kt * 128; d.lddst = 2048;
    } else {
        const int j = job - 1248 - 4096, e = j >> 7, rem = j & 127, kt = rem & 7, nt = rem >> 3;
        d.src = c.in[I_W2] + ((size_t)(l * 16 + e) * 1024 + (size_t)kt * 128) * 2048 + nt * 128; d.ldsrc = 2048; d.nvalid = 128;
        d.dst = (bf16_t*)(c.ws + WS_W2) + ((size_t)e * 2048 + nt * 128) * 1024 + kt * 128; d.lddst = 1024;
    }
    return d;
}
__device__ __forceinline__ void conv_load(const CJob& d, int n4, int kr, f32x4 (&v)[8]) {
#pragma unroll
    for (int p = 0; p < 4; ++p)
#pragma unroll
        for (int hh = 0; hh < 2; ++hh) v[2 * p + hh] = (4 * n4 < d.nvalid) ? *(const f32x4*)(d.src + (size_t)(32 * p + 2 * kr + hh) * d.ldsrc + 4 * n4) : (f32x4){0.f, 0.f, 0.f, 0.f};
}
__device__ __forceinline__ void conv_tile(const Ctx& c, const CJob& d, LDSP unsigned* Tt, int n4, int kr, const f32x4 (&v)[8]) {
#pragma unroll
    for (int p = 0; p < 4; ++p)
#pragma unroll
        for (int i = 0; i < 4; ++i) Tt[(4 * n4 + i) * 65 + 16 * p + kr] = pk2(v[2 * p][i], v[2 * p + 1][i]);
    __syncthreads();
#pragma unroll
    for (int q = 0; q < 4; ++q) {
        const int id = q * 512 + c.tid, n = id >> 4, kq = id & 15;
        const u32x4 o = (u32x4){Tt[n * 65 + 4 * kq], Tt[n * 65 + 4 * kq + 1], Tt[n * 65 + 4 * kq + 2], Tt[n * 65 + 4 * kq + 3]};
        *(u32x4*)(d.dst + (size_t)n * d.lddst + kq * 8) = o;
    }
}
__device__ __forceinline__ void convert_phase(const Ctx& c, int l) {
    LDSP unsigned* Tb = (LDSP unsigned*)c.lds;
    const int n4 = c.tid & 31, kr = c.tid >> 5;
    const int G = c.G;
    int job = c.bid;
    if (job >= CONV_JOBS) return;
    CJob ja = conv_desc(c, l, job), jb = ja;
    f32x4 va[8], vb[8];
    conv_load(ja, n4, kr, va);
    if (job + G < CONV_JOBS) { jb = conv_desc(c, l, job + G); conv_load(jb, n4, kr, vb); }
    for (; job < CONV_JOBS; job += 2 * G) {
        conv_tile(c, ja, Tb, n4, kr, va);
        const CJob ja_done = ja;
        if (job + 2 * G < CONV_JOBS) { ja = conv_desc(c, l, job + 2 * G); conv_load(ja, n4, kr, va); }
        if (job + G < CONV_JOBS) {
            conv_tile(c, jb, Tb + 128 * 65, n4, kr, vb);
            if (job + 3 * G < CONV_JOBS) { jb = conv_desc(c, l, job + 3 * G); conv_load(jb, n4, kr, vb); }
        }
        (void)ja_done;
    }
    __syncthreads();
}

__device__ __forceinline__ void row_stats(const f32x4 (&v)[8], float& mu, float& rstd) {
    float s = 0.f;
#pragma unroll
    for (int j = 0; j < 8; ++j) s += v[j][0] + v[j][1] + v[j][2] + v[j][3];
    mu = wsum(s) * (1.f / 2048.f);
    float q = 0.f;
#pragma unroll
    for (int j = 0; j < 8; ++j) { const f32x4 d = v[j] - mu; q += d[0] * d[0] + d[1] * d[1] + d[2] * d[2] + d[3] * d[3]; }
    rstd = rsqrtf(wsum(q) * (1.f / 2048.f) + LN_EPS);
}
__device__ __forceinline__ void modulate_store(const f32x4 (&v)[8], const float* shift, const float* scale, bf16_t* urow, int lane) {
    float mu, rstd; row_stats(v, mu, rstd);
#pragma unroll
    for (int j = 0; j < 8; ++j) {
        const int col = 256 * j + 4 * lane;
        const f32x4 sh = *(const f32x4*)(shift + col), sc = *(const f32x4*)(scale + col);
        const f32x4 y = (v[j] - mu) * rstd * (sc + 1.f) + sh;
        *(u32x2*)(urow + col) = pack4(y);
    }
}
__device__ __forceinline__ void phase_l0_modulate(const Ctx& c) {
    const float* modv = (const float*)(c.ws + WS_MODV);
    float* X = (float*)(c.ws + WS_X); bf16_t* U = (bf16_t*)(c.ws + WS_U);
    for (int row = c.bid * 8 + c.wave; row < MROWS; row += c.G * 8) {
        const int b = row / T, t = row % T;
        const float* src = t < CTX ? c.in[I_CTX] + ((size_t)b * CTX + t) * D : c.in[I_X] + ((size_t)b * SEQ + (t - CTX)) * D;
        const int r = t < CTX ? 4 : b;
        f32x4 v[8];
#pragma unroll
        for (int j = 0; j < 8; ++j) v[j] = *(const f32x4*)(src + 256 * j + 4 * c.lane);
#pragma unroll
        for (int j = 0; j < 8; ++j) *(f32x4*)(X + (size_t)row * D + 256 * j + 4 * c.lane) = v[j];
        modulate_store(v, modv + (size_t)(0 * 5 + r) * 12288, modv + (size_t)(0 * 5 + r) * 12288 + 2048, U + (size_t)row * D, c.lane);
    }
}

constexpr int GP_RAW = 0;
constexpr int GP_UT = 0;
constexpr int GP_WT = 18432;
constexpr int GP_A = 36864;
constexpr int GP_AP = 65;
constexpr int GP_TB = 53504;
constexpr int GP_CW = 53312;
constexpr int GP_Q = GP_CW + 7680;
constexpr int GP_K = GP_Q + 17408;
constexpr int GP_V = GP_K + 17408;
constexpr int GP_KDT = GP_V + 17408;
constexpr int GP_P = GP_KDT + 18432;
constexpr int GP_SM = GP_P + 9216;
constexpr int GP_END = GP_SM + 1024;
static_assert(GP_END <= 160 * 1024, "gdn prep lds");

#ifdef MK_GSTAMP
#define GST(k) do { if (c.bid == 0 && tid == 0) { const unsigned long long t_ = __builtin_amdgcn_s_memrealtime(); gst[k] += t_ - gst[8]; gst[8] = t_; } } while (0)
#else
#define GST(k)
#endif
__device__ __forceinline__ void gdn_prep_unit(const Ctx& c, int l, int cc) {
    const int n = cc % NCH, dir = (cc / NCH) & 1, h = (cc / (NCH * 2)) & 3, b = cc / (NCH * 8);
    int tid_ = c.tid; asm volatile("" : "+v"(tid_));
    const int tid = tid_, lane = tid_ & 63, wave = c.wave;
    LDSP unsigned char* L = c.lds;
    LDSP bf16_t* raw = (LDSP bf16_t*)(L + GP_RAW);
    LDSP float* cw = (LDSP float*)(L + GP_CW);
    LDSP bf16_t* Qs = (LDSP bf16_t*)(L + GP_Q);
    LDSP bf16_t* Ks = (LDSP bf16_t*)(L + GP_K);
    LDSP bf16_t* Vs = (LDSP bf16_t*)(L + GP_V);
    LDSP bf16_t* KdT = (LDSP bf16_t*)(L + GP_KDT);
    LDSP bf16_t* Pm = (LDSP bf16_t*)(L + GP_P);
    LDSP bf16_t* UT = (LDSP bf16_t*)(L + GP_UT);
    LDSP bf16_t* WT = (LDSP bf16_t*)(L + GP_WT);
    LDSP float* Am = (LDSP float*)(L + GP_A);
    LDSP float* sm = (LDSP float*)(L + GP_SM);
    const bf16_t* proj = (const bf16_t*)(c.ws + WS_RA + RA_PROJ);
    const int seg0 = n < 4 ? 0 : CTX, seg1 = n < 4 ? CTX : T;
    const size_t rowb = (size_t)b * T;
#ifdef MK_GSTAMP
    volatile LDSP unsigned long long* gst = (volatile LDSP unsigned long long*)(c.lds + 147456 - 48 - 80);
    if (c.bid == 0 && tid == 0) gst[8] = __builtin_amdgcn_s_memrealtime();
#endif

    for (int ch = tid; ch < 68 * 48; ch += 512) {
        const int rr = ch / 48, c16 = ch % 48, part = c16 >> 4, d8 = c16 & 15;
        const int t = n * 64 - 2 + rr;
        u32x4 v = (u32x4){0u, 0u, 0u, 0u};
        if (t >= seg0 && t < seg1) v = *(const u32x4*)(proj + (rowb + t) * NINP + part * 512 + h * 128 + d8 * 8);
        *(LDSP u32x4*)(raw + rr * 392 + part * 128 + d8 * 8) = v;
    }
    for (int i = tid; i < 5 * 384; i += 512) {
        const int j = i / 384, cidx = i % 384, part = cidx >> 7, d = cidx & 127;
        cw[i] = c.in[I_CONV][(size_t)(l * 5 + j) * 1536 + part * 512 + h * 128 + d];
    }
    if (wave == 0) {
        const int t = tok_of(n, dir, lane);
        const bf16_t* pr = proj + (rowb + t) * NINP;
        const float beta = sigmoidf_(bf2f(pr[C_ABETA + dir * 4 + h]));
        const float la = -__expf(c.in[I_ALOG][l * 8 + dir * 4 + h]) * softplusf_(bf2f(pr[C_ADEC + dir * 4 + h]) + c.in[I_DTB][l * 8 + dir * 4 + h]);
        float g = la;
#pragma unroll
        for (int m = 1; m < 64; m <<= 1) { const float o = __shfl_up(g, m); if (lane >= m) g += o; }
        const float gend = __shfl(g, 63);
        sm[lane] = g; sm[64 + lane] = beta; sm[128 + lane] = __expf(g); sm[192 + lane] = __expf(gend - g);
    }
    __syncthreads();
    GST(0);
    {
        const int i = tid >> 3, gq = tid & 7;
        const int rc = (dir ? 63 - i : i) + 2;
#pragma unroll
        for (int part = 0; part < 3; ++part) {
            float a[16];
#pragma unroll
            for (int e = 0; e < 16; ++e) a[e] = 0.f;
#pragma unroll
            for (int j = 0; j < 5; ++j) {
                const LDSP bf16_t* rp = raw + (rc - 2 + j) * 392 + part * 128 + gq * 16;
                const LDSP float* wp = cw + j * 384 + part * 128 + gq * 16;
#pragma unroll
                for (int hf = 0; hf < 2; ++hf) {
                    const u32x4 r4 = *(const LDSP u32x4*)(rp + hf * 8);
                    const f32x4 w0 = *(const LDSP f32x4*)(wp + hf * 8), w1 = *(const LDSP f32x4*)(wp + hf * 8 + 4);
                    a[hf * 8 + 0] += bflo(r4[0]) * w0[0]; a[hf * 8 + 1] += bfhi(r4[0]) * w0[1]; a[hf * 8 + 2] += bflo(r4[1]) * w0[2]; a[hf * 8 + 3] += bfhi(r4[1]) * w0[3];
                    a[hf * 8 + 4] += bflo(r4[2]) * w1[0]; a[hf * 8 + 5] += bfhi(r4[2]) * w1[1]; a[hf * 8 + 6] += bflo(r4[3]) * w1[2]; a[hf * 8 + 7] += bfhi(r4[3]) * w1[3];
                }
            }
            float ss = 0.f;
#pragma unroll
            for (int e = 0; e < 16; ++e) { a[e] = siluf_(a[e]); ss += a[e] * a[e]; }
            float sc = 1.f;
            if (part < 2) {
#pragma unroll
                for (int m = 1; m < 8; m <<= 1) ss += __shfl_xor(ss, m);
                sc = rsqrtf(ss + NORM_EPS) * (part == 0 ? 0.08838834764831845f : 1.f);
            }
            LDSP bf16_t* dq = (part == 0 ? Qs : part == 1 ? Ks : Vs) + i * 136 + gq * 16;
            *(LDSP u32x4*)dq = (u32x4){pk2(a[0] * sc, a[1] * sc), pk2(a[2] * sc, a[3] * sc), pk2(a[4] * sc, a[5] * sc), pk2(a[6] * sc, a[7] * sc)};
            *(LDSP u32x4*)(dq + 8) = (u32x4){pk2(a[8] * sc, a[9] * sc), pk2(a[10] * sc, a[11] * sc), pk2(a[12] * sc, a[13] * sc), pk2(a[14] * sc, a[15] * sc)};
            asm volatile("" ::: "memory");
        }
    }
    __syncthreads();
    GST(1);
#pragma unroll
    for (int p = 0; p < 2; ++p) {
        const int id = p * 512 + tid, d = id & 127, i0 = (id >> 7) * 8;
        unsigned w[4];
#pragma unroll
        for (int e = 0; e < 8; e += 2) w[e >> 1] = pk2(bf2f(Ks[(i0 + e) * 136 + d]) * sm[192 + i0 + e], bf2f(Ks[(i0 + e + 1) * 136 + d]) * sm[192 + i0 + e + 1]);
        *(LDSP u32x4*)(KdT + d * 72 + i0) = (u32x4){w[0], w[1], w[2], w[3]};
    }
#pragma unroll
    for (int tt = 0; tt < 4; ++tt) {
        const int id = wave * 4 + tt, which = id >> 4, ti = (id & 15) >> 2, tj = id & 3;
        const int r = lane & 15, q4 = lane >> 4;
        if (which == 0) {
            if (tj <= ti) {
                f32x4 a = mma_tile<4>(Ks + ti * 16 * 136, 136, Ks + tj * 16 * 136, 136, (f32x4){0.f, 0.f, 0.f, 0.f}, lane);
                const int j = tj * 16 + r; const float gj = sm[j];
#pragma unroll
                for (int e = 0; e < 4; ++e) { const int i = ti * 16 + q4 * 4 + e; Am[i * GP_AP + j] = (i > j) ? sm[64 + i] * a[e] * __expf(sm[i] - gj) : 0.f; }
            }
        } else {
            f32x4 o = (f32x4){0.f, 0.f, 0.f, 0.f};
            if (tj <= ti) {
                const f32x4 a = mma_tile<4>(Ks + tj * 16 * 136, 136, Qs + ti * 16 * 136, 136, (f32x4){0.f, 0.f, 0.f, 0.f}, lane);
                const int i = ti * 16 + r; const float gi = sm[i];
#pragma unroll
                for (int e = 0; e < 4; ++e) { const int j = tj * 16 + q4 * 4 + e; o[e] = (i >= j) ? a[e] * __expf(gi - sm[j]) : 0.f; }
            }
            *(LDSP u32x2*)(Pm + (ti * 16 + r) * 72 + tj * 16 + q4 * 4) = pack4(o);
        }
    }
    __syncthreads();
    GST(2);
    {
        LDSP float* TB = (LDSP float*)(L + GP_TB);
        const int r = lane & 15, q4 = lane >> 4;
        if (wave == 0) {
            const int I = lane >> 4, cidx = lane & 15;
            float x[16];
#pragma unroll
            for (int i = 0; i < 16; ++i) {
                float v = (i == cidx) ? 1.f : 0.f;
#pragma unroll
                for (int j = 0; j < i; ++j) v -= Am[(16 * I + i) * GP_AP + 16 * I + j] * x[j];
                x[i] = v;
            }
#pragma unroll
            for (int i = 0; i < 16; ++i) TB[(I * 16 + i) * 16 + cidx] = x[i];
        }
        f32x4 acc[4][2];
        const LDSP bf16_t* src = wave < 4 ? Vs : Ks;
        const int cb = (wave & 3) * 32;
#pragma unroll
        for (int I = 0; I < 4; ++I)
#pragma unroll
            for (int t = 0; t < 2; ++t)
#pragma unroll
                for (int e = 0; e < 4; ++e) {
                    const int row = 16 * I + 4 * q4 + e;
                    acc[I][t][e] = sm[64 + row] * bf2f(src[row * 136 + cb + 16 * t + r]) * (wave < 4 ? 1.f : sm[128 + row]);
                }
        __syncthreads();
        LDSP bf16_t* dstp = wave < 4 ? UT : WT;
#pragma unroll
        for (int I = 0; I < 4; ++I) {
            f32x4 x[2] = {(f32x4){0.f, 0.f, 0.f, 0.f}, (f32x4){0.f, 0.f, 0.f, 0.f}};
#pragma unroll
            for (int s4 = 0; s4 < 4; ++s4) {
                const float a = TB[(I * 16 + r) * 16 + 4 * q4 + s4];
#pragma unroll
                for (int t = 0; t < 2; ++t) x[t] = __builtin_amdgcn_mfma_f32_16x16x4f32(a, acc[I][t][s4], x[t], 0, 0, 0);
            }
#pragma unroll
            for (int Ip = I + 1; Ip < 4; ++Ip)
#pragma unroll
                for (int s4 = 0; s4 < 4; ++s4) {
                    const float a = -Am[(16 * Ip + r) * GP_AP + 16 * I + 4 * q4 + s4];
#pragma unroll
                    for (int t = 0; t < 2; ++t) acc[Ip][t] = __builtin_amdgcn_mfma_f32_16x16x4f32(a, x[t][s4], acc[Ip][t], 0, 0, 0);
                }
#pragma unroll
            for (int t = 0; t < 2; ++t) *(LDSP u32x2*)(dstp + (cb + 16 * t + r) * 72 + 16 * I + 4 * q4) = pack4(x[t]);
        }
    }
    __syncthreads();
    GST(3);
    {
        const size_t cs = (size_t)n * 32 + cc / NCH;
        bf16_t* Mg = (bf16_t*)(c.ws + WS_RA + RA_GM) + cs * 16384;
        bf16_t* Bg = (bf16_t*)(c.ws + WS_RA + RA_GB) + cs * 16384;
        bf16_t* Qg = (bf16_t*)(c.ws + WS_RA + RA_GQ) + cs * 8192;
        bf16_t* Og = (bf16_t*)(c.ws + WS_RA + RA_GO) + cs * 8192;
        const float ge = sm[128 + 63];
        const int r = lane & 15, q4 = lane >> 4;
        const f32x4 z = (f32x4){0.f, 0.f, 0.f, 0.f};
        for (int id = wave; id < 192; id += 8) {
            if (id < 32) {
                const int td = id >> 2, ti = id & 3;
                const f32x4 a = mma_tile<2>(WT + td * 16 * 72, 72, Pm + ti * 16 * 72, 72, z, lane);
                const int i = ti * 16 + r, d0 = td * 16 + q4 * 4; const float egi = sm[128 + i];
                f32x4 o;
#pragma unroll
                for (int e = 0; e < 4; ++e) o[e] = bf2f(Qs[i * 136 + d0 + e]) * egi - a[e];
                *(u32x2*)(Qg + (((ti * 4 + (td >> 1)) * 4 + ((2 * td + (q4 >> 1)) & 3)) * 16 + r) * 8 + 4 * (q4 & 1)) = pack4(o);
            } else if (id < 64) {
                const int td = (id - 32) >> 2, ti = id & 3;
                const f32x4 a = mma_tile<2>(UT + td * 16 * 72, 72, Pm + ti * 16 * 72, 72, z, lane);
                *(u32x2*)(Og + ((ti * 8 + td) * 64 + lane) * 4) = pack4(a);
            } else if (id < 128) {
                const int tc = (id - 64) >> 3, tr = id & 7;
                const f32x4 a = mma_tile<2>(WT + tc * 16 * 72, 72, KdT + tr * 16 * 72, 72, z, lane);
                const int dk = tr * 16 + r, d0 = tc * 16 + q4 * 4;
                f32x4 o;
#pragma unroll
                for (int e = 0; e < 4; ++e) o[e] = ((dk == d0 + e) ? ge : 0.f) - a[e];
                *(u32x2*)(Mg + (((tr * 4 + (tc >> 1)) * 4 + ((2 * tc + (q4 >> 1)) & 3)) * 16 + r) * 8 + 4 * (q4 & 1)) = pack4(o);
            } else {
                const int tr = (id - 128) >> 3, tc = id & 7;
                const f32x4 a = mma_tile<2>(KdT + tr * 16 * 72, 72, UT + tc * 16 * 72, 72, z, lane);
                *(u32x2*)(Bg + ((tc * 8 + tr) * 64 + lane) * 4) = pack4(a);
            }
        }
    }
    __syncthreads();
    GST(4);
}

constexpr int DP_QS = 0;
constexpr int DP_KSELF = 17408;
constexpr int DP_KSC = 34816;
constexpr int DP_KDT = 60928;
constexpr int DP_VT = 79360;
constexpr int DP_P = 97792;
constexpr int DP_TOT = 107008;
constexpr int DP_CODE = 111104;
constexpr int DP_QG = 115200;
constexpr int DP_END = 132608;

template <int MIX>
__device__ __forceinline__ void diag_prep_unit(const Ctx& c, int l, int cc) {
    constexpr int DK = (MIX == 1) ? 128 : 64;
    constexpr int PQ = DK + 8;
    const int n = cc % NCH, dir = (cc / NCH) & 1, h = (cc / (NCH * 2)) & 3, b = cc / (NCH * 8);
    const int tid = c.tid, lane = c.lane, wave = c.wave;
    LDSP unsigned char* L = c.lds;
    LDSP bf16_t* Qs = (LDSP bf16_t*)(L + DP_QS);
    LDSP bf16_t* Kself = (LDSP bf16_t*)(L + DP_KSELF);
    LDSP bf16_t* Ksc = (LDSP bf16_t*)(L + DP_KSC);
    LDSP bf16_t* KdT = (LDSP bf16_t*)(L + DP_KDT);
    LDSP bf16_t* VT = (LDSP bf16_t*)(L + DP_VT);
    LDSP bf16_t* Pm = (LDSP bf16_t*)(L + DP_P);
    LDSP float* tot = (LDSP float*)(L + DP_TOT);
    LDSP float* code = (LDSP float*)(L + DP_CODE);
    LDSP bf16_t* Qt = (LDSP bf16_t*)(L + DP_QG);
    const bf16_t* proj = (const bf16_t*)(c.ws + WS_RA + RA_PROJ);
    const size_t rowb = (size_t)b * T;
    bf16_t* Bg; bf16_t* Qg; bf16_t* Og; float* Ag;
    const size_t cs = (size_t)n * 32 + cc / NCH;
    if (MIX == 1) { Bg = (bf16_t*)(c.ws + WS_RA + RA_HB) + cs * 16384; Qg = (bf16_t*)(c.ws + WS_RA + RA_HQ) + cs * 8192;
                    Og = (bf16_t*)(c.ws + WS_RA + RA_HO) + cs * 8192; Ag = (float*)(c.ws + WS_RA + RA_HA) + cs * 128; }
    else          { Bg = (bf16_t*)(c.ws + WS_RA + RA_LB) + cs * 8192; Qg = (bf16_t*)(c.ws + WS_RA + RA_LQ) + cs * 4096;
                    Og = (bf16_t*)(c.ws + WS_RA + RA_LO) + cs * 8192; Ag = (float*)(c.ws + WS_RA + RA_LA) + cs * 64; }

    {
        constexpr int CPR = DK / 8;
        const int vcol = (MIX == 1 ? C_CI : C_BV) + h * 128;
        const int qcol = (MIX == 1 ? C_CQ + h * 128 : C_BQ + h * 64), kcol = (MIX == 1 ? C_CF + dir * 512 + h * 128 : C_BK + h * 64);
#pragma unroll
        for (int p = 0; p < 2; ++p) {
            const int id = p * 512 + tid, i = id >> 4, c8 = id & 15;
            *(LDSP u32x4*)(VT + i * 136 + c8 * 8) = *(const u32x4*)(proj + (rowb + tok_of(n, dir, i)) * NINP + vcol + c8 * 8);
        }
#pragma unroll
        for (int p = 0; p < (64 * CPR) / 512; ++p) {
            const int id = p * 512 + tid, i = id / CPR, c8 = id % CPR;
            const bf16_t* pr = proj + (rowb + tok_of(n, dir, i)) * NINP;
            *(LDSP u32x4*)(Qs + i * PQ + c8 * 8) = *(const u32x4*)(pr + qcol + c8 * 8);
            *(LDSP u32x4*)(Kself + i * PQ + c8 * 8) = *(const u32x4*)(pr + kcol + c8 * 8);
        }
        if (MIX == 2) for (int i = tid; i < 64 * 16; i += 512) code[i] = bf2f(proj[(rowb + tok_of(n, dir, i >> 4)) * NINP + C_BCODE + dir * 16 + (i & 15)]);
        for (int i = tid; i < 64 * 36; i += 512) ((LDSP unsigned*)Pm)[i] = 0u;
    }
    __syncthreads();
    constexpr int TPT = DK / 8, NSUB = 64 / TPT;
    const int d = tid % DK, J = tid / DK, I = (J * TPT) >> 4;
    float qv[TPT], kv[TPT], bl[TPT];
    {
        float lb = 0.f, wg[16], bg = 0.f;
        if (MIX == 1) {
            const float* gam = c.in[I_HGAM] + (size_t)dir * DEPTH * 512 + h * 128 + d;
            float mx = gam[0];
#pragma unroll
            for (int i = 1; i < DEPTH; ++i) mx = fmaxf(mx, gam[i * 512]);
            float den = 0.f, num = 0.f;
#pragma unroll
            for (int i = 0; i < DEPTH; ++i) { const float e = __expf(gam[i * 512] - mx); den += e; if (i >= 1 && i <= l) num += e; }
            lb = num / den;
        } else {
#pragma unroll
            for (int r = 0; r < 16; ++r) wg[r] = c.in[I_GLAW][((size_t)(l * 2 + dir) * 16 + r) * 256 + h * 64 + d];
            bg = c.in[I_GLAB][(l * 2 + dir) * 256 + h * 64 + d];
        }
        float run = 0.f;
#pragma unroll
        for (int s = 0; s < TPT; ++s) {
            const int i = J * TPT + s, t = tok_of(n, dir, i);
            float la;
            if (MIX == 1) {
                qv[s] = bf2f(Qs[i * PQ + d]);
                const float f = lb + (1.f - lb) * sigmoidf_(bf2f(Kself[i * PQ + d]));
                la = __logf(f); kv[s] = 1.f - f;
            } else {
                float q0 = bf2f(Qs[i * PQ + d]) * 0.125f, k0 = bf2f(Kself[i * PQ + d]);
                if (n >= 4) {
                    const int pos = t - CTX, hf = d >> 5, idx = d & 31, fi = idx & 15;
                    const float p = (float)(hf ? (pos & 63) : (pos >> 6));
                    const float inv = __expf(-(float)fi * (9.210340371976184f / 16.f));
                    float ang = p * inv;
                    const float kk = rintf(ang * 0.15915494309189535f);
                    ang = fmaf(-kk, 6.2831855f, ang); ang = fmaf(-kk, -1.7484555e-7f, ang);
                    const float cs = __cosf(ang), sn = __sinf(ang);
                    const int dp = idx < 16 ? d + 16 : d - 16;
                    const float q1 = bf2f(Qs[i * PQ + dp]) * 0.125f, k1 = bf2f(Kself[i * PQ + dp]);
                    if (idx < 16) { q0 = q0 * cs - q1 * sn; k0 = k0 * cs - k1 * sn; }
                    else          { q0 = q1 * sn + q0 * cs; k0 = k1 * sn + k0 * cs; }
                }
                qv[s] = q0; kv[s] = k0;
                float gt = bg;
#pragma unroll
                for (int r = 0; r < 16; ++r) gt += code[i * 16 + r] * wg[r];
                la = -softplusf_(-gt) * (1.f / 16.f);
            }
            run += la; bl[s] = run;
        }
        tot[J * 128 + d] = run;
    }
    __syncthreads();
    {
        float pre = 0.f, bend = 0.f, hb = 0.f, tI[4] = {0.f, 0.f, 0.f, 0.f};
#pragma unroll
        for (int m = 0; m < NSUB; ++m) {
            const float tm = tot[m * 128 + d]; const int Im = (m * TPT) >> 4;
            bend += tm; tI[Im] += tm;
            if (Im < I) pre += tm; else if (Im == I && m < J) hb += tm;
        }
        unsigned kd[TPT / 2];
#pragma unroll
        for (int s = 0; s < TPT; ++s) {
            const int i = J * TPT + s, s16 = i & 15;
            const float b16 = hb + bl[s];
            Qs[i * PQ + d] = f2bf(qv[s] * __expf(b16));
            Kself[i * PQ + d] = f2bf(kv[s] * __expf(-b16));
            Qt[i * PQ + d] = f2bf(qv[s] * __expf(pre + b16));
            const float kdv = kv[s] * __expf(bend - pre - b16);
            if (s & 1) kd[s >> 1] = (kd[s >> 1] & 0xffffu) | ((unsigned)f2bf(kdv) << 16); else kd[s >> 1] = f2bf(kdv);
            float off = 0.f;
#pragma unroll
            for (int Ip = 1; Ip < 4; ++Ip) {
                if (Ip > I) { off += tI[Ip - 1]; Ksc[((Ip * (Ip - 1) / 2 + I) * 16 + s16) * PQ + d] = f2bf(kv[s] * __expf(off - b16)); }
            }
        }
#pragma unroll
        for (int w8 = 0; w8 < TPT / 8; ++w8)
            *(LDSP u32x4*)(KdT + d * 72 + J * TPT + w8 * 8) = (u32x4){kd[w8 * 4], kd[w8 * 4 + 1], kd[w8 * 4 + 2], kd[w8 * 4 + 3]};
        if (J == 0) Ag[d] = __expf(bend);
    }
    __syncthreads();
#pragma unroll
    for (int p = 0; p < (64 * DK / 8) / 512; ++p) {
        const int id = p * 512 + tid, fl = id & 63, fr = id >> 6;
        const int ott_ = fr / (DK / 32), kk_ = fr % (DK / 32);
        *(u32x4*)(Qg + (size_t)id * 8) = *(const LDSP u32x4*)(Qt + (ott_ * 16 + (fl & 15)) * PQ + kk_ * 32 + (fl >> 4) * 8);
    }
    for (int blk = wave; blk < 10; blk += 8) {
        int Ib, Jb;
        if (blk < 4) { Ib = blk; Jb = blk; } else { const int s = blk - 4; Ib = s < 1 ? 1 : (s < 3 ? 2 : 3); Jb = s - (Ib * (Ib - 1) / 2); }
        const LDSP bf16_t* kp = (Ib == Jb) ? Kself + Jb * 16 * PQ : Ksc + (Ib * (Ib - 1) / 2 + Jb) * 16 * PQ;
        const f32x4 a = mma_tile<DK / 32>(kp, PQ, Qs + Ib * 16 * PQ, PQ, (f32x4){0.f, 0.f, 0.f, 0.f}, lane);
        const int r = lane & 15, q4 = lane >> 4;
        f32x4 o;
#pragma unroll
        for (int e = 0; e < 4; ++e) o[e] = (Ib > Jb || r >= q4 * 4 + e) ? a[e] : 0.f;
        *(LDSP u32x2*)(Pm + (Ib * 16 + r) * 72 + Jb * 16 + q4 * 4) = pack4(o);
    }
    __syncthreads();
    {
        const int r = lane & 15, q4 = lane >> 4;
        const f32x4 z = (f32x4){0.f, 0.f, 0.f, 0.f};
        constexpr int NT2 = (DK / 16) * 8;
        for (int id = wave; id < 32 + NT2; id += 8) {
            if (id < 32) {
                const int td = id >> 2, ti = id & 3;
                f32x4 a = z;
#pragma unroll
                for (int kk = 0; kk < 2; ++kk)
                    a = __builtin_amdgcn_mfma_f32_16x16x32_bf16(frag_tr16(VT + kk * 32 * 136 + td * 16, 136, lane), *(const LDSP bf16x8*)(Pm + (ti * 16 + r) * 72 + kk * 32 + q4 * 8), a, 0, 0, 0);
                *(u32x2*)(Og + ((ti * 8 + td) * 64 + lane) * 4) = pack4(a);
            } else {
                const int j = id - 32, tk = j >> 3, tv = j & 7;
                f32x4 a = z;
#pragma unroll
                for (int kk = 0; kk < 2; ++kk)
                    a = __builtin_amdgcn_mfma_f32_16x16x32_bf16(*(const LDSP bf16x8*)(KdT + (tk * 16 + r) * 72 + kk * 32 + q4 * 8), frag_tr16(VT + kk * 32 * 136 + tv * 16, 136, lane), a, 0, 0, 0);
                *(u32x2*)(Bg + ((tv * (DK / 16) + tk) * 64 + lane) * 4) = pack4(a);
            }
        }
    }
    __syncthreads();
}

template <int MIX, int DVS, int RING>
__device__ __forceinline__ void scan_unit(const Ctx& c, int chain, int slice) {
    constexpr int DK = (MIX == 2) ? 64 : 128;
    constexpr int PS = DK + 8;
    constexpr int NDK = DK / 16, NG = 8 / NDK;
    constexpr int NS = (DVS / 16) / NG;
    constexpr int NO = (DVS / 16) / 2;
    constexpr int KS = DK / 32;
    const int lane = c.lane, wave = c.wave, r = lane & 15, q4 = lane >> 4;
    const int dir = chain & 1, h = (chain >> 1) & 3, b = chain >> 3;
    LDSP bf16_t* ST = (LDSP bf16_t*)c.lds;
    constexpr int PO = DVS + 8;
    LDSP bf16_t* OS = ST + DVS * PS;
    for (int i = c.tid; i < DVS * PS / 2; i += 512) ((LDSP unsigned*)ST)[i] = 0u;
    const int dkt = wave % NDK;
    const int dvt0 = (wave / NDK) * NS;
    const int ott = wave >> 1;
    const int odv0 = (wave & 1) * NO;
    const bf16_t* Mg = (const bf16_t*)(c.ws + WS_RA + RA_GM);
    const bf16_t* Bg = (const bf16_t*)(c.ws + WS_RA + (MIX == 0 ? RA_GB : MIX == 1 ? RA_HB : RA_LB));
    const bf16_t* Qg = (const bf16_t*)(c.ws + WS_RA + (MIX == 0 ? RA_GQ : MIX == 1 ? RA_HQ : RA_LQ));
    const bf16_t* Og = (const bf16_t*)(c.ws + WS_RA + (MIX == 0 ? RA_GO : MIX == 1 ? RA_HO : RA_LO));
    const float* Ag = (const float*)(c.ws + WS_RA + (MIX == 1 ? RA_HA : RA_LA));
    bf16_t* OB = (bf16_t*)(c.ws + WS_RA + RA_OB) + ((size_t)(MIX * 2 + dir) * MROWS) * 512;
    f32x4 S[NS];
#pragma unroll
    for (int t = 0; t < NS; ++t) S[t] = (f32x4){0.f, 0.f, 0.f, 0.f};
    struct Ld { bf16x8 mf[KS]; u32x2 bt[NS]; f32x4 ae; bf16x8 qf[KS]; u32x2 ot[NO]; };
    Ld ring[RING];
    auto load = [&](Ld& d, int s) {
        const int n = dir ? (s < 4 ? 3 - s : 71 - s) : s;
        const size_t cc = (size_t)n * 32 + chain;
        if (MIX == 0) {
#pragma unroll
            for (int kk = 0; kk < KS; ++kk) d.mf[kk] = *(const bf16x8*)(Mg + cc * 16384 + ((dkt * 4 + kk) * 64 + lane) * 8);
        } else {
            d.ae = *(const f32x4*)(Ag + cc * DK + dkt * 16 + q4 * 4);
        }
#pragma unroll
        for (int t = 0; t < NS; ++t) d.bt[t] = *(const u32x2*)(Bg + cc * (128 * DK) + (((slice * (DVS / 16) + dvt0 + t) * NDK + dkt) * 64 + lane) * 4);
#pragma unroll
        for (int kk = 0; kk < KS; ++kk) d.qf[kk] = *(const bf16x8*)(Qg + cc * (64 * DK) + ((ott * KS + kk) * 64 + lane) * 8);
#pragma unroll
        for (int t = 0; t < NO; ++t) d.ot[t] = *(const u32x2*)(Og + cc * 8192 + ((ott * 8 + slice * (DVS / 16) + odv0 + t) * 64 + lane) * 4);
    };
#pragma unroll
    for (int k = 0; k < RING; ++k) load(ring[k], k);
    __syncthreads();
    for (int s0 = 0; s0 < NCH; s0 += RING) {
#pragma unroll
      for (int k = 0; k < RING; ++k) {
        const int s = s0 + k;
        if (s >= NCH) break;
        Ld& cur = ring[k];
        const int n = dir ? (s < 4 ? 3 - s : 71 - s) : s;
#pragma unroll
        for (int t = 0; t < NO; ++t) {
            f32x4 a = (f32x4){bflo(cur.ot[t].x), bfhi(cur.ot[t].x), bflo(cur.ot[t].y), bfhi(cur.ot[t].y)};
#pragma unroll
            for (int kk = 0; kk < KS; ++kk) {
                const bf16x8 sf = *(const LDSP bf16x8*)(ST + ((odv0 + t) * 16 + r) * PS + kk * 32 + q4 * 8);
                a = __builtin_amdgcn_mfma_f32_16x16x32_bf16(sf, cur.qf[kk], a, 0, 0, 0);
            }
            *(LDSP u32x2*)(OS + (s & 1) * 64 * PO + (ott * 16 + r) * PO + (odv0 + t) * 16 + q4 * 4) = pack4(a);
        }
        f32x4 Sn[NS];
#pragma unroll
        for (int t = 0; t < NS; ++t) {
            const f32x4 bm = (f32x4){bflo(cur.bt[t].x), bfhi(cur.bt[t].x), bflo(cur.bt[t].y), bfhi(cur.bt[t].y)};
            if (MIX == 0) {
                f32x4 a = bm;
#pragma unroll
                for (int kk = 0; kk < KS; ++kk) {
                    const bf16x8 sf = *(const LDSP bf16x8*)(ST + ((dvt0 + t) * 16 + r) * PS + kk * 32 + q4 * 8);
                    a = __builtin_amdgcn_mfma_f32_16x16x32_bf16(cur.mf[kk], sf, a, 0, 0, 0);
                }
                Sn[t] = a;
            } else {
                Sn[t] = cur.ae * S[t] + bm;
            }
        }
        if (s + RING < NCH) load(cur, s + RING);
        __syncthreads();
#pragma unroll
        for (int t = 0; t < NS; ++t) { S[t] = Sn[t]; *(LDSP u32x2*)(ST + ((dvt0 + t) * 16 + r) * PS + dkt * 16 + q4 * 4) = pack4(Sn[t]); }
#pragma unroll
        for (int id = c.tid; id < 64 * (DVS / 8); id += 512) {
            const int i = id / (DVS / 8), ch = id % (DVS / 8);
            *(u32x4*)(OB + ((size_t)b * T + tok_of(n, dir, i)) * 512 + h * 128 + slice * DVS + ch * 8) = *(const LDSP u32x4*)(OS + (s & 1) * 64 * PO + i * PO + ch * 8);
        }
        __syncthreads();
      }
    }
}

constexpr int NA_Q = 0, NA_K = 17408, NA_VT = 34816, NA_P = 53248, NA_GRP = 62464;
constexpr int NA_RPB = 2 * NA_GRP;
__device__ __forceinline__ void na_pair(const Ctx& c, int l, int pair) {
    const int tid = c.tid, lane = c.lane, wave = c.wave, grp = wave >> 2, gw = wave & 3, gt = tid & 255;
    const int r = lane & 15, q4 = lane >> 4;
    const bool is_lat = pair < 512;
    int b, h, gr = 0, qb = 0;
    if (is_lat) { const int u = pair * 2 + grp; b = u >> 8; h = (u >> 6) & 3; gr = u & 63; }
    else { const int u = (pair - 512) * 2 + grp; b = u >> 4; h = (u >> 2) & 3; qb = u & 3; }
    const int NT = is_lat ? 12 : 4;
    const int rs = gr - 4 < 0 ? 0 : (gr - 4 > 56 ? 56 : gr - 4);
    LDSP unsigned char* L = c.lds + grp * NA_GRP;
    LDSP bf16_t* Qs = (LDSP bf16_t*)(L + NA_Q);
    LDSP bf16_t* Kt = (LDSP bf16_t*)(L + NA_K);
    LDSP bf16_t* VT = (LDSP bf16_t*)(L + NA_VT);
    LDSP bf16_t* Pm = (LDSP bf16_t*)(L + NA_P);
    LDSP float* rpb = (LDSP float*)(c.lds + NA_RPB);
    const bf16_t* proj = (const bf16_t*)(c.ws + WS_RA + RA_PROJ);
    const size_t rowb = (size_t)b * T;
    const int qtok0 = is_lat ? CTX + gr * 64 : qb * 64;
#pragma unroll
    for (int p = 0; p < 4; ++p) {
        const int id = p * 256 + gt, qi = id >> 4, c8 = id & 15;
        *(LDSP u32x4*)(Qs + qi * 136 + c8 * 8) = *(const u32x4*)(proj + (rowb + qtok0 + qi) * NINP + C_DQ + h * 128 + c8 * 8);
    }
    if (tid < 465) rpb[tid] = c.in[I_RPB][(size_t)(l * 4 + h) * 465 + tid];
    float m_run = -1e30f, l_run = 0.f;
    f32x4 acc[8];
#pragma unroll
    for (int dt = 0; dt < 8; ++dt) acc[dt] = (f32x4){0.f, 0.f, 0.f, 0.f};
    const float SC = 0.08838834764831845f * 1.4426950408889634f;
    const int cq = gw * 16 + r;
    const int cs = cq - 8 < 0 ? 0 : (cq - 8 > 48 ? 48 : cq - 8);
    u32x4 kreg[4], vreg[4];
#define NA_KTOK0(kt_) (is_lat ? ((kt_) < 8 ? CTX + (rs + (kt_)) * 64 : ((kt_) - 8) * 64) : (kt_) * 64)
#define NA_PREFETCH(kt_) do { const int kb_ = NA_KTOK0(kt_); _Pragma("unroll") for (int p = 0; p < 4; ++p) { \
        const int id = p * 256 + gt; kreg[p] = *(const u32x4*)(proj + (rowb + kb_ + (id >> 4)) * NINP + C_DK + h * 128 + (id & 15) * 8); \
        vreg[p] = *(const u32x4*)(proj + (rowb + kb_ + (id >> 4)) * NINP + C_DV + h * 128 + (id & 15) * 8); } } while (0)
    NA_PREFETCH(0);
    for (int kt = 0; kt < NT; ++kt) {
        const bool loc = is_lat && kt < 8;
        __syncthreads();
#pragma unroll
        for (int p = 0; p < 4; ++p) {
            const int id = p * 256 + gt, j = id >> 4, c8 = id & 15;
            *(LDSP u32x4*)(Kt + j * 136 + c8 * 8) = kreg[p];
            *(LDSP u32x4*)(VT + j * 136 + c8 * 8) = vreg[p];
        }
        if (kt + 1 < NT) NA_PREFETCH(kt + 1);
        __syncthreads();
        f32x4 sc[4];
        float tmax = -1e30f;
        const int ct0 = loc ? (gw <= 1 ? 0 : gw - 1) : 0, ct1 = loc ? (gw >= 2 ? 3 : gw + 1) : 3;
#pragma unroll
        for (int ct = 0; ct < 4; ++ct) {
            if (ct < ct0 || ct > ct1) { sc[ct] = (f32x4){-INFINITY, -INFINITY, -INFINITY, -INFINITY}; continue; }
            sc[ct] = mma_tile<4>(Kt + ct * 16 * 136, 136, Qs + gw * 16 * 136, 136, (f32x4){0.f, 0.f, 0.f, 0.f}, lane);
#pragma unroll
            for (int e = 0; e < 4; ++e) {
                float s = sc[ct][e] * SC;
                if (loc) {
                    const int ck = ct * 16 + q4 * 4 + e;
                    int dc = ck - cq; dc = dc < -15 ? -15 : (dc > 15 ? 15 : dc);
                    const int dr = rs + kt - gr + 7;
                    s += rpb[dr * 31 + dc + 15] * 1.4426950408889634f;
                    if (ck < cs || ck >= cs + 16) s = -INFINITY;
                }
                sc[ct][e] = s; tmax = fmaxf(tmax, s);
            }
        }
        tmax = fmaxf(tmax, __shfl_xor(tmax, 16)); tmax = fmaxf(tmax, __shfl_xor(tmax, 32));
        const float m_new = fmaxf(m_run, tmax);
        const float alpha = __builtin_amdgcn_exp2f(m_run - m_new);
        float psum = 0.f;
#pragma unroll
        for (int ct = 0; ct < 4; ++ct) {
            f32x4 p;
#pragma unroll
            for (int e = 0; e < 4; ++e) { p[e] = __builtin_amdgcn_exp2f(sc[ct][e] - m_new); psum += p[e]; }
            *(LDSP u32x2*)(Pm + (gw * 16 + r) * 72 + ct * 16 + q4 * 4) = pack4(p);
        }
        psum += __shfl_xor(psum, 16); psum += __shfl_xor(psum, 32);
        l_run = l_run * alpha + psum; m_run = m_new;
#pragma unroll
        for (int dt = 0; dt < 8; ++dt) {
            acc[dt] = acc[dt] * alpha;
#pragma unroll
            for (int kk = 0; kk < 2; ++kk) {
                if (2 * kk + 1 < ct0 || 2 * kk > ct1) continue;
                const bf16x8 vf = frag_tr16(VT + kk * 32 * 136 + dt * 16, 136, lane);
                const bf16x8 pf = *(const LDSP bf16x8*)(Pm + (gw * 16 + r) * 72 + kk * 32 + q4 * 8);
                acc[dt] = __builtin_amdgcn_mfma_f32_16x16x32_bf16(vf, pf, acc[dt], 0, 0, 0);
            }
        }
    }
    const float inv = 1.f / l_run;
    bf16_t* mix = (bf16_t*)(c.ws + WS_MIX) + (rowb + qtok0 + gw * 16 + r) * D + 1536 + h * 128;
#pragma unroll
    for (int dt = 0; dt < 8; ++dt) *(u32x2*)(mix + dt * 16 + q4 * 4) = pack4(acc[dt] * inv);
    __syncthreads();
}

__device__ __forceinline__ void phase_combine(const Ctx& c, int l) {
    const bf16_t* proj = (const bf16_t*)(c.ws + WS_RA + RA_PROJ);
    const bf16_t* OB = (const bf16_t*)(c.ws + WS_RA + RA_OB);
    bf16_t* mix = (bf16_t*)(c.ws + WS_MIX);
    const int lane = c.lane, d0 = (lane & 15) * 8;
    for (int row = c.bid * 8 + c.wave; row < MROWS; row += c.G * 8) {
#pragma unroll
        for (int mx = 0; mx < 3; ++mx) {
            const int om = mx == 0 ? 0 : 3 - mx;
            const u32x4 a = *(const u32x4*)(OB + ((size_t)(om * 2 + 0) * MROWS + row) * 512 + lane * 8);
            const u32x4 bq = *(const u32x4*)(OB + ((size_t)(om * 2 + 1) * MROWS + row) * 512 + lane * 8);
            const u32x4 g = *(const u32x4*)(proj + (size_t)row * NINP + (mx == 0 ? C_AZ : mx == 1 ? C_BR : C_CG) + lane * 8);
            const float* nw = c.in[mx == 0 ? I_GDNN : mx == 1 ? I_GLAN : I_HGN] + l * 128 + d0;
            float o[8]; float ss = 0.f;
#pragma unroll
            for (int m = 0; m < 4; ++m) { o[2 * m] = bflo(a[m]) + bflo(bq[m]); o[2 * m + 1] = bfhi(a[m]) + bfhi(bq[m]); ss += o[2 * m] * o[2 * m] + o[2 * m + 1] * o[2 * m + 1]; }
#pragma unroll
            for (int m = 1; m < 16; m <<= 1) ss += __shfl_xor(ss, m);
            const float rn = rsqrtf(ss * (1.f / 128.f) + NORM_EPS);
            float y[8];
#pragma unroll
            for (int m = 0; m < 4; ++m) {
                const float g0 = bflo(g[m]), g1 = bfhi(g[m]);
                const float a0 = (mx == 2) ? sigmoidf_(g0) : siluf_(g0), a1 = (mx == 2) ? sigmoidf_(g1) : siluf_(g1);
                y[2 * m] = o[2 * m] * rn * nw[2 * m] * a0; y[2 * m + 1] = o[2 * m + 1] * rn * nw[2 * m + 1] * a1;
            }
            *(u32x4*)(mix + (size_t)row * D + mx * 512 + lane * 8) = (u32x4){pk2(y[0], y[1]), pk2(y[2], y[3]), pk2(y[4], y[5]), pk2(y[6], y[7])};
        }
    }
}

__device__ __forceinline__ void phase_ln_router(const Ctx& c, int l) {
    LDSP float* wr = (LDSP float*)c.lds;
    for (int i = c.tid; i < 2048 * 16; i += 512) { const int k = i >> 4, e = i & 15; wr[e * 2048 + k] = c.in[I_ROUT][(size_t)l * 2048 * 16 + i]; }
    __syncthreads();
    const float* modv = (const float*)(c.ws + WS_MODV);
    const float* tb = (const float*)(c.ws + WS_RA + RA_TBUF);
    float* X1 = (float*)(c.ws + WS_X1); bf16_t* U = (bf16_t*)(c.ws + WS_U); float* aff = (float*)(c.ws + WS_AFF);
    const float* lg = c.in[I_LNG] + (size_t)(l * 2 + 0) * D; const float* lbp = c.in[I_LNB] + (size_t)(l * 2 + 0) * D;
    const int lane = c.lane;
    for (int row = c.bid * 8 + c.wave; row < MROWS; row += c.G * 8) {
        const int b = row / T, t = row % T;
        if (l == DEPTH - 1 && t < CTX) continue;
        const int r = t < CTX ? 4 : b;
        f32x4 v[8];
#pragma unroll
        for (int j = 0; j < 8; ++j) v[j] = *(const f32x4*)(tb + (size_t)row * D + 256 * j + 4 * lane);
        float mu, rstd; row_stats(v, mu, rstd);
#pragma unroll
        for (int j = 0; j < 8; ++j) {
            const int col = 256 * j + 4 * lane;
            v[j] = (v[j] - mu) * rstd * *(const f32x4*)(lg + col) + *(const f32x4*)(lbp + col);
            *(f32x4*)(X1 + (size_t)row * D + col) = v[j];
        }
        row_stats(v, mu, rstd);
        const float* sh = modv + (size_t)(l * 5 + r) * 12288 + 3 * 2048; const float* scp = sh + 2048;
        float lg16[16];
#pragma unroll
        for (int e = 0; e < 16; ++e) lg16[e] = 0.f;
#pragma unroll
        for (int j = 0; j < 8; ++j) {
            const int col = 256 * j + 4 * lane;
            const f32x4 y = (v[j] - mu) * rstd * (*(const f32x4*)(scp + col) + 1.f) + *(const f32x4*)(sh + col);
            *(u32x2*)(U + (size_t)row * D + col) = pack4(y);
#pragma unroll
            for (int e = 0; e < 16; ++e) { const f32x4 w = *(const LDSP f32x4*)(wr + e * 2048 + col); lg16[e] += y[0] * w[0] + y[1] * w[1] + y[2] * w[2] + y[3] * w[3]; }
        }
        float mxv = -1e30f;
#pragma unroll
        for (int e = 0; e < 16; ++e) { lg16[e] = wsum(lg16[e]); mxv = fmaxf(mxv, lg16[e]); }
        float den = 0.f;
#pragma unroll
        for (int e = 0; e < 16; ++e) { lg16[e] = expf(lg16[e] - mxv); den += lg16[e]; }
        const float rd = 1.f / den;
        float mine = 0.f;
#pragma unroll
        for (int e = 0; e < 16; ++e) if (lane == e) mine = lg16[e] * rd;
        if (lane < 16) aff[((size_t)b * 16 + lane) * T + t] = mine;
    }
    __syncthreads();
}

__device__ __forceinline__ void topk_unit(const Ctx& c, int prob) {
    const bool lat = prob < 64; const int pe = lat ? prob : prob - 64, b = pe >> 4, e = pe & 15;
    const int n = lat ? 4096 : 256, kcap = lat ? 512 : 32, tok0 = lat ? CTX : 0;
    LDSP unsigned* keys = (LDSP unsigned*)c.lds;
    LDSP unsigned* hist = keys + 4096;
    LDSP unsigned* bc = hist + 256;
    LDSP unsigned* wsum_ = bc + 4;
    const float* aff = (const float*)(c.ws + WS_AFF);
    const int tid = c.tid, lane = c.lane, wave = c.wave;
    const size_t rowb = (size_t)b * T + tok0;
    for (int i = tid; i < n; i += 512) keys[i] = __float_as_uint(aff[((size_t)b * 16 + e) * T + tok0 + i]);
    unsigned prefix = 0u, mask = 0u, krem = (unsigned)kcap;
    for (int pass = 0; pass < 4; ++pass) {
        const int shift = 24 - 8 * pass;
        if (tid < 256) hist[tid] = 0u;
        __syncthreads();
        for (int i = tid; i < n; i += 512) { const unsigned k = keys[i]; if ((k & mask) == prefix) __hip_atomic_fetch_add(&hist[(k >> shift) & 255u], 1u, __ATOMIC_RELAXED, __HIP_MEMORY_SCOPE_WORKGROUP); }
        __syncthreads();
        if (tid == 0) {
            unsigned cum = 0u; int bin = 255;
            for (; bin > 0; --bin) { const unsigned hcount = hist[bin]; if (cum + hcount >= krem) break; cum += hcount; }
            bc[0] = prefix | ((unsigned)bin << shift); bc[1] = krem - cum;
        }
        __syncthreads();
        prefix = bc[0]; krem = bc[1]; mask |= 255u << shift;
        __syncthreads();
    }
    const int per = n / 512 > 0 ? n / 512 : 1;
    const int i0 = tid * per;
    unsigned cnt = 0u;
    if (i0 < n) for (int j = 0; j < per; ++j) { const unsigned k = keys[i0 + j]; cnt += (k > prefix) ? 1u : 0u; cnt += (k == prefix) ? 0x10000u : 0u; }
    unsigned inc = cnt;
#pragma unroll
    for (int m = 1; m < 64; m <<= 1) { const unsigned o = __shfl_up(inc, m); if (lane >= m) inc += o; }
    if (lane == 63) wsum_[wave] = inc;
    __syncthreads();
    unsigned base = 0u;
    for (int w = 0; w < wave; ++w) base += wsum_[w];
    unsigned excl = base + inc - cnt;
    int* idx = (int*)(c.ws + WS_IDX); float* gate = (float*)(c.ws + WS_GATE); int* inv = (int*)(c.ws + WS_INV);
    const int slot0 = lat ? b * 512 : 2048 + b * 32;
    if (i0 < n) for (int j = 0; j < per; ++j) {
        const unsigned k = keys[i0 + j];
        const unsigned gtb = excl & 0xffffu, eqb = excl >> 16;
        const bool sel = (k > prefix) || (k == prefix && eqb < krem);
        int srow = -1;
        if (sel) {
            srow = slot0 + (int)(gtb + (eqb < krem ? eqb : krem));
            idx[e * EROWS + srow] = (int)(rowb + i0 + j);
            gate[e * EROWS + srow] = __uint_as_float(k);
        }
        inv[(rowb + i0 + j) * 16 + e] = srow;
        excl += (k > prefix) ? 1u : 0u; excl += (k == prefix) ? 0x10000u : 0u;
    }
    __syncthreads();
}

__device__ __forceinline__ void phase_gather(const Ctx& c, int l) {
    const int* idx = (const int*)(c.ws + WS_IDX);
    const bf16_t* U = (const bf16_t*)(c.ws + WS_U); bf16_t* XS = (bf16_t*)(c.ws + WS_RA + RA_XS);
    const int nrow = (l == DEPTH - 1) ? 2048 : EROWS, nreal = (l == DEPTH - 1) ? 2048 : 2176;
    for (int g = c.bid * 8 + c.wave; g < NEXP * nrow; g += c.G * 8) {
        const int e = g / nrow, s = g % nrow;
        u32x4 v[4];
        if (s < nreal) {
            const int src = idx[e * EROWS + s];
#pragma unroll
            for (int j = 0; j < 4; ++j) v[j] = *(const u32x4*)(U + (size_t)src * D + j * 512 + c.lane * 8);
        } else {
#pragma unroll
            for (int j = 0; j < 4; ++j) v[j] = (u32x4){0u, 0u, 0u, 0u};
            if (c.lane == 0) ((float*)(c.ws + WS_GATE))[e * EROWS + s] = 0.f;
        }
#pragma unroll
        for (int j = 0; j < 4; ++j) *(u32x4*)(XS + ((size_t)e * EROWS + s) * D + j * 512 + c.lane * 8) = v[j];
    }
}

__device__ __forceinline__ void phase_final(const Ctx& c, int l) {
    const float* modv = (const float*)(c.ws + WS_MODV);
    const float* X1 = (const float*)(c.ws + WS_X1); float* X = (float*)(c.ws + WS_X); bf16_t* U = (bf16_t*)(c.ws + WS_U);
    const bf16_t* YS = (const bf16_t*)(c.ws + WS_RA + RA_YS); const int* inv = (const int*)(c.ws + WS_INV);
    const float* lg = c.in[I_LNG] + (size_t)(l * 2 + 1) * D; const float* lbp = c.in[I_LNB] + (size_t)(l * 2 + 1) * D;
    const int lane = c.lane;
    for (int row = c.bid * 8 + c.wave; row < MROWS; row += c.G * 8) {
        const int b = row / T, t = row % T;
        if (l == DEPTH - 1 && t < CTX) continue;
        const int r = t < CTX ? 4 : b;
        f32x4 y[8];
#pragma unroll
        for (int j = 0; j < 8; ++j) y[j] = (f32x4){0.f, 0.f, 0.f, 0.f};
        const int myinv = inv[(size_t)row * 16 + (lane & 15)];
        for (int e = 0; e < 16; ++e) {
            const int s = __shfl(myinv, e);
            if (s >= 0) {
                const bf16_t* yr = YS + ((size_t)e * EROWS + s) * D;
#pragma unroll
                for (int j = 0; j < 8; ++j) { const u32x2 w = *(const u32x2*)(yr + 256 * j + 4 * lane); y[j] += (f32x4){bflo(w.x), bfhi(w.x), bflo(w.y), bfhi(w.y)}; }
            }
        }
        const float* m5 = modv + (size_t)(l * 5 + r) * 12288 + 5 * 2048;
        f32x4 v[8];
#pragma unroll
        for (int j = 0; j < 8; ++j) { const int col = 256 * j + 4 * lane; v[j] = *(const f32x4*)(X1 + (size_t)row * D + col) * ALPHA + *(const f32x4*)(m5 + col) * y[j]; }
        float mu, rstd; row_stats(v, mu, rstd);
#pragma unroll
        for (int j = 0; j < 8; ++j) { const int col = 256 * j + 4 * lane; v[j] = (v[j] - mu) * rstd * *(const f32x4*)(lg + col) + *(const f32x4*)(lbp + col); }
        if (l == DEPTH - 1) {
            float* o = c.out + ((size_t)b * SEQ + (t - CTX)) * D;
#pragma unroll
            for (int j = 0; j < 8; ++j) *(f32x4*)(o + 256 * j + 4 * lane) = v[j];
        } else {
#pragma unroll
            for (int j = 0; j < 8; ++j) *(f32x4*)(X + (size_t)row * D + 256 * j + 4 * lane) = v[j];
            const float* sh = modv + (size_t)((l + 1) * 5 + r) * 12288;
            modulate_store(v, sh, sh + 2048, U + (size_t)row * D, lane);
        }
    }
}

struct EpiOut {
    static constexpr bool PERM = false, AFTER_DRAIN = false;
    const float* X; const float* modv_l; float* Tb;
    __device__ __forceinline__ void operator()(const pg8::f32x4 (&acc)[2][2][4][2], const pg8::Unit& u, int wr, int wc, int fr, int fq) const {
        const int row0 = u.pm * 256 + wr * 64 + fr, col0 = u.pn * 256 + wc * 32 + 4 * fq;
        const int r = (u.pm % 17 == 0) ? 4 : u.pm / 17;
        const float* m2 = modv_l + (size_t)r * 12288 + 2 * 2048 + col0;
        pg8::f32x4 mv[2][2];
#pragma unroll
        for (int bj = 0; bj < 2; ++bj)
#pragma unroll
            for (int n = 0; n < 2; ++n) mv[bj][n] = *(const pg8::f32x4*)(m2 + bj * 128 + n * 16);
#pragma unroll
        for (int ai = 0; ai < 2; ++ai)
#pragma unroll
            for (int m = 0; m < 4; ++m) {
                const size_t off = (size_t)(row0 + ai * 128 + m * 16) * D + col0;
#pragma unroll
                for (int bj = 0; bj < 2; ++bj)
#pragma unroll
                    for (int n = 0; n < 2; ++n)
                        *(pg8::f32x4*)(Tb + off + bj * 128 + n * 16) = *(const pg8::f32x4*)(X + off + bj * 128 + n * 16) * ALPHA + mv[bj][n] * acc[ai][bj][m][n];
            }
    }
};
struct EpiHid {
    static constexpr bool PERM = true, AFTER_DRAIN = false;
    bf16_t* H;
    __device__ __forceinline__ void operator()(const pg8::f32x4 (&acc)[2][2][4][2], const pg8::Unit& u, int wr, int wc, int fr, int fq) const {
        const int row0 = u.pm * 256 + wr * 64 + fr, col0 = (u.pn & 7) * 128 + wc * 32 + 8 * fq;
#pragma unroll
        for (int ai = 0; ai < 2; ++ai)
#pragma unroll
            for (int m = 0; m < 4; ++m) {
                float hv[8];
#pragma unroll
                for (int n = 0; n < 2; ++n)
#pragma unroll
                    for (int j = 0; j < 4; ++j) hv[n * 4 + j] = siluf_(acc[ai][0][m][n][j]) * acc[ai][1][m][n][j];
                *(u32x4*)(H + (size_t)(row0 + ai * 128 + m * 16) * 1024 + col0) = (u32x4){pk2(hv[0], hv[1]), pk2(hv[2], hv[3]), pk2(hv[4], hv[5]), pk2(hv[6], hv[7])};
            }
    }
};
struct EpiY {
    static constexpr bool PERM = true, AFTER_DRAIN = false;
    bf16_t* Y; const float* gate;
    __device__ __forceinline__ void operator()(const pg8::f32x4 (&acc)[2][2][4][2], const pg8::Unit& u, int wr, int wc, int fr, int fq) const {
        const int row0 = u.pm * 256 + wr * 64 + fr, col0 = (u.pn & 7) * 256 + wc * 32 + 8 * fq;
#pragma unroll
        for (int ai = 0; ai < 2; ++ai)
#pragma unroll
            for (int m = 0; m < 4; ++m) {
                const int row = row0 + ai * 128 + m * 16; const float g = gate[row];
#pragma unroll
                for (int bj = 0; bj < 2; ++bj) {
                    const pg8::f32x4 v0 = acc[ai][bj][m][0] * g, v1 = acc[ai][bj][m][1] * g;
                    *(u32x4*)(Y + (size_t)row * D + col0 + bj * 128) = (u32x4){pk2(v0[0], v0[1]), pk2(v0[2], v0[3]), pk2(v1[0], v1[1]), pk2(v1[2], v1[3])};
                }
            }
    }
};
struct SchedLin {
    int G, c, nUnits, nPn, skip_ctx;
    __device__ __forceinline__ bool next(int i, pg8::Unit& u) const {
        const int L = i * G + c; if (L >= nUnits) return false;
        const int pml = L / nPn; u.pn = L % nPn; u.pm = skip_ctx ? (pml >> 4) * 17 + 1 + (pml & 15) : pml; return true;
    }
    __device__ __forceinline__ void a_ready(const pg8::Unit&) const {}
    __device__ __forceinline__ void done(const pg8::Unit&) const {}
};
struct SchedMoe {
    int G, c, nPm, nUnits;
    __device__ __forceinline__ bool next(int i, pg8::Unit& u) const {
        const int L = i * G + c; if (L >= nUnits) return false;
        const int per = nPm * 8, e = L / per, rem = L % per; u.pm = e * 9 + (rem >> 3); u.pn = e * 8 + (rem & 7); return true;
    }
    __device__ __forceinline__ void a_ready(const pg8::Unit&) const {}
    __device__ __forceinline__ void done(const pg8::Unit&) const {}
};
}

struct Args { const float* in[24]; float* out; unsigned char* ws; int ph_lo, ph_hi; };
constexpr int LDS_BYTES = 147456;
#ifndef MK_NG
#define MK_NG 128
#define MK_NH 48
#endif
constexpr int N_PHASES = 2 + 11 * mk::DEPTH;

__global__ __launch_bounds__(512, 2) void mega_fwd(Args a) {
    using namespace mk;
    extern __shared__ __attribute__((aligned(16))) unsigned char lds_raw[];
    Ctx c0;
#pragma unroll
    for (int i = 0; i < 24; ++i) c0.in[i] = a.in[i];
    c0.out = a.out; c0.ws = a.ws; c0.lds = (LDSP unsigned char*)lds_raw;
    const int wave_s = __builtin_amdgcn_readfirstlane((int)threadIdx.x >> 6);
    c0.tid = threadIdx.x; c0.lane = c0.tid & 63; c0.wave = wave_s; c0.G = gridDim.x; c0.bid = blockIdx.x;
    const int lo = a.ph_lo, hi = a.ph_hi;
    volatile LAS unsigned* st = (volatile LAS unsigned*)(lds_raw + LDS_BYTES - 16);
    if (c0.tid == 0) { st[0] = 0u; st[1] = 0u; st[2] = 0u; st[3] = 0u; }
    __syncthreads();
    XcdBarrier bar; bar.bar = (unsigned*)(a.ws + WS_BAR); bar.x = 0; bar.st = st;
    if (hi - lo > 1) bar = xcd_barrier_post((unsigned*)(a.ws + WS_BAR), st);
    int ph = 0;
#define PH_CTX Ctx c = c0; { int wz = wave_s; asm volatile("" : "+s"(wz)); unsigned zz = 0u; asm volatile("" : "+v"(zz)); const int lz = (int)__builtin_amdgcn_mbcnt_hi(~0u, __builtin_amdgcn_mbcnt_lo(~0u, zz)); int bz = c0.bid; asm volatile("" : "+s"(bz)); c.bid = bz; c.wave = wz; c.lane = lz; c.tid = wz * 64 + lz; }
#define PH_ON (ph >= lo && ph < hi)
#ifdef MK_DBL
#define REP(id) for (int rep_ = 0; rep_ < 1 + (((MK_DBL) >> (id)) & 1); ++rep_, __syncthreads())
#else
#define REP(id)
#endif
#ifdef MK_TPROBE_A
    volatile LAS unsigned long long* tp = (volatile LAS unsigned long long*)(lds_raw + LDS_BYTES - 48);
    if (c0.bid == (MK_TPROBE_WG) && c0.tid == 0) { tp[0] = __builtin_amdgcn_s_memrealtime(); tp[1] = 0ull; tp[2] = 0ull; tp[3] = 0ull; }
#ifdef MK_GSTAMP
    if (c0.tid == 0) { volatile LAS unsigned long long* g0 = (volatile LAS unsigned long long*)(lds_raw + LDS_BYTES - 48 - 80); for (int i = 0; i < 9; ++i) g0[i] = 0ull; }
    __syncthreads();
#endif
#define PH_END do { if (PH_ON && ph + 1 < hi) xcd_barrier(bar); \
        if (c0.bid == (MK_TPROBE_WG) && threadIdx.x == 0) { const unsigned long long now_ = __builtin_amdgcn_s_memrealtime(); const int kind_ = ph < 2 ? ph : 2 + (ph - 2) % 11; \
            if (kind_ >= (MK_TPROBE_A) && kind_ <= (MK_TPROBE_B)) tp[1] += now_ - tp[0]; tp[0] = now_; } ++ph; } while (0)
#else
#define PH_END do { if (PH_ON && ph + 1 < hi) xcd_barrier(bar); ++ph; } while (0)
#endif

    if (PH_ON) REP(0) { PH_CTX
        if (c.bid < 192) { modv_fill_s(c); for (int u = c.bid; u < 192; u += c.G) modv_unit(c, u); }
        convert_phase(c, 0);
    }
    PH_END;
    if (PH_ON) REP(1) { PH_CTX phase_l0_modulate(c); }
    PH_END;

    for (int l = 0; l < DEPTH; ++l) {
        const bool last = (l == DEPTH - 1);
        if (PH_ON) REP(2) { PH_CTX
            pg8::Gemm g{(const pg8::bf16_t*)(c.ws + WS_U), (const pg8::bf16_t*)(c.ws + WS_WIN), MROWS, NINP, D};
            pg8::StaticOrder S; S.init(MROWS, NINP, c.G, c.bid);
            pg8::EpiBf16<0> E{(pg8::bf16_t*)(c.ws + WS_RA + RA_PROJ), NINP, nullptr, 0, 0};
            pg8::gemm_phase<pg8::EpiBf16<0>, pg8::StaticOrder, false>((PG8_LAS unsigned char*)c.lds, g, S, E, nullptr, c.tid);
        }
        PH_END;
        if (PH_ON) REP(3) { PH_CTX
            for (int cc = c.bid; cc < NCC; cc += c.G) gdn_prep_unit(c, l, cc);
        }
        if (PH_ON) REP(4) { PH_CTX
            for (int cc = c.bid; cc < NCC; cc += c.G) diag_prep_unit<1>(c, l, cc);
        }
        if (PH_ON) REP(5) { PH_CTX
            for (int cc = c.bid; cc < NCC; cc += c.G) diag_prep_unit<2>(c, l, cc);
        }
        PH_END;
        if (PH_ON) REP(6) { PH_CTX
            for (int u = c.bid; u < 128; u += c.G) if (u < 64) { scan_unit<0, 64, 3>(c, u & 31, u >> 5); __syncthreads(); }
        }
        if (PH_ON) REP(7) { PH_CTX
            for (int u = c.bid; u < 128; u += c.G) if (u >= 64 && u < 96) { scan_unit<1, 128, 2>(c, u - 64, 0); __syncthreads(); }
        }
        if (PH_ON) REP(8) { PH_CTX
            for (int u = c.bid; u < 128; u += c.G) if (u >= 96) { scan_unit<2, 128, 4>(c, u - 96, 0); __syncthreads(); }
        }
#ifdef MK_TPROBE_A
        if (PH_ON && c0.bid == (MK_TPROBE_WG) && threadIdx.x == 0) { tp[2] += __builtin_amdgcn_s_memrealtime() - tp[0]; }
#endif
        if (PH_ON) REP(9) { PH_CTX
            const int nq = last ? 64 : 68, qx = c.bid & 7;
            unsigned* qhead = (unsigned*)(c.ws + WS_BAR) + 3584 + 8 * (l * 8 + qx);
            volatile LAS unsigned* tk = (volatile LAS unsigned*)(lds_raw + LDS_BYTES - 64);
            for (;;) {
                if (c.tid == 0) tk[0] = __hip_atomic_fetch_add(qhead, 1u, __ATOMIC_RELAXED, __HIP_MEMORY_SCOPE_AGENT);
                __syncthreads();
                const int t = (int)tk[0];
                if (t >= nq) break;
                na_pair(c, l, t < 64 ? 64 * qx + t : 512 + 4 * qx + (t - 64));
            }
        }
#ifdef MK_TPROBE_A
        if (PH_ON && c0.bid == (MK_TPROBE_WG) && threadIdx.x == 0) { tp[3] += __builtin_amdgcn_s_memrealtime() - tp[0]; }
#endif
        PH_END;
        if (PH_ON) REP(10) { PH_CTX phase_combine(c, l); }
        PH_END;
        if (PH_ON) REP(11) { PH_CTX
            pg8::Gemm g{(const pg8::bf16_t*)(c.ws + WS_MIX), (const pg8::bf16_t*)(c.ws + WS_WOUT), MROWS, D, D};
            SchedLin S{c.G, c.bid, (last ? 64 : 68) * 8, 8, last ? 1 : 0};
            EpiOut E{(const float*)(c.ws + WS_X), (const float*)(c.ws + WS_MODV) + (size_t)l * 5 * 12288, (float*)(c.ws + WS_RA + RA_TBUF)};
            pg8::gemm_phase<EpiOut, SchedLin, false>((PG8_LAS unsigned char*)c.lds, g, S, E, nullptr, c.tid);
        }
        PH_END;
        if (PH_ON) REP(12) { PH_CTX phase_ln_router(c, l); }
        PH_END;
        if (PH_ON) REP(13) { PH_CTX const int nprob = last ? 64 : 128; for (int p = c.bid; p < nprob; p += c.G) topk_unit(c, p); }
        PH_END;
        if (PH_ON) REP(14) { PH_CTX phase_gather(c, l); }
        PH_END;
        if (PH_ON) REP(15) { PH_CTX
            pg8::Gemm g{(const pg8::bf16_t*)(c.ws + WS_RA + RA_XS), (const pg8::bf16_t*)(c.ws + WS_W13), NEXP * EROWS, NEXP * 2048, D};
            SchedMoe S{c.G, c.bid, last ? 8 : 9, NEXP * (last ? 8 : 9) * 8};
            EpiHid E{(bf16_t*)(c.ws + WS_RA + RA_HID)};
            pg8::gemm_phase<EpiHid, SchedMoe, false>((PG8_LAS unsigned char*)c.lds, g, S, E, nullptr, c.tid);
        }
        PH_END;
        if (PH_ON) REP(16) { PH_CTX
            pg8::Gemm g{(const pg8::bf16_t*)(c.ws + WS_RA + RA_HID), (const pg8::bf16_t*)(c.ws + WS_W2), NEXP * EROWS, NEXP * 2048, 1024};
            SchedMoe S{c.G, c.bid, last ? 8 : 9, NEXP * (last ? 8 : 9) * 8};
            EpiY E{(bf16_t*)(c.ws + WS_RA + RA_YS), (const float*)(c.ws + WS_GATE)};
            pg8::gemm_phase<EpiY, SchedMoe, false>((PG8_LAS unsigned char*)c.lds, g, S, E, nullptr, c.tid);
        }
        PH_END;
        if (PH_ON) REP(17) { PH_CTX phase_final(c, l); }
        if (PH_ON) REP(18) { PH_CTX if (!last) convert_phase(c, l + 1); }
        PH_END;
    }
#ifdef MK_TPROBE_A
    if (c0.bid == (MK_TPROBE_WG) && threadIdx.x == 0) { const unsigned long long t0_ = __builtin_amdgcn_s_memrealtime(), w_ =
#ifdef MK_GSTAMP
        ((volatile LAS unsigned long long*)(lds_raw + LDS_BYTES - 48 - 80))[MK_GSTAMP] * (unsigned long long)(MK_TPROBE_MULT);
#else
        tp[MK_TPROBE_SEL] * (unsigned long long)(MK_TPROBE_MULT);
#endif
        while (__builtin_amdgcn_s_memrealtime() - t0_ < w_) __builtin_amdgcn_s_sleep(32); }
#endif
}

#ifdef MK_STOP
__global__ void digest_k(const unsigned* w0, size_t n0, const unsigned* w1, size_t n1, float* out, size_t nout) {
    for (size_t i = (size_t)blockIdx.x * blockDim.x + threadIdx.x; i < nout; i += (size_t)gridDim.x * blockDim.x) {
        unsigned h = 0u;
        for (size_t j = i; j < n0 + n1; j += nout) {
#ifdef MK_RW0
            const size_t rw = j < n0 ? (size_t)(MK_RW0) : (size_t)(MK_RW1); const size_t row = (j < n0 ? j : j - n0) / rw;
            if (row % 4352 < 256) continue;
#endif
#ifdef MK_NANCOUNT
            { const unsigned wv = (j < n0 ? w0[j] : w1[j - n0]);
#ifdef MK_BF16
              if ((wv & 0x7F800000u) == 0x7F800000u || (wv & 0x7F80u) == 0x7F80u) h += 1u; }
#else
              if ((wv & 0x7F800000u) == 0x7F800000u) h += 1u; }
#endif
#else
            h = h * 31u + (j < n0 ? w0[j] : w1[j - n0]);
#endif
        }
#ifdef MK_NANCOUNT
        out[i] = 1000.f * (float)h;
#else
        out[i] = (float)(h & 0xFFFFFu);
#endif
    }
}
#endif
extern "C" void kernel_launch(void* const* d_in, const int* in_sizes, int n_in, void* d_out, int out_size, void* d_ws, size_t ws_size, hipStream_t stream) {
    static int grid = 0;
    if (grid == 0) {
        if (n_in != 24 || ws_size < mk::WS_TOTAL) { fprintf(stderr, "kernel_launch: n_in %d ws %zu (need %zu)\n", n_in, ws_size, (size_t)mk::WS_TOTAL); grid = -1; return; }
        int dev = 0, cus = 0, per_cu = 0;
        if (hipGetDevice(&dev) != hipSuccess || hipDeviceGetAttribute(&cus, hipDeviceAttributeMultiprocessorCount, dev) != hipSuccess) { grid = -1; return; }
        if (hipFuncSetAttribute((const void*)mega_fwd, hipFuncAttributeMaxDynamicSharedMemorySize, LDS_BYTES) != hipSuccess) { fprintf(stderr, "kernel_launch: hipFuncSetAttribute failed\n"); grid = -1; return; }
        if (hipOccupancyMaxActiveBlocksPerMultiprocessor(&per_cu, (const void*)mega_fwd, 512, LDS_BYTES) != hipSuccess || per_cu < 1) fprintf(stderr, "kernel_launch: occupancy query says %d\n", per_cu);
        (void)hipGetLastError();
        grid = cus;
    }
    if (grid < 0) return;
    (void)hipMemsetAsync((char*)d_ws + mk::WS_BAR, 0, 16384, stream);
    Args a{};
    for (int i = 0; i < 24; ++i) a.in[i] = (const float*)d_in[i];
    a.out = (float*)d_out; a.ws = (unsigned char*)d_ws;
#if MK_N_LAUNCHES == 1
    a.ph_lo = 0; a.ph_hi = N_PHASES;
    hipLaunchKernelGGL(mega_fwd, dim3(grid), dim3(512), LDS_BYTES, stream, a);
#else
#ifdef MK_STOP
    for (int p = 0; p < MK_STOP; ++p) { a.ph_lo = p; a.ph_hi = p + 1; hipLaunchKernelGGL(mega_fwd, dim3(grid), dim3(512), LDS_BYTES, stream, a); }
    hipLaunchKernelGGL(digest_k, dim3(2048), dim3(256), 0, stream, (const unsigned*)((char*)d_ws + (size_t)(MK_D0)), (size_t)(MK_N0) / 4, (const unsigned*)((char*)d_ws + (size_t)(MK_D1)), (size_t)(MK_N1) / 4, (float*)d_out, (size_t)out_size);
#else
    for (int p = 0; p < N_PHASES; ++p) { a.ph_lo = p; a.ph_hi = p + 1; hipLaunchKernelGGL(mega_fwd, dim3(grid), dim3(512), LDS_BYTES, stream, a); }
#endif
#endif
}
```

```cpp
#include <hip/hip_runtime.h>
#include <cstdio>
#include <cstdint>
#ifndef MK_N_LAUNCHES
#define MK_N_LAUNCHES 1
#endif
namespace pg8 {
#define PG8_LAS __attribute__((address_space(3)))
typedef unsigned short bf16_t;
typedef short bf16x8 __attribute__((ext_vector_type(8)));
typedef float f32x4 __attribute__((ext_vector_type(4)));
typedef unsigned u32x4 __attribute__((ext_vector_type(4)));
constexpr int BM = 256, BK = 64, HALF = 128, HTB = HALF * BK * 2  , STAGE_BYTES = 8 * HTB, NXCD = 8, WGM = 8;

__host__ __device__ __forceinline__ int lds_byte(int r, int c) { const int st = (r >> 4) * 2 + (c >> 5), rr = r & 15, cc = c & 31, ob = rr * 64 + cc * 2; return st * 1024 + (ob ^ (((ob >> 9) & 1) << 5)); }
__host__ __device__ __forceinline__ void stage_rc(int b, int& R, int& C) { const int st = b / 1024, sb = b % 1024, swz = sb ^ (((sb >> 9) & 1) << 5); R = (st >> 1) * 16 + swz / 64; C = (st & 1) * 32 + (swz % 64) / 2; }
__host__ __device__ __forceinline__ int perm32(int rho) { const int n = rho >> 4, i = rho & 15; return 8 * (i >> 2) + 4 * n + (i & 3); }

struct Unit { int pm, pn; };
struct Gemm { const bf16_t* A; const bf16_t* Bt; int M, N, K; };

struct StaticOrder {
    int nM, nN, nwg, G, c;
    __host__ __device__ void init(int M, int N, int G_, int c_) { nM = M / BM; nN = N / BM; nwg = nM * nN; G = G_; c = c_; }
    __host__ __device__ bool next(int i, Unit& u) const {
        const long L = (long)i * G + c; if (L >= nwg) return false;
        int wgid = (int)L; { const int q = nwg / NXCD, r = nwg % NXCD, xcd = wgid % NXCD, off = wgid / NXCD; wgid = (xcd < r ? xcd * (q + 1) : r * (q + 1) + (xcd - r) * q) + off; }
        const int nig = WGM * nN, gid = wgid / nig, fm = gid * WGM, gsz = (nM - fm) < WGM ? (nM - fm) : WGM;
        u.pm = fm + ((wgid % nig) % gsz); u.pn = (wgid % nig) / gsz; return true;
    }
    __device__ __forceinline__ void a_ready(const Unit&) const {}
    __device__ __forceinline__ void done(const Unit&) const {}
};
struct CountedOrder : StaticOrder {
    const unsigned* ready; unsigned need; unsigned* tmo;
    __device__ __forceinline__ void a_ready(const Unit& u) const {
        if (threadIdx.x < 64) {
            const unsigned long long t0 = __builtin_amdgcn_s_memrealtime(); unsigned polls = 0;
            while ((unsigned)__builtin_amdgcn_readfirstlane(__hip_atomic_load(ready + 64 * u.pm, __ATOMIC_RELAXED, __HIP_MEMORY_SCOPE_AGENT)) < need) {
                if ((++polls & 255u) == 0u && __builtin_amdgcn_readfirstlane(__hip_atomic_load(tmo, __ATOMIC_RELAXED, __HIP_MEMORY_SCOPE_AGENT)) != 0u) break;
                if (__builtin_amdgcn_s_memrealtime() - t0 > 2000000ull) {
                    if (threadIdx.x == 0) { unsigned expect = 0u; __hip_atomic_compare_exchange_strong(tmo + 1, &expect, 0x600u | (unsigned)(u.pm & 0xff), __ATOMIC_RELAXED, __ATOMIC_RELAXED, __HIP_MEMORY_SCOPE_AGENT); __hip_atomic_store(tmo, 1u, __ATOMIC_RELAXED, __HIP_MEMORY_SCOPE_AGENT); }
                    break; }
                __builtin_amdgcn_s_sleep(2); }
            __builtin_amdgcn_fence(__ATOMIC_ACQUIRE, "agent");
            asm volatile("s_waitcnt vmcnt(0)" ::: "memory");
        }
#if !defined(BROKEN_HOOK_NO_BARRIER)
        asm volatile("" ::: "memory"); __builtin_amdgcn_s_barrier(); asm volatile("" ::: "memory");
#endif
    }
};

typedef float f32x2_cv __attribute__((ext_vector_type(2)));
typedef __bf16 bf16x2_cv __attribute__((ext_vector_type(2)));
__device__ __forceinline__ unsigned cvt_pk_bf16(float lo, float hi) { const bf16x2_cv v = __builtin_convertvector((f32x2_cv){lo, hi}, bf16x2_cv); return __builtin_bit_cast(unsigned, v); }
typedef float f32x2 __attribute__((ext_vector_type(2)));
__device__ __forceinline__ f32x2 gelu_pk(f32x2 v) {
    const f32x2 av = __builtin_elementwise_abs(v), d = av * 0.2316418882f + 1.0f;
    f32x2 t; t.x = __builtin_amdgcn_rcpf(d.x); t.y = __builtin_amdgcn_rcpf(d.y);
    f32x2 q = t * 0.5307027145f + (-0.7265760135f); q = q * t + 0.7107068705f; q = q * t + (-0.142248368f); q = q * t + 0.127414796f; q = q * t;
    const f32x2 s = (v * v) * (-0.72134752044f);
    f32x2 e; e.x = __builtin_amdgcn_exp2f(s.x); e.y = __builtin_amdgcn_exp2f(s.y);
    const f32x2 m = v * (q * e), r = v - m;
    f32x2 o; o.x = v.x < 0.f ? m.x : r.x; o.y = v.y < 0.f ? m.y : r.y; return o;
}

struct EpiF32 {
    static constexpr bool PERM = false, AFTER_DRAIN = false;
    float* C; int ldc; const float* bias;
    __device__ __forceinline__ void operator()(const f32x4 (&acc)[2][2][4][2], const Unit& u, int wr, int wc, int fr, int fq) const {
        const int row0 = u.pm * BM + wr * 64 + fr, col0 = u.pn * BM + wc * 32 + 4 * fq;
        f32x4 bv[2][2];
#pragma unroll
        for (int bj = 0; bj < 2; ++bj)
#pragma unroll
            for (int n = 0; n < 2; ++n) bv[bj][n] = bias ? *(const f32x4*)(bias + col0 + bj * HALF + n * 16) : (f32x4){0.f, 0.f, 0.f, 0.f};
#pragma unroll
        for (int ai = 0; ai < 2; ++ai)
#pragma unroll
            for (int m = 0; m < 4; ++m) { float* rowp = C + (size_t)(row0 + ai * HALF + m * 16) * ldc + col0;
#pragma unroll
                for (int bj = 0; bj < 2; ++bj)
#pragma unroll
                    for (int n = 0; n < 2; ++n) *(f32x4*)(rowp + bj * HALF + n * 16) = acc[ai][bj][m][n] + bv[bj][n]; }
    }
};
template <int ACT  > struct EpiBf16 {
    static constexpr bool PERM = true, AFTER_DRAIN = false;
    bf16_t* O; int ldc; const float* bias; int split_cols; size_t split_stride;
    __device__ __forceinline__ void operator()(const f32x4 (&acc)[2][2][4][2], const Unit& u, int wr, int wc, int fr, int fq) const {
        const int row0 = u.pm * BM + wr * 64 + fr; int colt = u.pn * BM; bf16_t* base = O;
        if (split_cols) { const int t = colt / split_cols; base += (size_t)t * split_stride; colt -= t * split_cols; }
        const int col0 = colt + wc * 32 + 8 * fq, bcol0 = u.pn * BM + wc * 32 + 8 * fq;
        f32x4 bv[2][2];
#pragma unroll
        for (int bj = 0; bj < 2; ++bj)
#pragma unroll
            for (int n = 0; n < 2; ++n) bv[bj][n] = bias ? *(const f32x4*)(bias + bcol0 + bj * HALF + 4 * n) : (f32x4){0.f, 0.f, 0.f, 0.f};
#pragma unroll
        for (int ai = 0; ai < 2; ++ai)
#pragma unroll
            for (int m = 0; m < 4; ++m) { bf16_t* rowp = base + (size_t)(row0 + ai * HALF + m * 16) * ldc + col0;
#pragma unroll
                for (int bj = 0; bj < 2; ++bj) { f32x4 v0 = acc[ai][bj][m][0] + bv[bj][0], v1 = acc[ai][bj][m][1] + bv[bj][1];
                    if (ACT == 1) { f32x2 a = gelu_pk((f32x2){v0[0], v0[1]}), b = gelu_pk((f32x2){v0[2], v0[3]}), c = gelu_pk((f32x2){v1[0], v1[1]}), d = gelu_pk((f32x2){v1[2], v1[3]});
                        v0 = (f32x4){a.x, a.y, b.x, b.y}; v1 = (f32x4){c.x, c.y, d.x, d.y}; }
                    if (ACT == 2) {
#pragma unroll
                        for (int j = 0; j < 4; ++j) { v0[j] = 0.5f * v0[j] * (1.0f + erff(v0[j] * 0.70710678f)); v1[j] = 0.5f * v1[j] * (1.0f + erff(v1[j] * 0.70710678f)); } }
                    u32x4 w; w.x = cvt_pk_bf16(v0[0], v0[1]); w.y = cvt_pk_bf16(v0[2], v0[3]); w.z = cvt_pk_bf16(v1[0], v1[1]); w.w = cvt_pk_bf16(v1[2], v1[3]);
                    *(u32x4*)(rowp + bj * HALF) = w; } }
    }
};

struct PanelStats {
    unsigned* xbuf;
    unsigned* cnt;
    unsigned* tmo;
    int ntn; float eps;
    unsigned code;
    __device__ __forceinline__ bool run(const f32x4 (&v)[2][2][4][2], const Unit& u, int wr, int wc, int fr, int fq, PG8_LAS unsigned char* lds, int wid, int lane) const {
        typedef float f32x2v __attribute__((ext_vector_type(2)));
        PG8_LAS f32x2v* P = (PG8_LAS f32x2v*)lds;
        PG8_LAS f32x2v* S = (PG8_LAS f32x2v*)(lds + 8192);
        PG8_LAS unsigned* flag = (PG8_LAS unsigned*)(lds + 8192 + 2048);
#pragma unroll
        for (int ai = 0; ai < 2; ++ai)
#pragma unroll
            for (int m = 0; m < 4; ++m) {
                float s = 0.f;
#pragma unroll
                for (int bj = 0; bj < 2; ++bj)
#pragma unroll
                    for (int n = 0; n < 2; ++n) { const f32x4 x = v[ai][bj][m][n]; s += (x[0] + x[1]) + (x[2] + x[3]); }
                s += __shfl_xor(s, 16); s += __shfl_xor(s, 32);
                const float mw = s * (1.0f / 64.0f); float q = 0.f;
#pragma unroll
                for (int bj = 0; bj < 2; ++bj)
#pragma unroll
                    for (int n = 0; n < 2; ++n) { const f32x4 d = v[ai][bj][m][n] - mw; q += (d[0] * d[0] + d[1] * d[1]) + (d[2] * d[2] + d[3] * d[3]); }
                q += __shfl_xor(q, 16); q += __shfl_xor(q, 32);
                if (fq == 0) P[(ai * HALF + wr * 64 + m * 16 + fr) * 4 + wc] = (f32x2v){mw, q};
            }
        asm volatile("s_waitcnt lgkmcnt(0)" ::: "memory"); __builtin_amdgcn_s_barrier(); asm volatile("" ::: "memory");
#if defined(BROKEN_NO_WAIT)
        if (blockIdx.x >= 64) { const long long t0 = clock64(); while (clock64() - t0 < 60000) __builtin_amdgcn_s_sleep(8); }
#endif
        const int row = wid * 32 + (lane & 31);
        if (lane < 32) {
            const f32x2v a = P[row * 4 + 0], b = P[row * 4 + 1], c = P[row * 4 + 2], d = P[row * 4 + 3];
            const float mt = (a.x + b.x + c.x + d.x) * 0.25f;
            const float da = a.x - mt, db = b.x - mt, dc = c.x - mt, dd = d.x - mt;
            const float m2 = (a.y + b.y) + (c.y + d.y) + 64.0f * ((da * da + db * db) + (dc * dc + dd * dd));
            unsigned long long* slot = (unsigned long long*)xbuf + ((size_t)(u.pm * BM + row) * 4 + u.pn);
            __hip_atomic_store(slot, ((unsigned long long)__float_as_uint(m2) << 32) | __float_as_uint(mt), __ATOMIC_RELAXED, __HIP_MEMORY_SCOPE_AGENT);
        }
        asm volatile("s_waitcnt vmcnt(0)" ::: "memory");
        if (lane == 0) __hip_atomic_fetch_add(cnt + 64 * u.pm, 1u, __ATOMIC_RELAXED, __HIP_MEMORY_SCOPE_AGENT);
        if (wid == 0) {
            bool dead = false; const unsigned long long t0 = __builtin_amdgcn_s_memrealtime(); const unsigned want = 8u * (unsigned)ntn;
            for (;;) {
#if defined(BROKEN_NO_WAIT)
                break;
#endif
                if ((unsigned)__builtin_amdgcn_readfirstlane(__hip_atomic_load(cnt + 64 * u.pm, __ATOMIC_RELAXED, __HIP_MEMORY_SCOPE_AGENT)) >= want) break;
                if (__builtin_amdgcn_s_memrealtime() - t0 > 2000000ull) {
                    if (lane == 0) { unsigned expect = 0u; __hip_atomic_compare_exchange_strong(tmo + 1, &expect, code | (unsigned)(u.pm & 0xff), __ATOMIC_RELAXED, __ATOMIC_RELAXED, __HIP_MEMORY_SCOPE_AGENT);
                                     __hip_atomic_store(tmo, 1u, __ATOMIC_RELAXED, __HIP_MEMORY_SCOPE_AGENT); }
                    dead = true; break; }
                __builtin_amdgcn_s_sleep(2);
            }
            __builtin_amdgcn_fence(__ATOMIC_ACQUIRE, "agent");
            if (lane == 0) flag[0] = dead ? 1u : 0u;
        }
        asm volatile("s_waitcnt vmcnt(0) lgkmcnt(0)" ::: "memory"); __builtin_amdgcn_s_barrier(); asm volatile("" ::: "memory");
        const bool bad = flag[0] != 0u;
        if (lane < 32) {
            const unsigned long long* slot = (const unsigned long long*)xbuf + (size_t)(u.pm * BM + row) * 4; float mt[4], m2[4]; float ms = 0.f;
#pragma unroll
            for (int t = 0; t < 4; ++t) { if (t < ntn) { const unsigned long long w = __hip_atomic_load(slot + t, __ATOMIC_RELAXED, __HIP_MEMORY_SCOPE_AGENT); mt[t] = __uint_as_float((unsigned)w); m2[t] = __uint_as_float((unsigned)(w >> 32)); } else { mt[t] = 0.f; m2[t] = 0.f; } ms += mt[t]; }
            const float mean = ms / (float)ntn; float q = 0.f;
#pragma unroll
            for (int t = 0; t < 4; ++t) if (t < ntn) { const float dm = mt[t] - mean; q += m2[t] + 256.0f * dm * dm; }
            S[row] = (f32x2v){mean, 1.0f / sqrtf(q / (256.0f * (float)ntn) + eps)};
        }
        asm volatile("s_waitcnt lgkmcnt(0)" ::: "memory"); __builtin_amdgcn_s_barrier(); asm volatile("" ::: "memory");
        return bad;
    }
};
struct EpiLnRes {
    static constexpr bool PERM = false, AFTER_DRAIN = true;
    const float* base; float* out; int ldc; const float* bias; PanelStats st; unsigned poison;
    __device__ __forceinline__ void refuse(size_t i0, size_t stride, int M, int N) const { const float q = __builtin_nanf(""); for (size_t i = i0; i < (size_t)M * N; i += stride) out[(i / N) * ldc + i % N] = q;
        if (i0 == 0) { unsigned expect = 0u; __hip_atomic_compare_exchange_strong(st.tmo + 1, &expect, 0x7f0u, __ATOMIC_RELAXED, __ATOMIC_RELAXED, __HIP_MEMORY_SCOPE_AGENT); __hip_atomic_store(st.tmo, 1u, __ATOMIC_RELAXED, __HIP_MEMORY_SCOPE_AGENT); } }
    __device__ __forceinline__ void fused(f32x4 (&acc)[2][2][4][2], const Unit& u, int wr, int wc, int fr, int fq, PG8_LAS unsigned char* lds, int wid, int lane) const {
        typedef float f32x2v __attribute__((ext_vector_type(2)));
        const PG8_LAS f32x2v* S = (const PG8_LAS f32x2v*)(lds + 8192);
        const int col0 = u.pn * BM + wc * 32 + 4 * fq;
#pragma unroll
        for (int bj = 0; bj < 2; ++bj)
#pragma unroll
            for (int n = 0; n < 2; ++n) { const f32x4 bv = bias ? *(const f32x4*)(bias + col0 + bj * HALF + n * 16) : (f32x4){0.f, 0.f, 0.f, 0.f};
#pragma unroll
                for (int ai = 0; ai < 2; ++ai)
#pragma unroll
                    for (int m = 0; m < 4; ++m) acc[ai][bj][m][n] += bv; }
        const bool bad = st.run(acc, u, wr, wc, fr, fq, lds, wid, lane) || poison != 0u;
        const float qnan = __builtin_nanf("");
#pragma unroll
        for (int ai = 0; ai < 2; ++ai)
#pragma unroll
            for (int m = 0; m < 4; ++m) { const int r = ai * HALF + wr * 64 + m * 16 + fr; const f32x2v sr = S[r]; const size_t off = (size_t)(u.pm * BM + r) * ldc + col0;
#pragma unroll
                for (int bj = 0; bj < 2; ++bj)
#pragma unroll
                    for (int n = 0; n < 2; ++n) { const f32x4 bs = *(const f32x4*)(base + off + bj * HALF + n * 16); f32x4 o = bs + (acc[ai][bj][m][n] - sr.x) * sr.y;
                        if (bad) o = (f32x4){qnan, qnan, qnan, qnan}; *(f32x4*)(out + off + bj * HALF + n * 16) = o; }
                asm volatile("" ::: "memory"); }
    }
};
struct EpiLnResLn {
    static constexpr bool PERM = false, AFTER_DRAIN = true;
    const float* base; float* out; bf16_t* xn; int ldc; const float* bias; PanelStats st1, st2; unsigned poison;
    __device__ __forceinline__ void refuse(size_t i0, size_t stride, int M, int N) const { const float q = __builtin_nanf(""); for (size_t i = i0; i < (size_t)M * N; i += stride) { const size_t o = (i / N) * ldc + i % N; out[o] = q; xn[o] = (bf16_t)0x7fc0u; }
        if (i0 == 0) { unsigned expect = 0u; __hip_atomic_compare_exchange_strong(st1.tmo + 1, &expect, 0x7f0u, __ATOMIC_RELAXED, __ATOMIC_RELAXED, __HIP_MEMORY_SCOPE_AGENT); __hip_atomic_store(st1.tmo, 1u, __ATOMIC_RELAXED, __HIP_MEMORY_SCOPE_AGENT); } }
    __device__ __forceinline__ void fused(f32x4 (&acc)[2][2][4][2], const Unit& u, int wr, int wc, int fr, int fq, PG8_LAS unsigned char* lds, int wid, int lane) const {
        typedef float f32x2v __attribute__((ext_vector_type(2))); typedef unsigned u32x2v __attribute__((ext_vector_type(2)));
        const PG8_LAS f32x2v* S = (const PG8_LAS f32x2v*)(lds + 8192);
        const int col0 = u.pn * BM + wc * 32 + 4 * fq;
#pragma unroll
        for (int bj = 0; bj < 2; ++bj)
#pragma unroll
            for (int n = 0; n < 2; ++n) { const f32x4 bv = bias ? *(const f32x4*)(bias + col0 + bj * HALF + n * 16) : (f32x4){0.f, 0.f, 0.f, 0.f};
#pragma unroll
                for (int ai = 0; ai < 2; ++ai)
#pragma unroll
                    for (int m = 0; m < 4; ++m) acc[ai][bj][m][n] += bv; }
        bool bad = st1.run(acc, u, wr, wc, fr, fq, lds, wid, lane) || poison != 0u;
        const float qnan = __builtin_nanf("");
#pragma unroll
        for (int ai = 0; ai < 2; ++ai)
#pragma unroll
            for (int m = 0; m < 4; ++m) { const int r = ai * HALF + wr * 64 + m * 16 + fr; const f32x2v sr = S[r]; const size_t off = (size_t)(u.pm * BM + r) * ldc + col0;
#pragma unroll
                for (int bj = 0; bj < 2; ++bj)
#pragma unroll
                    for (int n = 0; n < 2; ++n) { const f32x4 bs = *(const f32x4*)(base + off + bj * HALF + n * 16); acc[ai][bj][m][n] = bs + (acc[ai][bj][m][n] - sr.x) * sr.y; }
                asm volatile("" : "+v"(acc[ai][0][m][0]), "+v"(acc[ai][0][m][1]), "+v"(acc[ai][1][m][0]), "+v"(acc[ai][1][m][1]));
                if (m & 1) asm volatile("" ::: "memory"); }
        const bool bad1 = bad;
        bad = st2.run(acc, u, wr, wc, fr, fq, lds, wid, lane) || bad;
#pragma unroll
        for (int ai = 0; ai < 2; ++ai)
#pragma unroll
            for (int m = 0; m < 4; ++m) { const int r = ai * HALF + wr * 64 + m * 16 + fr; const f32x2v sr = S[r]; const size_t off = (size_t)(u.pm * BM + r) * ldc + col0;
#pragma unroll
                for (int bj = 0; bj < 2; ++bj)
#pragma unroll
                    for (int n = 0; n < 2; ++n) { const f32x4 x1 = acc[ai][bj][m][n]; *(f32x4*)(out + off + bj * HALF + n * 16) = bad1 ? (f32x4){qnan, qnan, qnan, qnan} : x1;
                        const f32x4 o = (x1 - sr.x) * sr.y; u32x2v w; w.x = cvt_pk_bf16(o[0], o[1]); w.y = cvt_pk_bf16(o[2], o[3]);
                        if (bad) { w.x = 0x7fc07fc0u; w.y = 0x7fc07fc0u; } *(u32x2v*)(xn + off + bj * HALF + n * 16) = w; }
                asm volatile("" ::: "memory"); }
    }
};

template <class Epi, class Sched, bool STAMP = false>
__device__ __forceinline__ void gemm_phase(PG8_LAS unsigned char* lds, const Gemm g, const Sched& S, const Epi& E, unsigned long long* stamps, int tid_in) {
    int tid_ = tid_in; asm volatile("" : "+v"(tid_));
    const int tid = tid_, wid = __builtin_amdgcn_readfirstlane(tid >> 6), lane = tid & 63, wr = wid >> 2, wc = wid & 3, fr = lane & 15, fq = lane >> 4;
    const int K = g.K, nt = K / BK;
    int ts_lo = 0, ts_hi = 0, nts = 0; const unsigned long long rt_entry = STAMP ? (unsigned long long)wall_clock64() : 0ull;
#define PG8_STAMP() do { if (STAMP && wid == 0 && nts < 64) { const unsigned long long _c = (unsigned long long)clock64(); \
        ts_lo = (lane == nts) ? (int)(unsigned)_c : ts_lo; ts_hi = (lane == nts) ? (int)(unsigned)(_c >> 32) : ts_hi; ++nts; } } while (0)
    PG8_STAMP();
    unsigned voffA[2], voffB[2];
#pragma unroll
    for (int i = 0; i < 2; ++i) { int R, C; stage_rc(tid * 16 + i * 8192, R, C); const int Rb = Epi::PERM ? ((R & ~31) + perm32(R & 31)) : R;
        voffA[i] = (unsigned)(R * K + C) * 2u; voffB[i] = (unsigned)(Rb * K + C) * 2u; }
    const size_t kstep = (size_t)(BK * 2);
    const size_t hstep = (size_t)HALF * K * 2;
    const size_t tstep = 2 * hstep;
    const unsigned ldsw = (unsigned)wid * 1024u;
    const int aoff = lds_byte(wr * 64 + fr, fq * 8), boff = lds_byte(wc * 32 + fr, fq * 8);
#define PG8_SA(b, h) (((b) * 2 + (h)) * HTB)
#define PG8_SB(b, h) ((4 + (b) * 2 + (h)) * HTB)
#define PG8_STAGE(bufoff, gbase, voff) do { _Pragma("unroll") for (int _i = 0; _i < 2; ++_i) \
        __builtin_amdgcn_global_load_lds((const unsigned*)((const char*)(gbase) + (voff)[_i]), (PG8_LAS unsigned*)(lds + (bufoff) + ldsw + _i * 8192), 16, 0, 0); } while (0)
#define PG8_LDA(dst, b, h) do { _Pragma("unroll") for (int m = 0; m < 4; ++m) _Pragma("unroll") for (int k = 0; k < 2; ++k) dst[m][k] = *(const PG8_LAS bf16x8*)(lds + PG8_SA(b, h) + aoff + m * 2048 + k * 1024); } while (0)
#define PG8_LDB(dst, b, h) do { _Pragma("unroll") for (int n = 0; n < 2; ++n) _Pragma("unroll") for (int k = 0; k < 2; ++k) dst[n][k] = *(const PG8_LAS bf16x8*)(lds + PG8_SB(b, h) + boff + n * 2048 + k * 1024); } while (0)
#define PG8_MMA(ai, bj, At, Bt) do { __builtin_amdgcn_s_setprio(1); _Pragma("unroll") for (int m = 0; m < 4; ++m) _Pragma("unroll") for (int n = 0; n < 2; ++n) _Pragma("unroll") for (int k = 0; k < 2; ++k) \
        acc[ai][bj][m][n] = __builtin_amdgcn_mfma_f32_16x16x32_bf16(Bt[n][k], At[m][k], acc[ai][bj][m][n], 0, 0, 0); __builtin_amdgcn_s_setprio(0); } while (0)
#define PG8_WAIT_V(n) asm volatile("s_waitcnt vmcnt(" #n ")" ::: "memory")
#define PG8_WAIT_L(n) asm volatile("s_waitcnt lgkmcnt(" #n ")" ::: "memory")
#define PG8_BAR __builtin_amdgcn_s_barrier()
#define PG8_SCHED __builtin_amdgcn_sched_barrier(0)
    Unit cur, nxt; int ui = 0;
    if (!S.next(0, cur)) return;
    f32x4 acc[2][2][4][2];
#pragma unroll
    for (int a = 0; a < 2; ++a)
#pragma unroll
        for (int b = 0; b < 2; ++b)
#pragma unroll
            for (int m = 0; m < 4; ++m)
#pragma unroll
                for (int n = 0; n < 2; ++n) acc[a][b][m][n] = (f32x4){0.f, 0.f, 0.f, 0.f};
    bf16x8 At[4][2], B0[2][2], B1[2][2];
    const char* cA = (const char*)g.A + (size_t)cur.pm * tstep; const char* cB = (const char*)g.Bt + (size_t)cur.pn * tstep;
    S.a_ready(cur);
    PG8_STAGE(PG8_SB(0, 0), cB, voffB); PG8_STAGE(PG8_SA(0, 0), cA, voffA); PG8_STAGE(PG8_SB(0, 1), cB + hstep, voffB); PG8_STAGE(PG8_SA(0, 1), cA + hstep, voffA);
    if (wr == 1) PG8_BAR;
    PG8_WAIT_V(4); PG8_BAR;
    PG8_STAGE(PG8_SB(1, 0), cB + kstep, voffB); PG8_STAGE(PG8_SA(1, 0), cA + kstep, voffA); PG8_STAGE(PG8_SB(1, 1), cB + hstep + kstep, voffB);
    PG8_WAIT_V(6); PG8_BAR;
    PG8_STAMP();
    for (;;) {
        const bool has_next = S.next(ui + 1, nxt);
        const char* nA = has_next ? (const char*)g.A + (size_t)nxt.pm * tstep : cA; const char* nB = has_next ? (const char*)g.Bt + (size_t)nxt.pn * tstep : cB;
        for (int t = 0; t < nt; t += 2) {
            const bool last = (t == nt - 2);
            const char* a1 = cA + (size_t)(t + 1) * kstep;
            const char* a2 = last ? nA : cA + (size_t)(t + 2) * kstep; const char* b2 = last ? nB : cB + (size_t)(t + 2) * kstep;
            const char* a3 = a2 + kstep; const char* b3 = b2 + kstep;
            if (last && has_next) S.a_ready(nxt);
            PG8_LDB(B0, 0, 0); PG8_SCHED; PG8_LDA(At, 0, 0); PG8_STAGE(PG8_SA(1, 1), a1 + hstep, voffA);
            PG8_WAIT_L(8); PG8_BAR; PG8_WAIT_L(0); PG8_MMA(0, 0, At, B0); PG8_BAR; PG8_SCHED;
            PG8_LDB(B1, 0, 1); PG8_STAGE(PG8_SB(0, 0), b2, voffB);
            PG8_BAR; PG8_WAIT_L(0); PG8_MMA(0, 1, At, B1); PG8_BAR;
            PG8_LDA(At, 0, 1); PG8_STAGE(PG8_SA(0, 0), a2, voffA);
            PG8_BAR; PG8_WAIT_L(0); PG8_MMA(1, 0, At, B0); PG8_BAR; PG8_SCHED;
            PG8_STAGE(PG8_SB(0, 1), b2 + hstep, voffB);
            PG8_WAIT_V(6); PG8_BAR; PG8_MMA(1, 1, At, B1); PG8_BAR;
            PG8_LDB(B0, 1, 0); PG8_SCHED; PG8_LDA(At, 1, 0); PG8_STAGE(PG8_SA(0, 1), a2 + hstep, voffA);
            PG8_WAIT_L(8); PG8_BAR; PG8_WAIT_L(0); PG8_MMA(0, 0, At, B0); PG8_BAR; PG8_SCHED;
            PG8_LDB(B1, 1, 1); PG8_STAGE(PG8_SB(1, 0), b3, voffB);
            PG8_BAR; PG8_WAIT_L(0); PG8_MMA(0, 1, At, B1); PG8_BAR;
            PG8_LDA(At, 1, 1); PG8_STAGE(PG8_SA(1, 0), a3, voffA);
            PG8_BAR; PG8_WAIT_L(0); PG8_MMA(1, 0, At, B0); PG8_BAR; PG8_SCHED;
            PG8_STAGE(PG8_SB(1, 1), b3 + hstep, voffB);
            PG8_WAIT_V(6); PG8_BAR; PG8_MMA(1, 1, At, B1); PG8_BAR;
        }
        PG8_STAMP();
        if constexpr (!Epi::AFTER_DRAIN) { E(acc, cur, wr, wc, fr, fq); S.done(cur); }
        PG8_STAMP();
        if (!has_next) break;
#pragma unroll
        for (int a = 0; a < 2; ++a)
#pragma unroll
            for (int b = 0; b < 2; ++b)
#pragma unroll
                for (int m = 0; m < 4; ++m)
#pragma unroll
                    for (int n = 0; n < 2; ++n) acc[a][b][m][n] = (f32x4){0.f, 0.f, 0.f, 0.f};
        cur = nxt; cA = nA; cB = nB; ++ui;
    }
    PG8_WAIT_V(0);
    if (wr == 0) PG8_BAR;
    PG8_BAR;
    if constexpr (Epi::AFTER_DRAIN) { E.fused(acc, cur, wr, wc, fr, fq, lds, wid, lane); S.done(cur); }
    PG8_STAMP();
    if (STAMP && wid == 0) { stamps[lane] = lane < nts ? (((unsigned long long)(unsigned)ts_hi << 32) | (unsigned)ts_lo) : 0ull;
        if (lane == 62) stamps[62] = rt_entry; if (lane == 63) stamps[63] = (unsigned long long)wall_clock64(); }
#undef PG8_STAMP
#undef PG8_SA
#undef PG8_SB
#undef PG8_STAGE
#undef PG8_LDA
#undef PG8_LDB
#undef PG8_MMA
#undef PG8_WAIT_V
#undef PG8_WAIT_L
#undef PG8_BAR
#undef PG8_SCHED
}
}
#define XB_TMO      128
#define XB_XCNT(j)  (256  + 64 * (j))
#define XB_XSUB(j)  (1280 + 64 * (j))
#define XB_XGEN(j)  (2304 + 64 * (j))
#define XB_TOP      3328
#define XB_TOPGEN   3392
#define XCD_BAR_WORDS 3456
#define XB_SPIN_CAP (1u << 18)
#define LAS __attribute__((address_space(3)))

__device__ __forceinline__ unsigned xb_ld(unsigned* p)              { return __hip_atomic_load(p, __ATOMIC_RELAXED, __HIP_MEMORY_SCOPE_AGENT); }
__device__ __forceinline__ unsigned xb_add(unsigned* p, unsigned v) { return __hip_atomic_fetch_add(p, v, __ATOMIC_RELAXED, __HIP_MEMORY_SCOPE_AGENT); }
__device__ __forceinline__ unsigned xb_xcc_id() { return (unsigned)__builtin_amdgcn_s_getreg((3 << 11) | 20) & 0xFu; }
#define XB_SPIN(cond, bar) do { unsigned _sp = 0; while (cond) { __builtin_amdgcn_s_sleep(1); \
    if ((++_sp & 255u) == 0u) { if (xb_ld(&(bar)[XB_TMO])) break; if (_sp > XB_SPIN_CAP) { atomicAdd(&(bar)[XB_TMO], 1u); break; } } } } while (0)

struct XcdBarrier {
    unsigned* bar; unsigned x;
    volatile LAS unsigned* st;
};

__device__ __forceinline__ XcdBarrier xcd_barrier_post(unsigned* bar, volatile LAS unsigned* st) {
    XcdBarrier b; b.bar = bar; b.x = xb_xcc_id(); b.st = st;
    if (threadIdx.x == 0) (void)xb_add(&bar[XB_XCNT(b.x)], 1u);
    return b;
}
__device__ __forceinline__ void xcd_barrier_complete(unsigned* bar, unsigned x, unsigned& nloc, unsigned& nx) {
    const unsigned G = gridDim.x * gridDim.y * gridDim.z;
    unsigned sum, cnt, mine, sp = 0u;
    for (;;) {
        sum = 0u; cnt = 0u; mine = 0u;
#pragma unroll
        for (unsigned j = 0; j < 16; ++j) { const unsigned c = xb_ld(&bar[XB_XCNT(j)]); sum += c; cnt += (c > 0u) ? 1u : 0u; mine = (j == x) ? c : mine; }
        if (sum == G) break;
        __builtin_amdgcn_s_sleep(1);
        if ((++sp & 255u) == 0u) { if (xb_ld(&bar[XB_TMO])) break; if (sp > XB_SPIN_CAP) { atomicAdd(&bar[XB_TMO], 1u); break; } }
    }
    nloc = mine > 0u ? mine : 1u; nx = cnt > 0u ? cnt : 1u;
}

__device__ __forceinline__ void xcd_barrier(const XcdBarrier& b) {
    asm volatile("s_waitcnt vmcnt(0)" ::: "memory");
    __syncthreads();
    if (threadIdx.x == 0) {
        unsigned* bar = b.bar;
        __builtin_amdgcn_s_waitcnt(0);
        unsigned nloc = b.st[0], nx = b.st[1];
        if (nloc == 0u) { xcd_barrier_complete(bar, b.x, nloc, nx); b.st[0] = nloc; b.st[1] = nx; }
        const unsigned old = xb_add(&bar[XB_XSUB(b.x)], 1u);
        const unsigned gen = old / nloc;
        if (old + 1u == (gen + 1u) * nloc) {
            __builtin_amdgcn_fence(__ATOMIC_RELEASE, "agent");
            asm volatile("s_waitcnt vmcnt(0)" ::: "memory");
            const unsigned og = xb_add(&bar[XB_TOP], 1u);
            const unsigned tg = og / nx;
            if (og + 1u == (tg + 1u) * nx) xb_add(&bar[XB_TOPGEN], 1u);
            else XB_SPIN(xb_ld(&bar[XB_TOPGEN]) == tg, bar);
            __builtin_amdgcn_fence(__ATOMIC_ACQUIRE, "agent");
            xb_add(&bar[XB_XGEN(b.x)], 1u);
            asm volatile("s_waitcnt vmcnt(0)" ::: "memory");
        } else {
            XB_SPIN(xb_ld(&bar[XB_XGEN(b.x)]) == gen, bar);
            __builtin_amdgcn_fence(__ATOMIC_ACQUIRE, "agent");
            asm volatile("s_waitcnt vmcnt(0)" ::: "memory");
        }
    }
    __syncthreads();
}

namespace mk {
typedef unsigned short bf16_t;
typedef short bf16x8 __attribute__((ext_vector_type(8)));
typedef float f32x4 __attribute__((ext_vector_type(4)));
typedef unsigned u32x2 __attribute__((ext_vector_type(2)));
typedef unsigned u32x4 __attribute__((ext_vector_type(4)));
#define LDSP __attribute__((address_space(3)))

constexpr int D = 2048, NB = 4, SEQ = 4096, DEPTH = 4, CTX = 256, T = CTX + SEQ, MROWS = NB * T;
constexpr int NIN = 7728, NINP = 7936, NCH = T / 64;
constexpr int C_AQ = 0, C_AK = 512, C_AV = 1024, C_AZ = 1536, C_ABETA = 2048, C_ADEC = 2056,
              C_BQ = 2064, C_BK = 2320, C_BV = 2576, C_BR = 3088, C_BCODE = 3600,
              C_CQ = 3632, C_CI = 4144, C_CG = 4656, C_CF = 5168, C_DQ = 6192, C_DK = 6704, C_DV = 7216;
constexpr int NEXP = 16, EROWS = 2304;
constexpr float ALPHA = 1.681792830507429f;
constexpr float LN_EPS = 1e-5f, NORM_EPS = 1e-6f;
constexpr int NCC = NB * 4 * 2 * NCH;

enum { I_X = 0, I_C, I_CTX, I_CCTX, I_WMOD, I_BMOD, I_WIN, I_WOUT, I_LNG, I_LNB, I_CONV, I_ALOG, I_DTB, I_GDNN, I_GLAW, I_GLAB, I_GLAN, I_HGAM, I_HGN, I_RPB, I_ROUT, I_W1, I_W3, I_W2 };

constexpr size_t WS_BAR = 0;
constexpr size_t WS_MODV = 16384;
constexpr size_t WS_AFF = WS_MODV + 983040;
constexpr size_t WS_INV = WS_AFF + 1114112;
constexpr size_t WS_IDX = WS_INV + 1114112;
constexpr size_t WS_GATE = WS_IDX + 147456;
constexpr size_t WS_WIN = WS_GATE + 147456;
constexpr size_t WS_WOUT = WS_WIN + 32505856;
constexpr size_t WS_W13 = WS_WOUT + 8388608;
constexpr size_t WS_W2 = WS_W13 + 134217728;
constexpr size_t WSET_BYTES = 32505856 + 8388608 + 134217728 + 67108864;
constexpr size_t WS_X = WS_W2 + 67108864 + WSET_BYTES;
constexpr size_t WS_X1 = WS_X + 142606336;
constexpr size_t WS_U = WS_X1 + 142606336;
constexpr size_t WS_MIX = WS_U + 71303168;
constexpr size_t WS_RA = WS_MIX + 71303168;
constexpr size_t RA_PROJ = 0;
constexpr size_t RA_GM = RA_PROJ + 276299776;
constexpr size_t RA_GB = RA_GM + 71303168;
constexpr size_t RA_GQ = RA_GB + 71303168;
constexpr size_t RA_GO = RA_GQ + 35651584;
constexpr size_t RA_HB = RA_GO + 35651584;
constexpr size_t RA_HQ = RA_HB + 71303168;
constexpr size_t RA_HO = RA_HQ + 35651584;
constexpr size_t RA_HA = RA_HO + 35651584;
constexpr size_t RA_LB = RA_HA + 1114112;
constexpr size_t RA_LQ = RA_LB + 35651584;
constexpr size_t RA_LO = RA_LQ + 17825792;
constexpr size_t RA_LA = RA_LO + 35651584;
constexpr size_t RA_OB = RA_LA + 557056;
constexpr size_t RA_END = RA_OB + 106954752;
constexpr size_t RA_TBUF = 0;
constexpr size_t RA_XS = 142606336;
constexpr size_t RA_HID = RA_XS + 150994944;
constexpr size_t RA_YS = RA_HID + 75497472;
constexpr size_t WS_TOTAL = WS_RA + RA_END;
static_assert(RA_YS + 150994944 <= RA_END, "region A");

struct Ctx {
    const float* in[24]; float* out; unsigned char* ws;
    LDSP unsigned char* lds; int tid, lane, wave, G, bid;
};

__device__ __forceinline__ float bf2f(unsigned b) { return __uint_as_float(b << 16); }
__device__ __forceinline__ float bflo(unsigned u) { return __uint_as_float(u << 16); }
__device__ __forceinline__ float bfhi(unsigned u) { return __uint_as_float(u & 0xffff0000u); }
__device__ __forceinline__ unsigned pk2(float lo, float hi) { return pg8::cvt_pk_bf16(lo, hi); }
__device__ __forceinline__ bf16_t f2bf(float x) { return (bf16_t)(pk2(x, 0.f) & 0xffffu); }
__device__ __forceinline__ float sigmoidf_(float x) { return __builtin_amdgcn_rcpf(1.f + __builtin_amdgcn_exp2f(-1.4426950408889634f * x)); }
__device__ __forceinline__ float siluf_(float x) { return x * __builtin_amdgcn_rcpf(1.f + __builtin_amdgcn_exp2f(-1.4426950408889634f * x)); }
__device__ __forceinline__ float softplusf_(float x) { return x > 20.f ? x : log1pf(__expf(x)); }
__device__ __forceinline__ float wsum(float v) {
#pragma unroll
    for (int m = 32; m >= 1; m >>= 1) v += __shfl_xor(v, m);
    return v;
}

template <int KS>
__device__ __forceinline__ f32x4 mma_tile(const LDSP bf16_t* a, int lda, const LDSP bf16_t* b, int ldb, f32x4 acc, int lane) {
    const int r = lane & 15, q = lane >> 4;
#pragma unroll
    for (int kk = 0; kk < KS; ++kk) {
        const bf16x8 af = *(const LDSP bf16x8*)(a + r * lda + kk * 32 + q * 8);
        const bf16x8 bf = *(const LDSP bf16x8*)(b + r * ldb + kk * 32 + q * 8);
        acc = __builtin_amdgcn_mfma_f32_16x16x32_bf16(af, bf, acc, 0, 0, 0);
    }
    return acc;
}
typedef short s16x4 __attribute__((ext_vector_type(4)));
__device__ __forceinline__ bf16x8 frag_tr16(const LDSP bf16_t* base, int ld, int lane) {
    const int g = lane >> 4, i = lane & 15;
    const LDSP bf16_t* p = base + (8 * g + (i >> 2)) * ld + 4 * (i & 3);
    const s16x4 lo = __builtin_amdgcn_ds_read_tr16_b64_v4i16((LDSP s16x4*)p);
    const s16x4 hi = __builtin_amdgcn_ds_read_tr16_b64_v4i16((LDSP s16x4*)(p + 4 * ld));
    return (bf16x8){lo[0], lo[1], lo[2], lo[3], hi[0], hi[1], hi[2], hi[3]};
}
__device__ __forceinline__ u32x2 pack4(f32x4 v) { u32x2 o; o.x = pk2(v[0], v[1]); o.y = pk2(v[2], v[3]); return o; }

__device__ __forceinline__ int tok_of(int n, int dir, int i) { return n * 64 + (dir ? 63 - i : i); }

__device__ __forceinline__ void modv_fill_s(const Ctx& c) {
    LDSP float* s = (LDSP float*)c.lds;
    for (int i = c.tid; i < 5 * 2048; i += 512) {
        const int r = i >> 11, k = i & 2047;
        const float v = r < 4 ? c.in[I_C][r * 2048 + k] : c.in[I_CCTX][k];
        s[i] = siluf_(v);
    }
    __syncthreads();
}
__device__ __forceinline__ void modv_unit(const Ctx& c, int unit) {
    const int l = unit / 48, cb = unit % 48;
    LDSP float* s = (LDSP float*)c.lds;
    LDSP float* red = s + 5 * 2048;
    const float* W = c.in[I_WMOD] + (size_t)l * 2048 * 12288 + cb * 256 + c.lane * 4;
    const int k0 = c.wave * 256;
    f32x4 acc[5];
#pragma unroll
    for (int r = 0; r < 5; ++r) acc[r] = (f32x4){0.f, 0.f, 0.f, 0.f};
#pragma unroll 8
    for (int k = 0; k < 256; ++k) {
        const f32x4 w = *(const f32x4*)(W + (size_t)(k0 + k) * 12288);
#pragma unroll
        for (int r = 0; r < 5; ++r) { const float sv = s[r * 2048 + k0 + k]; acc[r] += w * sv; }
    }
#pragma unroll
    for (int r = 0; r < 5; ++r) *(LDSP f32x4*)(red + (c.wave * 5 + r) * 256 + c.lane * 4) = acc[r];
    __syncthreads();
    float* modv = (float*)(c.ws + WS_MODV);
    for (int o = c.tid; o < 5 * 256; o += 512) {
        const int r = o >> 8, col = o & 255;
        float sum = 0.f;
#pragma unroll
        for (int w = 0; w < 8; ++w) sum += red[(w * 5 + r) * 256 + col];
        modv[(size_t)(l * 5 + r) * 12288 + cb * 256 + col] = sum + c.in[I_BMOD][l * 12288 + cb * 256 + col];
    }
    __syncthreads();
}

struct CJob { const float* src; bf16_t* dst; int ldsrc, lddst, nvalid; };
constexpr int CONV_JOBS = 992 + 256 + 3 * 2048;
__device__ __forceinline__ CJob conv_desc(const Ctx& c, int l, int job) {
    CJob d;
    if (job < 992) {
        const int kt = job & 15, nt = job >> 4;
        d.src = c.in[I_WIN] + (size_t)l * 2048 * NIN + (size_t)kt * 128 * NIN + nt * 128; d.ldsrc = NIN; d.nvalid = NIN - nt * 128;
        d.dst = (bf16_t*)(c.ws + WS_WIN + (l & 1) * WSET_BYTES) + (size_t)nt * 128 * 2048 + kt * 128; d.lddst = 2048;
    } else if (job < 1248) {
        const int j = job - 992, kt = j & 15, nt = j >> 4;
        d.src = c.in[I_WOUT] + (size_t)l * 2048 * 2048 + (size_t)kt * 128 * 2048 + nt * 128; d.ldsrc = 2048; d.nvalid = 128;
        d.dst = (bf16_t*)(c.ws + WS_WOUT + (l & 1) * WSET_BYTES) + (size_t)nt * 128 * 2048 + kt * 128; d.lddst = 2048;
    } else if (job < 1248 + 4096) {
        const int j = job - 1248, which = j >> 11, jj = j & 2047, e = jj >> 7, rem = jj & 127, kt = rem & 15, nt = rem >> 4;
        d.src = c.in[which ? I_W3 : I_W1] + ((size_t)(l * 16 + e) * 2048 + (size_t)kt * 128) * 1024 + nt * 128; d.ldsrc = 1024; d.nvalid = 128;
        d.dst = (bf16_t*)(c.ws + WS_W13 + (l & 1) * WSET_BYTES) + ((size_t)e * 2048 + nt * 256 + which * 128) * 2048 + kt * 128; d.lddst = 2048;
    } else {
        const int j = job - 1248 - 4096, e = j >> 7, rem = j & 127, kt = rem & 7, nt = rem >> 3;
        d.src = c.in[I_W2] + ((size_t)(l * 16 + e) * 1024 + (size_t)kt * 128) * 2048 + nt * 128; d.ldsrc = 2048; d.nvalid = 128;
        d.dst = (bf16_t*)(c.ws + WS_W2 + (l & 1) * WSET_BYTES) + ((size_t)e * 2048 + nt * 128) * 1024 + kt * 128; d.lddst = 1024;
    }
    return d;
}
__device__ __forceinline__ void conv_load(const CJob& d, int n4, int kr, f32x4 (&v)[8]) {
#pragma unroll
    for (int p = 0; p < 4; ++p)
#pragma unroll
        for (int hh = 0; hh < 2; ++hh) v[2 * p + hh] = (4 * n4 < d.nvalid) ? *(const f32x4*)(d.src + (size_t)(32 * p + 2 * kr + hh) * d.ldsrc + 4 * n4) : (f32x4){0.f, 0.f, 0.f, 0.f};
}
__device__ __forceinline__ void conv_tile(const Ctx& c, const CJob& d, LDSP unsigned* Tt, int n4, int kr, const f32x4 (&v)[8]) {
#pragma unroll
    for (int p = 0; p < 4; ++p)
#pragma unroll
        for (int i = 0; i < 4; ++i) Tt[(4 * n4 + i) * 65 + 16 * p + kr] = pk2(v[2 * p][i], v[2 * p + 1][i]);
    __syncthreads();
#pragma unroll
    for (int q = 0; q < 4; ++q) {
        const int id = q * 512 + c.tid, n = id >> 4, kq = id & 15;
        const u32x4 o = (u32x4){Tt[n * 65 + 4 * kq], Tt[n * 65 + 4 * kq + 1], Tt[n * 65 + 4 * kq + 2], Tt[n * 65 + 4 * kq + 3]};
        *(u32x4*)(d.dst + (size_t)n * d.lddst + kq * 8) = o;
    }
}
__device__ __forceinline__ void convert_phase(const Ctx& c, int l) {
    LDSP unsigned* Tb = (LDSP unsigned*)c.lds;
    const int n4 = c.tid & 31, kr = c.tid >> 5;
    const int G = c.G;
    int job = c.bid;
    if (job >= CONV_JOBS) return;
    CJob ja = conv_desc(c, l, job), jb = ja;
    f32x4 va[8], vb[8];
    conv_load(ja, n4, kr, va);
    if (job + G < CONV_JOBS) { jb = conv_desc(c, l, job + G); conv_load(jb, n4, kr, vb); }
    for (; job < CONV_JOBS; job += 2 * G) {
        conv_tile(c, ja, Tb, n4, kr, va);
        const CJob ja_done = ja;
        if (job + 2 * G < CONV_JOBS) { ja = conv_desc(c, l, job + 2 * G); conv_load(ja, n4, kr, va); }
        if (job + G < CONV_JOBS) {
            conv_tile(c, jb, Tb + 128 * 65, n4, kr, vb);
            if (job + 3 * G < CONV_JOBS) { jb = conv_desc(c, l, job + 3 * G); conv_load(jb, n4, kr, vb); }
        }
        (void)ja_done;
    }
    __syncthreads();
}

__device__ __forceinline__ void convert_queue(const Ctx& c, int l, int quota) {
    unsigned* qh = (unsigned*)(c.ws + WS_BAR) + 3900 + 16 * l;
    volatile LDSP unsigned* tk = (volatile LDSP unsigned*)(c.lds + 147456 - 64);
    LDSP unsigned* Tb = (LDSP unsigned*)c.lds;
    const int n4 = c.tid & 31, kr = c.tid >> 5;
    for (int it = 0; it < quota; ++it) {
        __syncthreads();
        if (c.tid == 0) tk[0] = __hip_atomic_fetch_add(qh, 1u, __ATOMIC_RELAXED, __HIP_MEMORY_SCOPE_AGENT);
        __syncthreads();
        const int job = (int)tk[0];
        if (job >= CONV_JOBS) break;
        const CJob d = conv_desc(c, l, job);
        f32x4 v[8];
        conv_load(d, n4, kr, v);
        conv_tile(c, d, Tb, n4, kr, v);
    }
    __syncthreads();
}

__device__ __forceinline__ void row_stats(const f32x4 (&v)[8], float& mu, float& rstd) {
    float s = 0.f;
#pragma unroll
    for (int j = 0; j < 8; ++j) s += v[j][0] + v[j][1] + v[j][2] + v[j][3];
    mu = wsum(s) * (1.f / 2048.f);
    float q = 0.f;
#pragma unroll
    for (int j = 0; j < 8; ++j) { const f32x4 d = v[j] - mu; q += d[0] * d[0] + d[1] * d[1] + d[2] * d[2] + d[3] * d[3]; }
    rstd = rsqrtf(wsum(q) * (1.f / 2048.f) + LN_EPS);
}
__device__ __forceinline__ void modulate_store(const f32x4 (&v)[8], const float* shift, const float* scale, bf16_t* urow, int lane) {
    float mu, rstd; row_stats(v, mu, rstd);
#pragma unroll
    for (int j = 0; j < 8; ++j) {
        const int col = 256 * j + 4 * lane;
        const f32x4 sh = *(const f32x4*)(shift + col), sc = *(const f32x4*)(scale + col);
        const f32x4 y = (v[j] - mu) * rstd * (sc + 1.f) + sh;
        *(u32x2*)(urow + col) = pack4(y);
    }
}
__device__ __forceinline__ void phase_l0_modulate(const Ctx& c) {
    const float* modv = (const float*)(c.ws + WS_MODV);
    float* X = (float*)(c.ws + WS_X); bf16_t* U = (bf16_t*)(c.ws + WS_U);
    for (int row = c.bid * 8 + c.wave; row < MROWS; row += c.G * 8) {
        const int b = row / T, t = row % T;
        const float* src = t < CTX ? c.in[I_CTX] + ((size_t)b * CTX + t) * D : c.in[I_X] + ((size_t)b * SEQ + (t - CTX)) * D;
        const int r = t < CTX ? 4 : b;
        f32x4 v[8];
#pragma unroll
        for (int j = 0; j < 8; ++j) v[j] = *(const f32x4*)(src + 256 * j + 4 * c.lane);
#pragma unroll
        for (int j = 0; j < 8; ++j) *(f32x4*)(X + (size_t)row * D + 256 * j + 4 * c.lane) = v[j];
        modulate_store(v, modv + (size_t)(0 * 5 + r) * 12288, modv + (size_t)(0 * 5 + r) * 12288 + 2048, U + (size_t)row * D, c.lane);
    }
}

constexpr int GP_RAW = 0;
constexpr int GP_UT = 0;
constexpr int GP_WT = 18432;
constexpr int GP_A = 36864;
constexpr int GP_AP = 65;
constexpr int GP_TB = 53504;
constexpr int GP_CW = 53312;
constexpr int GP_Q = GP_CW + 7680;
constexpr int GP_K = GP_Q + 17408;
constexpr int GP_V = GP_K + 17408;
constexpr int GP_KDT = GP_V + 17408;
constexpr int GP_P = GP_KDT + 18432;
constexpr int GP_SM = GP_P + 9216;
constexpr int GP_END = GP_SM + 1024;
static_assert(GP_END <= 160 * 1024, "gdn prep lds");

#ifdef MK_GSTAMP
#define GST(k) do { if (c.bid == 0 && tid == 0) { const unsigned long long t_ = __builtin_amdgcn_s_memrealtime(); gst[k] += t_ - gst[8]; gst[8] = t_; } } while (0)
#else
#define GST(k)
#endif
__device__ __forceinline__ void gdn_prep_unit(const Ctx& c, int l, int cc) {
    const int n = cc % NCH, dir = (cc / NCH) & 1, h = (cc / (NCH * 2)) & 3, b = cc / (NCH * 8);
    int tid_ = c.tid; asm volatile("" : "+v"(tid_));
    const int tid = tid_, lane = tid_ & 63, wave = c.wave;
    LDSP unsigned char* L = c.lds;
    LDSP bf16_t* raw = (LDSP bf16_t*)(L + GP_RAW);
    LDSP float* cw = (LDSP float*)(L + GP_CW);
    LDSP bf16_t* Qs = (LDSP bf16_t*)(L + GP_Q);
    LDSP bf16_t* Ks = (LDSP bf16_t*)(L + GP_K);
    LDSP bf16_t* Vs = (LDSP bf16_t*)(L + GP_V);
    LDSP bf16_t* KdT = (LDSP bf16_t*)(L + GP_KDT);
    LDSP bf16_t* Pm = (LDSP bf16_t*)(L + GP_P);
    LDSP bf16_t* UT = (LDSP bf16_t*)(L + GP_UT);
    LDSP bf16_t* WT = (LDSP bf16_t*)(L + GP_WT);
    LDSP float* Am = (LDSP float*)(L + GP_A);
    LDSP float* sm = (LDSP float*)(L + GP_SM);
    const bf16_t* proj = (const bf16_t*)(c.ws + WS_RA + RA_PROJ);
    const int seg0 = n < 4 ? 0 : CTX, seg1 = n < 4 ? CTX : T;
    const size_t rowb = (size_t)b * T;
#ifdef MK_GSTAMP
    volatile LDSP unsigned long long* gst = (volatile LDSP unsigned long long*)(c.lds + 147456 - 48 - 80);
    if (c.bid == 0 && tid == 0) gst[8] = __builtin_amdgcn_s_memrealtime();
#endif

    for (int ch = tid; ch < 68 * 48; ch += 512) {
        const int rr = ch / 48, c16 = ch % 48, part = c16 >> 4, d8 = c16 & 15;
        const int t = n * 64 - 2 + rr;
        u32x4 v = (u32x4){0u, 0u, 0u, 0u};
        if (t >= seg0 && t < seg1) v = *(const u32x4*)(proj + (rowb + t) * NINP + part * 512 + h * 128 + d8 * 8);
        *(LDSP u32x4*)(raw + rr * 392 + part * 128 + d8 * 8) = v;
    }
    for (int i = tid; i < 5 * 384; i += 512) {
        const int j = i / 384, cidx = i % 384, part = cidx >> 7, d = cidx & 127;
        cw[i] = c.in[I_CONV][(size_t)(l * 5 + j) * 1536 + part * 512 + h * 128 + d];
    }
    if (wave == 0) {
        const int t = tok_of(n, dir, lane);
        const bf16_t* pr = proj + (rowb + t) * NINP;
        const float beta = sigmoidf_(bf2f(pr[C_ABETA + dir * 4 + h]));
        const float la = -__expf(c.in[I_ALOG][l * 8 + dir * 4 + h]) * softplusf_(bf2f(pr[C_ADEC + dir * 4 + h]) + c.in[I_DTB][l * 8 + dir * 4 + h]);
        float g = la;
#pragma unroll
        for (int m = 1; m < 64; m <<= 1) { const float o = __shfl_up(g, m); if (lane >= m) g += o; }
        const float gend = __shfl(g, 63);
        sm[lane] = g; sm[64 + lane] = beta; sm[128 + lane] = __expf(g); sm[192 + lane] = __expf(gend - g);
    }
    __syncthreads();
    GST(0);
    {
        const int i = tid >> 3, gq = tid & 7;
        const int rc = (dir ? 63 - i : i) + 2;
#pragma unroll
        for (int part = 0; part < 3; ++part) {
            float a[16];
#pragma unroll
            for (int e = 0; e < 16; ++e) a[e] = 0.f;
#pragma unroll
            for (int j = 0; j < 5; ++j) {
                const LDSP bf16_t* rp = raw + (rc - 2 + j) * 392 + part * 128 + gq * 16;
                const LDSP float* wp = cw + j * 384 + part * 128 + gq * 16;
#pragma unroll
                for (int hf = 0; hf < 2; ++hf) {
                    const u32x4 r4 = *(const LDSP u32x4*)(rp + hf * 8);
                    const f32x4 w0 = *(const LDSP f32x4*)(wp + hf * 8), w1 = *(const LDSP f32x4*)(wp + hf * 8 + 4);
                    a[hf * 8 + 0] += bflo(r4[0]) * w0[0]; a[hf * 8 + 1] += bfhi(r4[0]) * w0[1]; a[hf * 8 + 2] += bflo(r4[1]) * w0[2]; a[hf * 8 + 3] += bfhi(r4[1]) * w0[3];
                    a[hf * 8 + 4] += bflo(r4[2]) * w1[0]; a[hf * 8 + 5] += bfhi(r4[2]) * w1[1]; a[hf * 8 + 6] += bflo(r4[3]) * w1[2]; a[hf * 8 + 7] += bfhi(r4[3]) * w1[3];
                }
            }
            float ss = 0.f;
#pragma unroll
            for (int e = 0; e < 16; ++e) { a[e] = siluf_(a[e]); ss += a[e] * a[e]; }
            float sc = 1.f;
            if (part < 2) {
#pragma unroll
                for (int m = 1; m < 8; m <<= 1) ss += __shfl_xor(ss, m);
                sc = rsqrtf(ss + NORM_EPS) * (part == 0 ? 0.08838834764831845f : 1.f);
            }
            LDSP bf16_t* dq = (part == 0 ? Qs : part == 1 ? Ks : Vs) + i * 136 + gq * 16;
            *(LDSP u32x4*)dq = (u32x4){pk2(a[0] * sc, a[1] * sc), pk2(a[2] * sc, a[3] * sc), pk2(a[4] * sc, a[5] * sc), pk2(a[6] * sc, a[7] * sc)};
            *(LDSP u32x4*)(dq + 8) = (u32x4){pk2(a[8] * sc, a[9] * sc), pk2(a[10] * sc, a[11] * sc), pk2(a[12] * sc, a[13] * sc), pk2(a[14] * sc, a[15] * sc)};
            asm volatile("" ::: "memory");
        }
    }
    __syncthreads();
    GST(1);
#pragma unroll
    for (int p = 0; p < 2; ++p) {
        const int id = p * 512 + tid, d = id & 127, i0 = (id >> 7) * 8;
        unsigned w[4];
#pragma unroll
        for (int e = 0; e < 8; e += 2) w[e >> 1] = pk2(bf2f(Ks[(i0 + e) * 136 + d]) * sm[192 + i0 + e], bf2f(Ks[(i0 + e + 1) * 136 + d]) * sm[192 + i0 + e + 1]);
        *(LDSP u32x4*)(KdT + d * 72 + i0) = (u32x4){w[0], w[1], w[2], w[3]};
    }
#pragma unroll
    for (int tt = 0; tt < 4; ++tt) {
        const int id = wave * 4 + tt, which = id >> 4, ti = (id & 15) >> 2, tj = id & 3;
        const int r = lane & 15, q4 = lane >> 4;
        if (which == 0) {
            if (tj <= ti) {
                f32x4 a = mma_tile<4>(Ks + ti * 16 * 136, 136, Ks + tj * 16 * 136, 136, (f32x4){0.f, 0.f, 0.f, 0.f}, lane);
                const int j = tj * 16 + r; const float gj = sm[j];
#pragma unroll
                for (int e = 0; e < 4; ++e) { const int i = ti * 16 + q4 * 4 + e; Am[i * GP_AP + j] = (i > j) ? sm[64 + i] * a[e] * __expf(sm[i] - gj) : 0.f; }
            }
        } else {
            f32x4 o = (f32x4){0.f, 0.f, 0.f, 0.f};
            if (tj <= ti) {
                const f32x4 a = mma_tile<4>(Ks + tj * 16 * 136, 136, Qs + ti * 16 * 136, 136, (f32x4){0.f, 0.f, 0.f, 0.f}, lane);
                const int i = ti * 16 + r; const float gi = sm[i];
#pragma unroll
                for (int e = 0; e < 4; ++e) { const int j = tj * 16 + q4 * 4 + e; o[e] = (i >= j) ? a[e] * __expf(gi - sm[j]) : 0.f; }
            }
            *(LDSP u32x2*)(Pm + (ti * 16 + r) * 72 + tj * 16 + q4 * 4) = pack4(o);
        }
    }
    __syncthreads();
    GST(2);
    {
        LDSP float* TB = (LDSP float*)(L + GP_TB);
        const int r = lane & 15, q4 = lane >> 4;
        if (wave == 0) {
            const int I = lane >> 4, cidx = lane & 15;
            float x[16];
#pragma unroll
            for (int i = 0; i < 16; ++i) {
                float v = (i == cidx) ? 1.f : 0.f;
#pragma unroll
                for (int j = 0; j < i; ++j) v -= Am[(16 * I + i) * GP_AP + 16 * I + j] * x[j];
                x[i] = v;
            }
#pragma unroll
            for (int i = 0; i < 16; ++i) TB[(I * 16 + i) * 16 + cidx] = x[i];
        }
        f32x4 acc[4][2];
        const LDSP bf16_t* src = wave < 4 ? Vs : Ks;
        const int cb = (wave & 3) * 32;
#pragma unroll
        for (int I = 0; I < 4; ++I)
#pragma unroll
            for (int t = 0; t < 2; ++t)
#pragma unroll
                for (int e = 0; e < 4; ++e) {
                    const int row = 16 * I + 4 * q4 + e;
                    acc[I][t][e] = sm[64 + row] * bf2f(src[row * 136 + cb + 16 * t + r]) * (wave < 4 ? 1.f : sm[128 + row]);
                }
        __syncthreads();
        LDSP bf16_t* dstp = wave < 4 ? UT : WT;
#pragma unroll
        for (int I = 0; I < 4; ++I) {
            f32x4 x[2] = {(f32x4){0.f, 0.f, 0.f, 0.f}, (f32x4){0.f, 0.f, 0.f, 0.f}};
#pragma unroll
            for (int s4 = 0; s4 < 4; ++s4) {
                const float a = TB[(I * 16 + r) * 16 + 4 * q4 + s4];
#pragma unroll
                for (int t = 0; t < 2; ++t) x[t] = __builtin_amdgcn_mfma_f32_16x16x4f32(a, acc[I][t][s4], x[t], 0, 0, 0);
            }
#pragma unroll
            for (int Ip = I + 1; Ip < 4; ++Ip)
#pragma unroll
                for (int s4 = 0; s4 < 4; ++s4) {
                    const float a = -Am[(16 * Ip + r) * GP_AP + 16 * I + 4 * q4 + s4];
#pragma unroll
                    for (int t = 0; t < 2; ++t) acc[Ip][t] = __builtin_amdgcn_mfma_f32_16x16x4f32(a, x[t][s4], acc[Ip][t], 0, 0, 0);
                }
#pragma unroll
            for (int t = 0; t < 2; ++t) *(LDSP u32x2*)(dstp + (cb + 16 * t + r) * 72 + 16 * I + 4 * q4) = pack4(x[t]);
        }
    }
    __syncthreads();
    GST(3);
    {
        const size_t cs = (size_t)n * 32 + cc / NCH;
        bf16_t* Mg = (bf16_t*)(c.ws + WS_RA + RA_GM) + cs * 16384;
        bf16_t* Bg = (bf16_t*)(c.ws + WS_RA + RA_GB) + cs * 16384;
        bf16_t* Qg = (bf16_t*)(c.ws + WS_RA + RA_GQ) + cs * 8192;
        bf16_t* Og = (bf16_t*)(c.ws + WS_RA + RA_GO) + cs * 8192;
        const float ge = sm[128 + 63];
        const int r = lane & 15, q4 = lane >> 4;
        const f32x4 z = (f32x4){0.f, 0.f, 0.f, 0.f};
        for (int id = wave; id < 192; id += 8) {
            if (id < 32) {
                const int td = id >> 2, ti = id & 3;
                const f32x4 a = mma_tile<2>(WT + td * 16 * 72, 72, Pm + ti * 16 * 72, 72, z, lane);
                const int i = ti * 16 + r, d0 = td * 16 + q4 * 4; const float egi = sm[128 + i];
                f32x4 o;
#pragma unroll
                for (int e = 0; e < 4; ++e) o[e] = bf2f(Qs[i * 136 + d0 + e]) * egi - a[e];
                *(u32x2*)(Qg + (((ti * 4 + (td >> 1)) * 4 + ((2 * td + (q4 >> 1)) & 3)) * 16 + r) * 8 + 4 * (q4 & 1)) = pack4(o);
            } else if (id < 64) {
                const int td = (id - 32) >> 2, ti = id & 3;
                const f32x4 a = mma_tile<2>(UT + td * 16 * 72, 72, Pm + ti * 16 * 72, 72, z, lane);
                *(u32x2*)(Og + ((ti * 8 + td) * 64 + lane) * 4) = pack4(a);
            } else if (id < 128) {
                const int tc = (id - 64) >> 3, tr = id & 7;
                const f32x4 a = mma_tile<2>(WT + tc * 16 * 72, 72, KdT + tr * 16 * 72, 72, z, lane);
                const int dk = tr * 16 + r, d0 = tc * 16 + q4 * 4;
                f32x4 o;
#pragma unroll
                for (int e = 0; e < 4; ++e) o[e] = ((dk == d0 + e) ? ge : 0.f) - a[e];
                *(u32x2*)(Mg + (((tr * 4 + (tc >> 1)) * 4 + ((2 * tc + (q4 >> 1)) & 3)) * 16 + r) * 8 + 4 * (q4 & 1)) = pack4(o);
            } else {
                const int tr = (id - 128) >> 3, tc = id & 7;
                const f32x4 a = mma_tile<2>(KdT + tr * 16 * 72, 72, UT + tc * 16 * 72, 72, z, lane);
                *(u32x2*)(Bg + ((tc * 8 + tr) * 64 + lane) * 4) = pack4(a);
            }
        }
    }
    __syncthreads();
    GST(4);
}

constexpr int DP_QS = 0;
constexpr int DP_KSELF = 17408;
constexpr int DP_KSC = 34816;
constexpr int DP_KDT = 60928;
constexpr int DP_VT = 79360;
constexpr int DP_P = 97792;
constexpr int DP_TOT = 107008;
constexpr int DP_CODE = 111104;
constexpr int DP_QG = 115200;
constexpr int DP_END = 132608;

template <int MIX>
__device__ __forceinline__ void diag_prep_unit(const Ctx& c, int l, int cc) {
    constexpr int DK = (MIX == 1) ? 128 : 64;
    constexpr int PQ = DK + 8;
    const int n = cc % NCH, dir = (cc / NCH) & 1, h = (cc / (NCH * 2)) & 3, b = cc / (NCH * 8);
    const int tid = c.tid, lane = c.lane, wave = c.wave;
    LDSP unsigned char* L = c.lds;
    LDSP bf16_t* Qs = (LDSP bf16_t*)(L + DP_QS);
    LDSP bf16_t* Kself = (LDSP bf16_t*)(L + DP_KSELF);
    LDSP bf16_t* Ksc = (LDSP bf16_t*)(L + DP_KSC);
    LDSP bf16_t* KdT = (LDSP bf16_t*)(L + DP_KDT);
    LDSP bf16_t* VT = (LDSP bf16_t*)(L + DP_VT);
    LDSP bf16_t* Pm = (LDSP bf16_t*)(L + DP_P);
    LDSP float* tot = (LDSP float*)(L + DP_TOT);
    LDSP float* code = (LDSP float*)(L + DP_CODE);
    LDSP bf16_t* Qt = (LDSP bf16_t*)(L + DP_QG);
    const bf16_t* proj = (const bf16_t*)(c.ws + WS_RA + RA_PROJ);
    const size_t rowb = (size_t)b * T;
    bf16_t* Bg; bf16_t* Qg; bf16_t* Og; float* Ag;
    const size_t cs = (size_t)n * 32 + cc / NCH;
    if (MIX == 1) { Bg = (bf16_t*)(c.ws + WS_RA + RA_HB) + cs * 16384; Qg = (bf16_t*)(c.ws + WS_RA + RA_HQ) + cs * 8192;
                    Og = (bf16_t*)(c.ws + WS_RA + RA_HO) + cs * 8192; Ag = (float*)(c.ws + WS_RA + RA_HA) + cs * 128; }
    else          { Bg = (bf16_t*)(c.ws + WS_RA + RA_LB) + cs * 8192; Qg = (bf16_t*)(c.ws + WS_RA + RA_LQ) + cs * 4096;
                    Og = (bf16_t*)(c.ws + WS_RA + RA_LO) + cs * 8192; Ag = (float*)(c.ws + WS_RA + RA_LA) + cs * 64; }

    {
        constexpr int CPR = DK / 8;
        const int vcol = (MIX == 1 ? C_CI : C_BV) + h * 128;
        const int qcol = (MIX == 1 ? C_CQ + h * 128 : C_BQ + h * 64), kcol = (MIX == 1 ? C_CF + dir * 512 + h * 128 : C_BK + h * 64);
#pragma unroll
        for (int p = 0; p < 2; ++p) {
            const int id = p * 512 + tid, i = id >> 4, c8 = id & 15;
            *(LDSP u32x4*)(VT + i * 136 + c8 * 8) = *(const u32x4*)(proj + (rowb + tok_of(n, dir, i)) * NINP + vcol + c8 * 8);
        }
#pragma unroll
        for (int p = 0; p < (64 * CPR) / 512; ++p) {
            const int id = p * 512 + tid, i = id / CPR, c8 = id % CPR;
            const bf16_t* pr = proj + (rowb + tok_of(n, dir, i)) * NINP;
            *(LDSP u32x4*)(Qs + i * PQ + c8 * 8) = *(const u32x4*)(pr + qcol + c8 * 8);
            *(LDSP u32x4*)(Kself + i * PQ + c8 * 8) = *(const u32x4*)(pr + kcol + c8 * 8);
        }
        if (MIX == 2) for (int i = tid; i < 64 * 16; i += 512) code[i] = bf2f(proj[(rowb + tok_of(n, dir, i >> 4)) * NINP + C_BCODE + dir * 16 + (i & 15)]);
        for (int i = tid; i < 64 * 36; i += 512) ((LDSP unsigned*)Pm)[i] = 0u;
    }
    __syncthreads();
    constexpr int TPT = DK / 8, NSUB = 64 / TPT;
    const int d = tid % DK, J = tid / DK, I = (J * TPT) >> 4;
    float qv[TPT], kv[TPT], bl[TPT];
    {
        float lb = 0.f, wg[16], bg = 0.f;
        if (MIX == 1) {
            const float* gam = c.in[I_HGAM] + (size_t)dir * DEPTH * 512 + h * 128 + d;
            float mx = gam[0];
#pragma unroll
            for (int i = 1; i < DEPTH; ++i) mx = fmaxf(mx, gam[i * 512]);
            float den = 0.f, num = 0.f;
#pragma unroll
            for (int i = 0; i < DEPTH; ++i) { const float e = __expf(gam[i * 512] - mx); den += e; if (i >= 1 && i <= l) num += e; }
            lb = num / den;
        } else {
#pragma unroll
            for (int r = 0; r < 16; ++r) wg[r] = c.in[I_GLAW][((size_t)(l * 2 + dir) * 16 + r) * 256 + h * 64 + d];
            bg = c.in[I_GLAB][(l * 2 + dir) * 256 + h * 64 + d];
        }
        float run = 0.f;
#pragma unroll
        for (int s = 0; s < TPT; ++s) {
            const int i = J * TPT + s, t = tok_of(n, dir, i);
            float la;
            if (MIX == 1) {
                qv[s] = bf2f(Qs[i * PQ + d]);
                const float f = lb + (1.f - lb) * sigmoidf_(bf2f(Kself[i * PQ + d]));
                la = __logf(f); kv[s] = 1.f - f;
            } else {
                float q0 = bf2f(Qs[i * PQ + d]) * 0.125f, k0 = bf2f(Kself[i * PQ + d]);
                if (n >= 4) {
                    const int pos = t - CTX, hf = d >> 5, idx = d & 31, fi = idx & 15;
                    const float p = (float)(hf ? (pos & 63) : (pos >> 6));
                    const float inv = __expf(-(float)fi * (9.210340371976184f / 16.f));
                    float ang = p * inv;
                    const float kk = rintf(ang * 0.15915494309189535f);
                    ang = fmaf(-kk, 6.2831855f, ang); ang = fmaf(-kk, -1.7484555e-7f, ang);
                    const float cs = __cosf(ang), sn = __sinf(ang);
                    const int dp = idx < 16 ? d + 16 : d - 16;
                    const float q1 = bf2f(Qs[i * PQ + dp]) * 0.125f, k1 = bf2f(Kself[i * PQ + dp]);
                    if (idx < 16) { q0 = q0 * cs - q1 * sn; k0 = k0 * cs - k1 * sn; }
                    else          { q0 = q1 * sn + q0 * cs; k0 = k1 * sn + k0 * cs; }
                }
                qv[s] = q0; kv[s] = k0;
                float gt = bg;
#pragma unroll
                for (int r = 0; r < 16; ++r) gt += code[i * 16 + r] * wg[r];
                la = -softplusf_(-gt) * (1.f / 16.f);
            }
            run += la; bl[s] = run;
        }
        tot[J * 128 + d] = run;
    }
    __syncthreads();
    {
        float pre = 0.f, bend = 0.f, hb = 0.f, tI[4] = {0.f, 0.f, 0.f, 0.f};
#pragma unroll
        for (int m = 0; m < NSUB; ++m) {
            const float tm = tot[m * 128 + d]; const int Im = (m * TPT) >> 4;
            bend += tm; tI[Im] += tm;
            if (Im < I) pre += tm; else if (Im == I && m < J) hb += tm;
        }
        unsigned kd[TPT / 2];
#pragma unroll
        for (int s = 0; s < TPT; ++s) {
            const int i = J * TPT + s, s16 = i & 15;
            const float b16 = hb + bl[s];
            Qs[i * PQ + d] = f2bf(qv[s] * __expf(b16));
            Kself[i * PQ + d] = f2bf(kv[s] * __expf(-b16));
            Qt[i * PQ + d] = f2bf(qv[s] * __expf(pre + b16));
            const float kdv = kv[s] * __expf(bend - pre - b16);
            if (s & 1) kd[s >> 1] = (kd[s >> 1] & 0xffffu) | ((unsigned)f2bf(kdv) << 16); else kd[s >> 1] = f2bf(kdv);
            float off = 0.f;
#pragma unroll
            for (int Ip = 1; Ip < 4; ++Ip) {
                if (Ip > I) { off += tI[Ip - 1]; Ksc[((Ip * (Ip - 1) / 2 + I) * 16 + s16) * PQ + d] = f2bf(kv[s] * __expf(off - b16)); }
            }
        }
#pragma unroll
        for (int w8 = 0; w8 < TPT / 8; ++w8)
            *(LDSP u32x4*)(KdT + d * 72 + J * TPT + w8 * 8) = (u32x4){kd[w8 * 4], kd[w8 * 4 + 1], kd[w8 * 4 + 2], kd[w8 * 4 + 3]};
        if (J == 0) Ag[d] = __expf(bend);
    }
    __syncthreads();
#pragma unroll
    for (int p = 0; p < (64 * DK / 8) / 512; ++p) {
        const int id = p * 512 + tid, fl = id & 63, fr = id >> 6;
        const int ott_ = fr / (DK / 32), kk_ = fr % (DK / 32);
        *(u32x4*)(Qg + (size_t)id * 8) = *(const LDSP u32x4*)(Qt + (ott_ * 16 + (fl & 15)) * PQ + kk_ * 32 + (fl >> 4) * 8);
    }
    for (int blk = wave; blk < 10; blk += 8) {
        int Ib, Jb;
        if (blk < 4) { Ib = blk; Jb = blk; } else { const int s = blk - 4; Ib = s < 1 ? 1 : (s < 3 ? 2 : 3); Jb = s - (Ib * (Ib - 1) / 2); }
        const LDSP bf16_t* kp = (Ib == Jb) ? Kself + Jb * 16 * PQ : Ksc + (Ib * (Ib - 1) / 2 + Jb) * 16 * PQ;
        const f32x4 a = mma_tile<DK / 32>(kp, PQ, Qs + Ib * 16 * PQ, PQ, (f32x4){0.f, 0.f, 0.f, 0.f}, lane);
        const int r = lane & 15, q4 = lane >> 4;
        f32x4 o;
#pragma unroll
        for (int e = 0; e < 4; ++e) o[e] = (Ib > Jb || r >= q4 * 4 + e) ? a[e] : 0.f;
        *(LDSP u32x2*)(Pm + (Ib * 16 + r) * 72 + Jb * 16 + q4 * 4) = pack4(o);
    }
    __syncthreads();
    {
        const int r = lane & 15, q4 = lane >> 4;
        const f32x4 z = (f32x4){0.f, 0.f, 0.f, 0.f};
        constexpr int NT2 = (DK / 16) * 8;
        for (int id = wave; id < 32 + NT2; id += 8) {
            if (id < 32) {
                const int td = id >> 2, ti = id & 3;
                f32x4 a = z;
#pragma unroll
                for (int kk = 0; kk < 2; ++kk)
                    a = __builtin_amdgcn_mfma_f32_16x16x32_bf16(frag_tr16(VT + kk * 32 * 136 + td * 16, 136, lane), *(const LDSP bf16x8*)(Pm + (ti * 16 + r) * 72 + kk * 32 + q4 * 8), a, 0, 0, 0);
                *(u32x2*)(Og + ((ti * 8 + td) * 64 + lane) * 4) = pack4(a);
            } else {
                const int j = id - 32, tk = j >> 3, tv = j & 7;
                f32x4 a = z;
#pragma unroll
                for (int kk = 0; kk < 2; ++kk)
                    a = __builtin_amdgcn_mfma_f32_16x16x32_bf16(*(const LDSP bf16x8*)(KdT + (tk * 16 + r) * 72 + kk * 32 + q4 * 8), frag_tr16(VT + kk * 32 * 136 + tv * 16, 136, lane), a, 0, 0, 0);
                *(u32x2*)(Bg + ((tv * (DK / 16) + tk) * 64 + lane) * 4) = pack4(a);
            }
        }
    }
    __syncthreads();
}

template <int MIX, int DVS, int RING>
__device__ __forceinline__ void scan_unit(const Ctx& c, int chain, int slice) {
    constexpr int DK = (MIX == 2) ? 64 : 128;
    constexpr int PS = DK + 8;
    constexpr int NDK = DK / 16, NG = 8 / NDK;
    constexpr int NS = (DVS / 16) / NG;
    constexpr int NO = (DVS / 16) / 2;
    constexpr int KS = DK / 32;
    const int lane = c.lane, wave = c.wave, r = lane & 15, q4 = lane >> 4;
    const int dir = chain & 1, h = (chain >> 1) & 3, b = chain >> 3;
    LDSP bf16_t* ST = (LDSP bf16_t*)c.lds;
    constexpr int PO = DVS + 8;
    LDSP bf16_t* OS = ST + DVS * PS;
    for (int i = c.tid; i < DVS * PS / 2; i += 512) ((LDSP unsigned*)ST)[i] = 0u;
    const int dkt = wave % NDK;
    const int dvt0 = (wave / NDK) * NS;
    const int ott = wave >> 1;
    const int odv0 = (wave & 1) * NO;
    const bf16_t* Mg = (const bf16_t*)(c.ws + WS_RA + RA_GM);
    const bf16_t* Bg = (const bf16_t*)(c.ws + WS_RA + (MIX == 0 ? RA_GB : MIX == 1 ? RA_HB : RA_LB));
    const bf16_t* Qg = (const bf16_t*)(c.ws + WS_RA + (MIX == 0 ? RA_GQ : MIX == 1 ? RA_HQ : RA_LQ));
    const bf16_t* Og = (const bf16_t*)(c.ws + WS_RA + (MIX == 0 ? RA_GO : MIX == 1 ? RA_HO : RA_LO));
    const float* Ag = (const float*)(c.ws + WS_RA + (MIX == 1 ? RA_HA : RA_LA));
    bf16_t* OB = (bf16_t*)(c.ws + WS_RA + RA_OB) + ((size_t)(MIX * 2 + dir) * MROWS) * 512;
    f32x4 S[NS];
#pragma unroll
    for (int t = 0; t < NS; ++t) S[t] = (f32x4){0.f, 0.f, 0.f, 0.f};
    struct Ld { bf16x8 mf[KS]; u32x2 bt[NS]; f32x4 ae; bf16x8 qf[KS]; u32x2 ot[NO]; };
    Ld ring[RING];
    auto load = [&](Ld& d, int s) {
        const int n = dir ? (s < 4 ? 3 - s : 71 - s) : s;
        const size_t cc = (size_t)n * 32 + chain;
        if (MIX == 0) {
#pragma unroll
            for (int kk = 0; kk < KS; ++kk) d.mf[kk] = *(const bf16x8*)(Mg + cc * 16384 + ((dkt * 4 + kk) * 64 + lane) * 8);
        } else {
            d.ae = *(const f32x4*)(Ag + cc * DK + dkt * 16 + q4 * 4);
        }
#pragma unroll
        for (int t = 0; t < NS; ++t) d.bt[t] = *(const u32x2*)(Bg + cc * (128 * DK) + (((slice * (DVS / 16) + dvt0 + t) * NDK + dkt) * 64 + lane) * 4);
#pragma unroll
        for (int kk = 0; kk < KS; ++kk) d.qf[kk] = *(const bf16x8*)(Qg + cc * (64 * DK) + ((ott * KS + kk) * 64 + lane) * 8);
#pragma unroll
        for (int t = 0; t < NO; ++t) d.ot[t] = *(const u32x2*)(Og + cc * 8192 + ((ott * 8 + slice * (DVS / 16) + odv0 + t) * 64 + lane) * 4);
    };
#pragma unroll
    for (int k = 0; k < RING; ++k) load(ring[k], k);
    __syncthreads();
    for (int s0 = 0; s0 < NCH; s0 += RING) {
#pragma unroll
      for (int k = 0; k < RING; ++k) {
        const int s = s0 + k;
        if (s >= NCH) break;
        Ld& cur = ring[k];
        const int n = dir ? (s < 4 ? 3 - s : 71 - s) : s;
#pragma unroll
        for (int t = 0; t < NO; ++t) {
            f32x4 a = (f32x4){bflo(cur.ot[t].x), bfhi(cur.ot[t].x), bflo(cur.ot[t].y), bfhi(cur.ot[t].y)};
#pragma unroll
            for (int kk = 0; kk < KS; ++kk) {
                const bf16x8 sf = *(const LDSP bf16x8*)(ST + ((odv0 + t) * 16 + r) * PS + kk * 32 + q4 * 8);
                a = __builtin_amdgcn_mfma_f32_16x16x32_bf16(sf, cur.qf[kk], a, 0, 0, 0);
            }
            *(LDSP u32x2*)(OS + (s & 1) * 64 * PO + (ott * 16 + r) * PO + (odv0 + t) * 16 + q4 * 4) = pack4(a);
        }
        f32x4 Sn[NS];
#pragma unroll
        for (int t = 0; t < NS; ++t) {
            const f32x4 bm = (f32x4){bflo(cur.bt[t].x), bfhi(cur.bt[t].x), bflo(cur.bt[t].y), bfhi(cur.bt[t].y)};
            if (MIX == 0) {
                f32x4 a = bm;
#pragma unroll
                for (int kk = 0; kk < KS; ++kk) {
                    const bf16x8 sf = *(const LDSP bf16x8*)(ST + ((dvt0 + t) * 16 + r) * PS + kk * 32 + q4 * 8);
                    a = __builtin_amdgcn_mfma_f32_16x16x32_bf16(cur.mf[kk], sf, a, 0, 0, 0);
                }
                Sn[t] = a;
            } else {
                Sn[t] = cur.ae * S[t] + bm;
            }
        }
        if (s + RING < NCH) load(cur, s + RING);
        __syncthreads();
#pragma unroll
        for (int t = 0; t < NS; ++t) { S[t] = Sn[t]; *(LDSP u32x2*)(ST + ((dvt0 + t) * 16 + r) * PS + dkt * 16 + q4 * 4) = pack4(Sn[t]); }
#pragma unroll
        for (int id = c.tid; id < 64 * (DVS / 8); id += 512) {
            const int i = id / (DVS / 8), ch = id % (DVS / 8);
            *(u32x4*)(OB + ((size_t)b * T + tok_of(n, dir, i)) * 512 + h * 128 + slice * DVS + ch * 8) = *(const LDSP u32x4*)(OS + (s & 1) * 64 * PO + i * PO + ch * 8);
        }
        __syncthreads();
      }
    }
}

constexpr int NA_Q = 0, NA_K = 17408, NA_VT = 34816, NA_P = 53248, NA_GRP = 62464;
constexpr int NA_RPB = 2 * NA_GRP;
__device__ __forceinline__ void na_pair(const Ctx& c, int l, int pair) {
    const int tid = c.tid, lane = c.lane, wave = c.wave, grp = wave >> 2, gw = wave & 3, gt = tid & 255;
    const int r = lane & 15, q4 = lane >> 4;
    const bool is_lat = pair < 512;
    int b, h, gr = 0, qb = 0;
    if (is_lat) { const int u = pair * 2 + grp; b = u >> 8; h = (u >> 6) & 3; gr = u & 63; }
    else { const int u = (pair - 512) * 2 + grp; b = u >> 4; h = (u >> 2) & 3; qb = u & 3; }
    const int NT = is_lat ? 12 : 4;
    const int rs = gr - 4 < 0 ? 0 : (gr - 4 > 56 ? 56 : gr - 4);
    LDSP unsigned char* L = c.lds + grp * NA_GRP;
    LDSP bf16_t* Qs = (LDSP bf16_t*)(L + NA_Q);
    LDSP bf16_t* Kt = (LDSP bf16_t*)(L + NA_K);
    LDSP bf16_t* VT = (LDSP bf16_t*)(L + NA_VT);
    LDSP bf16_t* Pm = (LDSP bf16_t*)(L + NA_P);
    LDSP float* rpb = (LDSP float*)(c.lds + NA_RPB);
    const bf16_t* proj = (const bf16_t*)(c.ws + WS_RA + RA_PROJ);
    const size_t rowb = (size_t)b * T;
    const int qtok0 = is_lat ? CTX + gr * 64 : qb * 64;
#pragma unroll
    for (int p = 0; p < 4; ++p) {
        const int id = p * 256 + gt, qi = id >> 4, c8 = id & 15;
        *(LDSP u32x4*)(Qs + qi * 136 + c8 * 8) = *(const u32x4*)(proj + (rowb + qtok0 + qi) * NINP + C_DQ + h * 128 + c8 * 8);
    }
    if (tid < 465) rpb[tid] = c.in[I_RPB][(size_t)(l * 4 + h) * 465 + tid];
    float m_run = -1e30f, l_run = 0.f;
    f32x4 acc[8];
#pragma unroll
    for (int dt = 0; dt < 8; ++dt) acc[dt] = (f32x4){0.f, 0.f, 0.f, 0.f};
    const float SC = 0.08838834764831845f * 1.4426950408889634f;
    const int cq = gw * 16 + r;
    const int cs = cq - 8 < 0 ? 0 : (cq - 8 > 48 ? 48 : cq - 8);
    u32x4 kreg[4], vreg[4];
#define NA_KTOK0(kt_) (is_lat ? ((kt_) < 8 ? CTX + (rs + (kt_)) * 64 : ((kt_) - 8) * 64) : (kt_) * 64)
#define NA_PREFETCH(kt_) do { const int kb_ = NA_KTOK0(kt_); _Pragma("unroll") for (int p = 0; p < 4; ++p) { \
        const int id = p * 256 + gt; kreg[p] = *(const u32x4*)(proj + (rowb + kb_ + (id >> 4)) * NINP + C_DK + h * 128 + (id & 15) * 8); \
        vreg[p] = *(const u32x4*)(proj + (rowb + kb_ + (id >> 4)) * NINP + C_DV + h * 128 + (id & 15) * 8); } } while (0)
    NA_PREFETCH(0);
    for (int kt = 0; kt < NT; ++kt) {
        const bool loc = is_lat && kt < 8;
        __syncthreads();
#pragma unroll
        for (int p = 0; p < 4; ++p) {
            const int id = p * 256 + gt, j = id >> 4, c8 = id & 15;
            *(LDSP u32x4*)(Kt + j * 136 + c8 * 8) = kreg[p];
            *(LDSP u32x4*)(VT + j * 136 + c8 * 8) = vreg[p];
        }
        if (kt + 1 < NT) NA_PREFETCH(kt + 1);
        __syncthreads();
        f32x4 sc[4];
        float tmax = -1e30f;
        const int ct0 = loc ? (gw <= 1 ? 0 : gw - 1) : 0, ct1 = loc ? (gw >= 2 ? 3 : gw + 1) : 3;
#pragma unroll
        for (int ct = 0; ct < 4; ++ct) {
            if (ct < ct0 || ct > ct1) { sc[ct] = (f32x4){-INFINITY, -INFINITY, -INFINITY, -INFINITY}; continue; }
            sc[ct] = mma_tile<4>(Kt + ct * 16 * 136, 136, Qs + gw * 16 * 136, 136, (f32x4){0.f, 0.f, 0.f, 0.f}, lane);
#pragma unroll
            for (int e = 0; e < 4; ++e) {
                float s = sc[ct][e] * SC;
                if (loc) {
                    const int ck = ct * 16 + q4 * 4 + e;
                    int dc = ck - cq; dc = dc < -15 ? -15 : (dc > 15 ? 15 : dc);
                    const int dr = rs + kt - gr + 7;
                    s += rpb[dr * 31 + dc + 15] * 1.4426950408889634f;
                    if (ck < cs || ck >= cs + 16) s = -INFINITY;
                }
                sc[ct][e] = s; tmax = fmaxf(tmax, s);
            }
        }
        tmax = fmaxf(tmax, __shfl_xor(tmax, 16)); tmax = fmaxf(tmax, __shfl_xor(tmax, 32));
        const float m_new = fmaxf(m_run, tmax);
        const float alpha = __builtin_amdgcn_exp2f(m_run - m_new);
        float psum = 0.f;
#pragma unroll
        for (int ct = 0; ct < 4; ++ct) {
            f32x4 p;
#pragma unroll
            for (int e = 0; e < 4; ++e) { p[e] = __builtin_amdgcn_exp2f(sc[ct][e] - m_new); psum += p[e]; }
            *(LDSP u32x2*)(Pm + (gw * 16 + r) * 72 + ct * 16 + q4 * 4) = pack4(p);
        }
        psum += __shfl_xor(psum, 16); psum += __shfl_xor(psum, 32);
        l_run = l_run * alpha + psum; m_run = m_new;
#pragma unroll
        for (int dt = 0; dt < 8; ++dt) {
            acc[dt] = acc[dt] * alpha;
#pragma unroll
            for (int kk = 0; kk < 2; ++kk) {
                if (2 * kk + 1 < ct0 || 2 * kk > ct1) continue;
                const bf16x8 vf = frag_tr16(VT + kk * 32 * 136 + dt * 16, 136, lane);
                const bf16x8 pf = *(const LDSP bf16x8*)(Pm + (gw * 16 + r) * 72 + kk * 32 + q4 * 8);
                acc[dt] = __builtin_amdgcn_mfma_f32_16x16x32_bf16(vf, pf, acc[dt], 0, 0, 0);
            }
        }
    }
    const float inv = 1.f / l_run;
    bf16_t* mix = (bf16_t*)(c.ws + WS_MIX) + (rowb + qtok0 + gw * 16 + r) * D + 1536 + h * 128;
#pragma unroll
    for (int dt = 0; dt < 8; ++dt) *(u32x2*)(mix + dt * 16 + q4 * 4) = pack4(acc[dt] * inv);
    __syncthreads();
}

__device__ __forceinline__ void phase_combine(const Ctx& c, int l) {
    const bf16_t* proj = (const bf16_t*)(c.ws + WS_RA + RA_PROJ);
    const bf16_t* OB = (const bf16_t*)(c.ws + WS_RA + RA_OB);
    bf16_t* mix = (bf16_t*)(c.ws + WS_MIX);
    const int lane = c.lane, d0 = (lane & 15) * 8;
    for (int row = c.bid * 8 + c.wave; row < MROWS; row += c.G * 8) {
#pragma unroll
        for (int mx = 0; mx < 3; ++mx) {
            const int om = mx == 0 ? 0 : 3 - mx;
            const u32x4 a = *(const u32x4*)(OB + ((size_t)(om * 2 + 0) * MROWS + row) * 512 + lane * 8);
            const u32x4 bq = *(const u32x4*)(OB + ((size_t)(om * 2 + 1) * MROWS + row) * 512 + lane * 8);
            const u32x4 g = *(const u32x4*)(proj + (size_t)row * NINP + (mx == 0 ? C_AZ : mx == 1 ? C_BR : C_CG) + lane * 8);
            const float* nw = c.in[mx == 0 ? I_GDNN : mx == 1 ? I_GLAN : I_HGN] + l * 128 + d0;
            float o[8]; float ss = 0.f;
#pragma unroll
            for (int m = 0; m < 4; ++m) { o[2 * m] = bflo(a[m]) + bflo(bq[m]); o[2 * m + 1] = bfhi(a[m]) + bfhi(bq[m]); ss += o[2 * m] * o[2 * m] + o[2 * m + 1] * o[2 * m + 1]; }
#pragma unroll
            for (int m = 1; m < 16; m <<= 1) ss += __shfl_xor(ss, m);
            const float rn = rsqrtf(ss * (1.f / 128.f) + NORM_EPS);
            float y[8];
#pragma unroll
            for (int m = 0; m < 4; ++m) {
                const float g0 = bflo(g[m]), g1 = bfhi(g[m]);
                const float a0 = (mx == 2) ? sigmoidf_(g0) : siluf_(g0), a1 = (mx == 2) ? sigmoidf_(g1) : siluf_(g1);
                y[2 * m] = o[2 * m] * rn * nw[2 * m] * a0; y[2 * m + 1] = o[2 * m + 1] * rn * nw[2 * m + 1] * a1;
            }
            *(u32x4*)(mix + (size_t)row * D + mx * 512 + lane * 8) = (u32x4){pk2(y[0], y[1]), pk2(y[2], y[3]), pk2(y[4], y[5]), pk2(y[6], y[7])};
        }
    }
}

__device__ __forceinline__ void phase_ln_router(const Ctx& c, int l) {
    LDSP float* wr = (LDSP float*)c.lds;
    for (int i = c.tid; i < 2048 * 16; i += 512) { const int k = i >> 4, e = i & 15; wr[e * 2048 + k] = c.in[I_ROUT][(size_t)l * 2048 * 16 + i]; }
    __syncthreads();
    const float* modv = (const float*)(c.ws + WS_MODV);
    const float* tb = (const float*)(c.ws + WS_RA + RA_TBUF);
    float* X1 = (float*)(c.ws + WS_X1); bf16_t* U = (bf16_t*)(c.ws + WS_U); float* aff = (float*)(c.ws + WS_AFF);
    const float* lg = c.in[I_LNG] + (size_t)(l * 2 + 0) * D; const float* lbp = c.in[I_LNB] + (size_t)(l * 2 + 0) * D;
    const int lane = c.lane;
    for (int row = c.bid * 8 + c.wave; row < MROWS; row += c.G * 8) {
        const int b = row / T, t = row % T;
        if (l == DEPTH - 1 && t < CTX) continue;
        const int r = t < CTX ? 4 : b;
        f32x4 v[8];
#pragma unroll
        for (int j = 0; j < 8; ++j) v[j] = *(const f32x4*)(tb + (size_t)row * D + 256 * j + 4 * lane);
        float mu, rstd; row_stats(v, mu, rstd);
#pragma unroll
        for (int j = 0; j < 8; ++j) {
            const int col = 256 * j + 4 * lane;
            v[j] = (v[j] - mu) * rstd * *(const f32x4*)(lg + col) + *(const f32x4*)(lbp + col);
            *(f32x4*)(X1 + (size_t)row * D + col) = v[j];
        }
        row_stats(v, mu, rstd);
        const float* sh = modv + (size_t)(l * 5 + r) * 12288 + 3 * 2048; const float* scp = sh + 2048;
        float lg16[16];
#pragma unroll
        for (int e = 0; e < 16; ++e) lg16[e] = 0.f;
#pragma unroll
        for (int j = 0; j < 8; ++j) {
            const int col = 256 * j + 4 * lane;
            const f32x4 y = (v[j] - mu) * rstd * (*(const f32x4*)(scp + col) + 1.f) + *(const f32x4*)(sh + col);
            *(u32x2*)(U + (size_t)row * D + col) = pack4(y);
#pragma unroll
            for (int e = 0; e < 16; ++e) { const f32x4 w = *(const LDSP f32x4*)(wr + e * 2048 + col); lg16[e] += y[0] * w[0] + y[1] * w[1] + y[2] * w[2] + y[3] * w[3]; }
        }
        float mxv = -1e30f;
#pragma unroll
        for (int e = 0; e < 16; ++e) { lg16[e] = wsum(lg16[e]); mxv = fmaxf(mxv, lg16[e]); }
        float den = 0.f;
#pragma unroll
        for (int e = 0; e < 16; ++e) { lg16[e] = expf(lg16[e] - mxv); den += lg16[e]; }
        const float rd = 1.f / den;
        float mine = 0.f;
#pragma unroll
        for (int e = 0; e < 16; ++e) if (lane == e) mine = lg16[e] * rd;
        if (lane < 16) aff[((size_t)b * 16 + lane) * T + t] = mine;
    }
    __syncthreads();
}

__device__ __forceinline__ void topk_unit(const Ctx& c, int prob) {
    const bool lat = prob < 64; const int pe = lat ? prob : prob - 64, b = pe >> 4, e = pe & 15;
    const int n = lat ? 4096 : 256, kcap = lat ? 512 : 32, tok0 = lat ? CTX : 0;
    LDSP unsigned* keys = (LDSP unsigned*)c.lds;
    LDSP unsigned* hist = keys + 4096;
    LDSP unsigned* bc = hist + 256;
    LDSP unsigned* wsum_ = bc + 4;
    const float* aff = (const float*)(c.ws + WS_AFF);
    const int tid = c.tid, lane = c.lane, wave = c.wave;
    const size_t rowb = (size_t)b * T + tok0;
    for (int i = tid; i < n; i += 512) keys[i] = __float_as_uint(aff[((size_t)b * 16 + e) * T + tok0 + i]);
    unsigned prefix = 0u, mask = 0u, krem = (unsigned)kcap;
    for (int pass = 0; pass < 4; ++pass) {
        const int shift = 24 - 8 * pass;
        if (tid < 256) hist[tid] = 0u;
        __syncthreads();
        for (int i = tid; i < n; i += 512) { const unsigned k = keys[i]; if ((k & mask) == prefix) __hip_atomic_fetch_add(&hist[(k >> shift) & 255u], 1u, __ATOMIC_RELAXED, __HIP_MEMORY_SCOPE_WORKGROUP); }
        __syncthreads();
        if (tid == 0) {
            unsigned cum = 0u; int bin = 255;
            for (; bin > 0; --bin) { const unsigned hcount = hist[bin]; if (cum + hcount >= krem) break; cum += hcount; }
            bc[0] = prefix | ((unsigned)bin << shift); bc[1] = krem - cum;
        }
        __syncthreads();
        prefix = bc[0]; krem = bc[1]; mask |= 255u << shift;
        __syncthreads();
    }
    const int per = n / 512 > 0 ? n / 512 : 1;
    const int i0 = tid * per;
    unsigned cnt = 0u;
    if (i0 < n) for (int j = 0; j < per; ++j) { const unsigned k = keys[i0 + j]; cnt += (k > prefix) ? 1u : 0u; cnt += (k == prefix) ? 0x10000u : 0u; }
    unsigned inc = cnt;
#pragma unroll
    for (int m = 1; m < 64; m <<= 1) { const unsigned o = __shfl_up(inc, m); if (lane >= m) inc += o; }
    if (lane == 63) wsum_[wave] = inc;
    __syncthreads();
    unsigned base = 0u;
    for (int w = 0; w < wave; ++w) base += wsum_[w];
    unsigned excl = base + inc - cnt;
    int* idx = (int*)(c.ws + WS_IDX); float* gate = (float*)(c.ws + WS_GATE); int* inv = (int*)(c.ws + WS_INV);
    const int slot0 = lat ? b * 512 : 2048 + b * 32;
    if (i0 < n) for (int j = 0; j < per; ++j) {
        const unsigned k = keys[i0 + j];
        const unsigned gtb = excl & 0xffffu, eqb = excl >> 16;
        const bool sel = (k > prefix) || (k == prefix && eqb < krem);
        int srow = -1;
        if (sel) {
            srow = slot0 + (int)(gtb + (eqb < krem ? eqb : krem));
            idx[e * EROWS + srow] = (int)(rowb + i0 + j);
            gate[e * EROWS + srow] = __uint_as_float(k);
        }
        inv[(rowb + i0 + j) * 16 + e] = srow;
        excl += (k > prefix) ? 1u : 0u; excl += (k == prefix) ? 0x10000u : 0u;
    }
    __syncthreads();
}

__device__ __forceinline__ void phase_gather(const Ctx& c, int l) {
    const int* idx = (const int*)(c.ws + WS_IDX);
    const bf16_t* U = (const bf16_t*)(c.ws + WS_U); bf16_t* XS = (bf16_t*)(c.ws + WS_RA + RA_XS);
    const int nrow = (l == DEPTH - 1) ? 2048 : EROWS, nreal = (l == DEPTH - 1) ? 2048 : 2176;
    for (int g = c.bid * 8 + c.wave; g < NEXP * nrow; g += c.G * 8) {
        const int e = g / nrow, s = g % nrow;
        u32x4 v[4];
        if (s < nreal) {
            const int src = idx[e * EROWS + s];
#pragma unroll
            for (int j = 0; j < 4; ++j) v[j] = *(const u32x4*)(U + (size_t)src * D + j * 512 + c.lane * 8);
        } else {
#pragma unroll
            for (int j = 0; j < 4; ++j) v[j] = (u32x4){0u, 0u, 0u, 0u};
            if (c.lane == 0) ((float*)(c.ws + WS_GATE))[e * EROWS + s] = 0.f;
        }
#pragma unroll
        for (int j = 0; j < 4; ++j) *(u32x4*)(XS + ((size_t)e * EROWS + s) * D + j * 512 + c.lane * 8) = v[j];
    }
}

__device__ __forceinline__ void phase_final(const Ctx& c, int l) {
    const float* modv = (const float*)(c.ws + WS_MODV);
    const float* X1 = (const float*)(c.ws + WS_X1); float* X = (float*)(c.ws + WS_X); bf16_t* U = (bf16_t*)(c.ws + WS_U);
    const bf16_t* YS = (const bf16_t*)(c.ws + WS_RA + RA_YS); const int* inv = (const int*)(c.ws + WS_INV);
    const float* lg = c.in[I_LNG] + (size_t)(l * 2 + 1) * D; const float* lbp = c.in[I_LNB] + (size_t)(l * 2 + 1) * D;
    const int lane = c.lane;
    for (int row = c.bid * 8 + c.wave; row < MROWS; row += c.G * 8) {
        const int b = row / T, t = row % T;
        if (l == DEPTH - 1 && t < CTX) continue;
        const int r = t < CTX ? 4 : b;
        f32x4 y[8];
#pragma unroll
        for (int j = 0; j < 8; ++j) y[j] = (f32x4){0.f, 0.f, 0.f, 0.f};
        const int myinv = inv[(size_t)row * 16 + (lane & 15)];
        for (int e = 0; e < 16; ++e) {
            const int s = __shfl(myinv, e);
            if (s >= 0) {
                const bf16_t* yr = YS + ((size_t)e * EROWS + s) * D;
#pragma unroll
                for (int j = 0; j < 8; ++j) { const u32x2 w = *(const u32x2*)(yr + 256 * j + 4 * lane); y[j] += (f32x4){bflo(w.x), bfhi(w.x), bflo(w.y), bfhi(w.y)}; }
            }
        }
        const float* m5 = modv + (size_t)(l * 5 + r) * 12288 + 5 * 2048;
        f32x4 v[8];
#pragma unroll
        for (int j = 0; j < 8; ++j) { const int col = 256 * j + 4 * lane; v[j] = *(const f32x4*)(X1 + (size_t)row * D + col) * ALPHA + *(const f32x4*)(m5 + col) * y[j]; }
        float mu, rstd; row_stats(v, mu, rstd);
#pragma unroll
        for (int j = 0; j < 8; ++j) { const int col = 256 * j + 4 * lane; v[j] = (v[j] - mu) * rstd * *(const f32x4*)(lg + col) + *(const f32x4*)(lbp + col); }
        if (l == DEPTH - 1) {
            float* o = c.out + ((size_t)b * SEQ + (t - CTX)) * D;
#pragma unroll
            for (int j = 0; j < 8; ++j) *(f32x4*)(o + 256 * j + 4 * lane) = v[j];
        } else {
#pragma unroll
            for (int j = 0; j < 8; ++j) *(f32x4*)(X + (size_t)row * D + 256 * j + 4 * lane) = v[j];
            const float* sh = modv + (size_t)((l + 1) * 5 + r) * 12288;
            modulate_store(v, sh, sh + 2048, U + (size_t)row * D, lane);
        }
    }
}

struct EpiOut {
    static constexpr bool PERM = false, AFTER_DRAIN = false;
    const float* X; const float* modv_l; float* Tb;
    __device__ __forceinline__ void operator()(const pg8::f32x4 (&acc)[2][2][4][2], const pg8::Unit& u, int wr, int wc, int fr, int fq) const {
        const int row0 = u.pm * 256 + wr * 64 + fr, col0 = u.pn * 256 + wc * 32 + 4 * fq;
        const int r = (u.pm % 17 == 0) ? 4 : u.pm / 17;
        const float* m2 = modv_l + (size_t)r * 12288 + 2 * 2048 + col0;
        pg8::f32x4 mv[2][2];
#pragma unroll
        for (int bj = 0; bj < 2; ++bj)
#pragma unroll
            for (int n = 0; n < 2; ++n) mv[bj][n] = *(const pg8::f32x4*)(m2 + bj * 128 + n * 16);
#pragma unroll
        for (int ai = 0; ai < 2; ++ai)
#pragma unroll
            for (int m = 0; m < 4; ++m) {
                const size_t off = (size_t)(row0 + ai * 128 + m * 16) * D + col0;
#pragma unroll
                for (int bj = 0; bj < 2; ++bj)
#pragma unroll
                    for (int n = 0; n < 2; ++n)
                        *(pg8::f32x4*)(Tb + off + bj * 128 + n * 16) = *(const pg8::f32x4*)(X + off + bj * 128 + n * 16) * ALPHA + mv[bj][n] * acc[ai][bj][m][n];
            }
    }
};
struct EpiHid {
    static constexpr bool PERM = true, AFTER_DRAIN = false;
    bf16_t* H;
    __device__ __forceinline__ void operator()(const pg8::f32x4 (&acc)[2][2][4][2], const pg8::Unit& u, int wr, int wc, int fr, int fq) const {
        const int row0 = u.pm * 256 + wr * 64 + fr, col0 = (u.pn & 7) * 128 + wc * 32 + 8 * fq;
#pragma unroll
        for (int ai = 0; ai < 2; ++ai)
#pragma unroll
            for (int m = 0; m < 4; ++m) {
                float hv[8];
#pragma unroll
                for (int n = 0; n < 2; ++n)
#pragma unroll
                    for (int j = 0; j < 4; ++j) hv[n * 4 + j] = siluf_(acc[ai][0][m][n][j]) * acc[ai][1][m][n][j];
                *(u32x4*)(H + (size_t)(row0 + ai * 128 + m * 16) * 1024 + col0) = (u32x4){pk2(hv[0], hv[1]), pk2(hv[2], hv[3]), pk2(hv[4], hv[5]), pk2(hv[6], hv[7])};
            }
    }
};
struct EpiY {
    static constexpr bool PERM = true, AFTER_DRAIN = false;
    bf16_t* Y; const float* gate;
    __device__ __forceinline__ void operator()(const pg8::f32x4 (&acc)[2][2][4][2], const pg8::Unit& u, int wr, int wc, int fr, int fq) const {
        const int row0 = u.pm * 256 + wr * 64 + fr, col0 = (u.pn & 7) * 256 + wc * 32 + 8 * fq;
#pragma unroll
        for (int ai = 0; ai < 2; ++ai)
#pragma unroll
            for (int m = 0; m < 4; ++m) {
                const int row = row0 + ai * 128 + m * 16; const float g = gate[row];
#pragma unroll
                for (int bj = 0; bj < 2; ++bj) {
                    const pg8::f32x4 v0 = acc[ai][bj][m][0] * g, v1 = acc[ai][bj][m][1] * g;
                    *(u32x4*)(Y + (size_t)row * D + col0 + bj * 128) = (u32x4){pk2(v0[0], v0[1]), pk2(v0[2], v0[3]), pk2(v1[0], v1[1]), pk2(v1[2], v1[3])};
                }
            }
    }
};
struct SchedLin {
    int G, c, nUnits, nPn, skip_ctx;
    __device__ __forceinline__ bool next(int i, pg8::Unit& u) const {
        const int L = i * G + c; if (L >= nUnits) return false;
        const int pml = L / nPn; u.pn = L % nPn; u.pm = skip_ctx ? (pml >> 4) * 17 + 1 + (pml & 15) : pml; return true;
    }
    __device__ __forceinline__ void a_ready(const pg8::Unit&) const {}
    __device__ __forceinline__ void done(const pg8::Unit&) const {}
};
struct SchedMoe {
    int G, c, nPm, nUnits;
    __device__ __forceinline__ bool next(int i, pg8::Unit& u) const {
        const int L = i * G + c; if (L >= nUnits) return false;
        const int per = nPm * 8, e = L / per, rem = L % per; u.pm = e * 9 + (rem >> 3); u.pn = e * 8 + (rem & 7); return true;
    }
    __device__ __forceinline__ void a_ready(const pg8::Unit&) const {}
    __device__ __forceinline__ void done(const pg8::Unit&) const {}
};
}

struct Args { const float* in[24]; float* out; unsigned char* ws; int ph_lo, ph_hi; };
constexpr int LDS_BYTES = 147456;
#ifndef MK_Q_IN
#define MK_Q_IN 8
#define MK_Q_OUT 8
#define MK_Q_G1 4
#define MK_Q_G2 3
#define MK_Q_TK 10
#endif
#ifndef MK_NG
#define MK_NG 128
#define MK_NH 48
#endif
constexpr int N_PHASES = 2 + 11 * mk::DEPTH;

__global__ __launch_bounds__(512, 2) void mega_fwd(Args a) {
    using namespace mk;
    extern __shared__ __attribute__((aligned(16))) unsigned char lds_raw[];
    Ctx c0;
#pragma unroll
    for (int i = 0; i < 24; ++i) c0.in[i] = a.in[i];
    c0.out = a.out; c0.ws = a.ws; c0.lds = (LDSP unsigned char*)lds_raw;
    const int wave_s = __builtin_amdgcn_readfirstlane((int)threadIdx.x >> 6);
    c0.tid = threadIdx.x; c0.lane = c0.tid & 63; c0.wave = wave_s; c0.G = gridDim.x; c0.bid = blockIdx.x;
    const int lo = a.ph_lo, hi = a.ph_hi;
    volatile LAS unsigned* st = (volatile LAS unsigned*)(lds_raw + LDS_BYTES - 16);
    if (c0.tid == 0) { st[0] = 0u; st[1] = 0u; st[2] = 0u; st[3] = 0u; }
    __syncthreads();
    XcdBarrier bar; bar.bar = (unsigned*)(a.ws + WS_BAR); bar.x = 0; bar.st = st;
    if (hi - lo > 1) bar = xcd_barrier_post((unsigned*)(a.ws + WS_BAR), st);
    int ph = 0;
#define PH_CTX Ctx c = c0; { int wz = wave_s; asm volatile("" : "+s"(wz)); unsigned zz = 0u; asm volatile("" : "+v"(zz)); const int lz = (int)__builtin_amdgcn_mbcnt_hi(~0u, __builtin_amdgcn_mbcnt_lo(~0u, zz)); int bz = c0.bid; asm volatile("" : "+s"(bz)); c.bid = bz; c.wave = wz; c.lane = lz; c.tid = wz * 64 + lz; }
#define PH_ON (ph >= lo && ph < hi)
#ifdef MK_DBL
#define REP(id) for (int rep_ = 0; rep_ < 1 + (((MK_DBL) >> (id)) & 1); ++rep_, __syncthreads())
#else
#define REP(id)
#endif
#ifdef MK_TPROBE_A
    volatile LAS unsigned long long* tp = (volatile LAS unsigned long long*)(lds_raw + LDS_BYTES - 48);
    if (c0.bid == (MK_TPROBE_WG) && c0.tid == 0) { tp[0] = __builtin_amdgcn_s_memrealtime(); tp[1] = 0ull; tp[2] = 0ull; tp[3] = 0ull; }
#ifdef MK_GSTAMP
    if (c0.tid == 0) { volatile LAS unsigned long long* g0 = (volatile LAS unsigned long long*)(lds_raw + LDS_BYTES - 48 - 80); for (int i = 0; i < 9; ++i) g0[i] = 0ull; }
    __syncthreads();
#endif
#define PH_END do { if (PH_ON && ph + 1 < hi) xcd_barrier(bar); \
        if (c0.bid == (MK_TPROBE_WG) && threadIdx.x == 0) { const unsigned long long now_ = __builtin_amdgcn_s_memrealtime(); const int kind_ = ph < 2 ? ph : 2 + (ph - 2) % 11; \
            if (kind_ >= (MK_TPROBE_A) && kind_ <= (MK_TPROBE_B)) tp[1] += now_ - tp[0]; tp[0] = now_; } ++ph; } while (0)
#else
#define PH_END do { if (PH_ON && ph + 1 < hi) xcd_barrier(bar); ++ph; } while (0)
#endif

    if (PH_ON) REP(0) { PH_CTX
        if (c.bid < 192) { modv_fill_s(c); for (int u = c.bid; u < 192; u += c.G) modv_unit(c, u); }
        convert_phase(c, 0);
    }
    PH_END;
    if (PH_ON) REP(1) { PH_CTX phase_l0_modulate(c); }
    PH_END;

    for (int l = 0; l < DEPTH; ++l) {
        const bool last = (l == DEPTH - 1);
        if (PH_ON) REP(2) { PH_CTX
            pg8::Gemm g{(const pg8::bf16_t*)(c.ws + WS_U), (const pg8::bf16_t*)(c.ws + WS_WIN + (l & 1) * WSET_BYTES), MROWS, NINP, D};
            pg8::StaticOrder S; S.init(MROWS, NINP, c.G, c.bid);
            pg8::EpiBf16<0> E{(pg8::bf16_t*)(c.ws + WS_RA + RA_PROJ), NINP, nullptr, 0, 0};
            pg8::gemm_phase<pg8::EpiBf16<0>, pg8::StaticOrder, false>((PG8_LAS unsigned char*)c.lds, g, S, E, nullptr, c.tid);
            if (!last && c.G == 256 && 8 * 256 + c.bid >= 68 * 31) convert_queue(c, l + 1, MK_Q_IN);
        }
        PH_END;
        if (PH_ON) REP(3) { PH_CTX
            for (int cc = c.bid; cc < NCC; cc += c.G) gdn_prep_unit(c, l, cc);
        }
        if (PH_ON) REP(4) { PH_CTX
            for (int cc = c.bid; cc < NCC; cc += c.G) diag_prep_unit<1>(c, l, cc);
        }
        if (PH_ON) REP(5) { PH_CTX
            for (int cc = c.bid; cc < NCC; cc += c.G) diag_prep_unit<2>(c, l, cc);
        }
        PH_END;
        if (PH_ON) REP(6) { PH_CTX
            for (int u = c.bid; u < 128; u += c.G) if (u < 64) { scan_unit<0, 64, 3>(c, u & 31, u >> 5); __syncthreads(); }
        }
        if (PH_ON) REP(7) { PH_CTX
            for (int u = c.bid; u < 128; u += c.G) if (u >= 64 && u < 96) { scan_unit<1, 128, 2>(c, u - 64, 0); __syncthreads(); }
        }
        if (PH_ON) REP(8) { PH_CTX
            for (int u = c.bid; u < 128; u += c.G) if (u >= 96) { scan_unit<2, 128, 4>(c, u - 96, 0); __syncthreads(); }
        }
#ifdef MK_TPROBE_A
        if (PH_ON && c0.bid == (MK_TPROBE_WG) && threadIdx.x == 0) { tp[2] += __builtin_amdgcn_s_memrealtime() - tp[0]; }
#endif
        if (PH_ON) REP(9) { PH_CTX
            const int nq = last ? 64 : 68, qx = c.bid & 7;
            unsigned* qhead = (unsigned*)(c.ws + WS_BAR) + 3584 + 8 * (l * 8 + qx);
            volatile LAS unsigned* tk = (volatile LAS unsigned*)(lds_raw + LDS_BYTES - 64);
            for (;;) {
                if (c.tid == 0) tk[0] = __hip_atomic_fetch_add(qhead, 1u, __ATOMIC_RELAXED, __HIP_MEMORY_SCOPE_AGENT);
                __syncthreads();
                const int t = (int)tk[0];
                if (t >= nq) break;
                na_pair(c, l, t < 64 ? 64 * qx + t : 512 + 4 * qx + (t - 64));
            }
        }
#ifdef MK_TPROBE_A
        if (PH_ON && c0.bid == (MK_TPROBE_WG) && threadIdx.x == 0) { tp[3] += __builtin_amdgcn_s_memrealtime() - tp[0]; }
#endif
        PH_END;
        if (PH_ON) REP(10) { PH_CTX phase_combine(c, l); }
        PH_END;
        if (PH_ON) REP(11) { PH_CTX
            pg8::Gemm g{(const pg8::bf16_t*)(c.ws + WS_MIX), (const pg8::bf16_t*)(c.ws + WS_WOUT + (l & 1) * WSET_BYTES), MROWS, D, D};
            SchedLin S{c.G, c.bid, (last ? 64 : 68) * 8, 8, last ? 1 : 0};
            EpiOut E{(const float*)(c.ws + WS_X), (const float*)(c.ws + WS_MODV) + (size_t)l * 5 * 12288, (float*)(c.ws + WS_RA + RA_TBUF)};
            pg8::gemm_phase<EpiOut, SchedLin, false>((PG8_LAS unsigned char*)c.lds, g, S, E, nullptr, c.tid);
            if (!last && c.G == 256 && 2 * 256 + c.bid >= 68 * 8) convert_queue(c, l + 1, MK_Q_OUT);
        }
        PH_END;
        if (PH_ON) REP(12) { PH_CTX phase_ln_router(c, l); }
        PH_END;
        if (PH_ON) REP(13) { PH_CTX const int nprob = last ? 64 : 128; for (int p = c.bid; p < nprob; p += c.G) topk_unit(c, p);
            if (!last && c.G == 256 && c.bid >= 64) convert_queue(c, l + 1, c.bid >= 128 ? MK_Q_TK : MK_Q_TK / 2); }
        PH_END;
        if (PH_ON) REP(14) { PH_CTX phase_gather(c, l); }
        PH_END;
        if (PH_ON) REP(15) { PH_CTX
            pg8::Gemm g{(const pg8::bf16_t*)(c.ws + WS_RA + RA_XS), (const pg8::bf16_t*)(c.ws + WS_W13 + (l & 1) * WSET_BYTES), NEXP * EROWS, NEXP * 2048, D};
            SchedMoe S{c.G, c.bid, last ? 8 : 9, NEXP * (last ? 8 : 9) * 8};
            EpiHid E{(bf16_t*)(c.ws + WS_RA + RA_HID)};
            pg8::gemm_phase<EpiHid, SchedMoe, false>((PG8_LAS unsigned char*)c.lds, g, S, E, nullptr, c.tid);
            if (!last && c.G == 256 && 4 * 256 + c.bid >= 16 * 9 * 8) convert_queue(c, l + 1, MK_Q_G1);
        }
        PH_END;
        if (PH_ON) REP(16) { PH_CTX
            pg8::Gemm g{(const pg8::bf16_t*)(c.ws + WS_RA + RA_HID), (const pg8::bf16_t*)(c.ws + WS_W2 + (l & 1) * WSET_BYTES), NEXP * EROWS, NEXP * 2048, 1024};
            SchedMoe S{c.G, c.bid, last ? 8 : 9, NEXP * (last ? 8 : 9) * 8};
            EpiY E{(bf16_t*)(c.ws + WS_RA + RA_YS), (const float*)(c.ws + WS_GATE)};
            pg8::gemm_phase<EpiY, SchedMoe, false>((PG8_LAS unsigned char*)c.lds, g, S, E, nullptr, c.tid);
            if (!last && c.G == 256 && 4 * 256 + c.bid >= 16 * 9 * 8) convert_queue(c, l + 1, MK_Q_G2);
        }
        PH_END;
        if (PH_ON) REP(17) { PH_CTX phase_final(c, l); }
        if (PH_ON) REP(18) { PH_CTX if (!last) convert_queue(c, l + 1, CONV_JOBS); }
        PH_END;
    }
#ifdef MK_TPROBE_A
    if (c0.bid == (MK_TPROBE_WG) && threadIdx.x == 0) { const unsigned long long t0_ = __builtin_amdgcn_s_memrealtime(), w_ =
#ifdef MK_GSTAMP
        ((volatile LAS unsigned long long*)(lds_raw + LDS_BYTES - 48 - 80))[MK_GSTAMP] * (unsigned long long)(MK_TPROBE_MULT);
#else
        tp[MK_TPROBE_SEL] * (unsigned long long)(MK_TPROBE_MULT);
#endif
        while (__builtin_amdgcn_s_memrealtime() - t0_ < w_) __builtin_amdgcn_s_sleep(32); }
#endif
}

#ifdef MK_STOP
__global__ void digest_k(const unsigned* w0, size_t n0, const unsigned* w1, size_t n1, float* out, size_t nout) {
    for (size_t i = (size_t)blockIdx.x * blockDim.x + threadIdx.x; i < nout; i += (size_t)gridDim.x * blockDim.x) {
        unsigned h = 0u;
        for (size_t j = i; j < n0 + n1; j += nout) {
#ifdef MK_RW0
            const size_t rw = j < n0 ? (size_t)(MK_RW0) : (size_t)(MK_RW1); const size_t row = (j < n0 ? j : j - n0) / rw;
            if (row % 4352 < 256) continue;
#endif
#ifdef MK_NANCOUNT
            { const unsigned wv = (j < n0 ? w0[j] : w1[j - n0]);
#ifdef MK_BF16
              if ((wv & 0x7F800000u) == 0x7F800000u || (wv & 0x7F80u) == 0x7F80u) h += 1u; }
#else
              if ((wv & 0x7F800000u) == 0x7F800000u) h += 1u; }
#endif
#else
            h = h * 31u + (j < n0 ? w0[j] : w1[j - n0]);
#endif
        }
#ifdef MK_NANCOUNT
        out[i] = 1000.f * (float)h;
#else
        out[i] = (float)(h & 0xFFFFFu);
#endif
    }
}
#endif
extern "C" void kernel_launch(void* const* d_in, const int* in_sizes, int n_in, void* d_out, int out_size, void* d_ws, size_t ws_size, hipStream_t stream) {
    static int grid = 0;
    if (grid == 0) {
        if (n_in != 24 || ws_size < mk::WS_TOTAL) { fprintf(stderr, "kernel_launch: n_in %d ws %zu (need %zu)\n", n_in, ws_size, (size_t)mk::WS_TOTAL); grid = -1; return; }
        int dev = 0, cus = 0, per_cu = 0;
        if (hipGetDevice(&dev) != hipSuccess || hipDeviceGetAttribute(&cus, hipDeviceAttributeMultiprocessorCount, dev) != hipSuccess) { grid = -1; return; }
        if (hipFuncSetAttribute((const void*)mega_fwd, hipFuncAttributeMaxDynamicSharedMemorySize, LDS_BYTES) != hipSuccess) { fprintf(stderr, "kernel_launch: hipFuncSetAttribute failed\n"); grid = -1; return; }
        if (hipOccupancyMaxActiveBlocksPerMultiprocessor(&per_cu, (const void*)mega_fwd, 512, LDS_BYTES) != hipSuccess || per_cu < 1) fprintf(stderr, "kernel_launch: occupancy query says %d\n", per_cu);
        (void)hipGetLastError();
        grid = cus;
    }
    if (grid < 0) return;
    (void)hipMemsetAsync((char*)d_ws + mk::WS_BAR, 0, 16384, stream);
    Args a{};
    for (int i = 0; i < 24; ++i) a.in[i] = (const float*)d_in[i];
    a.out = (float*)d_out; a.ws = (unsigned char*)d_ws;
#if MK_N_LAUNCHES == 1
    a.ph_lo = 0; a.ph_hi = N_PHASES;
    hipLaunchKernelGGL(mega_fwd, dim3(grid), dim3(512), LDS_BYTES, stream, a);
#else
#ifdef MK_STOP
    for (int p = 0; p < MK_STOP; ++p) { a.ph_lo = p; a.ph_hi = p + 1; hipLaunchKernelGGL(mega_fwd, dim3(grid), dim3(512), LDS_BYTES, stream, a); }
    hipLaunchKernelGGL(digest_k, dim3(2048), dim3(256), 0, stream, (const unsigned*)((char*)d_ws + (size_t)(MK_D0)), (size_t)(MK_N0) / 4, (const unsigned*)((char*)d_ws + (size_t)(MK_D1)), (size_t)(MK_N1) / 4, (float*)d_out, (size_t)out_size);
#else
    for (int p = 0; p < N_PHASES; ++p) { a.ph_lo = p; a.ph_hi = p + 1; hipLaunchKernelGGL(mega_fwd, dim3(grid), dim3(512), LDS_BYTES, stream, a); }
#endif
#endif
}
```

```cpp
#include <hip/hip_runtime.h>
#include <cstdio>
#include <cstdint>
#ifndef MK_N_LAUNCHES
#define MK_N_LAUNCHES 1
#endif
namespace pg8 {
#define PG8_LAS __attribute__((address_space(3)))
typedef unsigned short bf16_t;
typedef short bf16x8 __attribute__((ext_vector_type(8)));
typedef float f32x4 __attribute__((ext_vector_type(4)));
typedef unsigned u32x4 __attribute__((ext_vector_type(4)));
constexpr int BM = 256, BK = 64, HALF = 128, HTB = HALF * BK * 2  , STAGE_BYTES = 8 * HTB, NXCD = 8, WGM = 8;

__host__ __device__ __forceinline__ int lds_byte(int r, int c) { const int st = (r >> 4) * 2 + (c >> 5), rr = r & 15, cc = c & 31, ob = rr * 64 + cc * 2; return st * 1024 + (ob ^ (((ob >> 9) & 1) << 5)); }
__host__ __device__ __forceinline__ void stage_rc(int b, int& R, int& C) { const int st = b / 1024, sb = b % 1024, swz = sb ^ (((sb >> 9) & 1) << 5); R = (st >> 1) * 16 + swz / 64; C = (st & 1) * 32 + (swz % 64) / 2; }
__host__ __device__ __forceinline__ int perm32(int rho) { const int n = rho >> 4, i = rho & 15; return 8 * (i >> 2) + 4 * n + (i & 3); }

struct Unit { int pm, pn; };
struct Gemm { const bf16_t* A; const bf16_t* Bt; int M, N, K; };

struct StaticOrder {
    int nM, nN, nwg, G, c;
    __host__ __device__ void init(int M, int N, int G_, int c_) { nM = M / BM; nN = N / BM; nwg = nM * nN; G = G_; c = c_; }
    __host__ __device__ bool next(int i, Unit& u) const {
        const long L = (long)i * G + c; if (L >= nwg) return false;
        int wgid = (int)L; { const int q = nwg / NXCD, r = nwg % NXCD, xcd = wgid % NXCD, off = wgid / NXCD; wgid = (xcd < r ? xcd * (q + 1) : r * (q + 1) + (xcd - r) * q) + off; }
        const int nig = WGM * nN, gid = wgid / nig, fm = gid * WGM, gsz = (nM - fm) < WGM ? (nM - fm) : WGM;
        u.pm = fm + ((wgid % nig) % gsz); u.pn = (wgid % nig) / gsz; return true;
    }
    __device__ __forceinline__ void a_ready(const Unit&) const {}
    __device__ __forceinline__ void done(const Unit&) const {}
};
struct CountedOrder : StaticOrder {
    const unsigned* ready; unsigned need; unsigned* tmo;
    __device__ __forceinline__ void a_ready(const Unit& u) const {
        if (threadIdx.x < 64) {
            const unsigned long long t0 = __builtin_amdgcn_s_memrealtime(); unsigned polls = 0;
            while ((unsigned)__builtin_amdgcn_readfirstlane(__hip_atomic_load(ready + 64 * u.pm, __ATOMIC_RELAXED, __HIP_MEMORY_SCOPE_AGENT)) < need) {
                if ((++polls & 255u) == 0u && __builtin_amdgcn_readfirstlane(__hip_atomic_load(tmo, __ATOMIC_RELAXED, __HIP_MEMORY_SCOPE_AGENT)) != 0u) break;
                if (__builtin_amdgcn_s_memrealtime() - t0 > 2000000ull) {
                    if (threadIdx.x == 0) { unsigned expect = 0u; __hip_atomic_compare_exchange_strong(tmo + 1, &expect, 0x600u | (unsigned)(u.pm & 0xff), __ATOMIC_RELAXED, __ATOMIC_RELAXED, __HIP_MEMORY_SCOPE_AGENT); __hip_atomic_store(tmo, 1u, __ATOMIC_RELAXED, __HIP_MEMORY_SCOPE_AGENT); }
                    break; }
                __builtin_amdgcn_s_sleep(2); }
            __builtin_amdgcn_fence(__ATOMIC_ACQUIRE, "agent");
            asm volatile("s_waitcnt vmcnt(0)" ::: "memory");
        }
#if !defined(BROKEN_HOOK_NO_BARRIER)
        asm volatile("" ::: "memory"); __builtin_amdgcn_s_barrier(); asm volatile("" ::: "memory");
#endif
    }
};

typedef float f32x2_cv __attribute__((ext_vector_type(2)));
typedef __bf16 bf16x2_cv __attribute__((ext_vector_type(2)));
__device__ __forceinline__ unsigned cvt_pk_bf16(float lo, float hi) { const bf16x2_cv v = __builtin_convertvector((f32x2_cv){lo, hi}, bf16x2_cv); return __builtin_bit_cast(unsigned, v); }
typedef float f32x2 __attribute__((ext_vector_type(2)));
__device__ __forceinline__ f32x2 gelu_pk(f32x2 v) {
    const f32x2 av = __builtin_elementwise_abs(v), d = av * 0.2316418882f + 1.0f;
    f32x2 t; t.x = __builtin_amdgcn_rcpf(d.x); t.y = __builtin_amdgcn_rcpf(d.y);
    f32x2 q = t * 0.5307027145f + (-0.7265760135f); q = q * t + 0.7107068705f; q = q * t + (-0.142248368f); q = q * t + 0.127414796f; q = q * t;
    const f32x2 s = (v * v) * (-0.72134752044f);
    f32x2 e; e.x = __builtin_amdgcn_exp2f(s.x); e.y = __builtin_amdgcn_exp2f(s.y);
    const f32x2 m = v * (q * e), r = v - m;
    f32x2 o; o.x = v.x < 0.f ? m.x : r.x; o.y = v.y < 0.f ? m.y : r.y; return o;
}

struct EpiF32 {
    static constexpr bool PERM = false, AFTER_DRAIN = false;
    float* C; int ldc; const float* bias;
    __device__ __forceinline__ void operator()(const f32x4 (&acc)[2][2][4][2], const Unit& u, int wr, int wc, int fr, int fq) const {
        const int row0 = u.pm * BM + wr * 64 + fr, col0 = u.pn * BM + wc * 32 + 4 * fq;
        f32x4 bv[2][2];
#pragma unroll
        for (int bj = 0; bj < 2; ++bj)
#pragma unroll
            for (int n = 0; n < 2; ++n) bv[bj][n] = bias ? *(const f32x4*)(bias + col0 + bj * HALF + n * 16) : (f32x4){0.f, 0.f, 0.f, 0.f};
#pragma unroll
        for (int ai = 0; ai < 2; ++ai)
#pragma unroll
            for (int m = 0; m < 4; ++m) { float* rowp = C + (size_t)(row0 + ai * HALF + m * 16) * ldc + col0;
#pragma unroll
                for (int bj = 0; bj < 2; ++bj)
#pragma unroll
                    for (int n = 0; n < 2; ++n) *(f32x4*)(rowp + bj * HALF + n * 16) = acc[ai][bj][m][n] + bv[bj][n]; }
    }
};
template <int ACT  > struct EpiBf16 {
    static constexpr bool PERM = true, AFTER_DRAIN = false;
    bf16_t* O; int ldc; const float* bias; int split_cols; size_t split_stride;
    __device__ __forceinline__ void operator()(const f32x4 (&acc)[2][2][4][2], const Unit& u, int wr, int wc, int fr, int fq) const {
        const int row0 = u.pm * BM + wr * 64 + fr; int colt = u.pn * BM; bf16_t* base = O;
        if (split_cols) { const int t = colt / split_cols; base += (size_t)t * split_stride; colt -= t * split_cols; }
        const int col0 = colt + wc * 32 + 8 * fq, bcol0 = u.pn * BM + wc * 32 + 8 * fq;
        f32x4 bv[2][2];
#pragma unroll
        for (int bj = 0; bj < 2; ++bj)
#pragma unroll
            for (int n = 0; n < 2; ++n) bv[bj][n] = bias ? *(const f32x4*)(bias + bcol0 + bj * HALF + 4 * n) : (f32x4){0.f, 0.f, 0.f, 0.f};
#pragma unroll
        for (int ai = 0; ai < 2; ++ai)
#pragma unroll
            for (int m = 0; m < 4; ++m) { bf16_t* rowp = base + (size_t)(row0 + ai * HALF + m * 16) * ldc + col0;
#pragma unroll
                for (int bj = 0; bj < 2; ++bj) { f32x4 v0 = acc[ai][bj][m][0] + bv[bj][0], v1 = acc[ai][bj][m][1] + bv[bj][1];
                    if (ACT == 1) { f32x2 a = gelu_pk((f32x2){v0[0], v0[1]}), b = gelu_pk((f32x2){v0[2], v0[3]}), c = gelu_pk((f32x2){v1[0], v1[1]}), d = gelu_pk((f32x2){v1[2], v1[3]});
                        v0 = (f32x4){a.x, a.y, b.x, b.y}; v1 = (f32x4){c.x, c.y, d.x, d.y}; }
                    if (ACT == 2) {
#pragma unroll
                        for (int j = 0; j < 4; ++j) { v0[j] = 0.5f * v0[j] * (1.0f + erff(v0[j] * 0.70710678f)); v1[j] = 0.5f * v1[j] * (1.0f + erff(v1[j] * 0.70710678f)); } }
                    u32x4 w; w.x = cvt_pk_bf16(v0[0], v0[1]); w.y = cvt_pk_bf16(v0[2], v0[3]); w.z = cvt_pk_bf16(v1[0], v1[1]); w.w = cvt_pk_bf16(v1[2], v1[3]);
                    *(u32x4*)(rowp + bj * HALF) = w; } }
    }
};

struct PanelStats {
    unsigned* xbuf;
    unsigned* cnt;
    unsigned* tmo;
    int ntn; float eps;
    unsigned code;
    __device__ __forceinline__ bool run(const f32x4 (&v)[2][2][4][2], const Unit& u, int wr, int wc, int fr, int fq, PG8_LAS unsigned char* lds, int wid, int lane) const {
        typedef float f32x2v __attribute__((ext_vector_type(2)));
        PG8_LAS f32x2v* P = (PG8_LAS f32x2v*)lds;
        PG8_LAS f32x2v* S = (PG8_LAS f32x2v*)(lds + 8192);
        PG8_LAS unsigned* flag = (PG8_LAS unsigned*)(lds + 8192 + 2048);
#pragma unroll
        for (int ai = 0; ai < 2; ++ai)
#pragma unroll
            for (int m = 0; m < 4; ++m) {
                float s = 0.f;
#pragma unroll
                for (int bj = 0; bj < 2; ++bj)
#pragma unroll
                    for (int n = 0; n < 2; ++n) { const f32x4 x = v[ai][bj][m][n]; s += (x[0] + x[1]) + (x[2] + x[3]); }
                s += __shfl_xor(s, 16); s += __shfl_xor(s, 32);
                const float mw = s * (1.0f / 64.0f); float q = 0.f;
#pragma unroll
                for (int bj = 0; bj < 2; ++bj)
#pragma unroll
                    for (int n = 0; n < 2; ++n) { const f32x4 d = v[ai][bj][m][n] - mw; q += (d[0] * d[0] + d[1] * d[1]) + (d[2] * d[2] + d[3] * d[3]); }
                q += __shfl_xor(q, 16); q += __shfl_xor(q, 32);
                if (fq == 0) P[(ai * HALF + wr * 64 + m * 16 + fr) * 4 + wc] = (f32x2v){mw, q};
            }
        asm volatile("s_waitcnt lgkmcnt(0)" ::: "memory"); __builtin_amdgcn_s_barrier(); asm volatile("" ::: "memory");
#if defined(BROKEN_NO_WAIT)
        if (blockIdx.x >= 64) { const long long t0 = clock64(); while (clock64() - t0 < 60000) __builtin_amdgcn_s_sleep(8); }
#endif
        const int row = wid * 32 + (lane & 31);
        if (lane < 32) {
            const f32x2v a = P[row * 4 + 0], b = P[row * 4 + 1], c = P[row * 4 + 2], d = P[row * 4 + 3];
            const float mt = (a.x + b.x + c.x + d.x) * 0.25f;
            const float da = a.x - mt, db = b.x - mt, dc = c.x - mt, dd = d.x - mt;
            const float m2 = (a.y + b.y) + (c.y + d.y) + 64.0f * ((da * da + db * db) + (dc * dc + dd * dd));
            unsigned long long* slot = (unsigned long long*)xbuf + ((size_t)(u.pm * BM + row) * 4 + u.pn);
            __hip_atomic_store(slot, ((unsigned long long)__float_as_uint(m2) << 32) | __float_as_uint(mt), __ATOMIC_RELAXED, __HIP_MEMORY_SCOPE_AGENT);
        }
        asm volatile("s_waitcnt vmcnt(0)" ::: "memory");
        if (lane == 0) __hip_atomic_fetch_add(cnt + 64 * u.pm, 1u, __ATOMIC_RELAXED, __HIP_MEMORY_SCOPE_AGENT);
        if (wid == 0) {
            bool dead = false; const unsigned long long t0 = __builtin_amdgcn_s_memrealtime(); const unsigned want = 8u * (unsigned)ntn;
            for (;;) {
#if defined(BROKEN_NO_WAIT)
                break;
#endif
                if ((unsigned)__builtin_amdgcn_readfirstlane(__hip_atomic_load(cnt + 64 * u.pm, __ATOMIC_RELAXED, __HIP_MEMORY_SCOPE_AGENT)) >= want) break;
                if (__builtin_amdgcn_s_memrealtime() - t0 > 2000000ull) {
                    if (lane == 0) { unsigned expect = 0u; __hip_atomic_compare_exchange_strong(tmo + 1, &expect, code | (unsigned)(u.pm & 0xff), __ATOMIC_RELAXED, __ATOMIC_RELAXED, __HIP_MEMORY_SCOPE_AGENT);
                                     __hip_atomic_store(tmo, 1u, __ATOMIC_RELAXED, __HIP_MEMORY_SCOPE_AGENT); }
                    dead = true; break; }
                __builtin_amdgcn_s_sleep(2);
            }
            __builtin_amdgcn_fence(__ATOMIC_ACQUIRE, "agent");
            if (lane == 0) flag[0] = dead ? 1u : 0u;
        }
        asm volatile("s_waitcnt vmcnt(0) lgkmcnt(0)" ::: "memory"); __builtin_amdgcn_s_barrier(); asm volatile("" ::: "memory");
        const bool bad = flag[0] != 0u;
        if (lane < 32) {
            const unsigned long long* slot = (const unsigned long long*)xbuf + (size_t)(u.pm * BM + row) * 4; float mt[4], m2[4]; float ms = 0.f;
#pragma unroll
            for (int t = 0; t < 4; ++t) { if (t < ntn) { const unsigned long long w = __hip_atomic_load(slot + t, __ATOMIC_RELAXED, __HIP_MEMORY_SCOPE_AGENT); mt[t] = __uint_as_float((unsigned)w); m2[t] = __uint_as_float((unsigned)(w >> 32)); } else { mt[t] = 0.f; m2[t] = 0.f; } ms += mt[t]; }
            const float mean = ms / (float)ntn; float q = 0.f;
#pragma unroll
            for (int t = 0; t < 4; ++t) if (t < ntn) { const float dm = mt[t] - mean; q += m2[t] + 256.0f * dm * dm; }
            S[row] = (f32x2v){mean, 1.0f / sqrtf(q / (256.0f * (float)ntn) + eps)};
        }
        asm volatile("s_waitcnt lgkmcnt(0)" ::: "memory"); __builtin_amdgcn_s_barrier(); asm volatile("" ::: "memory");
        return bad;
    }
};
struct EpiLnRes {
    static constexpr bool PERM = false, AFTER_DRAIN = true;
    const float* base; float* out; int ldc; const float* bias; PanelStats st; unsigned poison;
    __device__ __forceinline__ void refuse(size_t i0, size_t stride, int M, int N) const { const float q = __builtin_nanf(""); for (size_t i = i0; i < (size_t)M * N; i += stride) out[(i / N) * ldc + i % N] = q;
        if (i0 == 0) { unsigned expect = 0u; __hip_atomic_compare_exchange_strong(st.tmo + 1, &expect, 0x7f0u, __ATOMIC_RELAXED, __ATOMIC_RELAXED, __HIP_MEMORY_SCOPE_AGENT); __hip_atomic_store(st.tmo, 1u, __ATOMIC_RELAXED, __HIP_MEMORY_SCOPE_AGENT); } }
    __device__ __forceinline__ void fused(f32x4 (&acc)[2][2][4][2], const Unit& u, int wr, int wc, int fr, int fq, PG8_LAS unsigned char* lds, int wid, int lane) const {
        typedef float f32x2v __attribute__((ext_vector_type(2)));
        const PG8_LAS f32x2v* S = (const PG8_LAS f32x2v*)(lds + 8192);
        const int col0 = u.pn * BM + wc * 32 + 4 * fq;
#pragma unroll
        for (int bj = 0; bj < 2; ++bj)
#pragma unroll
            for (int n = 0; n < 2; ++n) { const f32x4 bv = bias ? *(const f32x4*)(bias + col0 + bj * HALF + n * 16) : (f32x4){0.f, 0.f, 0.f, 0.f};
#pragma unroll
                for (int ai = 0; ai < 2; ++ai)
#pragma unroll
                    for (int m = 0; m < 4; ++m) acc[ai][bj][m][n] += bv; }
        const bool bad = st.run(acc, u, wr, wc, fr, fq, lds, wid, lane) || poison != 0u;
        const float qnan = __builtin_nanf("");
#pragma unroll
        for (int ai = 0; ai < 2; ++ai)
#pragma unroll
            for (int m = 0; m < 4; ++m) { const int r = ai * HALF + wr * 64 + m * 16 + fr; const f32x2v sr = S[r]; const size_t off = (size_t)(u.pm * BM + r) * ldc + col0;
#pragma unroll
                for (int bj = 0; bj < 2; ++bj)
#pragma unroll
                    for (int n = 0; n < 2; ++n) { const f32x4 bs = *(const f32x4*)(base + off + bj * HALF + n * 16); f32x4 o = bs + (acc[ai][bj][m][n] - sr.x) * sr.y;
                        if (bad) o = (f32x4){qnan, qnan, qnan, qnan}; *(f32x4*)(out + off + bj * HALF + n * 16) = o; }
                asm volatile("" ::: "memory"); }
    }
};
struct EpiLnResLn {
    static constexpr bool PERM = false, AFTER_DRAIN = true;
    const float* base; float* out; bf16_t* xn; int ldc; const float* bias; PanelStats st1, st2; unsigned poison;
    __device__ __forceinline__ void refuse(size_t i0, size_t stride, int M, int N) const { const float q = __builtin_nanf(""); for (size_t i = i0; i < (size_t)M * N; i += stride) { const size_t o = (i / N) * ldc + i % N; out[o] = q; xn[o] = (bf16_t)0x7fc0u; }
        if (i0 == 0) { unsigned expect = 0u; __hip_atomic_compare_exchange_strong(st1.tmo + 1, &expect, 0x7f0u, __ATOMIC_RELAXED, __ATOMIC_RELAXED, __HIP_MEMORY_SCOPE_AGENT); __hip_atomic_store(st1.tmo, 1u, __ATOMIC_RELAXED, __HIP_MEMORY_SCOPE_AGENT); } }
    __device__ __forceinline__ void fused(f32x4 (&acc)[2][2][4][2], const Unit& u, int wr, int wc, int fr, int fq, PG8_LAS unsigned char* lds, int wid, int lane) const {
        typedef float f32x2v __attribute__((ext_vector_type(2))); typedef unsigned u32x2v __attribute__((ext_vector_type(2)));
        const PG8_LAS f32x2v* S = (const PG8_LAS f32x2v*)(lds + 8192);
        const int col0 = u.pn * BM + wc * 32 + 4 * fq;
#pragma unroll
        for (int bj = 0; bj < 2; ++bj)
#pragma unroll
            for (int n = 0; n < 2; ++n) { const f32x4 bv = bias ? *(const f32x4*)(bias + col0 + bj * HALF + n * 16) : (f32x4){0.f, 0.f, 0.f, 0.f};
#pragma unroll
                for (int ai = 0; ai < 2; ++ai)
#pragma unroll
                    for (int m = 0; m < 4; ++m) acc[ai][bj][m][n] += bv; }
        bool bad = st1.run(acc, u, wr, wc, fr, fq, lds, wid, lane) || poison != 0u;
        const float qnan = __builtin_nanf("");
#pragma unroll
        for (int ai = 0; ai < 2; ++ai)
#pragma unroll
            for (int m = 0; m < 4; ++m) { const int r = ai * HALF + wr * 64 + m * 16 + fr; const f32x2v sr = S[r]; const size_t off = (size_t)(u.pm * BM + r) * ldc + col0;
#pragma unroll
                for (int bj = 0; bj < 2; ++bj)
#pragma unroll
                    for (int n = 0; n < 2; ++n) { const f32x4 bs = *(const f32x4*)(base + off + bj * HALF + n * 16); acc[ai][bj][m][n] = bs + (acc[ai][bj][m][n] - sr.x) * sr.y; }
                asm volatile("" : "+v"(acc[ai][0][m][0]), "+v"(acc[ai][0][m][1]), "+v"(acc[ai][1][m][0]), "+v"(acc[ai][1][m][1]));
                if (m & 1) asm volatile("" ::: "memory"); }
        const bool bad1 = bad;
        bad = st2.run(acc, u, wr, wc, fr, fq, lds, wid, lane) || bad;
#pragma unroll
        for (int ai = 0; ai < 2; ++ai)
#pragma unroll
            for (int m = 0; m < 4; ++m) { const int r = ai * HALF + wr * 64 + m * 16 + fr; const f32x2v sr = S[r]; const size_t off = (size_t)(u.pm * BM + r) * ldc + col0;
#pragma unroll
                for (int bj = 0; bj < 2; ++bj)
#pragma unroll
                    for (int n = 0; n < 2; ++n) { const f32x4 x1 = acc[ai][bj][m][n]; *(f32x4*)(out + off + bj * HALF + n * 16) = bad1 ? (f32x4){qnan, qnan, qnan, qnan} : x1;
                        const f32x4 o = (x1 - sr.x) * sr.y; u32x2v w; w.x = cvt_pk_bf16(o[0], o[1]); w.y = cvt_pk_bf16(o[2], o[3]);
                        if (bad) { w.x = 0x7fc07fc0u; w.y = 0x7fc07fc0u; } *(u32x2v*)(xn + off + bj * HALF + n * 16) = w; }
                asm volatile("" ::: "memory"); }
    }
};

template <class Epi, class Sched, bool STAMP = false, bool GATHER = false>
__device__ __forceinline__ void gemm_phase(PG8_LAS unsigned char* lds, const Gemm g, const Sched& S, const Epi& E, unsigned long long* stamps, int tid_in) {
    int tid_ = tid_in; asm volatile("" : "+v"(tid_));
    const int tid = tid_, wid = __builtin_amdgcn_readfirstlane(tid >> 6), lane = tid & 63, wr = wid >> 2, wc = wid & 3, fr = lane & 15, fq = lane >> 4;
    const int K = g.K, nt = K / BK;
    int ts_lo = 0, ts_hi = 0, nts = 0; const unsigned long long rt_entry = STAMP ? (unsigned long long)wall_clock64() : 0ull;
#define PG8_STAMP() do { if (STAMP && wid == 0 && nts < 64) { const unsigned long long _c = (unsigned long long)clock64(); \
        ts_lo = (lane == nts) ? (int)(unsigned)_c : ts_lo; ts_hi = (lane == nts) ? (int)(unsigned)(_c >> 32) : ts_hi; ++nts; } } while (0)
    PG8_STAMP();
    unsigned voffA[2], voffB[2];
#pragma unroll
    for (int i = 0; i < 2; ++i) { int R, C; stage_rc(tid * 16 + i * 8192, R, C); const int Rb = Epi::PERM ? ((R & ~31) + perm32(R & 31)) : R;
        voffA[i] = (unsigned)(R * K + C) * 2u; voffB[i] = (unsigned)(Rb * K + C) * 2u; }
    int pR[2], pC[2];
#pragma unroll
    for (int i = 0; i < 2; ++i) { int R, C; stage_rc(tid * 16 + i * 8192, R, C); pR[i] = R; pC[i] = C * 2; }
    unsigned gc[2][2], gn[2][2];
#define PG8_GOFS(dst, u) do { _Pragma("unroll") for (int h_ = 0; h_ < 2; ++h_) _Pragma("unroll") for (int i_ = 0; i_ < 2; ++i_) \
        dst[h_][i_] = (unsigned)S.arow(u, h_ * HALF + pR[i_]) * (unsigned)(K * 2) + (unsigned)pC[i_]; } while (0)
#define PG8_STAGE_G(bufoff, gbase, ofs) do { _Pragma("unroll") for (int _i = 0; _i < 2; ++_i) \
        __builtin_amdgcn_global_load_lds((const unsigned*)((const char*)(gbase) + (ofs)[_i]), (PG8_LAS unsigned*)(lds + (bufoff) + ldsw + _i * 8192), 16, 0, 0); } while (0)
    const size_t kstep = (size_t)(BK * 2);
    const size_t hstep = (size_t)HALF * K * 2;
    const size_t tstep = 2 * hstep;
    const unsigned ldsw = (unsigned)wid * 1024u;
    const int aoff = lds_byte(wr * 64 + fr, fq * 8), boff = lds_byte(wc * 32 + fr, fq * 8);
#define PG8_SA(b, h) (((b) * 2 + (h)) * HTB)
#define PG8_SB(b, h) ((4 + (b) * 2 + (h)) * HTB)
#define PG8_STAGE(bufoff, gbase, voff) do { _Pragma("unroll") for (int _i = 0; _i < 2; ++_i) \
        __builtin_amdgcn_global_load_lds((const unsigned*)((const char*)(gbase) + (voff)[_i]), (PG8_LAS unsigned*)(lds + (bufoff) + ldsw + _i * 8192), 16, 0, 0); } while (0)
#define PG8_LDA(dst, b, h) do { _Pragma("unroll") for (int m = 0; m < 4; ++m) _Pragma("unroll") for (int k = 0; k < 2; ++k) dst[m][k] = *(const PG8_LAS bf16x8*)(lds + PG8_SA(b, h) + aoff + m * 2048 + k * 1024); } while (0)
#define PG8_LDB(dst, b, h) do { _Pragma("unroll") for (int n = 0; n < 2; ++n) _Pragma("unroll") for (int k = 0; k < 2; ++k) dst[n][k] = *(const PG8_LAS bf16x8*)(lds + PG8_SB(b, h) + boff + n * 2048 + k * 1024); } while (0)
#define PG8_MMA(ai, bj, At, Bt) do { __builtin_amdgcn_s_setprio(1); _Pragma("unroll") for (int m = 0; m < 4; ++m) _Pragma("unroll") for (int n = 0; n < 2; ++n) _Pragma("unroll") for (int k = 0; k < 2; ++k) \
        acc[ai][bj][m][n] = __builtin_amdgcn_mfma_f32_16x16x32_bf16(Bt[n][k], At[m][k], acc[ai][bj][m][n], 0, 0, 0); __builtin_amdgcn_s_setprio(0); } while (0)
#define PG8_WAIT_V(n) asm volatile("s_waitcnt vmcnt(" #n ")" ::: "memory")
#define PG8_WAIT_L(n) asm volatile("s_waitcnt lgkmcnt(" #n ")" ::: "memory")
#define PG8_BAR __builtin_amdgcn_s_barrier()
#define PG8_SCHED __builtin_amdgcn_sched_barrier(0)
    Unit cur, nxt; int ui = 0;
    if (!S.next(0, cur)) return;
    f32x4 acc[2][2][4][2];
#pragma unroll
    for (int a = 0; a < 2; ++a)
#pragma unroll
        for (int b = 0; b < 2; ++b)
#pragma unroll
            for (int m = 0; m < 4; ++m)
#pragma unroll
                for (int n = 0; n < 2; ++n) acc[a][b][m][n] = (f32x4){0.f, 0.f, 0.f, 0.f};
    bf16x8 At[4][2], B0[2][2], B1[2][2];
    const char* cA = (const char*)g.A + (size_t)cur.pm * tstep; const char* cB = (const char*)g.Bt + (size_t)cur.pn * tstep;
    S.a_ready(cur);
    const char* gA = (const char*)g.A;
    if constexpr (GATHER) { PG8_GOFS(gc, cur); }
#define PG8_STAGE_A(bufoff, plain_base, kofs, ofs_half) do { if constexpr (GATHER) { PG8_STAGE_G(bufoff, gA + (kofs), ofs_half); } else { PG8_STAGE(bufoff, plain_base, voffA); } } while (0)
    PG8_STAGE(PG8_SB(0, 0), cB, voffB); PG8_STAGE_A(PG8_SA(0, 0), cA, 0, gc[0]); PG8_STAGE(PG8_SB(0, 1), cB + hstep, voffB); PG8_STAGE_A(PG8_SA(0, 1), cA + hstep, 0, gc[1]);
    if (wr == 1) PG8_BAR;
    PG8_WAIT_V(4); PG8_BAR;
    PG8_STAGE(PG8_SB(1, 0), cB + kstep, voffB); PG8_STAGE_A(PG8_SA(1, 0), cA + kstep, kstep, gc[0]); PG8_STAGE(PG8_SB(1, 1), cB + hstep + kstep, voffB);
    PG8_WAIT_V(6); PG8_BAR;
    PG8_STAMP();
    for (;;) {
        const bool has_next = S.next(ui + 1, nxt);
        const char* nA = has_next ? (const char*)g.A + (size_t)nxt.pm * tstep : cA; const char* nB = has_next ? (const char*)g.Bt + (size_t)nxt.pn * tstep : cB;
        if constexpr (GATHER) { if (has_next) { PG8_GOFS(gn, nxt); } else { _Pragma("unroll") for (int h_ = 0; h_ < 2; ++h_) _Pragma("unroll") for (int i_ = 0; i_ < 2; ++i_) gn[h_][i_] = gc[h_][i_]; } }
        for (int t = 0; t < nt; t += 2) {
            const bool last = (t == nt - 2);
            const char* a1 = cA + (size_t)(t + 1) * kstep;
            const char* a2 = last ? nA : cA + (size_t)(t + 2) * kstep; const char* b2 = last ? nB : cB + (size_t)(t + 2) * kstep;
            const char* a3 = a2 + kstep; const char* b3 = b2 + kstep;
            unsigned g2[2][2]; size_t k2 = 0;
            if constexpr (GATHER) { k2 = last ? 0 : (size_t)(t + 2) * kstep;
                _Pragma("unroll") for (int h_ = 0; h_ < 2; ++h_) _Pragma("unroll") for (int i_ = 0; i_ < 2; ++i_) g2[h_][i_] = last ? gn[h_][i_] : gc[h_][i_]; }
            if (last && has_next) S.a_ready(nxt);
            PG8_LDB(B0, 0, 0); PG8_SCHED; PG8_LDA(At, 0, 0); PG8_STAGE_A(PG8_SA(1, 1), a1 + hstep, (size_t)(t + 1) * kstep, gc[1]);
            PG8_WAIT_L(8); PG8_BAR; PG8_WAIT_L(0); PG8_MMA(0, 0, At, B0); PG8_BAR; PG8_SCHED;
            PG8_LDB(B1, 0, 1); PG8_STAGE(PG8_SB(0, 0), b2, voffB);
            PG8_BAR; PG8_WAIT_L(0); PG8_MMA(0, 1, At, B1); PG8_BAR;
            PG8_LDA(At, 0, 1); PG8_STAGE_A(PG8_SA(0, 0), a2, k2, g2[0]);
            PG8_BAR; PG8_WAIT_L(0); PG8_MMA(1, 0, At, B0); PG8_BAR; PG8_SCHED;
            PG8_STAGE(PG8_SB(0, 1), b2 + hstep, voffB);
            PG8_WAIT_V(6); PG8_BAR; PG8_MMA(1, 1, At, B1); PG8_BAR;
            PG8_LDB(B0, 1, 0); PG8_SCHED; PG8_LDA(At, 1, 0); PG8_STAGE_A(PG8_SA(0, 1), a2 + hstep, k2, g2[1]);
            PG8_WAIT_L(8); PG8_BAR; PG8_WAIT_L(0); PG8_MMA(0, 0, At, B0); PG8_BAR; PG8_SCHED;
            PG8_LDB(B1, 1, 1); PG8_STAGE(PG8_SB(1, 0), b3, voffB);
            PG8_BAR; PG8_WAIT_L(0); PG8_MMA(0, 1, At, B1); PG8_BAR;
            PG8_LDA(At, 1, 1); PG8_STAGE_A(PG8_SA(1, 0), a3, k2 + kstep, g2[0]);
            PG8_BAR; PG8_WAIT_L(0); PG8_MMA(1, 0, At, B0); PG8_BAR; PG8_SCHED;
            PG8_STAGE(PG8_SB(1, 1), b3 + hstep, voffB);
            PG8_WAIT_V(6); PG8_BAR; PG8_MMA(1, 1, At, B1); PG8_BAR;
        }
        PG8_STAMP();
        if constexpr (!Epi::AFTER_DRAIN) { E(acc, cur, wr, wc, fr, fq); S.done(cur); }
        PG8_STAMP();
        if (!has_next) break;
#pragma unroll
        for (int a = 0; a < 2; ++a)
#pragma unroll
            for (int b = 0; b < 2; ++b)
#pragma unroll
                for (int m = 0; m < 4; ++m)
#pragma unroll
                    for (int n = 0; n < 2; ++n) acc[a][b][m][n] = (f32x4){0.f, 0.f, 0.f, 0.f};
        cur = nxt; cA = nA; cB = nB; ++ui;
        if constexpr (GATHER) { _Pragma("unroll") for (int h_ = 0; h_ < 2; ++h_) _Pragma("unroll") for (int i_ = 0; i_ < 2; ++i_) gc[h_][i_] = gn[h_][i_]; }
    }
    PG8_WAIT_V(0);
    if (wr == 0) PG8_BAR;
    PG8_BAR;
    if constexpr (Epi::AFTER_DRAIN) { E.fused(acc, cur, wr, wc, fr, fq, lds, wid, lane); S.done(cur); }
    PG8_STAMP();
    if (STAMP && wid == 0) { stamps[lane] = lane < nts ? (((unsigned long long)(unsigned)ts_hi << 32) | (unsigned)ts_lo) : 0ull;
        if (lane == 62) stamps[62] = rt_entry; if (lane == 63) stamps[63] = (unsigned long long)wall_clock64(); }
#undef PG8_STAMP
#undef PG8_SA
#undef PG8_SB
#undef PG8_STAGE
#undef PG8_STAGE_A
#undef PG8_STAGE_G
#undef PG8_GOFS
#undef PG8_LDA
#undef PG8_LDB
#undef PG8_MMA
#undef PG8_WAIT_V
#undef PG8_WAIT_L
#undef PG8_BAR
#undef PG8_SCHED
}
}
#define XB_TMO      128
#define XB_XCNT(j)  (256  + 64 * (j))
#define XB_XSUB(j)  (1280 + 64 * (j))
#define XB_XGEN(j)  (2304 + 64 * (j))
#define XB_TOP      3328
#define XB_TOPGEN   3392
#define XCD_BAR_WORDS 3456
#define XB_SPIN_CAP (1u << 18)
#define LAS __attribute__((address_space(3)))

__device__ __forceinline__ unsigned xb_ld(unsigned* p)              { return __hip_atomic_load(p, __ATOMIC_RELAXED, __HIP_MEMORY_SCOPE_AGENT); }
__device__ __forceinline__ unsigned xb_add(unsigned* p, unsigned v) { return __hip_atomic_fetch_add(p, v, __ATOMIC_RELAXED, __HIP_MEMORY_SCOPE_AGENT); }
__device__ __forceinline__ unsigned xb_xcc_id() { return (unsigned)__builtin_amdgcn_s_getreg((3 << 11) | 20) & 0xFu; }
#define XB_SPIN(cond, bar) do { unsigned _sp = 0; while (cond) { __builtin_amdgcn_s_sleep(1); \
    if ((++_sp & 255u) == 0u) { if (xb_ld(&(bar)[XB_TMO])) break; if (_sp > XB_SPIN_CAP) { atomicAdd(&(bar)[XB_TMO], 1u); break; } } } } while (0)

struct XcdBarrier {
    unsigned* bar; unsigned x;
    volatile LAS unsigned* st;
};

__device__ __forceinline__ XcdBarrier xcd_barrier_post(unsigned* bar, volatile LAS unsigned* st) {
    XcdBarrier b; b.bar = bar; b.x = xb_xcc_id(); b.st = st;
    if (threadIdx.x == 0) (void)xb_add(&bar[XB_XCNT(b.x)], 1u);
    return b;
}
__device__ __forceinline__ void xcd_barrier_complete(unsigned* bar, unsigned x, unsigned& nloc, unsigned& nx) {
    const unsigned G = gridDim.x * gridDim.y * gridDim.z;
    unsigned sum, cnt, mine, sp = 0u;
    for (;;) {
        sum = 0u; cnt = 0u; mine = 0u;
#pragma unroll
        for (unsigned j = 0; j < 16; ++j) { const unsigned c = xb_ld(&bar[XB_XCNT(j)]); sum += c; cnt += (c > 0u) ? 1u : 0u; mine = (j == x) ? c : mine; }
        if (sum == G) break;
        __builtin_amdgcn_s_sleep(1);
        if ((++sp & 255u) == 0u) { if (xb_ld(&bar[XB_TMO])) break; if (sp > XB_SPIN_CAP) { atomicAdd(&bar[XB_TMO], 1u); break; } }
    }
    nloc = mine > 0u ? mine : 1u; nx = cnt > 0u ? cnt : 1u;
}

__device__ __forceinline__ void xcd_barrier(const XcdBarrier& b) {
    asm volatile("s_waitcnt vmcnt(0)" ::: "memory");
    __syncthreads();
    if (threadIdx.x == 0) {
        unsigned* bar = b.bar;
        __builtin_amdgcn_s_waitcnt(0);
        unsigned nloc = b.st[0], nx = b.st[1];
        if (nloc == 0u) { xcd_barrier_complete(bar, b.x, nloc, nx); b.st[0] = nloc; b.st[1] = nx; }
        const unsigned old = xb_add(&bar[XB_XSUB(b.x)], 1u);
        const unsigned gen = old / nloc;
        if (old + 1u == (gen + 1u) * nloc) {
            __builtin_amdgcn_fence(__ATOMIC_RELEASE, "agent");
            asm volatile("s_waitcnt vmcnt(0)" ::: "memory");
            const unsigned og = xb_add(&bar[XB_TOP], 1u);
            const unsigned tg = og / nx;
            if (og + 1u == (tg + 1u) * nx) xb_add(&bar[XB_TOPGEN], 1u);
            else XB_SPIN(xb_ld(&bar[XB_TOPGEN]) == tg, bar);
            __builtin_amdgcn_fence(__ATOMIC_ACQUIRE, "agent");
            xb_add(&bar[XB_XGEN(b.x)], 1u);
            asm volatile("s_waitcnt vmcnt(0)" ::: "memory");
        } else {
            XB_SPIN(xb_ld(&bar[XB_XGEN(b.x)]) == gen, bar);
            __builtin_amdgcn_fence(__ATOMIC_ACQUIRE, "agent");
            asm volatile("s_waitcnt vmcnt(0)" ::: "memory");
        }
    }
    __syncthreads();
}

namespace mk {
typedef unsigned short bf16_t;
typedef short bf16x8 __attribute__((ext_vector_type(8)));
typedef float f32x4 __attribute__((ext_vector_type(4)));
typedef unsigned u32x2 __attribute__((ext_vector_type(2)));
typedef unsigned u32x4 __attribute__((ext_vector_type(4)));
#define LDSP __attribute__((address_space(3)))

constexpr int D = 2048, NB = 4, SEQ = 4096, DEPTH = 4, CTX = 256, T = CTX + SEQ, MROWS = NB * T;
constexpr int NIN = 7728, NINP = 7936, NCH = T / 64;
constexpr int C_AQ = 0, C_AK = 512, C_AV = 1024, C_AZ = 1536, C_ABETA = 2048, C_ADEC = 2056,
              C_BQ = 2064, C_BK = 2320, C_BV = 2576, C_BR = 3088, C_BCODE = 3600,
              C_CQ = 3632, C_CI = 4144, C_CG = 4656, C_CF = 5168, C_DQ = 6192, C_DK = 6704, C_DV = 7216;
constexpr int NEXP = 16, EROWS = 2304;
constexpr float ALPHA = 1.681792830507429f;
constexpr float LN_EPS = 1e-5f, NORM_EPS = 1e-6f;
constexpr int NCC = NB * 4 * 2 * NCH;

enum { I_X = 0, I_C, I_CTX, I_CCTX, I_WMOD, I_BMOD, I_WIN, I_WOUT, I_LNG, I_LNB, I_CONV, I_ALOG, I_DTB, I_GDNN, I_GLAW, I_GLAB, I_GLAN, I_HGAM, I_HGN, I_RPB, I_ROUT, I_W1, I_W3, I_W2 };

constexpr size_t WS_BAR = 0;
constexpr size_t WS_MODV = 16384;
constexpr size_t WS_AFF = WS_MODV + 983040;
constexpr size_t WS_INV = WS_AFF + 1114112;
constexpr size_t WS_IDX = WS_INV + 1114112;
constexpr size_t WS_GATE = WS_IDX + 147456;
constexpr size_t WS_WIN = WS_GATE + 147456;
constexpr size_t WS_WOUT = WS_WIN + 32505856;
constexpr size_t WS_W13 = WS_WOUT + 8388608;
constexpr size_t WS_W2 = WS_W13 + 134217728;
constexpr size_t WSET_BYTES = 32505856 + 8388608 + 134217728 + 67108864;
constexpr size_t WS_X = WS_W2 + 67108864 + WSET_BYTES;
constexpr size_t WS_X1 = WS_X + 142606336;
constexpr size_t WS_U = WS_X1 + 142606336;
constexpr size_t WS_MIX = WS_U + 71303168;
constexpr size_t WS_RA = WS_MIX + 71303168;
constexpr size_t RA_PROJ = 0;
constexpr size_t RA_GM = RA_PROJ + 276299776;
constexpr size_t RA_GB = RA_GM + 71303168;
constexpr size_t RA_GQ = RA_GB + 71303168;
constexpr size_t RA_GO = RA_GQ + 35651584;
constexpr size_t RA_HB = RA_GO + 35651584;
constexpr size_t RA_HQ = RA_HB + 71303168;
constexpr size_t RA_HO = RA_HQ + 35651584;
constexpr size_t RA_HA = RA_HO + 35651584;
constexpr size_t RA_LB = RA_HA + 1114112;
constexpr size_t RA_LQ = RA_LB + 35651584;
constexpr size_t RA_LO = RA_LQ + 17825792;
constexpr size_t RA_LA = RA_LO + 35651584;
constexpr size_t RA_OB = RA_LA + 557056;
constexpr size_t RA_END = RA_OB + 106954752;
constexpr size_t RA_TBUF = 0;
constexpr size_t RA_XS = 142606336;
constexpr size_t RA_HID = RA_XS + 150994944;
constexpr size_t RA_YS = RA_HID + 75497472;
constexpr size_t WS_TOTAL = WS_RA + RA_END;
static_assert(RA_YS + 150994944 <= RA_END, "region A");

struct Ctx {
    const float* in[24]; float* out; unsigned char* ws;
    LDSP unsigned char* lds; int tid, lane, wave, G, bid;
};

__device__ __forceinline__ float bf2f(unsigned b) { return __uint_as_float(b << 16); }
__device__ __forceinline__ float bflo(unsigned u) { return __uint_as_float(u << 16); }
__device__ __forceinline__ float bfhi(unsigned u) { return __uint_as_float(u & 0xffff0000u); }
__device__ __forceinline__ unsigned pk2(float lo, float hi) { return pg8::cvt_pk_bf16(lo, hi); }
__device__ __forceinline__ bf16_t f2bf(float x) { return (bf16_t)(pk2(x, 0.f) & 0xffffu); }
__device__ __forceinline__ float sigmoidf_(float x) { return __builtin_amdgcn_rcpf(1.f + __builtin_amdgcn_exp2f(-1.4426950408889634f * x)); }
__device__ __forceinline__ float siluf_(float x) { return x * __builtin_amdgcn_rcpf(1.f + __builtin_amdgcn_exp2f(-1.4426950408889634f * x)); }
__device__ __forceinline__ float softplusf_(float x) { return x > 20.f ? x : log1pf(__expf(x)); }
__device__ __forceinline__ float wsum(float v) {
#pragma unroll
    for (int m = 32; m >= 1; m >>= 1) v += __shfl_xor(v, m);
    return v;
}

template <int KS>
__device__ __forceinline__ f32x4 mma_tile(const LDSP bf16_t* a, int lda, const LDSP bf16_t* b, int ldb, f32x4 acc, int lane) {
    const int r = lane & 15, q = lane >> 4;
#pragma unroll
    for (int kk = 0; kk < KS; ++kk) {
        const bf16x8 af = *(const LDSP bf16x8*)(a + r * lda + kk * 32 + q * 8);
        const bf16x8 bf = *(const LDSP bf16x8*)(b + r * ldb + kk * 32 + q * 8);
        acc = __builtin_amdgcn_mfma_f32_16x16x32_bf16(af, bf, acc, 0, 0, 0);
    }
    return acc;
}
typedef short s16x4 __attribute__((ext_vector_type(4)));
__device__ __forceinline__ bf16x8 frag_tr16(const LDSP bf16_t* base, int ld, int lane) {
    const int g = lane >> 4, i = lane & 15;
    const LDSP bf16_t* p = base + (8 * g + (i >> 2)) * ld + 4 * (i & 3);
    const s16x4 lo = __builtin_amdgcn_ds_read_tr16_b64_v4i16((LDSP s16x4*)p);
    const s16x4 hi = __builtin_amdgcn_ds_read_tr16_b64_v4i16((LDSP s16x4*)(p + 4 * ld));
    return (bf16x8){lo[0], lo[1], lo[2], lo[3], hi[0], hi[1], hi[2], hi[3]};
}
__device__ __forceinline__ u32x2 pack4(f32x4 v) { u32x2 o; o.x = pk2(v[0], v[1]); o.y = pk2(v[2], v[3]); return o; }

__device__ __forceinline__ int tok_of(int n, int dir, int i) { return n * 64 + (dir ? 63 - i : i); }

__device__ __forceinline__ void modv_fill_s(const Ctx& c) {
    LDSP float* s = (LDSP float*)c.lds;
    for (int i = c.tid; i < 5 * 2048; i += 512) {
        const int r = i >> 11, k = i & 2047;
        const float v = r < 4 ? c.in[I_C][r * 2048 + k] : c.in[I_CCTX][k];
        s[i] = siluf_(v);
    }
    __syncthreads();
}
__device__ __forceinline__ void modv_unit(const Ctx& c, int unit) {
    const int l = unit / 48, cb = unit % 48;
    LDSP float* s = (LDSP float*)c.lds;
    LDSP float* red = s + 5 * 2048;
    const float* W = c.in[I_WMOD] + (size_t)l * 2048 * 12288 + cb * 256 + c.lane * 4;
    const int k0 = c.wave * 256;
    f32x4 acc[5];
#pragma unroll
    for (int r = 0; r < 5; ++r) acc[r] = (f32x4){0.f, 0.f, 0.f, 0.f};
#pragma unroll 8
    for (int k = 0; k < 256; ++k) {
        const f32x4 w = *(const f32x4*)(W + (size_t)(k0 + k) * 12288);
#pragma unroll
        for (int r = 0; r < 5; ++r) { const float sv = s[r * 2048 + k0 + k]; acc[r] += w * sv; }
    }
#pragma unroll
    for (int r = 0; r < 5; ++r) *(LDSP f32x4*)(red + (c.wave * 5 + r) * 256 + c.lane * 4) = acc[r];
    __syncthreads();
    float* modv = (float*)(c.ws + WS_MODV);
    for (int o = c.tid; o < 5 * 256; o += 512) {
        const int r = o >> 8, col = o & 255;
        float sum = 0.f;
#pragma unroll
        for (int w = 0; w < 8; ++w) sum += red[(w * 5 + r) * 256 + col];
        modv[(size_t)(l * 5 + r) * 12288 + cb * 256 + col] = sum + c.in[I_BMOD][l * 12288 + cb * 256 + col];
    }
    __syncthreads();
}

struct CJob { const float* src; bf16_t* dst; int ldsrc, lddst, nvalid; };
constexpr int CONV_JOBS = 992 + 256 + 3 * 2048;
__device__ __forceinline__ CJob conv_desc(const Ctx& c, int l, int job) {
    CJob d;
    if (job < 992) {
        const int kt = job & 15, nt = job >> 4;
        d.src = c.in[I_WIN] + (size_t)l * 2048 * NIN + (size_t)kt * 128 * NIN + nt * 128; d.ldsrc = NIN; d.nvalid = NIN - nt * 128;
        d.dst = (bf16_t*)(c.ws + WS_WIN + (l & 1) * WSET_BYTES) + (size_t)nt * 128 * 2048 + kt * 128; d.lddst = 2048;
    } else if (job < 1248) {
        const int j = job - 992, kt = j & 15, nt = j >> 4;
        d.src = c.in[I_WOUT] + (size_t)l * 2048 * 2048 + (size_t)kt * 128 * 2048 + nt * 128; d.ldsrc = 2048; d.nvalid = 128;
        d.dst = (bf16_t*)(c.ws + WS_WOUT + (l & 1) * WSET_BYTES) + (size_t)nt * 128 * 2048 + kt * 128; d.lddst = 2048;
    } else if (job < 1248 + 4096) {
        const int j = job - 1248, which = j >> 11, jj = j & 2047, e = jj >> 7, rem = jj & 127, kt = rem & 15, nt = rem >> 4;
        d.src = c.in[which ? I_W3 : I_W1] + ((size_t)(l * 16 + e) * 2048 + (size_t)kt * 128) * 1024 + nt * 128; d.ldsrc = 1024; d.nvalid = 128;
        d.dst = (bf16_t*)(c.ws + WS_W13 + (l & 1) * WSET_BYTES) + ((size_t)e * 2048 + nt * 256 + which * 128) * 2048 + kt * 128; d.lddst = 2048;
    } else {
        const int j = job - 1248 - 4096, e = j >> 7, rem = j & 127, kt = rem & 7, nt = rem >> 3;
        d.src = c.in[I_W2] + ((size_t)(l * 16 + e) * 1024 + (size_t)kt * 128) * 2048 + nt * 128; d.ldsrc = 2048; d.nvalid = 128;
        d.dst = (bf16_t*)(c.ws + WS_W2 + (l & 1) * WSET_BYTES) + ((size_t)e * 2048 + nt * 128) * 1024 + kt * 128; d.lddst = 1024;
    }
    return d;
}
__device__ __forceinline__ void conv_load(const CJob& d, int n4, int kr, f32x4 (&v)[8]) {
#pragma unroll
    for (int p = 0; p < 4; ++p)
#pragma unroll
        for (int hh = 0; hh < 2; ++hh) v[2 * p + hh] = (4 * n4 < d.nvalid) ? *(const f32x4*)(d.src + (size_t)(32 * p + 2 * kr + hh) * d.ldsrc + 4 * n4) : (f32x4){0.f, 0.f, 0.f, 0.f};
}
__device__ __forceinline__ void conv_tile(const Ctx& c, const CJob& d, LDSP unsigned* Tt, int n4, int kr, const f32x4 (&v)[8]) {
#pragma unroll
    for (int p = 0; p < 4; ++p)
#pragma unroll
        for (int i = 0; i < 4; ++i) Tt[(4 * n4 + i) * 65 + 16 * p + kr] = pk2(v[2 * p][i], v[2 * p + 1][i]);
    __syncthreads();
#pragma unroll
    for (int q = 0; q < 4; ++q) {
        const int id = q * 512 + c.tid, n = id >> 4, kq = id & 15;
        const u32x4 o = (u32x4){Tt[n * 65 + 4 * kq], Tt[n * 65 + 4 * kq + 1], Tt[n * 65 + 4 * kq + 2], Tt[n * 65 + 4 * kq + 3]};
        *(u32x4*)(d.dst + (size_t)n * d.lddst + kq * 8) = o;
    }
}
__device__ __forceinline__ void convert_phase(const Ctx& c, int l) {
    LDSP unsigned* Tb = (LDSP unsigned*)c.lds;
    const int n4 = c.tid & 31, kr = c.tid >> 5;
    const int G = c.G;
    int job = c.bid;
    if (job >= CONV_JOBS) return;
    CJob ja = conv_desc(c, l, job), jb = ja;
    f32x4 va[8], vb[8];
    conv_load(ja, n4, kr, va);
    if (job + G < CONV_JOBS) { jb = conv_desc(c, l, job + G); conv_load(jb, n4, kr, vb); }
    for (; job < CONV_JOBS; job += 2 * G) {
        conv_tile(c, ja, Tb, n4, kr, va);
        const CJob ja_done = ja;
        if (job + 2 * G < CONV_JOBS) { ja = conv_desc(c, l, job + 2 * G); conv_load(ja, n4, kr, va); }
        if (job + G < CONV_JOBS) {
            conv_tile(c, jb, Tb + 128 * 65, n4, kr, vb);
            if (job + 3 * G < CONV_JOBS) { jb = conv_desc(c, l, job + 3 * G); conv_load(jb, n4, kr, vb); }
        }
        (void)ja_done;
    }
    __syncthreads();
}

__device__ __forceinline__ void convert_queue(const Ctx& c, int l, int quota) {
    unsigned* qh = (unsigned*)(c.ws + WS_BAR) + 3900 + 16 * l;
    volatile LDSP unsigned* tk = (volatile LDSP unsigned*)(c.lds + 147456 - 64);
    LDSP unsigned* Tb = (LDSP unsigned*)c.lds;
    const int n4 = c.tid & 31, kr = c.tid >> 5;
    for (int it = 0; it < quota; ++it) {
        __syncthreads();
        if (c.tid == 0) tk[0] = __hip_atomic_fetch_add(qh, 1u, __ATOMIC_RELAXED, __HIP_MEMORY_SCOPE_AGENT);
        __syncthreads();
        const int job = (int)tk[0];
        if (job >= CONV_JOBS) break;
        const CJob d = conv_desc(c, l, job);
        f32x4 v[8];
        conv_load(d, n4, kr, v);
        conv_tile(c, d, Tb, n4, kr, v);
    }
    __syncthreads();
}

__device__ __forceinline__ void row_stats(const f32x4 (&v)[8], float& mu, float& rstd) {
    float s = 0.f;
#pragma unroll
    for (int j = 0; j < 8; ++j) s += v[j][0] + v[j][1] + v[j][2] + v[j][3];
    mu = wsum(s) * (1.f / 2048.f);
    float q = 0.f;
#pragma unroll
    for (int j = 0; j < 8; ++j) { const f32x4 d = v[j] - mu; q += d[0] * d[0] + d[1] * d[1] + d[2] * d[2] + d[3] * d[3]; }
    rstd = rsqrtf(wsum(q) * (1.f / 2048.f) + LN_EPS);
}
__device__ __forceinline__ void modulate_store(const f32x4 (&v)[8], const float* shift, const float* scale, bf16_t* urow, int lane) {
    float mu, rstd; row_stats(v, mu, rstd);
#pragma unroll
    for (int j = 0; j < 8; ++j) {
        const int col = 256 * j + 4 * lane;
        const f32x4 sh = *(const f32x4*)(shift + col), sc = *(const f32x4*)(scale + col);
        const f32x4 y = (v[j] - mu) * rstd * (sc + 1.f) + sh;
        *(u32x2*)(urow + col) = pack4(y);
    }
}
__device__ __forceinline__ void phase_l0_modulate(const Ctx& c) {
    const float* modv = (const float*)(c.ws + WS_MODV);
    float* X = (float*)(c.ws + WS_X); bf16_t* U = (bf16_t*)(c.ws + WS_U);
    for (int row = c.bid * 8 + c.wave; row < MROWS; row += c.G * 8) {
        const int b = row / T, t = row % T;
        const float* src = t < CTX ? c.in[I_CTX] + ((size_t)b * CTX + t) * D : c.in[I_X] + ((size_t)b * SEQ + (t - CTX)) * D;
        const int r = t < CTX ? 4 : b;
        f32x4 v[8];
#pragma unroll
        for (int j = 0; j < 8; ++j) v[j] = *(const f32x4*)(src + 256 * j + 4 * c.lane);
#pragma unroll
        for (int j = 0; j < 8; ++j) *(f32x4*)(X + (size_t)row * D + 256 * j + 4 * c.lane) = v[j];
        modulate_store(v, modv + (size_t)(0 * 5 + r) * 12288, modv + (size_t)(0 * 5 + r) * 12288 + 2048, U + (size_t)row * D, c.lane);
    }
}

constexpr int GP_RAW = 0;
constexpr int GP_UT = 0;
constexpr int GP_WT = 18432;
constexpr int GP_A = 36864;
constexpr int GP_AP = 65;
constexpr int GP_TB = 53504;
constexpr int GP_CW = 53312;
constexpr int GP_Q = GP_CW + 7680;
constexpr int GP_K = GP_Q + 17408;
constexpr int GP_V = GP_K + 17408;
constexpr int GP_KDT = GP_V + 17408;
constexpr int GP_P = GP_KDT + 18432;
constexpr int GP_SM = GP_P + 9216;
constexpr int GP_END = GP_SM + 1024;
static_assert(GP_END <= 160 * 1024, "gdn prep lds");

#ifdef MK_GSTAMP
#define GST(k) do { if (c.bid == 0 && tid == 0) { const unsigned long long t_ = __builtin_amdgcn_s_memrealtime(); gst[k] += t_ - gst[8]; gst[8] = t_; } } while (0)
#else
#define GST(k)
#endif
__device__ __forceinline__ void gdn_prep_unit(const Ctx& c, int l, int cc) {
    const int n = cc % NCH, dir = (cc / NCH) & 1, h = (cc / (NCH * 2)) & 3, b = cc / (NCH * 8);
    int tid_ = c.tid; asm volatile("" : "+v"(tid_));
    const int tid = tid_, lane = tid_ & 63, wave = c.wave;
    LDSP unsigned char* L = c.lds;
    LDSP bf16_t* raw = (LDSP bf16_t*)(L + GP_RAW);
    LDSP float* cw = (LDSP float*)(L + GP_CW);
    LDSP bf16_t* Qs = (LDSP bf16_t*)(L + GP_Q);
    LDSP bf16_t* Ks = (LDSP bf16_t*)(L + GP_K);
    LDSP bf16_t* Vs = (LDSP bf16_t*)(L + GP_V);
    LDSP bf16_t* KdT = (LDSP bf16_t*)(L + GP_KDT);
    LDSP bf16_t* Pm = (LDSP bf16_t*)(L + GP_P);
    LDSP bf16_t* UT = (LDSP bf16_t*)(L + GP_UT);
    LDSP bf16_t* WT = (LDSP bf16_t*)(L + GP_WT);
    LDSP float* Am = (LDSP float*)(L + GP_A);
    LDSP float* sm = (LDSP float*)(L + GP_SM);
    const bf16_t* proj = (const bf16_t*)(c.ws + WS_RA + RA_PROJ);
    const int seg0 = n < 4 ? 0 : CTX, seg1 = n < 4 ? CTX : T;
    const size_t rowb = (size_t)b * T;
#ifdef MK_GSTAMP
    volatile LDSP unsigned long long* gst = (volatile LDSP unsigned long long*)(c.lds + 147456 - 48 - 80);
    if (c.bid == 0 && tid == 0) gst[8] = __builtin_amdgcn_s_memrealtime();
#endif

    for (int ch = tid; ch < 68 * 48; ch += 512) {
        const int rr = ch / 48, c16 = ch % 48, part = c16 >> 4, d8 = c16 & 15;
        const int t = n * 64 - 2 + rr;
        u32x4 v = (u32x4){0u, 0u, 0u, 0u};
        if (t >= seg0 && t < seg1) v = *(const u32x4*)(proj + (rowb + t) * NINP + part * 512 + h * 128 + d8 * 8);
        *(LDSP u32x4*)(raw + rr * 392 + part * 128 + d8 * 8) = v;
    }
    for (int i = tid; i < 5 * 384; i += 512) {
        const int j = i / 384, cidx = i % 384, part = cidx >> 7, d = cidx & 127;
        cw[i] = c.in[I_CONV][(size_t)(l * 5 + j) * 1536 + part * 512 + h * 128 + d];
    }
    if (wave == 0) {
        const int t = tok_of(n, dir, lane);
        const bf16_t* pr = proj + (rowb + t) * NINP;
        const float beta = sigmoidf_(bf2f(pr[C_ABETA + dir * 4 + h]));
        const float la = -__expf(c.in[I_ALOG][l * 8 + dir * 4 + h]) * softplusf_(bf2f(pr[C_ADEC + dir * 4 + h]) + c.in[I_DTB][l * 8 + dir * 4 + h]);
        float g = la;
#pragma unroll
        for (int m = 1; m < 64; m <<= 1) { const float o = __shfl_up(g, m); if (lane >= m) g += o; }
        const float gend = __shfl(g, 63);
        sm[lane] = g; sm[64 + lane] = beta; sm[128 + lane] = __expf(g); sm[192 + lane] = __expf(gend - g);
    }
    __syncthreads();
    GST(0);
    {
        const int i = tid >> 3, gq = tid & 7;
        const int rc = (dir ? 63 - i : i) + 2;
#pragma unroll
        for (int part = 0; part < 3; ++part) {
            float a[16];
#pragma unroll
            for (int e = 0; e < 16; ++e) a[e] = 0.f;
#pragma unroll
            for (int j = 0; j < 5; ++j) {
                const LDSP bf16_t* rp = raw + (rc - 2 + j) * 392 + part * 128 + gq * 16;
                const LDSP float* wp = cw + j * 384 + part * 128 + gq * 16;
#pragma unroll
                for (int hf = 0; hf < 2; ++hf) {
                    const u32x4 r4 = *(const LDSP u32x4*)(rp + hf * 8);
                    const f32x4 w0 = *(const LDSP f32x4*)(wp + hf * 8), w1 = *(const LDSP f32x4*)(wp + hf * 8 + 4);
                    a[hf * 8 + 0] += bflo(r4[0]) * w0[0]; a[hf * 8 + 1] += bfhi(r4[0]) * w0[1]; a[hf * 8 + 2] += bflo(r4[1]) * w0[2]; a[hf * 8 + 3] += bfhi(r4[1]) * w0[3];
                    a[hf * 8 + 4] += bflo(r4[2]) * w1[0]; a[hf * 8 + 5] += bfhi(r4[2]) * w1[1]; a[hf * 8 + 6] += bflo(r4[3]) * w1[2]; a[hf * 8 + 7] += bfhi(r4[3]) * w1[3];
                }
            }
            float ss = 0.f;
#pragma unroll
            for (int e = 0; e < 16; ++e) { a[e] = siluf_(a[e]); ss += a[e] * a[e]; }
            float sc = 1.f;
            if (part < 2) {
#pragma unroll
                for (int m = 1; m < 8; m <<= 1) ss += __shfl_xor(ss, m);
                sc = rsqrtf(ss + NORM_EPS) * (part == 0 ? 0.08838834764831845f : 1.f);
            }
            LDSP bf16_t* dq = (part == 0 ? Qs : part == 1 ? Ks : Vs) + i * 136 + gq * 16;
            *(LDSP u32x4*)dq = (u32x4){pk2(a[0] * sc, a[1] * sc), pk2(a[2] * sc, a[3] * sc), pk2(a[4] * sc, a[5] * sc), pk2(a[6] * sc, a[7] * sc)};
            *(LDSP u32x4*)(dq + 8) = (u32x4){pk2(a[8] * sc, a[9] * sc), pk2(a[10] * sc, a[11] * sc), pk2(a[12] * sc, a[13] * sc), pk2(a[14] * sc, a[15] * sc)};
            asm volatile("" ::: "memory");
        }
    }
    __syncthreads();
    GST(1);
#pragma unroll
    for (int p = 0; p < 2; ++p) {
        const int id = p * 512 + tid, d = id & 127, i0 = (id >> 7) * 8;
        unsigned w[4];
#pragma unroll
        for (int e = 0; e < 8; e += 2) w[e >> 1] = pk2(bf2f(Ks[(i0 + e) * 136 + d]) * sm[192 + i0 + e], bf2f(Ks[(i0 + e + 1) * 136 + d]) * sm[192 + i0 + e + 1]);
        *(LDSP u32x4*)(KdT + d * 72 + i0) = (u32x4){w[0], w[1], w[2], w[3]};
    }
#pragma unroll
    for (int tt = 0; tt < 4; ++tt) {
        const int id = wave * 4 + tt, which = id >> 4, ti = (id & 15) >> 2, tj = id & 3;
        const int r = lane & 15, q4 = lane >> 4;
        if (which == 0) {
            if (tj <= ti) {
                f32x4 a = mma_tile<4>(Ks + ti * 16 * 136, 136, Ks + tj * 16 * 136, 136, (f32x4){0.f, 0.f, 0.f, 0.f}, lane);
                const int j = tj * 16 + r; const float gj = sm[j];
#pragma unroll
                for (int e = 0; e < 4; ++e) { const int i = ti * 16 + q4 * 4 + e; Am[i * GP_AP + j] = (i > j) ? sm[64 + i] * a[e] * __expf(sm[i] - gj) : 0.f; }
            }
        } else {
            f32x4 o = (f32x4){0.f, 0.f, 0.f, 0.f};
            if (tj <= ti) {
                const f32x4 a = mma_tile<4>(Ks + tj * 16 * 136, 136, Qs + ti * 16 * 136, 136, (f32x4){0.f, 0.f, 0.f, 0.f}, lane);
                const int i = ti * 16 + r; const float gi = sm[i];
#pragma unroll
                for (int e = 0; e < 4; ++e) { const int j = tj * 16 + q4 * 4 + e; o[e] = (i >= j) ? a[e] * __expf(gi - sm[j]) : 0.f; }
            }
            *(LDSP u32x2*)(Pm + (ti * 16 + r) * 72 + tj * 16 + q4 * 4) = pack4(o);
        }
    }
    __syncthreads();
    GST(2);
    {
        LDSP float* TB = (LDSP float*)(L + GP_TB);
        const int r = lane & 15, q4 = lane >> 4;
        if (wave == 0) {
            const int I = lane >> 4, cidx = lane & 15;
            float x[16];
#pragma unroll
            for (int i = 0; i < 16; ++i) {
                float v = (i == cidx) ? 1.f : 0.f;
#pragma unroll
                for (int j = 0; j < i; ++j) v -= Am[(16 * I + i) * GP_AP + 16 * I + j] * x[j];
                x[i] = v;
            }
#pragma unroll
            for (int i = 0; i < 16; ++i) TB[(I * 16 + i) * 16 + cidx] = x[i];
        }
        f32x4 acc[4][2];
        const LDSP bf16_t* src = wave < 4 ? Vs : Ks;
        const int cb = (wave & 3) * 32;
#pragma unroll
        for (int I = 0; I < 4; ++I)
#pragma unroll
            for (int t = 0; t < 2; ++t)
#pragma unroll
                for (int e = 0; e < 4; ++e) {
                    const int row = 16 * I + 4 * q4 + e;
                    acc[I][t][e] = sm[64 + row] * bf2f(src[row * 136 + cb + 16 * t + r]) * (wave < 4 ? 1.f : sm[128 + row]);
                }
        __syncthreads();
        LDSP bf16_t* dstp = wave < 4 ? UT : WT;
#pragma unroll
        for (int I = 0; I < 4; ++I) {
            f32x4 x[2] = {(f32x4){0.f, 0.f, 0.f, 0.f}, (f32x4){0.f, 0.f, 0.f, 0.f}};
#pragma unroll
            for (int s4 = 0; s4 < 4; ++s4) {
                const float a = TB[(I * 16 + r) * 16 + 4 * q4 + s4];
#pragma unroll
                for (int t = 0; t < 2; ++t) x[t] = __builtin_amdgcn_mfma_f32_16x16x4f32(a, acc[I][t][s4], x[t], 0, 0, 0);
            }
#pragma unroll
            for (int Ip = I + 1; Ip < 4; ++Ip)
#pragma unroll
                for (int s4 = 0; s4 < 4; ++s4) {
                    const float a = -Am[(16 * Ip + r) * GP_AP + 16 * I + 4 * q4 + s4];
#pragma unroll
                    for (int t = 0; t < 2; ++t) acc[Ip][t] = __builtin_amdgcn_mfma_f32_16x16x4f32(a, x[t][s4], acc[Ip][t], 0, 0, 0);
                }
#pragma unroll
            for (int t = 0; t < 2; ++t) *(LDSP u32x2*)(dstp + (cb + 16 * t + r) * 72 + 16 * I + 4 * q4) = pack4(x[t]);
        }
    }
    __syncthreads();
    GST(3);
    {
        const size_t cs = (size_t)n * 32 + cc / NCH;
        bf16_t* Mg = (bf16_t*)(c.ws + WS_RA + RA_GM) + cs * 16384;
        bf16_t* Bg = (bf16_t*)(c.ws + WS_RA + RA_GB) + cs * 16384;
        bf16_t* Qg = (bf16_t*)(c.ws + WS_RA + RA_GQ) + cs * 8192;
        bf16_t* Og = (bf16_t*)(c.ws + WS_RA + RA_GO) + cs * 8192;
        const float ge = sm[128 + 63];
        const int r = lane & 15, q4 = lane >> 4;
        const f32x4 z = (f32x4){0.f, 0.f, 0.f, 0.f};
        for (int id = wave; id < 192; id += 8) {
            if (id < 32) {
                const int td = id >> 2, ti = id & 3;
                const f32x4 a = mma_tile<2>(WT + td * 16 * 72, 72, Pm + ti * 16 * 72, 72, z, lane);
                const int i = ti * 16 + r, d0 = td * 16 + q4 * 4; const float egi = sm[128 + i];
                f32x4 o;
#pragma unroll
                for (int e = 0; e < 4; ++e) o[e] = bf2f(Qs[i * 136 + d0 + e]) * egi - a[e];
                *(u32x2*)(Qg + (((ti * 4 + (td >> 1)) * 4 + ((2 * td + (q4 >> 1)) & 3)) * 16 + r) * 8 + 4 * (q4 & 1)) = pack4(o);
            } else if (id < 64) {
                const int td = (id - 32) >> 2, ti = id & 3;
                const f32x4 a = mma_tile<2>(UT + td * 16 * 72, 72, Pm + ti * 16 * 72, 72, z, lane);
                *(u32x2*)(Og + ((ti * 8 + td) * 64 + lane) * 4) = pack4(a);
            } else if (id < 128) {
                const int tc = (id - 64) >> 3, tr = id & 7;
                const f32x4 a = mma_tile<2>(WT + tc * 16 * 72, 72, KdT + tr * 16 * 72, 72, z, lane);
                const int dk = tr * 16 + r, d0 = tc * 16 + q4 * 4;
                f32x4 o;
#pragma unroll
                for (int e = 0; e < 4; ++e) o[e] = ((dk == d0 + e) ? ge : 0.f) - a[e];
                *(u32x2*)(Mg + (((tr * 4 + (tc >> 1)) * 4 + ((2 * tc + (q4 >> 1)) & 3)) * 16 + r) * 8 + 4 * (q4 & 1)) = pack4(o);
            } else {
                const int tr = (id - 128) >> 3, tc = id & 7;
                const f32x4 a = mma_tile<2>(KdT + tr * 16 * 72, 72, UT + tc * 16 * 72, 72, z, lane);
                *(u32x2*)(Bg + ((tc * 8 + tr) * 64 + lane) * 4) = pack4(a);
            }
        }
    }
    __syncthreads();
    GST(4);
}

constexpr int DP_QS = 0;
constexpr int DP_KSELF = 17408;
constexpr int DP_KSC = 34816;
constexpr int DP_KDT = 60928;
constexpr int DP_VT = 79360;
constexpr int DP_P = 97792;
constexpr int DP_TOT = 107008;
constexpr int DP_CODE = 111104;
constexpr int DP_QG = 115200;
constexpr int DP_END = 132608;

template <int MIX>
__device__ __forceinline__ void diag_prep_unit(const Ctx& c, int l, int cc) {
    constexpr int DK = (MIX == 1) ? 128 : 64;
    constexpr int PQ = DK + 8;
    const int n = cc % NCH, dir = (cc / NCH) & 1, h = (cc / (NCH * 2)) & 3, b = cc / (NCH * 8);
    const int tid = c.tid, lane = c.lane, wave = c.wave;
    LDSP unsigned char* L = c.lds;
    LDSP bf16_t* Qs = (LDSP bf16_t*)(L + DP_QS);
    LDSP bf16_t* Kself = (LDSP bf16_t*)(L + DP_KSELF);
    LDSP bf16_t* Ksc = (LDSP bf16_t*)(L + DP_KSC);
    LDSP bf16_t* KdT = (LDSP bf16_t*)(L + DP_KDT);
    LDSP bf16_t* VT = (LDSP bf16_t*)(L + DP_VT);
    LDSP bf16_t* Pm = (LDSP bf16_t*)(L + DP_P);
    LDSP float* tot = (LDSP float*)(L + DP_TOT);
    LDSP float* code = (LDSP float*)(L + DP_CODE);
    LDSP bf16_t* Qt = (LDSP bf16_t*)(L + DP_QG);
    const bf16_t* proj = (const bf16_t*)(c.ws + WS_RA + RA_PROJ);
    const size_t rowb = (size_t)b * T;
    bf16_t* Bg; bf16_t* Qg; bf16_t* Og; float* Ag;
    const size_t cs = (size_t)n * 32 + cc / NCH;
    if (MIX == 1) { Bg = (bf16_t*)(c.ws + WS_RA + RA_HB) + cs * 16384; Qg = (bf16_t*)(c.ws + WS_RA + RA_HQ) + cs * 8192;
                    Og = (bf16_t*)(c.ws + WS_RA + RA_HO) + cs * 8192; Ag = (float*)(c.ws + WS_RA + RA_HA) + cs * 128; }
    else          { Bg = (bf16_t*)(c.ws + WS_RA + RA_LB) + cs * 8192; Qg = (bf16_t*)(c.ws + WS_RA + RA_LQ) + cs * 4096;
                    Og = (bf16_t*)(c.ws + WS_RA + RA_LO) + cs * 8192; Ag = (float*)(c.ws + WS_RA + RA_LA) + cs * 64; }

    {
        constexpr int CPR = DK / 8;
        const int vcol = (MIX == 1 ? C_CI : C_BV) + h * 128;
        const int qcol = (MIX == 1 ? C_CQ + h * 128 : C_BQ + h * 64), kcol = (MIX == 1 ? C_CF + dir * 512 + h * 128 : C_BK + h * 64);
#pragma unroll
        for (int p = 0; p < 2; ++p) {
            const int id = p * 512 + tid, i = id >> 4, c8 = id & 15;
            *(LDSP u32x4*)(VT + i * 136 + c8 * 8) = *(const u32x4*)(proj + (rowb + tok_of(n, dir, i)) * NINP + vcol + c8 * 8);
        }
#pragma unroll
        for (int p = 0; p < (64 * CPR) / 512; ++p) {
            const int id = p * 512 + tid, i = id / CPR, c8 = id % CPR;
            const bf16_t* pr = proj + (rowb + tok_of(n, dir, i)) * NINP;
            *(LDSP u32x4*)(Qs + i * PQ + c8 * 8) = *(const u32x4*)(pr + qcol + c8 * 8);
            *(LDSP u32x4*)(Kself + i * PQ + c8 * 8) = *(const u32x4*)(pr + kcol + c8 * 8);
        }
        if (MIX == 2) for (int i = tid; i < 64 * 16; i += 512) code[i] = bf2f(proj[(rowb + tok_of(n, dir, i >> 4)) * NINP + C_BCODE + dir * 16 + (i & 15)]);
        for (int i = tid; i < 64 * 36; i += 512) ((LDSP unsigned*)Pm)[i] = 0u;
    }
    __syncthreads();
    constexpr int TPT = DK / 8, NSUB = 64 / TPT;
    const int d = tid % DK, J = tid / DK, I = (J * TPT) >> 4;
    float qv[TPT], kv[TPT], bl[TPT];
    {
        float lb = 0.f, wg[16], bg = 0.f;
        if (MIX == 1) {
            const float* gam = c.in[I_HGAM] + (size_t)dir * DEPTH * 512 + h * 128 + d;
            float mx = gam[0];
#pragma unroll
            for (int i = 1; i < DEPTH; ++i) mx = fmaxf(mx, gam[i * 512]);
            float den = 0.f, num = 0.f;
#pragma unroll
            for (int i = 0; i < DEPTH; ++i) { const float e = __expf(gam[i * 512] - mx); den += e; if (i >= 1 && i <= l) num += e; }
            lb = num / den;
        } else {
#pragma unroll
            for (int r = 0; r < 16; ++r) wg[r] = c.in[I_GLAW][((size_t)(l * 2 + dir) * 16 + r) * 256 + h * 64 + d];
            bg = c.in[I_GLAB][(l * 2 + dir) * 256 + h * 64 + d];
        }
        float run = 0.f;
#pragma unroll
        for (int s = 0; s < TPT; ++s) {
            const int i = J * TPT + s, t = tok_of(n, dir, i);
            float la;
            if (MIX == 1) {
                qv[s] = bf2f(Qs[i * PQ + d]);
                const float f = lb + (1.f - lb) * sigmoidf_(bf2f(Kself[i * PQ + d]));
                la = __logf(f); kv[s] = 1.f - f;
            } else {
                float q0 = bf2f(Qs[i * PQ + d]) * 0.125f, k0 = bf2f(Kself[i * PQ + d]);
                if (n >= 4) {
                    const int pos = t - CTX, hf = d >> 5, idx = d & 31, fi = idx & 15;
                    const float p = (float)(hf ? (pos & 63) : (pos >> 6));
                    const float inv = __expf(-(float)fi * (9.210340371976184f / 16.f));
                    float ang = p * inv;
                    const float kk = rintf(ang * 0.15915494309189535f);
                    ang = fmaf(-kk, 6.2831855f, ang); ang = fmaf(-kk, -1.7484555e-7f, ang);
                    const float cs = __cosf(ang), sn = __sinf(ang);
                    const int dp = idx < 16 ? d + 16 : d - 16;
                    const float q1 = bf2f(Qs[i * PQ + dp]) * 0.125f, k1 = bf2f(Kself[i * PQ + dp]);
                    if (idx < 16) { q0 = q0 * cs - q1 * sn; k0 = k0 * cs - k1 * sn; }
                    else          { q0 = q1 * sn + q0 * cs; k0 = k1 * sn + k0 * cs; }
                }
                qv[s] = q0; kv[s] = k0;
                float gt = bg;
#pragma unroll
                for (int r = 0; r < 16; ++r) gt += code[i * 16 + r] * wg[r];
                la = -softplusf_(-gt) * (1.f / 16.f);
            }
            run += la; bl[s] = run;
        }
        tot[J * 128 + d] = run;
    }
    __syncthreads();
    {
        float pre = 0.f, bend = 0.f, hb = 0.f, tI[4] = {0.f, 0.f, 0.f, 0.f};
#pragma unroll
        for (int m = 0; m < NSUB; ++m) {
            const float tm = tot[m * 128 + d]; const int Im = (m * TPT) >> 4;
            bend += tm; tI[Im] += tm;
            if (Im < I) pre += tm; else if (Im == I && m < J) hb += tm;
        }
        unsigned kd[TPT / 2];
#pragma unroll
        for (int s = 0; s < TPT; ++s) {
            const int i = J * TPT + s, s16 = i & 15;
            const float b16 = hb + bl[s];
            Qs[i * PQ + d] = f2bf(qv[s] * __expf(b16));
            Kself[i * PQ + d] = f2bf(kv[s] * __expf(-b16));
            Qt[i * PQ + d] = f2bf(qv[s] * __expf(pre + b16));
            const float kdv = kv[s] * __expf(bend - pre - b16);
            if (s & 1) kd[s >> 1] = (kd[s >> 1] & 0xffffu) | ((unsigned)f2bf(kdv) << 16); else kd[s >> 1] = f2bf(kdv);
            float off = 0.f;
#pragma unroll
            for (int Ip = 1; Ip < 4; ++Ip) {
                if (Ip > I) { off += tI[Ip - 1]; Ksc[((Ip * (Ip - 1) / 2 + I) * 16 + s16) * PQ + d] = f2bf(kv[s] * __expf(off - b16)); }
            }
        }
#pragma unroll
        for (int w8 = 0; w8 < TPT / 8; ++w8)
            *(LDSP u32x4*)(KdT + d * 72 + J * TPT + w8 * 8) = (u32x4){kd[w8 * 4], kd[w8 * 4 + 1], kd[w8 * 4 + 2], kd[w8 * 4 + 3]};
        if (J == 0) Ag[d] = __expf(bend);
    }
    __syncthreads();
#pragma unroll
    for (int p = 0; p < (64 * DK / 8) / 512; ++p) {
        const int id = p * 512 + tid, fl = id & 63, fr = id >> 6;
        const int ott_ = fr / (DK / 32), kk_ = fr % (DK / 32);
        *(u32x4*)(Qg + (size_t)id * 8) = *(const LDSP u32x4*)(Qt + (ott_ * 16 + (fl & 15)) * PQ + kk_ * 32 + (fl >> 4) * 8);
    }
    for (int blk = wave; blk < 10; blk += 8) {
        int Ib, Jb;
        if (blk < 4) { Ib = blk; Jb = blk; } else { const int s = blk - 4; Ib = s < 1 ? 1 : (s < 3 ? 2 : 3); Jb = s - (Ib * (Ib - 1) / 2); }
        const LDSP bf16_t* kp = (Ib == Jb) ? Kself + Jb * 16 * PQ : Ksc + (Ib * (Ib - 1) / 2 + Jb) * 16 * PQ;
        const f32x4 a = mma_tile<DK / 32>(kp, PQ, Qs + Ib * 16 * PQ, PQ, (f32x4){0.f, 0.f, 0.f, 0.f}, lane);
        const int r = lane & 15, q4 = lane >> 4;
        f32x4 o;
#pragma unroll
        for (int e = 0; e < 4; ++e) o[e] = (Ib > Jb || r >= q4 * 4 + e) ? a[e] : 0.f;
        *(LDSP u32x2*)(Pm + (Ib * 16 + r) * 72 + Jb * 16 + q4 * 4) = pack4(o);
    }
    __syncthreads();
    {
        const int r = lane & 15, q4 = lane >> 4;
        const f32x4 z = (f32x4){0.f, 0.f, 0.f, 0.f};
        constexpr int NT2 = (DK / 16) * 8;
        for (int id = wave; id < 32 + NT2; id += 8) {
            if (id < 32) {
                const int td = id >> 2, ti = id & 3;
                f32x4 a = z;
#pragma unroll
                for (int kk = 0; kk < 2; ++kk)
                    a = __builtin_amdgcn_mfma_f32_16x16x32_bf16(frag_tr16(VT + kk * 32 * 136 + td * 16, 136, lane), *(const LDSP bf16x8*)(Pm + (ti * 16 + r) * 72 + kk * 32 + q4 * 8), a, 0, 0, 0);
                *(u32x2*)(Og + ((ti * 8 + td) * 64 + lane) * 4) = pack4(a);
            } else {
                const int j = id - 32, tk = j >> 3, tv = j & 7;
                f32x4 a = z;
#pragma unroll
                for (int kk = 0; kk < 2; ++kk)
                    a = __builtin_amdgcn_mfma_f32_16x16x32_bf16(*(const LDSP bf16x8*)(KdT + (tk * 16 + r) * 72 + kk * 32 + q4 * 8), frag_tr16(VT + kk * 32 * 136 + tv * 16, 136, lane), a, 0, 0, 0);
                *(u32x2*)(Bg + ((tv * (DK / 16) + tk) * 64 + lane) * 4) = pack4(a);
            }
        }
    }
    __syncthreads();
}

template <int MIX, int DVS, int RING>
__device__ __forceinline__ void scan_unit(const Ctx& c, int chain, int slice) {
    constexpr int DK = (MIX == 2) ? 64 : 128;
    constexpr int PS = DK + 8;
    constexpr int NDK = DK / 16, NG = 8 / NDK;
    constexpr int NS = (DVS / 16) / NG;
    constexpr int NO = (DVS / 16) / 2;
    constexpr int KS = DK / 32;
    const int lane = c.lane, wave = c.wave, r = lane & 15, q4 = lane >> 4;
    const int dir = chain & 1, h = (chain >> 1) & 3, b = chain >> 3;
    LDSP bf16_t* ST = (LDSP bf16_t*)c.lds;
    constexpr int PO = DVS + 8;
    LDSP bf16_t* OS = ST + DVS * PS;
    for (int i = c.tid; i < DVS * PS / 2; i += 512) ((LDSP unsigned*)ST)[i] = 0u;
    const int dkt = wave % NDK;
    const int dvt0 = (wave / NDK) * NS;
    const int ott = wave >> 1;
    const int odv0 = (wave & 1) * NO;
    const bf16_t* Mg = (const bf16_t*)(c.ws + WS_RA + RA_GM);
    const bf16_t* Bg = (const bf16_t*)(c.ws + WS_RA + (MIX == 0 ? RA_GB : MIX == 1 ? RA_HB : RA_LB));
    const bf16_t* Qg = (const bf16_t*)(c.ws + WS_RA + (MIX == 0 ? RA_GQ : MIX == 1 ? RA_HQ : RA_LQ));
    const bf16_t* Og = (const bf16_t*)(c.ws + WS_RA + (MIX == 0 ? RA_GO : MIX == 1 ? RA_HO : RA_LO));
    const float* Ag = (const float*)(c.ws + WS_RA + (MIX == 1 ? RA_HA : RA_LA));
    bf16_t* OB = (bf16_t*)(c.ws + WS_RA + RA_OB) + ((size_t)(MIX * 2 + dir) * MROWS) * 512;
    f32x4 S[NS];
#pragma unroll
    for (int t = 0; t < NS; ++t) S[t] = (f32x4){0.f, 0.f, 0.f, 0.f};
    struct Ld { bf16x8 mf[KS]; u32x2 bt[NS]; f32x4 ae; bf16x8 qf[KS]; u32x2 ot[NO]; };
    Ld ring[RING];
    auto load = [&](Ld& d, int s) {
        const int n = dir ? (s < 4 ? 3 - s : 71 - s) : s;
        const size_t cc = (size_t)n * 32 + chain;
        if (MIX == 0) {
#pragma unroll
            for (int kk = 0; kk < KS; ++kk) d.mf[kk] = *(const bf16x8*)(Mg + cc * 16384 + ((dkt * 4 + kk) * 64 + lane) * 8);
        } else {
            d.ae = *(const f32x4*)(Ag + cc * DK + dkt * 16 + q4 * 4);
        }
#pragma unroll
        for (int t = 0; t < NS; ++t) d.bt[t] = *(const u32x2*)(Bg + cc * (128 * DK) + (((slice * (DVS / 16) + dvt0 + t) * NDK + dkt) * 64 + lane) * 4);
#pragma unroll
        for (int kk = 0; kk < KS; ++kk) d.qf[kk] = *(const bf16x8*)(Qg + cc * (64 * DK) + ((ott * KS + kk) * 64 + lane) * 8);
#pragma unroll
        for (int t = 0; t < NO; ++t) d.ot[t] = *(const u32x2*)(Og + cc * 8192 + ((ott * 8 + slice * (DVS / 16) + odv0 + t) * 64 + lane) * 4);
    };
#pragma unroll
    for (int k = 0; k < RING; ++k) load(ring[k], k);
    __syncthreads();
    for (int s0 = 0; s0 < NCH; s0 += RING) {
#pragma unroll
      for (int k = 0; k < RING; ++k) {
        const int s = s0 + k;
        if (s >= NCH) break;
        Ld& cur = ring[k];
        const int n = dir ? (s < 4 ? 3 - s : 71 - s) : s;
#pragma unroll
        for (int t = 0; t < NO; ++t) {
            f32x4 a = (f32x4){bflo(cur.ot[t].x), bfhi(cur.ot[t].x), bflo(cur.ot[t].y), bfhi(cur.ot[t].y)};
#pragma unroll
            for (int kk = 0; kk < KS; ++kk) {
                const bf16x8 sf = *(const LDSP bf16x8*)(ST + ((odv0 + t) * 16 + r) * PS + kk * 32 + q4 * 8);
                a = __builtin_amdgcn_mfma_f32_16x16x32_bf16(sf, cur.qf[kk], a, 0, 0, 0);
            }
            *(LDSP u32x2*)(OS + (s & 1) * 64 * PO + (ott * 16 + r) * PO + (odv0 + t) * 16 + q4 * 4) = pack4(a);
        }
        f32x4 Sn[NS];
#pragma unroll
        for (int t = 0; t < NS; ++t) {
            const f32x4 bm = (f32x4){bflo(cur.bt[t].x), bfhi(cur.bt[t].x), bflo(cur.bt[t].y), bfhi(cur.bt[t].y)};
            if (MIX == 0) {
                f32x4 a = bm;
#pragma unroll
                for (int kk = 0; kk < KS; ++kk) {
                    const bf16x8 sf = *(const LDSP bf16x8*)(ST + ((dvt0 + t) * 16 + r) * PS + kk * 32 + q4 * 8);
                    a = __builtin_amdgcn_mfma_f32_16x16x32_bf16(cur.mf[kk], sf, a, 0, 0, 0);
                }
                Sn[t] = a;
            } else {
                Sn[t] = cur.ae * S[t] + bm;
            }
        }
        if (s + RING < NCH) load(cur, s + RING);
        __syncthreads();
#pragma unroll
        for (int t = 0; t < NS; ++t) { S[t] = Sn[t]; *(LDSP u32x2*)(ST + ((dvt0 + t) * 16 + r) * PS + dkt * 16 + q4 * 4) = pack4(Sn[t]); }
#pragma unroll
        for (int id = c.tid; id < 64 * (DVS / 8); id += 512) {
            const int i = id / (DVS / 8), ch = id % (DVS / 8);
            *(u32x4*)(OB + ((size_t)b * T + tok_of(n, dir, i)) * 512 + h * 128 + slice * DVS + ch * 8) = *(const LDSP u32x4*)(OS + (s & 1) * 64 * PO + i * PO + ch * 8);
        }
        __syncthreads();
      }
    }
}

constexpr int NA_Q = 0, NA_K = 17408, NA_VT = 34816, NA_P = 53248, NA_GRP = 62464;
constexpr int NA_RPB = 2 * NA_GRP;
__device__ __forceinline__ void na_pair(const Ctx& c, int l, int pair) {
    const int tid = c.tid, lane = c.lane, wave = c.wave, grp = wave >> 2, gw = wave & 3, gt = tid & 255;
    const int r = lane & 15, q4 = lane >> 4;
    const bool is_lat = pair < 512;
    int b, h, gr = 0, qb = 0;
    if (is_lat) { const int u = pair * 2 + grp; b = u >> 8; h = (u >> 6) & 3; gr = u & 63; }
    else { const int u = (pair - 512) * 2 + grp; b = u >> 4; h = (u >> 2) & 3; qb = u & 3; }
    const int NT = is_lat ? 12 : 4;
    const int rs = gr - 4 < 0 ? 0 : (gr - 4 > 56 ? 56 : gr - 4);
    LDSP unsigned char* L = c.lds + grp * NA_GRP;
    LDSP bf16_t* Qs = (LDSP bf16_t*)(L + NA_Q);
    LDSP bf16_t* Kt = (LDSP bf16_t*)(L + NA_K);
    LDSP bf16_t* VT = (LDSP bf16_t*)(L + NA_VT);
    LDSP bf16_t* Pm = (LDSP bf16_t*)(L + NA_P);
    LDSP float* rpb = (LDSP float*)(c.lds + NA_RPB);
    const bf16_t* proj = (const bf16_t*)(c.ws + WS_RA + RA_PROJ);
    const size_t rowb = (size_t)b * T;
    const int qtok0 = is_lat ? CTX + gr * 64 : qb * 64;
#pragma unroll
    for (int p = 0; p < 4; ++p) {
        const int id = p * 256 + gt, qi = id >> 4, c8 = id & 15;
        *(LDSP u32x4*)(Qs + qi * 136 + c8 * 8) = *(const u32x4*)(proj + (rowb + qtok0 + qi) * NINP + C_DQ + h * 128 + c8 * 8);
    }
    if (tid < 465) rpb[tid] = c.in[I_RPB][(size_t)(l * 4 + h) * 465 + tid];
    float m_run = -1e30f, l_run = 0.f;
    f32x4 acc[8];
#pragma unroll
    for (int dt = 0; dt < 8; ++dt) acc[dt] = (f32x4){0.f, 0.f, 0.f, 0.f};
    const float SC = 0.08838834764831845f * 1.4426950408889634f;
    const int cq = gw * 16 + r;
    const int cs = cq - 8 < 0 ? 0 : (cq - 8 > 48 ? 48 : cq - 8);
    u32x4 kreg[4], vreg[4];
#define NA_KTOK0(kt_) (is_lat ? ((kt_) < 8 ? CTX + (rs + (kt_)) * 64 : ((kt_) - 8) * 64) : (kt_) * 64)
#define NA_PREFETCH(kt_) do { const int kb_ = NA_KTOK0(kt_); _Pragma("unroll") for (int p = 0; p < 4; ++p) { \
        const int id = p * 256 + gt; kreg[p] = *(const u32x4*)(proj + (rowb + kb_ + (id >> 4)) * NINP + C_DK + h * 128 + (id & 15) * 8); \
        vreg[p] = *(const u32x4*)(proj + (rowb + kb_ + (id >> 4)) * NINP + C_DV + h * 128 + (id & 15) * 8); } } while (0)
    NA_PREFETCH(0);
    for (int kt = 0; kt < NT; ++kt) {
        const bool loc = is_lat && kt < 8;
        __syncthreads();
#pragma unroll
        for (int p = 0; p < 4; ++p) {
            const int id = p * 256 + gt, j = id >> 4, c8 = id & 15;
            *(LDSP u32x4*)(Kt + j * 136 + c8 * 8) = kreg[p];
            *(LDSP u32x4*)(VT + j * 136 + c8 * 8) = vreg[p];
        }
        if (kt + 1 < NT) NA_PREFETCH(kt + 1);
        __syncthreads();
        f32x4 sc[4];
        float tmax = -1e30f;
        const int ct0 = loc ? (gw <= 1 ? 0 : gw - 1) : 0, ct1 = loc ? (gw >= 2 ? 3 : gw + 1) : 3;
#pragma unroll
        for (int ct = 0; ct < 4; ++ct) {
            if (ct < ct0 || ct > ct1) { sc[ct] = (f32x4){-INFINITY, -INFINITY, -INFINITY, -INFINITY}; continue; }
            sc[ct] = mma_tile<4>(Kt + ct * 16 * 136, 136, Qs + gw * 16 * 136, 136, (f32x4){0.f, 0.f, 0.f, 0.f}, lane);
#pragma unroll
            for (int e = 0; e < 4; ++e) {
                float s = sc[ct][e] * SC;
                if (loc) {
                    const int ck = ct * 16 + q4 * 4 + e;
                    int dc = ck - cq; dc = dc < -15 ? -15 : (dc > 15 ? 15 : dc);
                    const int dr = rs + kt - gr + 7;
                    s += rpb[dr * 31 + dc + 15] * 1.4426950408889634f;
                    if (ck < cs || ck >= cs + 16) s = -INFINITY;
                }
                sc[ct][e] = s; tmax = fmaxf(tmax, s);
            }
        }
        tmax = fmaxf(tmax, __shfl_xor(tmax, 16)); tmax = fmaxf(tmax, __shfl_xor(tmax, 32));
        const float m_new = fmaxf(m_run, tmax);
        const float alpha = __builtin_amdgcn_exp2f(m_run - m_new);
        float psum = 0.f;
#pragma unroll
        for (int ct = 0; ct < 4; ++ct) {
            f32x4 p;
#pragma unroll
            for (int e = 0; e < 4; ++e) { p[e] = __builtin_amdgcn_exp2f(sc[ct][e] - m_new); psum += p[e]; }
            *(LDSP u32x2*)(Pm + (gw * 16 + r) * 72 + ct * 16 + q4 * 4) = pack4(p);
        }
        psum += __shfl_xor(psum, 16); psum += __shfl_xor(psum, 32);
        l_run = l_run * alpha + psum; m_run = m_new;
#pragma unroll
        for (int dt = 0; dt < 8; ++dt) {
            acc[dt] = acc[dt] * alpha;
#pragma unroll
            for (int kk = 0; kk < 2; ++kk) {
                if (2 * kk + 1 < ct0 || 2 * kk > ct1) continue;
                const bf16x8 vf = frag_tr16(VT + kk * 32 * 136 + dt * 16, 136, lane);
                const bf16x8 pf = *(const LDSP bf16x8*)(Pm + (gw * 16 + r) * 72 + kk * 32 + q4 * 8);
                acc[dt] = __builtin_amdgcn_mfma_f32_16x16x32_bf16(vf, pf, acc[dt], 0, 0, 0);
            }
        }
    }
    const float inv = 1.f / l_run;
    bf16_t* mix = (bf16_t*)(c.ws + WS_MIX) + (rowb + qtok0 + gw * 16 + r) * D + 1536 + h * 128;
#pragma unroll
    for (int dt = 0; dt < 8; ++dt) *(u32x2*)(mix + dt * 16 + q4 * 4) = pack4(acc[dt] * inv);
    __syncthreads();
}

__device__ __forceinline__ void phase_combine(const Ctx& c, int l) {
    const bf16_t* proj = (const bf16_t*)(c.ws + WS_RA + RA_PROJ);
    const bf16_t* OB = (const bf16_t*)(c.ws + WS_RA + RA_OB);
    bf16_t* mix = (bf16_t*)(c.ws + WS_MIX);
    const int lane = c.lane, d0 = (lane & 15) * 8;
    for (int row = c.bid * 8 + c.wave; row < MROWS; row += c.G * 8) {
#pragma unroll
        for (int mx = 0; mx < 3; ++mx) {
            const int om = mx == 0 ? 0 : 3 - mx;
            const u32x4 a = *(const u32x4*)(OB + ((size_t)(om * 2 + 0) * MROWS + row) * 512 + lane * 8);
            const u32x4 bq = *(const u32x4*)(OB + ((size_t)(om * 2 + 1) * MROWS + row) * 512 + lane * 8);
            const u32x4 g = *(const u32x4*)(proj + (size_t)row * NINP + (mx == 0 ? C_AZ : mx == 1 ? C_BR : C_CG) + lane * 8);
            const float* nw = c.in[mx == 0 ? I_GDNN : mx == 1 ? I_GLAN : I_HGN] + l * 128 + d0;
            float o[8]; float ss = 0.f;
#pragma unroll
            for (int m = 0; m < 4; ++m) { o[2 * m] = bflo(a[m]) + bflo(bq[m]); o[2 * m + 1] = bfhi(a[m]) + bfhi(bq[m]); ss += o[2 * m] * o[2 * m] + o[2 * m + 1] * o[2 * m + 1]; }
#pragma unroll
            for (int m = 1; m < 16; m <<= 1) ss += __shfl_xor(ss, m);
            const float rn = rsqrtf(ss * (1.f / 128.f) + NORM_EPS);
            float y[8];
#pragma unroll
            for (int m = 0; m < 4; ++m) {
                const float g0 = bflo(g[m]), g1 = bfhi(g[m]);
                const float a0 = (mx == 2) ? sigmoidf_(g0) : siluf_(g0), a1 = (mx == 2) ? sigmoidf_(g1) : siluf_(g1);
                y[2 * m] = o[2 * m] * rn * nw[2 * m] * a0; y[2 * m + 1] = o[2 * m + 1] * rn * nw[2 * m + 1] * a1;
            }
            *(u32x4*)(mix + (size_t)row * D + mx * 512 + lane * 8) = (u32x4){pk2(y[0], y[1]), pk2(y[2], y[3]), pk2(y[4], y[5]), pk2(y[6], y[7])};
        }
    }
}

__device__ __forceinline__ void phase_ln_router(const Ctx& c, int l) {
    LDSP float* wr = (LDSP float*)c.lds;
    for (int i = c.tid; i < 2048 * 16; i += 512) { const int k = i >> 4, e = i & 15; wr[e * 2048 + k] = c.in[I_ROUT][(size_t)l * 2048 * 16 + i]; }
    __syncthreads();
    const float* modv = (const float*)(c.ws + WS_MODV);
    const float* tb = (const float*)(c.ws + WS_RA + RA_TBUF);
    float* X1 = (float*)(c.ws + WS_X1); bf16_t* U = (bf16_t*)(c.ws + WS_U); float* aff = (float*)(c.ws + WS_AFF);
    const float* lg = c.in[I_LNG] + (size_t)(l * 2 + 0) * D; const float* lbp = c.in[I_LNB] + (size_t)(l * 2 + 0) * D;
    const int lane = c.lane;
    for (int row = c.bid * 8 + c.wave; row < MROWS; row += c.G * 8) {
        const int b = row / T, t = row % T;
        if (l == DEPTH - 1 && t < CTX) continue;
        const int r = t < CTX ? 4 : b;
        f32x4 v[8];
#pragma unroll
        for (int j = 0; j < 8; ++j) v[j] = *(const f32x4*)(tb + (size_t)row * D + 256 * j + 4 * lane);
        float mu, rstd; row_stats(v, mu, rstd);
#pragma unroll
        for (int j = 0; j < 8; ++j) {
            const int col = 256 * j + 4 * lane;
            v[j] = (v[j] - mu) * rstd * *(const f32x4*)(lg + col) + *(const f32x4*)(lbp + col);
            *(f32x4*)(X1 + (size_t)row * D + col) = v[j];
        }
        row_stats(v, mu, rstd);
        const float* sh = modv + (size_t)(l * 5 + r) * 12288 + 3 * 2048; const float* scp = sh + 2048;
        float lg16[16];
#pragma unroll
        for (int e = 0; e < 16; ++e) lg16[e] = 0.f;
#pragma unroll
        for (int j = 0; j < 8; ++j) {
            const int col = 256 * j + 4 * lane;
            const f32x4 y = (v[j] - mu) * rstd * (*(const f32x4*)(scp + col) + 1.f) + *(const f32x4*)(sh + col);
            *(u32x2*)(U + (size_t)row * D + col) = pack4(y);
#pragma unroll
            for (int e = 0; e < 16; ++e) { const f32x4 w = *(const LDSP f32x4*)(wr + e * 2048 + col); lg16[e] += y[0] * w[0] + y[1] * w[1] + y[2] * w[2] + y[3] * w[3]; }
        }
        float mxv = -1e30f;
#pragma unroll
        for (int e = 0; e < 16; ++e) { lg16[e] = wsum(lg16[e]); mxv = fmaxf(mxv, lg16[e]); }
        float den = 0.f;
#pragma unroll
        for (int e = 0; e < 16; ++e) { lg16[e] = expf(lg16[e] - mxv); den += lg16[e]; }
        const float rd = 1.f / den;
        float mine = 0.f;
#pragma unroll
        for (int e = 0; e < 16; ++e) if (lane == e) mine = lg16[e] * rd;
        if (lane < 16) aff[((size_t)b * 16 + lane) * T + t] = mine;
    }
    __syncthreads();
}

__device__ __forceinline__ void topk_unit(const Ctx& c, int prob) {
    const bool lat = prob < 64; const int pe = lat ? prob : prob - 64, b = pe >> 4, e = pe & 15;
    const int n = lat ? 4096 : 256, kcap = lat ? 512 : 32, tok0 = lat ? CTX : 0;
    LDSP unsigned* keys = (LDSP unsigned*)c.lds;
    LDSP unsigned* hist = keys + 4096;
    LDSP unsigned* bc = hist + 256;
    LDSP unsigned* wsum_ = bc + 4;
    const float* aff = (const float*)(c.ws + WS_AFF);
    const int tid = c.tid, lane = c.lane, wave = c.wave;
    const size_t rowb = (size_t)b * T + tok0;
    for (int i = tid; i < n; i += 512) keys[i] = __float_as_uint(aff[((size_t)b * 16 + e) * T + tok0 + i]);
    unsigned prefix = 0u, mask = 0u, krem = (unsigned)kcap;
    for (int pass = 0; pass < 4; ++pass) {
        const int shift = 24 - 8 * pass;
        if (tid < 256) hist[tid] = 0u;
        __syncthreads();
        for (int i = tid; i < n; i += 512) { const unsigned k = keys[i]; if ((k & mask) == prefix) __hip_atomic_fetch_add(&hist[(k >> shift) & 255u], 1u, __ATOMIC_RELAXED, __HIP_MEMORY_SCOPE_WORKGROUP); }
        __syncthreads();
        if (wave == 0) {
            unsigned hh[4], tot4 = 0u;
#pragma unroll
            for (int j = 0; j < 4; ++j) { hh[j] = hist[255 - 4 * lane - j]; tot4 += hh[j]; }
            unsigned inc4 = tot4;
#pragma unroll
            for (int m = 1; m < 64; m <<= 1) { const unsigned o = __shfl_up(inc4, m); if (lane >= m) inc4 += o; }
            unsigned cum = inc4 - tot4;
            if (cum < krem && krem <= inc4) {
#pragma unroll
                for (int j = 0; j < 4; ++j) {
                    if (cum < krem && krem <= cum + hh[j]) { bc[0] = prefix | ((unsigned)(255 - 4 * lane - j) << shift); bc[1] = krem - cum; }
                    cum += hh[j];
                }
            }
        }
        __syncthreads();
        prefix = bc[0]; krem = bc[1]; mask |= 255u << shift;
        __syncthreads();
    }
    const int per = n / 512 > 0 ? n / 512 : 1;
    const int i0 = tid * per;
    unsigned cnt = 0u;
    if (i0 < n) for (int j = 0; j < per; ++j) { const unsigned k = keys[i0 + j]; cnt += (k > prefix) ? 1u : 0u; cnt += (k == prefix) ? 0x10000u : 0u; }
    unsigned inc = cnt;
#pragma unroll
    for (int m = 1; m < 64; m <<= 1) { const unsigned o = __shfl_up(inc, m); if (lane >= m) inc += o; }
    if (lane == 63) wsum_[wave] = inc;
    __syncthreads();
    unsigned base = 0u;
    for (int w = 0; w < wave; ++w) base += wsum_[w];
    unsigned excl = base + inc - cnt;
    int* idx = (int*)(c.ws + WS_IDX); float* gate = (float*)(c.ws + WS_GATE); int* inv = (int*)(c.ws + WS_INV);
    const int slot0 = lat ? b * 512 : 2048 + b * 32;
    if (i0 < n) for (int j = 0; j < per; ++j) {
        const unsigned k = keys[i0 + j];
        const unsigned gtb = excl & 0xffffu, eqb = excl >> 16;
        const bool sel = (k > prefix) || (k == prefix && eqb < krem);
        int srow = -1;
        if (sel) {
            srow = slot0 + (int)(gtb + (eqb < krem ? eqb : krem));
            idx[e * EROWS + srow] = (int)(rowb + i0 + j);
            gate[e * EROWS + srow] = __uint_as_float(k);
        }
        inv[(rowb + i0 + j) * 16 + e] = srow;
        excl += (k > prefix) ? 1u : 0u; excl += (k == prefix) ? 0x10000u : 0u;
    }
    __syncthreads();
}

__device__ __forceinline__ void phase_gather(const Ctx& c, int l) {
    const int* idx = (const int*)(c.ws + WS_IDX);
    const bf16_t* U = (const bf16_t*)(c.ws + WS_U); bf16_t* XS = (bf16_t*)(c.ws + WS_RA + RA_XS);
    const int nrow = (l == DEPTH - 1) ? 2048 : EROWS, nreal = (l == DEPTH - 1) ? 2048 : 2176;
    for (int g = c.bid * 8 + c.wave; g < NEXP * nrow; g += c.G * 8) {
        const int e = g / nrow, s = g % nrow;
        u32x4 v[4];
        if (s < nreal) {
            const int src = idx[e * EROWS + s];
#pragma unroll
            for (int j = 0; j < 4; ++j) v[j] = *(const u32x4*)(U + (size_t)src * D + j * 512 + c.lane * 8);
        } else {
#pragma unroll
            for (int j = 0; j < 4; ++j) v[j] = (u32x4){0u, 0u, 0u, 0u};
            if (c.lane == 0) ((float*)(c.ws + WS_GATE))[e * EROWS + s] = 0.f;
        }
#pragma unroll
        for (int j = 0; j < 4; ++j) *(u32x4*)(XS + ((size_t)e * EROWS + s) * D + j * 512 + c.lane * 8) = v[j];
    }
}

__device__ __forceinline__ void phase_final(const Ctx& c, int l) {
    const float* modv = (const float*)(c.ws + WS_MODV);
    const float* X1 = (const float*)(c.ws + WS_X1); float* X = (float*)(c.ws + WS_X); bf16_t* U = (bf16_t*)(c.ws + WS_U);
    const bf16_t* YS = (const bf16_t*)(c.ws + WS_RA + RA_YS); const int* inv = (const int*)(c.ws + WS_INV);
    const float* lg = c.in[I_LNG] + (size_t)(l * 2 + 1) * D; const float* lbp = c.in[I_LNB] + (size_t)(l * 2 + 1) * D;
    const int lane = c.lane;
    for (int row = c.bid * 8 + c.wave; row < MROWS; row += c.G * 8) {
        const int b = row / T, t = row % T;
        if (l == DEPTH - 1 && t < CTX) continue;
        const int r = t < CTX ? 4 : b;
        f32x4 y[8];
#pragma unroll
        for (int j = 0; j < 8; ++j) y[j] = (f32x4){0.f, 0.f, 0.f, 0.f};
        const int myinv = inv[(size_t)row * 16 + (lane & 15)];
        for (int e = 0; e < 16; ++e) {
            const int s = __shfl(myinv, e);
            if (s >= 0) {
                const bf16_t* yr = YS + ((size_t)e * EROWS + s) * D;
#pragma unroll
                for (int j = 0; j < 8; ++j) { const u32x2 w = *(const u32x2*)(yr + 256 * j + 4 * lane); y[j] += (f32x4){bflo(w.x), bfhi(w.x), bflo(w.y), bfhi(w.y)}; }
            }
        }
        const float* m5 = modv + (size_t)(l * 5 + r) * 12288 + 5 * 2048;
        f32x4 v[8];
#pragma unroll
        for (int j = 0; j < 8; ++j) { const int col = 256 * j + 4 * lane; v[j] = *(const f32x4*)(X1 + (size_t)row * D + col) * ALPHA + *(const f32x4*)(m5 + col) * y[j]; }
        float mu, rstd; row_stats(v, mu, rstd);
#pragma unroll
        for (int j = 0; j < 8; ++j) { const int col = 256 * j + 4 * lane; v[j] = (v[j] - mu) * rstd * *(const f32x4*)(lg + col) + *(const f32x4*)(lbp + col); }
        if (l == DEPTH - 1) {
            float* o = c.out + ((size_t)b * SEQ + (t - CTX)) * D;
#pragma unroll
            for (int j = 0; j < 8; ++j) *(f32x4*)(o + 256 * j + 4 * lane) = v[j];
        } else {
#pragma unroll
            for (int j = 0; j < 8; ++j) *(f32x4*)(X + (size_t)row * D + 256 * j + 4 * lane) = v[j];
            const float* sh = modv + (size_t)((l + 1) * 5 + r) * 12288;
            modulate_store(v, sh, sh + 2048, U + (size_t)row * D, lane);
        }
    }
}

struct EpiOut {
    static constexpr bool PERM = false, AFTER_DRAIN = false;
    const float* X; const float* modv_l; float* Tb;
    __device__ __forceinline__ void operator()(const pg8::f32x4 (&acc)[2][2][4][2], const pg8::Unit& u, int wr, int wc, int fr, int fq) const {
        const int row0 = u.pm * 256 + wr * 64 + fr, col0 = u.pn * 256 + wc * 32 + 4 * fq;
        const int r = (u.pm % 17 == 0) ? 4 : u.pm / 17;
        const float* m2 = modv_l + (size_t)r * 12288 + 2 * 2048 + col0;
        pg8::f32x4 mv[2][2];
#pragma unroll
        for (int bj = 0; bj < 2; ++bj)
#pragma unroll
            for (int n = 0; n < 2; ++n) mv[bj][n] = *(const pg8::f32x4*)(m2 + bj * 128 + n * 16);
#pragma unroll
        for (int ai = 0; ai < 2; ++ai)
#pragma unroll
            for (int m = 0; m < 4; ++m) {
                const size_t off = (size_t)(row0 + ai * 128 + m * 16) * D + col0;
#pragma unroll
                for (int bj = 0; bj < 2; ++bj)
#pragma unroll
                    for (int n = 0; n < 2; ++n)
                        *(pg8::f32x4*)(Tb + off + bj * 128 + n * 16) = *(const pg8::f32x4*)(X + off + bj * 128 + n * 16) * ALPHA + mv[bj][n] * acc[ai][bj][m][n];
            }
    }
};
struct EpiHid {
    static constexpr bool PERM = true, AFTER_DRAIN = false;
    bf16_t* H;
    __device__ __forceinline__ void operator()(const pg8::f32x4 (&acc)[2][2][4][2], const pg8::Unit& u, int wr, int wc, int fr, int fq) const {
        const int row0 = u.pm * 256 + wr * 64 + fr, col0 = (u.pn & 7) * 128 + wc * 32 + 8 * fq;
#pragma unroll
        for (int ai = 0; ai < 2; ++ai)
#pragma unroll
            for (int m = 0; m < 4; ++m) {
                float hv[8];
#pragma unroll
                for (int n = 0; n < 2; ++n)
#pragma unroll
                    for (int j = 0; j < 4; ++j) hv[n * 4 + j] = siluf_(acc[ai][0][m][n][j]) * acc[ai][1][m][n][j];
                *(u32x4*)(H + (size_t)(row0 + ai * 128 + m * 16) * 1024 + col0) = (u32x4){pk2(hv[0], hv[1]), pk2(hv[2], hv[3]), pk2(hv[4], hv[5]), pk2(hv[6], hv[7])};
            }
    }
};
struct EpiY {
    static constexpr bool PERM = true, AFTER_DRAIN = false;
    bf16_t* Y; const float* gate;
    __device__ __forceinline__ void operator()(const pg8::f32x4 (&acc)[2][2][4][2], const pg8::Unit& u, int wr, int wc, int fr, int fq) const {
        const int row0 = u.pm * 256 + wr * 64 + fr, col0 = (u.pn & 7) * 256 + wc * 32 + 8 * fq;
#pragma unroll
        for (int ai = 0; ai < 2; ++ai)
#pragma unroll
            for (int m = 0; m < 4; ++m) {
                const int row = row0 + ai * 128 + m * 16; const float g = gate[row];
#pragma unroll
                for (int bj = 0; bj < 2; ++bj) {
                    const pg8::f32x4 v0 = acc[ai][bj][m][0] * g, v1 = acc[ai][bj][m][1] * g;
                    *(u32x4*)(Y + (size_t)row * D + col0 + bj * 128) = (u32x4){pk2(v0[0], v0[1]), pk2(v0[2], v0[3]), pk2(v1[0], v1[1]), pk2(v1[2], v1[3])};
                }
            }
    }
};
struct SchedLin {
    int G, c, nUnits, nPn, skip_ctx;
    __device__ __forceinline__ bool next(int i, pg8::Unit& u) const {
        const int L = i * G + c; if (L >= nUnits) return false;
        const int pml = L / nPn; u.pn = L % nPn; u.pm = skip_ctx ? (pml >> 4) * 17 + 1 + (pml & 15) : pml; return true;
    }
    __device__ __forceinline__ void a_ready(const pg8::Unit&) const {}
    __device__ __forceinline__ void done(const pg8::Unit&) const {}
};
struct SchedMoe {
    int G, c, nPm, nUnits; const int* idx; int nreal;
    __device__ __forceinline__ int arow(const pg8::Unit& u, int lr) const {
        const int e = u.pm / 9, s = (u.pm - e * 9) * 256 + lr;
        return s < nreal ? idx[e * EROWS + s] : 0;
    }
    __device__ __forceinline__ bool next(int i, pg8::Unit& u) const {
        const int L = i * G + c; if (L >= nUnits) return false;
        const int per = nPm * 8, e = L / per, rem = L % per; u.pm = e * 9 + (rem >> 3); u.pn = e * 8 + (rem & 7); return true;
    }
    __device__ __forceinline__ void a_ready(const pg8::Unit&) const {}
    __device__ __forceinline__ void done(const pg8::Unit&) const {}
};
}

struct Args { const float* in[24]; float* out; unsigned char* ws; int ph_lo, ph_hi; };
constexpr int LDS_BYTES = 147456;
#ifndef MK_Q_IN
#define MK_Q_IN 8
#define MK_Q_OUT 8
#define MK_Q_G1 4
#define MK_Q_G2 3
#define MK_Q_TK 10
#endif
#ifndef MK_NG
#define MK_NG 128
#define MK_NH 48
#endif
constexpr int N_PHASES = 2 + 10 * mk::DEPTH;

__global__ __launch_bounds__(512, 2) void mega_fwd(Args a) {
    using namespace mk;
    extern __shared__ __attribute__((aligned(16))) unsigned char lds_raw[];
    Ctx c0;
#pragma unroll
    for (int i = 0; i < 24; ++i) c0.in[i] = a.in[i];
    c0.out = a.out; c0.ws = a.ws; c0.lds = (LDSP unsigned char*)lds_raw;
    const int wave_s = __builtin_amdgcn_readfirstlane((int)threadIdx.x >> 6);
    c0.tid = threadIdx.x; c0.lane = c0.tid & 63; c0.wave = wave_s; c0.G = gridDim.x; c0.bid = blockIdx.x;
    const int lo = a.ph_lo, hi = a.ph_hi;
    volatile LAS unsigned* st = (volatile LAS unsigned*)(lds_raw + LDS_BYTES - 16);
    if (c0.tid == 0) { st[0] = 0u; st[1] = 0u; st[2] = 0u; st[3] = 0u; }
    __syncthreads();
    XcdBarrier bar; bar.bar = (unsigned*)(a.ws + WS_BAR); bar.x = 0; bar.st = st;
    if (hi - lo > 1) bar = xcd_barrier_post((unsigned*)(a.ws + WS_BAR), st);
    int ph = 0;
#define PH_CTX Ctx c = c0; { int wz = wave_s; asm volatile("" : "+s"(wz)); unsigned zz = 0u; asm volatile("" : "+v"(zz)); const int lz = (int)__builtin_amdgcn_mbcnt_hi(~0u, __builtin_amdgcn_mbcnt_lo(~0u, zz)); int bz = c0.bid; asm volatile("" : "+s"(bz)); c.bid = bz; c.wave = wz; c.lane = lz; c.tid = wz * 64 + lz; }
#define PH_ON (ph >= lo && ph < hi)
#ifdef MK_DBL
#define REP(id) for (int rep_ = 0; rep_ < 1 + (((MK_DBL) >> (id)) & 1); ++rep_, __syncthreads())
#else
#define REP(id)
#endif
#ifdef MK_TPROBE_A
    volatile LAS unsigned long long* tp = (volatile LAS unsigned long long*)(lds_raw + LDS_BYTES - 48);
    if (c0.bid == (MK_TPROBE_WG) && c0.tid == 0) { tp[0] = __builtin_amdgcn_s_memrealtime(); tp[1] = 0ull; tp[2] = 0ull; tp[3] = 0ull; }
#ifdef MK_GSTAMP
    if (c0.tid == 0) { volatile LAS unsigned long long* g0 = (volatile LAS unsigned long long*)(lds_raw + LDS_BYTES - 48 - 80); for (int i = 0; i < 9; ++i) g0[i] = 0ull; }
    __syncthreads();
#endif
#define PH_END do { if (PH_ON && ph + 1 < hi) xcd_barrier(bar); \
        if (c0.bid == (MK_TPROBE_WG) && threadIdx.x == 0) { const unsigned long long now_ = __builtin_amdgcn_s_memrealtime(); const int kind_ = ph < 2 ? ph : 2 + (ph - 2) % 10; \
            if (kind_ >= (MK_TPROBE_A) && kind_ <= (MK_TPROBE_B)) tp[1] += now_ - tp[0]; tp[0] = now_; } ++ph; } while (0)
#else
#define PH_END do { if (PH_ON && ph + 1 < hi) xcd_barrier(bar); ++ph; } while (0)
#endif

    if (PH_ON) REP(0) { PH_CTX
        if (c.bid < 192) { modv_fill_s(c); for (int u = c.bid; u < 192; u += c.G) modv_unit(c, u); }
        convert_phase(c, 0);
    }
    PH_END;
    if (PH_ON) REP(1) { PH_CTX phase_l0_modulate(c); }
    PH_END;

    for (int l = 0; l < DEPTH; ++l) {
        const bool last = (l == DEPTH - 1);
        if (PH_ON) REP(2) { PH_CTX
            pg8::Gemm g{(const pg8::bf16_t*)(c.ws + WS_U), (const pg8::bf16_t*)(c.ws + WS_WIN + (l & 1) * WSET_BYTES), MROWS, NINP, D};
            pg8::StaticOrder S; S.init(MROWS, NINP, c.G, c.bid);
            pg8::EpiBf16<0> E{(pg8::bf16_t*)(c.ws + WS_RA + RA_PROJ), NINP, nullptr, 0, 0};
            pg8::gemm_phase<pg8::EpiBf16<0>, pg8::StaticOrder, false>((PG8_LAS unsigned char*)c.lds, g, S, E, nullptr, c.tid);
            if (!last && c.G == 256 && 8 * 256 + c.bid >= 68 * 31) convert_queue(c, l + 1, MK_Q_IN);
        }
        PH_END;
        if (PH_ON) REP(3) { PH_CTX
            for (int cc = c.bid; cc < NCC; cc += c.G) gdn_prep_unit(c, l, cc);
        }
        if (PH_ON) REP(4) { PH_CTX
            for (int cc = c.bid; cc < NCC; cc += c.G) diag_prep_unit<1>(c, l, cc);
        }
        if (PH_ON) REP(5) { PH_CTX
            for (int cc = c.bid; cc < NCC; cc += c.G) diag_prep_unit<2>(c, l, cc);
        }
        PH_END;
        if (PH_ON) REP(6) { PH_CTX
            for (int u = c.bid; u < 128; u += c.G) if (u < 64) { scan_unit<0, 64, 3>(c, u & 31, u >> 5); __syncthreads(); }
        }
        if (PH_ON) REP(7) { PH_CTX
            for (int u = c.bid; u < 128; u += c.G) if (u >= 64 && u < 96) { scan_unit<1, 128, 2>(c, u - 64, 0); __syncthreads(); }
        }
        if (PH_ON) REP(8) { PH_CTX
            for (int u = c.bid; u < 128; u += c.G) if (u >= 96) { scan_unit<2, 128, 4>(c, u - 96, 0); __syncthreads(); }
        }
#ifdef MK_TPROBE_A
        if (PH_ON && c0.bid == (MK_TPROBE_WG) && threadIdx.x == 0) { tp[2] += __builtin_amdgcn_s_memrealtime() - tp[0]; }
#endif
        if (PH_ON) REP(9) { PH_CTX
            const int nq = last ? 64 : 68, qx = c.bid & 7;
            unsigned* qhead = (unsigned*)(c.ws + WS_BAR) + 3584 + 8 * (l * 8 + qx);
            volatile LAS unsigned* tk = (volatile LAS unsigned*)(lds_raw + LDS_BYTES - 64);
            for (;;) {
                if (c.tid == 0) tk[0] = __hip_atomic_fetch_add(qhead, 1u, __ATOMIC_RELAXED, __HIP_MEMORY_SCOPE_AGENT);
                __syncthreads();
                const int t = (int)tk[0];
                if (t >= nq) break;
                na_pair(c, l, t < 64 ? 64 * qx + t : 512 + 4 * qx + (t - 64));
            }
        }
#ifdef MK_TPROBE_A
        if (PH_ON && c0.bid == (MK_TPROBE_WG) && threadIdx.x == 0) { tp[3] += __builtin_amdgcn_s_memrealtime() - tp[0]; }
#endif
        PH_END;
        if (PH_ON) REP(10) { PH_CTX phase_combine(c, l); }
        PH_END;
        if (PH_ON) REP(11) { PH_CTX
            pg8::Gemm g{(const pg8::bf16_t*)(c.ws + WS_MIX), (const pg8::bf16_t*)(c.ws + WS_WOUT + (l & 1) * WSET_BYTES), MROWS, D, D};
            SchedLin S{c.G, c.bid, (last ? 64 : 68) * 8, 8, last ? 1 : 0};
            EpiOut E{(const float*)(c.ws + WS_X), (const float*)(c.ws + WS_MODV) + (size_t)l * 5 * 12288, (float*)(c.ws + WS_RA + RA_TBUF)};
            pg8::gemm_phase<EpiOut, SchedLin, false>((PG8_LAS unsigned char*)c.lds, g, S, E, nullptr, c.tid);
            if (!last && c.G == 256 && 2 * 256 + c.bid >= 68 * 8) convert_queue(c, l + 1, MK_Q_OUT);
        }
        PH_END;
        if (PH_ON) REP(12) { PH_CTX phase_ln_router(c, l); }
        PH_END;
        if (PH_ON) REP(13) { PH_CTX const int nprob = last ? 64 : 128; for (int p = c.bid; p < nprob; p += c.G) topk_unit(c, p);
            if (!last && c.G == 256 && c.bid >= 64) convert_queue(c, l + 1, c.bid >= 128 ? MK_Q_TK : MK_Q_TK / 2); }
        PH_END;
        if (PH_ON) REP(15) { PH_CTX
            pg8::Gemm g{(const pg8::bf16_t*)(c.ws + WS_U), (const pg8::bf16_t*)(c.ws + WS_W13 + (l & 1) * WSET_BYTES), NEXP * EROWS, NEXP * 2048, D};
            SchedMoe S{c.G, c.bid, last ? 8 : 9, NEXP * (last ? 8 : 9) * 8, (const int*)(c.ws + WS_IDX), last ? 2048 : 2176};
            EpiHid E{(bf16_t*)(c.ws + WS_RA + RA_HID)};
            pg8::gemm_phase<EpiHid, SchedMoe, false, true>((PG8_LAS unsigned char*)c.lds, g, S, E, nullptr, c.tid);
            if (!last && c.G == 256 && 4 * 256 + c.bid >= 16 * 9 * 8) convert_queue(c, l + 1, MK_Q_G1);
        }
        PH_END;
        if (PH_ON) REP(16) { PH_CTX
            pg8::Gemm g{(const pg8::bf16_t*)(c.ws + WS_RA + RA_HID), (const pg8::bf16_t*)(c.ws + WS_W2 + (l & 1) * WSET_BYTES), NEXP * EROWS, NEXP * 2048, 1024};
            SchedMoe S{c.G, c.bid, last ? 8 : 9, NEXP * (last ? 8 : 9) * 8, nullptr, 0};
            EpiY E{(bf16_t*)(c.ws + WS_RA + RA_YS), (const float*)(c.ws + WS_GATE)};
            pg8::gemm_phase<EpiY, SchedMoe, false>((PG8_LAS unsigned char*)c.lds, g, S, E, nullptr, c.tid);
            if (!last && c.G == 256 && 4 * 256 + c.bid >= 16 * 9 * 8) convert_queue(c, l + 1, MK_Q_G2);
        }
        PH_END;
        if (PH_ON) REP(17) { PH_CTX phase_final(c, l); }
        if (PH_ON) REP(18) { PH_CTX if (!last) convert_queue(c, l + 1, CONV_JOBS); }
        PH_END;
    }
#ifdef MK_TPROBE_A
    if (c0.bid == (MK_TPROBE_WG) && threadIdx.x == 0) { const unsigned long long t0_ = __builtin_amdgcn_s_memrealtime(), w_ =
#ifdef MK_GSTAMP
        ((volatile LAS unsigned long long*)(lds_raw + LDS_BYTES - 48 - 80))[MK_GSTAMP] * (unsigned long long)(MK_TPROBE_MULT);
#else
        tp[MK_TPROBE_SEL] * (unsigned long long)(MK_TPROBE_MULT);
#endif
        while (__builtin_amdgcn_s_memrealtime() - t0_ < w_) __builtin_amdgcn_s_sleep(32); }
#endif
}

#ifdef MK_STOP
__global__ void digest_k(const unsigned* w0, size_t n0, const unsigned* w1, size_t n1, float* out, size_t nout) {
    for (size_t i = (size_t)blockIdx.x * blockDim.x + threadIdx.x; i < nout; i += (size_t)gridDim.x * blockDim.x) {
        unsigned h = 0u;
        for (size_t j = i; j < n0 + n1; j += nout) {
#ifdef MK_RW0
            const size_t rw = j < n0 ? (size_t)(MK_RW0) : (size_t)(MK_RW1); const size_t row = (j < n0 ? j : j - n0) / rw;
            if (row % 4352 < 256) continue;
#endif
#ifdef MK_NANCOUNT
            { const unsigned wv = (j < n0 ? w0[j] : w1[j - n0]);
#ifdef MK_BF16
              if ((wv & 0x7F800000u) == 0x7F800000u || (wv & 0x7F80u) == 0x7F80u) h += 1u; }
#else
              if ((wv & 0x7F800000u) == 0x7F800000u) h += 1u; }
#endif
#else
            h = h * 31u + (j < n0 ? w0[j] : w1[j - n0]);
#endif
        }
#ifdef MK_NANCOUNT
        out[i] = 1000.f * (float)h;
#else
        out[i] = (float)(h & 0xFFFFFu);
#endif
    }
}
#endif
extern "C" void kernel_launch(void* const* d_in, const int* in_sizes, int n_in, void* d_out, int out_size, void* d_ws, size_t ws_size, hipStream_t stream) {
    static int grid = 0;
    if (grid == 0) {
        if (n_in != 24 || ws_size < mk::WS_TOTAL) { fprintf(stderr, "kernel_launch: n_in %d ws %zu (need %zu)\n", n_in, ws_size, (size_t)mk::WS_TOTAL); grid = -1; return; }
        int dev = 0, cus = 0, per_cu = 0;
        if (hipGetDevice(&dev) != hipSuccess || hipDeviceGetAttribute(&cus, hipDeviceAttributeMultiprocessorCount, dev) != hipSuccess) { grid = -1; return; }
        if (hipFuncSetAttribute((const void*)mega_fwd, hipFuncAttributeMaxDynamicSharedMemorySize, LDS_BYTES) != hipSuccess) { fprintf(stderr, "kernel_launch: hipFuncSetAttribute failed\n"); grid = -1; return; }
        if (hipOccupancyMaxActiveBlocksPerMultiprocessor(&per_cu, (const void*)mega_fwd, 512, LDS_BYTES) != hipSuccess || per_cu < 1) fprintf(stderr, "kernel_launch: occupancy query says %d\n", per_cu);
        (void)hipGetLastError();
        grid = cus;
    }
    if (grid < 0) return;
    (void)hipMemsetAsync((char*)d_ws + mk::WS_BAR, 0, 16384, stream);
    Args a{};
    for (int i = 0; i < 24; ++i) a.in[i] = (const float*)d_in[i];
    a.out = (float*)d_out; a.ws = (unsigned char*)d_ws;
#if MK_N_LAUNCHES == 1
    a.ph_lo = 0; a.ph_hi = N_PHASES;
    hipLaunchKernelGGL(mega_fwd, dim3(grid), dim3(512), LDS_BYTES, stream, a);
#else
#ifdef MK_STOP
    for (int p = 0; p < MK_STOP; ++p) { a.ph_lo = p; a.ph_hi = p + 1; hipLaunchKernelGGL(mega_fwd, dim3(grid), dim3(512), LDS_BYTES, stream, a); }
    hipLaunchKernelGGL(digest_k, dim3(2048), dim3(256), 0, stream, (const unsigned*)((char*)d_ws + (size_t)(MK_D0)), (size_t)(MK_N0) / 4, (const unsigned*)((char*)d_ws + (size_t)(MK_D1)), (size_t)(MK_N1) / 4, (float*)d_out, (size_t)out_size);
#else
    for (int p = 0; p < N_PHASES; ++p) { a.ph_lo = p; a.ph_hi = p + 1; hipLaunchKernelGGL(mega_fwd, dim3(grid), dim3(512), LDS_BYTES, stream, a); }
#endif
#endif
}
```

```cpp
#include <hip/hip_runtime.h>
#include <cstdio>
#include <cstdint>
#ifndef MK_N_LAUNCHES
#define MK_N_LAUNCHES 1
#endif
namespace pg8 {
#define PG8_LAS __attribute__((address_space(3)))
typedef unsigned short bf16_t;
typedef short bf16x8 __attribute__((ext_vector_type(8)));
typedef float f32x4 __attribute__((ext_vector_type(4)));
typedef unsigned u32x4 __attribute__((ext_vector_type(4)));
constexpr int BM = 256, BK = 64, HALF = 128, HTB = HALF * BK * 2  , STAGE_BYTES = 8 * HTB, NXCD = 8, WGM = 8;

__host__ __device__ __forceinline__ int lds_byte(int r, int c) { const int st = (r >> 4) * 2 + (c >> 5), rr = r & 15, cc = c & 31, ob = rr * 64 + cc * 2; return st * 1024 + (ob ^ (((ob >> 9) & 1) << 5)); }
__host__ __device__ __forceinline__ void stage_rc(int b, int& R, int& C) { const int st = b / 1024, sb = b % 1024, swz = sb ^ (((sb >> 9) & 1) << 5); R = (st >> 1) * 16 + swz / 64; C = (st & 1) * 32 + (swz % 64) / 2; }
__host__ __device__ __forceinline__ int perm32(int rho) { const int n = rho >> 4, i = rho & 15; return 8 * (i >> 2) + 4 * n + (i & 3); }

struct Unit { int pm, pn; };
struct Gemm { const bf16_t* A; const bf16_t* Bt; int M, N, K; };

struct StaticOrder {
    int nM, nN, nwg, G, c;
    __host__ __device__ void init(int M, int N, int G_, int c_) { nM = M / BM; nN = N / BM; nwg = nM * nN; G = G_; c = c_; }
    __host__ __device__ bool next(int i, Unit& u) const {
        const long L = (long)i * G + c; if (L >= nwg) return false;
        int wgid = (int)L; { const int q = nwg / NXCD, r = nwg % NXCD, xcd = wgid % NXCD, off = wgid / NXCD; wgid = (xcd < r ? xcd * (q + 1) : r * (q + 1) + (xcd - r) * q) + off; }
        const int nig = WGM * nN, gid = wgid / nig, fm = gid * WGM, gsz = (nM - fm) < WGM ? (nM - fm) : WGM;
        u.pm = fm + ((wgid % nig) % gsz); u.pn = (wgid % nig) / gsz; return true;
    }
    __device__ __forceinline__ void a_ready(const Unit&) const {}
    __device__ __forceinline__ void done(const Unit&) const {}
};
struct CountedOrder : StaticOrder {
    const unsigned* ready; unsigned need; unsigned* tmo;
    __device__ __forceinline__ void a_ready(const Unit& u) const {
        if (threadIdx.x < 64) {
            const unsigned long long t0 = __builtin_amdgcn_s_memrealtime(); unsigned polls = 0;
            while ((unsigned)__builtin_amdgcn_readfirstlane(__hip_atomic_load(ready + 64 * u.pm, __ATOMIC_RELAXED, __HIP_MEMORY_SCOPE_AGENT)) < need) {
                if ((++polls & 255u) == 0u && __builtin_amdgcn_readfirstlane(__hip_atomic_load(tmo, __ATOMIC_RELAXED, __HIP_MEMORY_SCOPE_AGENT)) != 0u) break;
                if (__builtin_amdgcn_s_memrealtime() - t0 > 2000000ull) {
                    if (threadIdx.x == 0) { unsigned expect = 0u; __hip_atomic_compare_exchange_strong(tmo + 1, &expect, 0x600u | (unsigned)(u.pm & 0xff), __ATOMIC_RELAXED, __ATOMIC_RELAXED, __HIP_MEMORY_SCOPE_AGENT); __hip_atomic_store(tmo, 1u, __ATOMIC_RELAXED, __HIP_MEMORY_SCOPE_AGENT); }
                    break; }
                __builtin_amdgcn_s_sleep(2); }
            __builtin_amdgcn_fence(__ATOMIC_ACQUIRE, "agent");
            asm volatile("s_waitcnt vmcnt(0)" ::: "memory");
        }
#if !defined(BROKEN_HOOK_NO_BARRIER)
        asm volatile("" ::: "memory"); __builtin_amdgcn_s_barrier(); asm volatile("" ::: "memory");
#endif
    }
};

typedef float f32x2_cv __attribute__((ext_vector_type(2)));
typedef __bf16 bf16x2_cv __attribute__((ext_vector_type(2)));
__device__ __forceinline__ unsigned cvt_pk_bf16(float lo, float hi) { const bf16x2_cv v = __builtin_convertvector((f32x2_cv){lo, hi}, bf16x2_cv); return __builtin_bit_cast(unsigned, v); }
typedef float f32x2 __attribute__((ext_vector_type(2)));
__device__ __forceinline__ f32x2 gelu_pk(f32x2 v) {
    const f32x2 av = __builtin_elementwise_abs(v), d = av * 0.2316418882f + 1.0f;
    f32x2 t; t.x = __builtin_amdgcn_rcpf(d.x); t.y = __builtin_amdgcn_rcpf(d.y);
    f32x2 q = t * 0.5307027145f + (-0.7265760135f); q = q * t + 0.7107068705f; q = q * t + (-0.142248368f); q = q * t + 0.127414796f; q = q * t;
    const f32x2 s = (v * v) * (-0.72134752044f);
    f32x2 e; e.x = __builtin_amdgcn_exp2f(s.x); e.y = __builtin_amdgcn_exp2f(s.y);
    const f32x2 m = v * (q * e), r = v - m;
    f32x2 o; o.x = v.x < 0.f ? m.x : r.x; o.y = v.y < 0.f ? m.y : r.y; return o;
}

struct EpiF32 {
    static constexpr bool PERM = false, AFTER_DRAIN = false;
    float* C; int ldc; const float* bias;
    __device__ __forceinline__ void operator()(const f32x4 (&acc)[2][2][4][2], const Unit& u, int wr, int wc, int fr, int fq) const {
        const int row0 = u.pm * BM + wr * 64 + fr, col0 = u.pn * BM + wc * 32 + 4 * fq;
        f32x4 bv[2][2];
#pragma unroll
        for (int bj = 0; bj < 2; ++bj)
#pragma unroll
            for (int n = 0; n < 2; ++n) bv[bj][n] = bias ? *(const f32x4*)(bias + col0 + bj * HALF + n * 16) : (f32x4){0.f, 0.f, 0.f, 0.f};
#pragma unroll
        for (int ai = 0; ai < 2; ++ai)
#pragma unroll
            for (int m = 0; m < 4; ++m) { float* rowp = C + (size_t)(row0 + ai * HALF + m * 16) * ldc + col0;
#pragma unroll
                for (int bj = 0; bj < 2; ++bj)
#pragma unroll
                    for (int n = 0; n < 2; ++n) *(f32x4*)(rowp + bj * HALF + n * 16) = acc[ai][bj][m][n] + bv[bj][n]; }
    }
};
template <int ACT  > struct EpiBf16 {
    static constexpr bool PERM = true, AFTER_DRAIN = false;
    bf16_t* O; int ldc; const float* bias; int split_cols; size_t split_stride;
    __device__ __forceinline__ void operator()(const f32x4 (&acc)[2][2][4][2], const Unit& u, int wr, int wc, int fr, int fq) const {
        const int row0 = u.pm * BM + wr * 64 + fr; int colt = u.pn * BM; bf16_t* base = O;
        if (split_cols) { const int t = colt / split_cols; base += (size_t)t * split_stride; colt -= t * split_cols; }
        const int col0 = colt + wc * 32 + 8 * fq, bcol0 = u.pn * BM + wc * 32 + 8 * fq;
        f32x4 bv[2][2];
#pragma unroll
        for (int bj = 0; bj < 2; ++bj)
#pragma unroll
            for (int n = 0; n < 2; ++n) bv[bj][n] = bias ? *(const f32x4*)(bias + bcol0 + bj * HALF + 4 * n) : (f32x4){0.f, 0.f, 0.f, 0.f};
#pragma unroll
        for (int ai = 0; ai < 2; ++ai)
#pragma unroll
            for (int m = 0; m < 4; ++m) { bf16_t* rowp = base + (size_t)(row0 + ai * HALF + m * 16) * ldc + col0;
#pragma unroll
                for (int bj = 0; bj < 2; ++bj) { f32x4 v0 = acc[ai][bj][m][0] + bv[bj][0], v1 = acc[ai][bj][m][1] + bv[bj][1];
                    if (ACT == 1) { f32x2 a = gelu_pk((f32x2){v0[0], v0[1]}), b = gelu_pk((f32x2){v0[2], v0[3]}), c = gelu_pk((f32x2){v1[0], v1[1]}), d = gelu_pk((f32x2){v1[2], v1[3]});
                        v0 = (f32x4){a.x, a.y, b.x, b.y}; v1 = (f32x4){c.x, c.y, d.x, d.y}; }
                    if (ACT == 2) {
#pragma unroll
                        for (int j = 0; j < 4; ++j) { v0[j] = 0.5f * v0[j] * (1.0f + erff(v0[j] * 0.70710678f)); v1[j] = 0.5f * v1[j] * (1.0f + erff(v1[j] * 0.70710678f)); } }
                    u32x4 w; w.x = cvt_pk_bf16(v0[0], v0[1]); w.y = cvt_pk_bf16(v0[2], v0[3]); w.z = cvt_pk_bf16(v1[0], v1[1]); w.w = cvt_pk_bf16(v1[2], v1[3]);
                    *(u32x4*)(rowp + bj * HALF) = w; } }
    }
};

struct PanelStats {
    unsigned* xbuf;
    unsigned* cnt;
    unsigned* tmo;
    int ntn; float eps;
    unsigned code;
    __device__ __forceinline__ bool run(const f32x4 (&v)[2][2][4][2], const Unit& u, int wr, int wc, int fr, int fq, PG8_LAS unsigned char* lds, int wid, int lane) const {
        typedef float f32x2v __attribute__((ext_vector_type(2)));
        PG8_LAS f32x2v* P = (PG8_LAS f32x2v*)lds;
        PG8_LAS f32x2v* S = (PG8_LAS f32x2v*)(lds + 8192);
        PG8_LAS unsigned* flag = (PG8_LAS unsigned*)(lds + 8192 + 2048);
#pragma unroll
        for (int ai = 0; ai < 2; ++ai)
#pragma unroll
            for (int m = 0; m < 4; ++m) {
                float s = 0.f;
#pragma unroll
                for (int bj = 0; bj < 2; ++bj)
#pragma unroll
                    for (int n = 0; n < 2; ++n) { const f32x4 x = v[ai][bj][m][n]; s += (x[0] + x[1]) + (x[2] + x[3]); }
                s += __shfl_xor(s, 16); s += __shfl_xor(s, 32);
                const float mw = s * (1.0f / 64.0f); float q = 0.f;
#pragma unroll
                for (int bj = 0; bj < 2; ++bj)
#pragma unroll
                    for (int n = 0; n < 2; ++n) { const f32x4 d = v[ai][bj][m][n] - mw; q += (d[0] * d[0] + d[1] * d[1]) + (d[2] * d[2] + d[3] * d[3]); }
                q += __shfl_xor(q, 16); q += __shfl_xor(q, 32);
                if (fq == 0) P[(ai * HALF + wr * 64 + m * 16 + fr) * 4 + wc] = (f32x2v){mw, q};
            }
        asm volatile("s_waitcnt lgkmcnt(0)" ::: "memory"); __builtin_amdgcn_s_barrier(); asm volatile("" ::: "memory");
#if defined(BROKEN_NO_WAIT)
        if (blockIdx.x >= 64) { const long long t0 = clock64(); while (clock64() - t0 < 60000) __builtin_amdgcn_s_sleep(8); }
#endif
        const int row = wid * 32 + (lane & 31);
        if (lane < 32) {
            const f32x2v a = P[row * 4 + 0], b = P[row * 4 + 1], c = P[row * 4 + 2], d = P[row * 4 + 3];
            const float mt = (a.x + b.x + c.x + d.x) * 0.25f;
            const float da = a.x - mt, db = b.x - mt, dc = c.x - mt, dd = d.x - mt;
            const float m2 = (a.y + b.y) + (c.y + d.y) + 64.0f * ((da * da + db * db) + (dc * dc + dd * dd));
            unsigned long long* slot = (unsigned long long*)xbuf + ((size_t)(u.pm * BM + row) * 4 + u.pn);
            __hip_atomic_store(slot, ((unsigned long long)__float_as_uint(m2) << 32) | __float_as_uint(mt), __ATOMIC_RELAXED, __HIP_MEMORY_SCOPE_AGENT);
        }
        asm volatile("s_waitcnt vmcnt(0)" ::: "memory");
        if (lane == 0) __hip_atomic_fetch_add(cnt + 64 * u.pm, 1u, __ATOMIC_RELAXED, __HIP_MEMORY_SCOPE_AGENT);
        if (wid == 0) {
            bool dead = false; const unsigned long long t0 = __builtin_amdgcn_s_memrealtime(); const unsigned want = 8u * (unsigned)ntn;
            for (;;) {
#if defined(BROKEN_NO_WAIT)
                break;
#endif
                if ((unsigned)__builtin_amdgcn_readfirstlane(__hip_atomic_load(cnt + 64 * u.pm, __ATOMIC_RELAXED, __HIP_MEMORY_SCOPE_AGENT)) >= want) break;
                if (__builtin_amdgcn_s_memrealtime() - t0 > 2000000ull) {
                    if (lane == 0) { unsigned expect = 0u; __hip_atomic_compare_exchange_strong(tmo + 1, &expect, code | (unsigned)(u.pm & 0xff), __ATOMIC_RELAXED, __ATOMIC_RELAXED, __HIP_MEMORY_SCOPE_AGENT);
                                     __hip_atomic_store(tmo, 1u, __ATOMIC_RELAXED, __HIP_MEMORY_SCOPE_AGENT); }
                    dead = true; break; }
                __builtin_amdgcn_s_sleep(2);
            }
            __builtin_amdgcn_fence(__ATOMIC_ACQUIRE, "agent");
            if (lane == 0) flag[0] = dead ? 1u : 0u;
        }
        asm volatile("s_waitcnt vmcnt(0) lgkmcnt(0)" ::: "memory"); __builtin_amdgcn_s_barrier(); asm volatile("" ::: "memory");
        const bool bad = flag[0] != 0u;
        if (lane < 32) {
            const unsigned long long* slot = (const unsigned long long*)xbuf + (size_t)(u.pm * BM + row) * 4; float mt[4], m2[4]; float ms = 0.f;
#pragma unroll
            for (int t = 0; t < 4; ++t) { if (t < ntn) { const unsigned long long w = __hip_atomic_load(slot + t, __ATOMIC_RELAXED, __HIP_MEMORY_SCOPE_AGENT); mt[t] = __uint_as_float((unsigned)w); m2[t] = __uint_as_float((unsigned)(w >> 32)); } else { mt[t] = 0.f; m2[t] = 0.f; } ms += mt[t]; }
            const float mean = ms / (float)ntn; float q = 0.f;
#pragma unroll
            for (int t = 0; t < 4; ++t) if (t < ntn) { const float dm = mt[t] - mean; q += m2[t] + 256.0f * dm * dm; }
            S[row] = (f32x2v){mean, 1.0f / sqrtf(q / (256.0f * (float)ntn) + eps)};
        }
        asm volatile("s_waitcnt lgkmcnt(0)" ::: "memory"); __builtin_amdgcn_s_barrier(); asm volatile("" ::: "memory");
        return bad;
    }
};
struct EpiLnRes {
    static constexpr bool PERM = false, AFTER_DRAIN = true;
    const float* base; float* out; int ldc; const float* bias; PanelStats st; unsigned poison;
    __device__ __forceinline__ void refuse(size_t i0, size_t stride, int M, int N) const { const float q = __builtin_nanf(""); for (size_t i = i0; i < (size_t)M * N; i += stride) out[(i / N) * ldc + i % N] = q;
        if (i0 == 0) { unsigned expect = 0u; __hip_atomic_compare_exchange_strong(st.tmo + 1, &expect, 0x7f0u, __ATOMIC_RELAXED, __ATOMIC_RELAXED, __HIP_MEMORY_SCOPE_AGENT); __hip_atomic_store(st.tmo, 1u, __ATOMIC_RELAXED, __HIP_MEMORY_SCOPE_AGENT); } }
    __device__ __forceinline__ void fused(f32x4 (&acc)[2][2][4][2], const Unit& u, int wr, int wc, int fr, int fq, PG8_LAS unsigned char* lds, int wid, int lane) const {
        typedef float f32x2v __attribute__((ext_vector_type(2)));
        const PG8_LAS f32x2v* S = (const PG8_LAS f32x2v*)(lds + 8192);
        const int col0 = u.pn * BM + wc * 32 + 4 * fq;
#pragma unroll
        for (int bj = 0; bj < 2; ++bj)
#pragma unroll
            for (int n = 0; n < 2; ++n) { const f32x4 bv = bias ? *(const f32x4*)(bias + col0 + bj * HALF + n * 16) : (f32x4){0.f, 0.f, 0.f, 0.f};
#pragma unroll
                for (int ai = 0; ai < 2; ++ai)
#pragma unroll
                    for (int m = 0; m < 4; ++m) acc[ai][bj][m][n] += bv; }
        const bool bad = st.run(acc, u, wr, wc, fr, fq, lds, wid, lane) || poison != 0u;
        const float qnan = __builtin_nanf("");
#pragma unroll
        for (int ai = 0; ai < 2; ++ai)
#pragma unroll
            for (int m = 0; m < 4; ++m) { const int r = ai * HALF + wr * 64 + m * 16 + fr; const f32x2v sr = S[r]; const size_t off = (size_t)(u.pm * BM + r) * ldc + col0;
#pragma unroll
                for (int bj = 0; bj < 2; ++bj)
#pragma unroll
                    for (int n = 0; n < 2; ++n) { const f32x4 bs = *(const f32x4*)(base + off + bj * HALF + n * 16); f32x4 o = bs + (acc[ai][bj][m][n] - sr.x) * sr.y;
                        if (bad) o = (f32x4){qnan, qnan, qnan, qnan}; *(f32x4*)(out + off + bj * HALF + n * 16) = o; }
                asm volatile("" ::: "memory"); }
    }
};
struct EpiLnResLn {
    static constexpr bool PERM = false, AFTER_DRAIN = true;
    const float* base; float* out; bf16_t* xn; int ldc; const float* bias; PanelStats st1, st2; unsigned poison;
    __device__ __forceinline__ void refuse(size_t i0, size_t stride, int M, int N) const { const float q = __builtin_nanf(""); for (size_t i = i0; i < (size_t)M * N; i += stride) { const size_t o = (i / N) * ldc + i % N; out[o] = q; xn[o] = (bf16_t)0x7fc0u; }
        if (i0 == 0) { unsigned expect = 0u; __hip_atomic_compare_exchange_strong(st1.tmo + 1, &expect, 0x7f0u, __ATOMIC_RELAXED, __ATOMIC_RELAXED, __HIP_MEMORY_SCOPE_AGENT); __hip_atomic_store(st1.tmo, 1u, __ATOMIC_RELAXED, __HIP_MEMORY_SCOPE_AGENT); } }
    __device__ __forceinline__ void fused(f32x4 (&acc)[2][2][4][2], const Unit& u, int wr, int wc, int fr, int fq, PG8_LAS unsigned char* lds, int wid, int lane) const {
        typedef float f32x2v __attribute__((ext_vector_type(2))); typedef unsigned u32x2v __attribute__((ext_vector_type(2)));
        const PG8_LAS f32x2v* S = (const PG8_LAS f32x2v*)(lds + 8192);
        const int col0 = u.pn * BM + wc * 32 + 4 * fq;
#pragma unroll
        for (int bj = 0; bj < 2; ++bj)
#pragma unroll
            for (int n = 0; n < 2; ++n) { const f32x4 bv = bias ? *(const f32x4*)(bias + col0 + bj * HALF + n * 16) : (f32x4){0.f, 0.f, 0.f, 0.f};
#pragma unroll
                for (int ai = 0; ai < 2; ++ai)
#pragma unroll
                    for (int m = 0; m < 4; ++m) acc[ai][bj][m][n] += bv; }
        bool bad = st1.run(acc, u, wr, wc, fr, fq, lds, wid, lane) || poison != 0u;
        const float qnan = __builtin_nanf("");
#pragma unroll
        for (int ai = 0; ai < 2; ++ai)
#pragma unroll
            for (int m = 0; m < 4; ++m) { const int r = ai * HALF + wr * 64 + m * 16 + fr; const f32x2v sr = S[r]; const size_t off = (size_t)(u.pm * BM + r) * ldc + col0;
#pragma unroll
                for (int bj = 0; bj < 2; ++bj)
#pragma unroll
                    for (int n = 0; n < 2; ++n) { const f32x4 bs = *(const f32x4*)(base + off + bj * HALF + n * 16); acc[ai][bj][m][n] = bs + (acc[ai][bj][m][n] - sr.x) * sr.y; }
                asm volatile("" : "+v"(acc[ai][0][m][0]), "+v"(acc[ai][0][m][1]), "+v"(acc[ai][1][m][0]), "+v"(acc[ai][1][m][1]));
                if (m & 1) asm volatile("" ::: "memory"); }
        const bool bad1 = bad;
        bad = st2.run(acc, u, wr, wc, fr, fq, lds, wid, lane) || bad;
#pragma unroll
        for (int ai = 0; ai < 2; ++ai)
#pragma unroll
            for (int m = 0; m < 4; ++m) { const int r = ai * HALF + wr * 64 + m * 16 + fr; const f32x2v sr = S[r]; const size_t off = (size_t)(u.pm * BM + r) * ldc + col0;
#pragma unroll
                for (int bj = 0; bj < 2; ++bj)
#pragma unroll
                    for (int n = 0; n < 2; ++n) { const f32x4 x1 = acc[ai][bj][m][n]; *(f32x4*)(out + off + bj * HALF + n * 16) = bad1 ? (f32x4){qnan, qnan, qnan, qnan} : x1;
                        const f32x4 o = (x1 - sr.x) * sr.y; u32x2v w; w.x = cvt_pk_bf16(o[0], o[1]); w.y = cvt_pk_bf16(o[2], o[3]);
                        if (bad) { w.x = 0x7fc07fc0u; w.y = 0x7fc07fc0u; } *(u32x2v*)(xn + off + bj * HALF + n * 16) = w; }
                asm volatile("" ::: "memory"); }
    }
};

template <class Epi, class Sched, bool STAMP = false, bool GATHER = false>
__device__ __forceinline__ void gemm_phase(PG8_LAS unsigned char* lds, const Gemm g, const Sched& S, const Epi& E, unsigned long long* stamps, int tid_in) {
    int tid_ = tid_in; asm volatile("" : "+v"(tid_));
    const int tid = tid_, wid = __builtin_amdgcn_readfirstlane(tid >> 6), lane = tid & 63, wr = wid >> 2, wc = wid & 3, fr = lane & 15, fq = lane >> 4;
    const int K = g.K, nt = K / BK;
    int ts_lo = 0, ts_hi = 0, nts = 0; const unsigned long long rt_entry = STAMP ? (unsigned long long)wall_clock64() : 0ull;
#define PG8_STAMP() do { if (STAMP && wid == 0 && nts < 64) { const unsigned long long _c = (unsigned long long)clock64(); \
        ts_lo = (lane == nts) ? (int)(unsigned)_c : ts_lo; ts_hi = (lane == nts) ? (int)(unsigned)(_c >> 32) : ts_hi; ++nts; } } while (0)
    PG8_STAMP();
    unsigned voffA[2], voffB[2];
#pragma unroll
    for (int i = 0; i < 2; ++i) { int R, C; stage_rc(tid * 16 + i * 8192, R, C); const int Rb = Epi::PERM ? ((R & ~31) + perm32(R & 31)) : R;
        voffA[i] = (unsigned)(R * K + C) * 2u; voffB[i] = (unsigned)(Rb * K + C) * 2u; }
    int pR[2], pC[2];
#pragma unroll
    for (int i = 0; i < 2; ++i) { int R, C; stage_rc(tid * 16 + i * 8192, R, C); pR[i] = R; pC[i] = C * 2; }
    unsigned gc[2][2], gn[2][2];
#define PG8_GOFS(dst, u) do { _Pragma("unroll") for (int h_ = 0; h_ < 2; ++h_) _Pragma("unroll") for (int i_ = 0; i_ < 2; ++i_) \
        dst[h_][i_] = (unsigned)S.arow(u, h_ * HALF + pR[i_]) * (unsigned)(K * 2) + (unsigned)pC[i_]; } while (0)
#define PG8_STAGE_G(bufoff, gbase, ofs) do { _Pragma("unroll") for (int _i = 0; _i < 2; ++_i) \
        __builtin_amdgcn_global_load_lds((const unsigned*)((const char*)(gbase) + (ofs)[_i]), (PG8_LAS unsigned*)(lds + (bufoff) + ldsw + _i * 8192), 16, 0, 0); } while (0)
    const size_t kstep = (size_t)(BK * 2);
    const size_t hstep = (size_t)HALF * K * 2;
    const size_t tstep = 2 * hstep;
    const unsigned ldsw = (unsigned)wid * 1024u;
    const int aoff = lds_byte(wr * 64 + fr, fq * 8), boff = lds_byte(wc * 32 + fr, fq * 8);
#define PG8_SA(b, h) (((b) * 2 + (h)) * HTB)
#define PG8_SB(b, h) ((4 + (b) * 2 + (h)) * HTB)
#define PG8_STAGE(bufoff, gbase, voff) do { _Pragma("unroll") for (int _i = 0; _i < 2; ++_i) \
        __builtin_amdgcn_global_load_lds((const unsigned*)((const char*)(gbase) + (voff)[_i]), (PG8_LAS unsigned*)(lds + (bufoff) + ldsw + _i * 8192), 16, 0, 0); } while (0)
#define PG8_LDA(dst, b, h) do { _Pragma("unroll") for (int m = 0; m < 4; ++m) _Pragma("unroll") for (int k = 0; k < 2; ++k) dst[m][k] = *(const PG8_LAS bf16x8*)(lds + PG8_SA(b, h) + aoff + m * 2048 + k * 1024); } while (0)
#define PG8_LDB(dst, b, h) do { _Pragma("unroll") for (int n = 0; n < 2; ++n) _Pragma("unroll") for (int k = 0; k < 2; ++k) dst[n][k] = *(const PG8_LAS bf16x8*)(lds + PG8_SB(b, h) + boff + n * 2048 + k * 1024); } while (0)
#define PG8_MMA(ai, bj, At, Bt) do { __builtin_amdgcn_s_setprio(1); _Pragma("unroll") for (int m = 0; m < 4; ++m) _Pragma("unroll") for (int n = 0; n < 2; ++n) _Pragma("unroll") for (int k = 0; k < 2; ++k) \
        acc[ai][bj][m][n] = __builtin_amdgcn_mfma_f32_16x16x32_bf16(Bt[n][k], At[m][k], acc[ai][bj][m][n], 0, 0, 0); __builtin_amdgcn_s_setprio(0); } while (0)
#define PG8_WAIT_V(n) asm volatile("s_waitcnt vmcnt(" #n ")" ::: "memory")
#define PG8_WAIT_L(n) asm volatile("s_waitcnt lgkmcnt(" #n ")" ::: "memory")
#define PG8_BAR __builtin_amdgcn_s_barrier()
#define PG8_SCHED __builtin_amdgcn_sched_barrier(0)
    Unit cur, nxt; int ui = 0;
    if (!S.next(0, cur)) return;
    f32x4 acc[2][2][4][2];
#pragma unroll
    for (int a = 0; a < 2; ++a)
#pragma unroll
        for (int b = 0; b < 2; ++b)
#pragma unroll
            for (int m = 0; m < 4; ++m)
#pragma unroll
                for (int n = 0; n < 2; ++n) acc[a][b][m][n] = (f32x4){0.f, 0.f, 0.f, 0.f};
    bf16x8 At[4][2], B0[2][2], B1[2][2];
    const char* cA = (const char*)g.A + (size_t)cur.pm * tstep; const char* cB = (const char*)g.Bt + (size_t)cur.pn * tstep;
    S.a_ready(cur);
    const char* gA = (const char*)g.A;
    if constexpr (GATHER) { PG8_GOFS(gc, cur); }
#define PG8_STAGE_A(bufoff, plain_base, kofs, ofs_half) do { if constexpr (GATHER) { PG8_STAGE_G(bufoff, gA + (kofs), ofs_half); } else { PG8_STAGE(bufoff, plain_base, voffA); } } while (0)
    PG8_STAGE(PG8_SB(0, 0), cB, voffB); PG8_STAGE_A(PG8_SA(0, 0), cA, 0, gc[0]); PG8_STAGE(PG8_SB(0, 1), cB + hstep, voffB); PG8_STAGE_A(PG8_SA(0, 1), cA + hstep, 0, gc[1]);
    if (wr == 1) PG8_BAR;
    PG8_WAIT_V(4); PG8_BAR;
    PG8_STAGE(PG8_SB(1, 0), cB + kstep, voffB); PG8_STAGE_A(PG8_SA(1, 0), cA + kstep, kstep, gc[0]); PG8_STAGE(PG8_SB(1, 1), cB + hstep + kstep, voffB);
    PG8_WAIT_V(6); PG8_BAR;
    PG8_STAMP();
    for (;;) {
        const bool has_next = S.next(ui + 1, nxt);
        const char* nA = has_next ? (const char*)g.A + (size_t)nxt.pm * tstep : cA; const char* nB = has_next ? (const char*)g.Bt + (size_t)nxt.pn * tstep : cB;
        if constexpr (GATHER) { if (has_next) { PG8_GOFS(gn, nxt); } else { _Pragma("unroll") for (int h_ = 0; h_ < 2; ++h_) _Pragma("unroll") for (int i_ = 0; i_ < 2; ++i_) gn[h_][i_] = gc[h_][i_]; } }
        for (int t = 0; t < nt; t += 2) {
            const bool last = (t == nt - 2);
            const char* a1 = cA + (size_t)(t + 1) * kstep;
            const char* a2 = last ? nA : cA + (size_t)(t + 2) * kstep; const char* b2 = last ? nB : cB + (size_t)(t + 2) * kstep;
            const char* a3 = a2 + kstep; const char* b3 = b2 + kstep;
            unsigned g2[2][2]; size_t k2 = 0;
            if constexpr (GATHER) { k2 = last ? 0 : (size_t)(t + 2) * kstep;
                _Pragma("unroll") for (int h_ = 0; h_ < 2; ++h_) _Pragma("unroll") for (int i_ = 0; i_ < 2; ++i_) g2[h_][i_] = last ? gn[h_][i_] : gc[h_][i_]; }
            if (last && has_next) S.a_ready(nxt);
            PG8_LDB(B0, 0, 0); PG8_SCHED; PG8_LDA(At, 0, 0); PG8_STAGE_A(PG8_SA(1, 1), a1 + hstep, (size_t)(t + 1) * kstep, gc[1]);
            PG8_WAIT_L(8); PG8_BAR; PG8_WAIT_L(0); PG8_MMA(0, 0, At, B0); PG8_BAR; PG8_SCHED;
            PG8_LDB(B1, 0, 1); PG8_STAGE(PG8_SB(0, 0), b2, voffB);
            PG8_BAR; PG8_WAIT_L(0); PG8_MMA(0, 1, At, B1); PG8_BAR;
            PG8_LDA(At, 0, 1); PG8_STAGE_A(PG8_SA(0, 0), a2, k2, g2[0]);
            PG8_BAR; PG8_WAIT_L(0); PG8_MMA(1, 0, At, B0); PG8_BAR; PG8_SCHED;
            PG8_STAGE(PG8_SB(0, 1), b2 + hstep, voffB);
            PG8_WAIT_V(6); PG8_BAR; PG8_MMA(1, 1, At, B1); PG8_BAR;
            PG8_LDB(B0, 1, 0); PG8_SCHED; PG8_LDA(At, 1, 0); PG8_STAGE_A(PG8_SA(0, 1), a2 + hstep, k2, g2[1]);
            PG8_WAIT_L(8); PG8_BAR; PG8_WAIT_L(0); PG8_MMA(0, 0, At, B0); PG8_BAR; PG8_SCHED;
            PG8_LDB(B1, 1, 1); PG8_STAGE(PG8_SB(1, 0), b3, voffB);
            PG8_BAR; PG8_WAIT_L(0); PG8_MMA(0, 1, At, B1); PG8_BAR;
            PG8_LDA(At, 1, 1); PG8_STAGE_A(PG8_SA(1, 0), a3, k2 + kstep, g2[0]);
            PG8_BAR; PG8_WAIT_L(0); PG8_MMA(1, 0, At, B0); PG8_BAR; PG8_SCHED;
            PG8_STAGE(PG8_SB(1, 1), b3 + hstep, voffB);
            PG8_WAIT_V(6); PG8_BAR; PG8_MMA(1, 1, At, B1); PG8_BAR;
        }
        PG8_STAMP();
        if constexpr (!Epi::AFTER_DRAIN) { E(acc, cur, wr, wc, fr, fq); S.done(cur); }
        PG8_STAMP();
        if (!has_next) break;
#pragma unroll
        for (int a = 0; a < 2; ++a)
#pragma unroll
            for (int b = 0; b < 2; ++b)
#pragma unroll
                for (int m = 0; m < 4; ++m)
#pragma unroll
                    for (int n = 0; n < 2; ++n) acc[a][b][m][n] = (f32x4){0.f, 0.f, 0.f, 0.f};
        cur = nxt; cA = nA; cB = nB; ++ui;
        if constexpr (GATHER) { _Pragma("unroll") for (int h_ = 0; h_ < 2; ++h_) _Pragma("unroll") for (int i_ = 0; i_ < 2; ++i_) gc[h_][i_] = gn[h_][i_]; }
    }
    PG8_WAIT_V(0);
    if (wr == 0) PG8_BAR;
    PG8_BAR;
    if constexpr (Epi::AFTER_DRAIN) { E.fused(acc, cur, wr, wc, fr, fq, lds, wid, lane); S.done(cur); }
    PG8_STAMP();
    if (STAMP && wid == 0) { stamps[lane] = lane < nts ? (((unsigned long long)(unsigned)ts_hi << 32) | (unsigned)ts_lo) : 0ull;
        if (lane == 62) stamps[62] = rt_entry; if (lane == 63) stamps[63] = (unsigned long long)wall_clock64(); }
#undef PG8_STAMP
#undef PG8_SA
#undef PG8_SB
#undef PG8_STAGE
#undef PG8_STAGE_A
#undef PG8_STAGE_G
#undef PG8_GOFS
#undef PG8_LDA
#undef PG8_LDB
#undef PG8_MMA
#undef PG8_WAIT_V
#undef PG8_WAIT_L
#undef PG8_BAR
#undef PG8_SCHED
}
}
#define XB_TMO      128
#define XB_XCNT(j)  (256  + 64 * (j))
#define XB_XSUB(j)  (1280 + 64 * (j))
#define XB_XGEN(j)  (2304 + 64 * (j))
#define XB_TOP      3328
#define XB_TOPGEN   3392
#define XCD_BAR_WORDS 3456
#define XB_SPIN_CAP (1u << 18)
#define LAS __attribute__((address_space(3)))

__device__ __forceinline__ unsigned xb_ld(unsigned* p)              { return __hip_atomic_load(p, __ATOMIC_RELAXED, __HIP_MEMORY_SCOPE_AGENT); }
__device__ __forceinline__ unsigned xb_add(unsigned* p, unsigned v) { return __hip_atomic_fetch_add(p, v, __ATOMIC_RELAXED, __HIP_MEMORY_SCOPE_AGENT); }
__device__ __forceinline__ unsigned xb_xcc_id() { return (unsigned)__builtin_amdgcn_s_getreg((3 << 11) | 20) & 0xFu; }
#define XB_SPIN(cond, bar) do { unsigned _sp = 0; while (cond) { __builtin_amdgcn_s_sleep(1); \
    if ((++_sp & 255u) == 0u) { if (xb_ld(&(bar)[XB_TMO])) break; if (_sp > XB_SPIN_CAP) { atomicAdd(&(bar)[XB_TMO], 1u); break; } } } } while (0)

struct XcdBarrier {
    unsigned* bar; unsigned x;
    volatile LAS unsigned* st;
};

__device__ __forceinline__ XcdBarrier xcd_barrier_post(unsigned* bar, volatile LAS unsigned* st) {
    XcdBarrier b; b.bar = bar; b.x = xb_xcc_id(); b.st = st;
    if (threadIdx.x == 0) (void)xb_add(&bar[XB_XCNT(b.x)], 1u);
    return b;
}
__device__ __forceinline__ void xcd_barrier_complete(unsigned* bar, unsigned x, unsigned& nloc, unsigned& nx) {
    const unsigned G = gridDim.x * gridDim.y * gridDim.z;
    unsigned sum, cnt, mine, sp = 0u;
    for (;;) {
        sum = 0u; cnt = 0u; mine = 0u;
#pragma unroll
        for (unsigned j = 0; j < 16; ++j) { const unsigned c = xb_ld(&bar[XB_XCNT(j)]); sum += c; cnt += (c > 0u) ? 1u : 0u; mine = (j == x) ? c : mine; }
        if (sum == G) break;
        __builtin_amdgcn_s_sleep(1);
        if ((++sp & 255u) == 0u) { if (xb_ld(&bar[XB_TMO])) break; if (sp > XB_SPIN_CAP) { atomicAdd(&bar[XB_TMO], 1u); break; } }
    }
    nloc = mine > 0u ? mine : 1u; nx = cnt > 0u ? cnt : 1u;
}

__device__ __forceinline__ void xcd_barrier(const XcdBarrier& b) {
    asm volatile("s_waitcnt vmcnt(0)" ::: "memory");
    __syncthreads();
    if (threadIdx.x == 0) {
        unsigned* bar = b.bar;
        __builtin_amdgcn_s_waitcnt(0);
        unsigned nloc = b.st[0], nx = b.st[1];
        if (nloc == 0u) { xcd_barrier_complete(bar, b.x, nloc, nx); b.st[0] = nloc; b.st[1] = nx; }
        const unsigned old = xb_add(&bar[XB_XSUB(b.x)], 1u);
        const unsigned gen = old / nloc;
        if (old + 1u == (gen + 1u) * nloc) {
            __builtin_amdgcn_fence(__ATOMIC_RELEASE, "agent");
            asm volatile("s_waitcnt vmcnt(0)" ::: "memory");
            const unsigned og = xb_add(&bar[XB_TOP], 1u);
            const unsigned tg = og / nx;
            if (og + 1u == (tg + 1u) * nx) xb_add(&bar[XB_TOPGEN], 1u);
            else XB_SPIN(xb_ld(&bar[XB_TOPGEN]) == tg, bar);
            __builtin_amdgcn_fence(__ATOMIC_ACQUIRE, "agent");
            xb_add(&bar[XB_XGEN(b.x)], 1u);
            asm volatile("s_waitcnt vmcnt(0)" ::: "memory");
        } else {
            XB_SPIN(xb_ld(&bar[XB_XGEN(b.x)]) == gen, bar);
            __builtin_amdgcn_fence(__ATOMIC_ACQUIRE, "agent");
            asm volatile("s_waitcnt vmcnt(0)" ::: "memory");
        }
    }
    __syncthreads();
}

namespace mk {
typedef unsigned short bf16_t;
typedef short bf16x8 __attribute__((ext_vector_type(8)));
typedef float f32x4 __attribute__((ext_vector_type(4)));
typedef unsigned u32x2 __attribute__((ext_vector_type(2)));
typedef unsigned u32x4 __attribute__((ext_vector_type(4)));
#define LDSP __attribute__((address_space(3)))

constexpr int D = 2048, NB = 4, SEQ = 4096, DEPTH = 4, CTX = 256, T = CTX + SEQ, MROWS = NB * T;
constexpr int NIN = 7728, NINP = 7936, NCH = T / 64;
constexpr int C_AQ = 0, C_AK = 512, C_AV = 1024, C_AZ = 1536, C_ABETA = 2048, C_ADEC = 2056,
              C_BQ = 2064, C_BK = 2320, C_BV = 2576, C_BR = 3088, C_BCODE = 3600,
              C_CQ = 3632, C_CI = 4144, C_CG = 4656, C_CF = 5168, C_DQ = 6192, C_DK = 6704, C_DV = 7216;
constexpr int NEXP = 16, EROWS = 2304;
constexpr float ALPHA = 1.681792830507429f;
constexpr float LN_EPS = 1e-5f, NORM_EPS = 1e-6f;
constexpr int NCC = NB * 4 * 2 * NCH;

enum { I_X = 0, I_C, I_CTX, I_CCTX, I_WMOD, I_BMOD, I_WIN, I_WOUT, I_LNG, I_LNB, I_CONV, I_ALOG, I_DTB, I_GDNN, I_GLAW, I_GLAB, I_GLAN, I_HGAM, I_HGN, I_RPB, I_ROUT, I_W1, I_W3, I_W2 };

constexpr size_t WS_BAR = 0;
constexpr size_t WS_MODV = 16384;
constexpr size_t WS_AFF = WS_MODV + 983040;
constexpr size_t WS_INV = WS_AFF + 1114112;
constexpr size_t WS_IDX = WS_INV + 1114112;
constexpr size_t WS_GATE = WS_IDX + 147456;
constexpr size_t WS_WIN = WS_GATE + 147456;
constexpr size_t WS_WOUT = WS_WIN + 32505856;
constexpr size_t WS_W13 = WS_WOUT + 8388608;
constexpr size_t WS_W2 = WS_W13 + 134217728;
constexpr size_t WSET_BYTES = 32505856 + 8388608 + 134217728 + 67108864;
constexpr size_t WS_X = WS_W2 + 67108864 + WSET_BYTES;
constexpr size_t WS_X1 = WS_X + 142606336;
constexpr size_t WS_U = WS_X1 + 142606336;
constexpr size_t WS_MIX = WS_U + 71303168;
constexpr size_t WS_RA = WS_MIX + 71303168;
constexpr size_t RA_PROJ = 0;
constexpr size_t RA_GM = RA_PROJ + 276299776;
constexpr size_t RA_GB = RA_GM + 71303168;
constexpr size_t RA_GQ = RA_GB + 71303168;
constexpr size_t RA_GO = RA_GQ + 35651584;
constexpr size_t RA_HB = RA_GO + 35651584;
constexpr size_t RA_HQ = RA_HB + 71303168;
constexpr size_t RA_HO = RA_HQ + 35651584;
constexpr size_t RA_HA = RA_HO + 35651584;
constexpr size_t RA_LB = RA_HA + 1114112;
constexpr size_t RA_LQ = RA_LB + 35651584;
constexpr size_t RA_LO = RA_LQ + 17825792;
constexpr size_t RA_LA = RA_LO + 35651584;
constexpr size_t RA_OB = RA_LA + 557056;
constexpr size_t RA_END = RA_OB + 106954752;
constexpr size_t RA_TBUF = 0;
constexpr size_t RA_XS = 142606336;
constexpr size_t RA_HID = RA_XS + 150994944;
constexpr size_t RA_YS = RA_HID + 75497472;
constexpr size_t WS_TOTAL = WS_RA + RA_END;
static_assert(RA_YS + 150994944 <= RA_END, "region A");

struct Ctx {
    const float* in[24]; float* out; unsigned char* ws;
    LDSP unsigned char* lds; int tid, lane, wave, G, bid;
};

__device__ __forceinline__ float bf2f(unsigned b) { return __uint_as_float(b << 16); }
__device__ __forceinline__ float bflo(unsigned u) { return __uint_as_float(u << 16); }
__device__ __forceinline__ float bfhi(unsigned u) { return __uint_as_float(u & 0xffff0000u); }
__device__ __forceinline__ unsigned pk2(float lo, float hi) { return pg8::cvt_pk_bf16(lo, hi); }
__device__ __forceinline__ bf16_t f2bf(float x) { return (bf16_t)(pk2(x, 0.f) & 0xffffu); }
__device__ __forceinline__ float sigmoidf_(float x) { return __builtin_amdgcn_rcpf(1.f + __builtin_amdgcn_exp2f(-1.4426950408889634f * x)); }
__device__ __forceinline__ float siluf_(float x) { return x * __builtin_amdgcn_rcpf(1.f + __builtin_amdgcn_exp2f(-1.4426950408889634f * x)); }
__device__ __forceinline__ float softplusf_(float x) { return x > 20.f ? x : log1pf(__expf(x)); }
__device__ __forceinline__ float wsum(float v) {
#pragma unroll
    for (int m = 32; m >= 1; m >>= 1) v += __shfl_xor(v, m);
    return v;
}

template <int KS>
__device__ __forceinline__ f32x4 mma_tile(const LDSP bf16_t* a, int lda, const LDSP bf16_t* b, int ldb, f32x4 acc, int lane) {
    const int r = lane & 15, q = lane >> 4;
#pragma unroll
    for (int kk = 0; kk < KS; ++kk) {
        const bf16x8 af = *(const LDSP bf16x8*)(a + r * lda + kk * 32 + q * 8);
        const bf16x8 bf = *(const LDSP bf16x8*)(b + r * ldb + kk * 32 + q * 8);
        acc = __builtin_amdgcn_mfma_f32_16x16x32_bf16(af, bf, acc, 0, 0, 0);
    }
    return acc;
}
typedef short s16x4 __attribute__((ext_vector_type(4)));
__device__ __forceinline__ bf16x8 frag_tr16(const LDSP bf16_t* base, int ld, int lane) {
    const int g = lane >> 4, i = lane & 15;
    const LDSP bf16_t* p = base + (8 * g + (i >> 2)) * ld + 4 * (i & 3);
    const s16x4 lo = __builtin_amdgcn_ds_read_tr16_b64_v4i16((LDSP s16x4*)p);
    const s16x4 hi = __builtin_amdgcn_ds_read_tr16_b64_v4i16((LDSP s16x4*)(p + 4 * ld));
    return (bf16x8){lo[0], lo[1], lo[2], lo[3], hi[0], hi[1], hi[2], hi[3]};
}
__device__ __forceinline__ u32x2 pack4(f32x4 v) { u32x2 o; o.x = pk2(v[0], v[1]); o.y = pk2(v[2], v[3]); return o; }

__device__ __forceinline__ int tok_of(int n, int dir, int i) { return n * 64 + (dir ? 63 - i : i); }

__device__ __forceinline__ void modv_fill_s(const Ctx& c) {
    LDSP float* s = (LDSP float*)c.lds;
    for (int i = c.tid; i < 5 * 2048; i += 512) {
        const int r = i >> 11, k = i & 2047;
        const float v = r < 4 ? c.in[I_C][r * 2048 + k] : c.in[I_CCTX][k];
        s[i] = siluf_(v);
    }
    __syncthreads();
}
__device__ __forceinline__ void modv_unit(const Ctx& c, int unit) {
    const int l = unit / 48, cb = unit % 48;
    LDSP float* s = (LDSP float*)c.lds;
    LDSP float* red = s + 5 * 2048;
    const float* W = c.in[I_WMOD] + (size_t)l * 2048 * 12288 + cb * 256 + c.lane * 4;
    const int k0 = c.wave * 256;
    f32x4 acc[5];
#pragma unroll
    for (int r = 0; r < 5; ++r) acc[r] = (f32x4){0.f, 0.f, 0.f, 0.f};
#pragma unroll 8
    for (int k = 0; k < 256; ++k) {
        const f32x4 w = *(const f32x4*)(W + (size_t)(k0 + k) * 12288);
#pragma unroll
        for (int r = 0; r < 5; ++r) { const float sv = s[r * 2048 + k0 + k]; acc[r] += w * sv; }
    }
#pragma unroll
    for (int r = 0; r < 5; ++r) *(LDSP f32x4*)(red + (c.wave * 5 + r) * 256 + c.lane * 4) = acc[r];
    __syncthreads();
    float* modv = (float*)(c.ws + WS_MODV);
    for (int o = c.tid; o < 5 * 256; o += 512) {
        const int r = o >> 8, col = o & 255;
        float sum = 0.f;
#pragma unroll
        for (int w = 0; w < 8; ++w) sum += red[(w * 5 + r) * 256 + col];
        modv[(size_t)(l * 5 + r) * 12288 + cb * 256 + col] = sum + c.in[I_BMOD][l * 12288 + cb * 256 + col];
    }
    __syncthreads();
}

struct CJob { const float* src; bf16_t* dst; int ldsrc, lddst, nvalid; };
constexpr int CONV_JOBS = 992 + 256 + 3 * 2048;
__device__ __forceinline__ CJob conv_desc(const Ctx& c, int l, int job) {
    CJob d;
    if (job < 992) {
        const int kt = job & 15, nt = job >> 4;
        d.src = c.in[I_WIN] + (size_t)l * 2048 * NIN + (size_t)kt * 128 * NIN + nt * 128; d.ldsrc = NIN; d.nvalid = NIN - nt * 128;
        d.dst = (bf16_t*)(c.ws + WS_WIN + (l & 1) * WSET_BYTES) + (size_t)nt * 128 * 2048 + kt * 128; d.lddst = 2048;
    } else if (job < 1248) {
        const int j = job - 992, kt = j & 15, nt = j >> 4;
        d.src = c.in[I_WOUT] + (size_t)l * 2048 * 2048 + (size_t)kt * 128 * 2048 + nt * 128; d.ldsrc = 2048; d.nvalid = 128;
        d.dst = (bf16_t*)(c.ws + WS_WOUT + (l & 1) * WSET_BYTES) + (size_t)nt * 128 * 2048 + kt * 128; d.lddst = 2048;
    } else if (job < 1248 + 4096) {
        const int j = job - 1248, which = j >> 11, jj = j & 2047, e = jj >> 7, rem = jj & 127, kt = rem & 15, nt = rem >> 4;
        d.src = c.in[which ? I_W3 : I_W1] + ((size_t)(l * 16 + e) * 2048 + (size_t)kt * 128) * 1024 + nt * 128; d.ldsrc = 1024; d.nvalid = 128;
        d.dst = (bf16_t*)(c.ws + WS_W13 + (l & 1) * WSET_BYTES) + ((size_t)e * 2048 + nt * 256 + which * 128) * 2048 + kt * 128; d.lddst = 2048;
    } else {
        const int j = job - 1248 - 4096, e = j >> 7, rem = j & 127, kt = rem & 7, nt = rem >> 3;
        d.src = c.in[I_W2] + ((size_t)(l * 16 + e) * 1024 + (size_t)kt * 128) * 2048 + nt * 128; d.ldsrc = 2048; d.nvalid = 128;
        d.dst = (bf16_t*)(c.ws + WS_W2 + (l & 1) * WSET_BYTES) + ((size_t)e * 2048 + nt * 128) * 1024 + kt * 128; d.lddst = 1024;
    }
    return d;
}
__device__ __forceinline__ void conv_load(const CJob& d, int n4, int kr, f32x4 (&v)[8]) {
#pragma unroll
    for (int p = 0; p < 4; ++p)
#pragma unroll
        for (int hh = 0; hh < 2; ++hh) v[2 * p + hh] = (4 * n4 < d.nvalid) ? *(const f32x4*)(d.src + (size_t)(32 * p + 2 * kr + hh) * d.ldsrc + 4 * n4) : (f32x4){0.f, 0.f, 0.f, 0.f};
}
__device__ __forceinline__ void conv_tile(const Ctx& c, const CJob& d, LDSP unsigned* Tt, int n4, int kr, const f32x4 (&v)[8]) {
#pragma unroll
    for (int p = 0; p < 4; ++p)
#pragma unroll
        for (int i = 0; i < 4; ++i) Tt[(4 * n4 + i) * 65 + 16 * p + kr] = pk2(v[2 * p][i], v[2 * p + 1][i]);
    __syncthreads();
#pragma unroll
    for (int q = 0; q < 4; ++q) {
        const int id = q * 512 + c.tid, n = id >> 4, kq = id & 15;
        const u32x4 o = (u32x4){Tt[n * 65 + 4 * kq], Tt[n * 65 + 4 * kq + 1], Tt[n * 65 + 4 * kq + 2], Tt[n * 65 + 4 * kq + 3]};
        *(u32x4*)(d.dst + (size_t)n * d.lddst + kq * 8) = o;
    }
}
__device__ __forceinline__ void convert_phase(const Ctx& c, int l) {
    LDSP unsigned* Tb = (LDSP unsigned*)c.lds;
    const int n4 = c.tid & 31, kr = c.tid >> 5;
    const int G = c.G;
    int job = c.bid;
    if (job >= CONV_JOBS) return;
    CJob ja = conv_desc(c, l, job), jb = ja;
    f32x4 va[8], vb[8];
    conv_load(ja, n4, kr, va);
    if (job + G < CONV_JOBS) { jb = conv_desc(c, l, job + G); conv_load(jb, n4, kr, vb); }
    for (; job < CONV_JOBS; job += 2 * G) {
        conv_tile(c, ja, Tb, n4, kr, va);
        const CJob ja_done = ja;
        if (job + 2 * G < CONV_JOBS) { ja = conv_desc(c, l, job + 2 * G); conv_load(ja, n4, kr, va); }
        if (job + G < CONV_JOBS) {
            conv_tile(c, jb, Tb + 128 * 65, n4, kr, vb);
            if (job + 3 * G < CONV_JOBS) { jb = conv_desc(c, l, job + 3 * G); conv_load(jb, n4, kr, vb); }
        }
        (void)ja_done;
    }
    __syncthreads();
}

__device__ __forceinline__ void convert_queue(const Ctx& c, int l, int quota) {
    unsigned* qh = (unsigned*)(c.ws + WS_BAR) + 3900 + 16 * l;
    volatile LDSP unsigned* tk = (volatile LDSP unsigned*)(c.lds + 147456 - 64);
    LDSP unsigned* Tb = (LDSP unsigned*)c.lds;
    const int n4 = c.tid & 31, kr = c.tid >> 5;
    for (int it = 0; it < quota; ++it) {
        __syncthreads();
        if (c.tid == 0) tk[0] = __hip_atomic_fetch_add(qh, 1u, __ATOMIC_RELAXED, __HIP_MEMORY_SCOPE_AGENT);
        __syncthreads();
        const int job = (int)tk[0];
        if (job >= CONV_JOBS) break;
        const CJob d = conv_desc(c, l, job);
        f32x4 v[8];
        conv_load(d, n4, kr, v);
        conv_tile(c, d, Tb, n4, kr, v);
    }
    __syncthreads();
}

__device__ __forceinline__ void row_stats(const f32x4 (&v)[8], float& mu, float& rstd) {
    float s = 0.f;
#pragma unroll
    for (int j = 0; j < 8; ++j) s += v[j][0] + v[j][1] + v[j][2] + v[j][3];
    mu = wsum(s) * (1.f / 2048.f);
    float q = 0.f;
#pragma unroll
    for (int j = 0; j < 8; ++j) { const f32x4 d = v[j] - mu; q += d[0] * d[0] + d[1] * d[1] + d[2] * d[2] + d[3] * d[3]; }
    rstd = rsqrtf(wsum(q) * (1.f / 2048.f) + LN_EPS);
}
__device__ __forceinline__ void modulate_store(const f32x4 (&v)[8], const float* shift, const float* scale, bf16_t* urow, int lane) {
    float mu, rstd; row_stats(v, mu, rstd);
#pragma unroll
    for (int j = 0; j < 8; ++j) {
        const int col = 256 * j + 4 * lane;
        const f32x4 sh = *(const f32x4*)(shift + col), sc = *(const f32x4*)(scale + col);
        const f32x4 y = (v[j] - mu) * rstd * (sc + 1.f) + sh;
        *(u32x2*)(urow + col) = pack4(y);
    }
}
__device__ __forceinline__ void phase_l0_modulate(const Ctx& c) {
    const float* modv = (const float*)(c.ws + WS_MODV);
    float* X = (float*)(c.ws + WS_X); bf16_t* U = (bf16_t*)(c.ws + WS_U);
    for (int row = c.bid * 8 + c.wave; row < MROWS; row += c.G * 8) {
        const int b = row / T, t = row % T;
        const float* src = t < CTX ? c.in[I_CTX] + ((size_t)b * CTX + t) * D : c.in[I_X] + ((size_t)b * SEQ + (t - CTX)) * D;
        const int r = t < CTX ? 4 : b;
        f32x4 v[8];
#pragma unroll
        for (int j = 0; j < 8; ++j) v[j] = *(const f32x4*)(src + 256 * j + 4 * c.lane);
#pragma unroll
        for (int j = 0; j < 8; ++j) *(f32x4*)(X + (size_t)row * D + 256 * j + 4 * c.lane) = v[j];
        modulate_store(v, modv + (size_t)(0 * 5 + r) * 12288, modv + (size_t)(0 * 5 + r) * 12288 + 2048, U + (size_t)row * D, c.lane);
    }
}

constexpr int GP_RAW = 0;
constexpr int GP_UT = 0;
constexpr int GP_WT = 18432;
constexpr int GP_A = 36864;
constexpr int GP_AP = 65;
constexpr int GP_TB = 53504;
constexpr int GP_CW = 53312;
constexpr int GP_Q = GP_CW + 7680;
constexpr int GP_K = GP_Q + 17408;
constexpr int GP_V = GP_K + 17408;
constexpr int GP_KDT = GP_V + 17408;
constexpr int GP_P = GP_KDT + 18432;
constexpr int GP_SM = GP_P + 9216;
constexpr int GP_END = GP_SM + 1024;
static_assert(GP_END <= 160 * 1024, "gdn prep lds");

#ifdef MK_GSTAMP
#define GST(k) do { if (c.bid == 0 && tid == 0) { const unsigned long long t_ = __builtin_amdgcn_s_memrealtime(); gst[k] += t_ - gst[8]; gst[8] = t_; } } while (0)
#else
#define GST(k)
#endif
__device__ __forceinline__ void gdn_prep_unit(const Ctx& c, int l, int cc) {
    const int n = cc % NCH, dir = (cc / NCH) & 1, h = (cc / (NCH * 2)) & 3, b = cc / (NCH * 8);
    int tid_ = c.tid; asm volatile("" : "+v"(tid_));
    const int tid = tid_, lane = tid_ & 63, wave = c.wave;
    LDSP unsigned char* L = c.lds;
    LDSP bf16_t* raw = (LDSP bf16_t*)(L + GP_RAW);
    LDSP float* cw = (LDSP float*)(L + GP_CW);
    LDSP bf16_t* Qs = (LDSP bf16_t*)(L + GP_Q);
    LDSP bf16_t* Ks = (LDSP bf16_t*)(L + GP_K);
    LDSP bf16_t* Vs = (LDSP bf16_t*)(L + GP_V);
    LDSP bf16_t* KdT = (LDSP bf16_t*)(L + GP_KDT);
    LDSP bf16_t* Pm = (LDSP bf16_t*)(L + GP_P);
    LDSP bf16_t* UT = (LDSP bf16_t*)(L + GP_UT);
    LDSP bf16_t* WT = (LDSP bf16_t*)(L + GP_WT);
    LDSP float* Am = (LDSP float*)(L + GP_A);
    LDSP float* sm = (LDSP float*)(L + GP_SM);
    const bf16_t* proj = (const bf16_t*)(c.ws + WS_RA + RA_PROJ);
    const int seg0 = n < 4 ? 0 : CTX, seg1 = n < 4 ? CTX : T;
    const size_t rowb = (size_t)b * T;
#ifdef MK_GSTAMP
    volatile LDSP unsigned long long* gst = (volatile LDSP unsigned long long*)(c.lds + 147456 - 48 - 80);
    if (c.bid == 0 && tid == 0) gst[8] = __builtin_amdgcn_s_memrealtime();
#endif

    for (int ch = tid; ch < 68 * 48; ch += 512) {
        const int rr = ch / 48, c16 = ch % 48, part = c16 >> 4, d8 = c16 & 15;
        const int t = n * 64 - 2 + rr;
        u32x4 v = (u32x4){0u, 0u, 0u, 0u};
        if (t >= seg0 && t < seg1) v = *(const u32x4*)(proj + (rowb + t) * NINP + part * 512 + h * 128 + d8 * 8);
        *(LDSP u32x4*)(raw + rr * 392 + part * 128 + d8 * 8) = v;
    }
    for (int i = tid; i < 5 * 384; i += 512) {
        const int j = i / 384, cidx = i % 384, part = cidx >> 7, d = cidx & 127;
        cw[i] = c.in[I_CONV][(size_t)(l * 5 + j) * 1536 + part * 512 + h * 128 + d];
    }
    if (wave == 0) {
        const int t = tok_of(n, dir, lane);
        const bf16_t* pr = proj + (rowb + t) * NINP;
        const float beta = sigmoidf_(bf2f(pr[C_ABETA + dir * 4 + h]));
        const float la = -__expf(c.in[I_ALOG][l * 8 + dir * 4 + h]) * softplusf_(bf2f(pr[C_ADEC + dir * 4 + h]) + c.in[I_DTB][l * 8 + dir * 4 + h]);
        float g = la;
#pragma unroll
        for (int m = 1; m < 64; m <<= 1) { const float o = __shfl_up(g, m); if (lane >= m) g += o; }
        const float gend = __shfl(g, 63);
        sm[lane] = g; sm[64 + lane] = beta; sm[128 + lane] = __expf(g); sm[192 + lane] = __expf(gend - g);
    }
    __syncthreads();
    GST(0);
    {
        const int i = tid >> 3, gq = tid & 7;
        const int rc = (dir ? 63 - i : i) + 2;
#pragma unroll
        for (int part = 0; part < 3; ++part) {
            float a[16];
#pragma unroll
            for (int e = 0; e < 16; ++e) a[e] = 0.f;
#pragma unroll
            for (int j = 0; j < 5; ++j) {
                const LDSP bf16_t* rp = raw + (rc - 2 + j) * 392 + part * 128 + gq * 16;
                const LDSP float* wp = cw + j * 384 + part * 128 + gq * 16;
#pragma unroll
                for (int hf = 0; hf < 2; ++hf) {
                    const u32x4 r4 = *(const LDSP u32x4*)(rp + hf * 8);
                    const f32x4 w0 = *(const LDSP f32x4*)(wp + hf * 8), w1 = *(const LDSP f32x4*)(wp + hf * 8 + 4);
                    a[hf * 8 + 0] += bflo(r4[0]) * w0[0]; a[hf * 8 + 1] += bfhi(r4[0]) * w0[1]; a[hf * 8 + 2] += bflo(r4[1]) * w0[2]; a[hf * 8 + 3] += bfhi(r4[1]) * w0[3];
                    a[hf * 8 + 4] += bflo(r4[2]) * w1[0]; a[hf * 8 + 5] += bfhi(r4[2]) * w1[1]; a[hf * 8 + 6] += bflo(r4[3]) * w1[2]; a[hf * 8 + 7] += bfhi(r4[3]) * w1[3];
                }
            }
            float ss = 0.f;
#pragma unroll
            for (int e = 0; e < 16; ++e) { a[e] = siluf_(a[e]); ss += a[e] * a[e]; }
            float sc = 1.f;
            if (part < 2) {
#pragma unroll
                for (int m = 1; m < 8; m <<= 1) ss += __shfl_xor(ss, m);
                sc = rsqrtf(ss + NORM_EPS) * (part == 0 ? 0.08838834764831845f : 1.f);
            }
            LDSP bf16_t* dq = (part == 0 ? Qs : part == 1 ? Ks : Vs) + i * 136 + gq * 16;
            *(LDSP u32x4*)dq = (u32x4){pk2(a[0] * sc, a[1] * sc), pk2(a[2] * sc, a[3] * sc), pk2(a[4] * sc, a[5] * sc), pk2(a[6] * sc, a[7] * sc)};
            *(LDSP u32x4*)(dq + 8) = (u32x4){pk2(a[8] * sc, a[9] * sc), pk2(a[10] * sc, a[11] * sc), pk2(a[12] * sc, a[13] * sc), pk2(a[14] * sc, a[15] * sc)};
            asm volatile("" ::: "memory");
        }
    }
    __syncthreads();
    GST(1);
#pragma unroll
    for (int p = 0; p < 2; ++p) {
        const int id = p * 512 + tid, d = id & 127, i0 = (id >> 7) * 8;
        unsigned w[4];
#pragma unroll
        for (int e = 0; e < 8; e += 2) w[e >> 1] = pk2(bf2f(Ks[(i0 + e) * 136 + d]) * sm[192 + i0 + e], bf2f(Ks[(i0 + e + 1) * 136 + d]) * sm[192 + i0 + e + 1]);
        *(LDSP u32x4*)(KdT + d * 72 + i0) = (u32x4){w[0], w[1], w[2], w[3]};
    }
#pragma unroll
    for (int tt = 0; tt < 4; ++tt) {
        const int id = wave * 4 + tt, which = id >> 4, ti = (id & 15) >> 2, tj = id & 3;
        const int r = lane & 15, q4 = lane >> 4;
        if (which == 0) {
            if (tj <= ti) {
                f32x4 a = mma_tile<4>(Ks + ti * 16 * 136, 136, Ks + tj * 16 * 136, 136, (f32x4){0.f, 0.f, 0.f, 0.f}, lane);
                const int j = tj * 16 + r; const float gj = sm[j];
#pragma unroll
                for (int e = 0; e < 4; ++e) { const int i = ti * 16 + q4 * 4 + e; Am[i * GP_AP + j] = (i > j) ? sm[64 + i] * a[e] * __expf(sm[i] - gj) : 0.f; }
            }
        } else {
            f32x4 o = (f32x4){0.f, 0.f, 0.f, 0.f};
            if (tj <= ti) {
                const f32x4 a = mma_tile<4>(Ks + tj * 16 * 136, 136, Qs + ti * 16 * 136, 136, (f32x4){0.f, 0.f, 0.f, 0.f}, lane);
                const int i = ti * 16 + r; const float gi = sm[i];
#pragma unroll
                for (int e = 0; e < 4; ++e) { const int j = tj * 16 + q4 * 4 + e; o[e] = (i >= j) ? a[e] * __expf(gi - sm[j]) : 0.f; }
            }
            *(LDSP u32x2*)(Pm + (ti * 16 + r) * 72 + tj * 16 + q4 * 4) = pack4(o);
        }
    }
    __syncthreads();
    GST(2);
    {
        LDSP float* TB = (LDSP float*)(L + GP_TB);
        const int r = lane & 15, q4 = lane >> 4;
        if (wave == 0) {
            const int I = lane >> 4, cidx = lane & 15;
            float x[16];
#pragma unroll
            for (int i = 0; i < 16; ++i) {
                float v = (i == cidx) ? 1.f : 0.f;
#pragma unroll
                for (int j = 0; j < i; ++j) v -= Am[(16 * I + i) * GP_AP + 16 * I + j] * x[j];
                x[i] = v;
            }
#pragma unroll
            for (int i = 0; i < 16; ++i) TB[(I * 16 + i) * 16 + cidx] = x[i];
        }
        f32x4 acc[4][2];
        const LDSP bf16_t* src = wave < 4 ? Vs : Ks;
        const int cb = (wave & 3) * 32;
#pragma unroll
        for (int I = 0; I < 4; ++I)
#pragma unroll
            for (int t = 0; t < 2; ++t)
#pragma unroll
                for (int e = 0; e < 4; ++e) {
                    const int row = 16 * I + 4 * q4 + e;
                    acc[I][t][e] = sm[64 + row] * bf2f(src[row * 136 + cb + 16 * t + r]) * (wave < 4 ? 1.f : sm[128 + row]);
                }
        __syncthreads();
        LDSP bf16_t* dstp = wave < 4 ? UT : WT;
#pragma unroll
        for (int I = 0; I < 4; ++I) {
            f32x4 x[2] = {(f32x4){0.f, 0.f, 0.f, 0.f}, (f32x4){0.f, 0.f, 0.f, 0.f}};
#pragma unroll
            for (int s4 = 0; s4 < 4; ++s4) {
                const float a = TB[(I * 16 + r) * 16 + 4 * q4 + s4];
#pragma unroll
                for (int t = 0; t < 2; ++t) x[t] = __builtin_amdgcn_mfma_f32_16x16x4f32(a, acc[I][t][s4], x[t], 0, 0, 0);
            }
#pragma unroll
            for (int Ip = I + 1; Ip < 4; ++Ip)
#pragma unroll
                for (int s4 = 0; s4 < 4; ++s4) {
                    const float a = -Am[(16 * Ip + r) * GP_AP + 16 * I + 4 * q4 + s4];
#pragma unroll
                    for (int t = 0; t < 2; ++t) acc[Ip][t] = __builtin_amdgcn_mfma_f32_16x16x4f32(a, x[t][s4], acc[Ip][t], 0, 0, 0);
                }
#pragma unroll
            for (int t = 0; t < 2; ++t) *(LDSP u32x2*)(dstp + (cb + 16 * t + r) * 72 + 16 * I + 4 * q4) = pack4(x[t]);
        }
    }
    __syncthreads();
    GST(3);
    {
        const size_t cs = (size_t)n * 32 + cc / NCH;
        bf16_t* Mg = (bf16_t*)(c.ws + WS_RA + RA_GM) + cs * 16384;
        bf16_t* Bg = (bf16_t*)(c.ws + WS_RA + RA_GB) + cs * 16384;
        bf16_t* Qg = (bf16_t*)(c.ws + WS_RA + RA_GQ) + cs * 8192;
        bf16_t* Og = (bf16_t*)(c.ws + WS_RA + RA_GO) + cs * 8192;
        const float ge = sm[128 + 63];
        const int r = lane & 15, q4 = lane >> 4;
        const f32x4 z = (f32x4){0.f, 0.f, 0.f, 0.f};
        for (int id = wave; id < 192; id += 8) {
            if (id < 32) {
                const int td = id >> 2, ti = id & 3;
                const f32x4 a = mma_tile<2>(WT + td * 16 * 72, 72, Pm + ti * 16 * 72, 72, z, lane);
                const int i = ti * 16 + r, d0 = td * 16 + q4 * 4; const float egi = sm[128 + i];
                f32x4 o;
#pragma unroll
                for (int e = 0; e < 4; ++e) o[e] = bf2f(Qs[i * 136 + d0 + e]) * egi - a[e];
                *(u32x2*)(Qg + (((ti * 4 + (td >> 1)) * 4 + ((2 * td + (q4 >> 1)) & 3)) * 16 + r) * 8 + 4 * (q4 & 1)) = pack4(o);
            } else if (id < 64) {
                const int td = (id - 32) >> 2, ti = id & 3;
                const f32x4 a = mma_tile<2>(UT + td * 16 * 72, 72, Pm + ti * 16 * 72, 72, z, lane);
                *(u32x2*)(Og + ((ti * 8 + td) * 64 + lane) * 4) = pack4(a);
            } else if (id < 128) {
                const int tc = (id - 64) >> 3, tr = id & 7;
                const f32x4 a = mma_tile<2>(WT + tc * 16 * 72, 72, KdT + tr * 16 * 72, 72, z, lane);
                const int dk = tr * 16 + r, d0 = tc * 16 + q4 * 4;
                f32x4 o;
#pragma unroll
                for (int e = 0; e < 4; ++e) o[e] = ((dk == d0 + e) ? ge : 0.f) - a[e];
                *(u32x2*)(Mg + (((tr * 4 + (tc >> 1)) * 4 + ((2 * tc + (q4 >> 1)) & 3)) * 16 + r) * 8 + 4 * (q4 & 1)) = pack4(o);
            } else {
                const int tr = (id - 128) >> 3, tc = id & 7;
                const f32x4 a = mma_tile<2>(KdT + tr * 16 * 72, 72, UT + tc * 16 * 72, 72, z, lane);
                *(u32x2*)(Bg + ((tc * 8 + tr) * 64 + lane) * 4) = pack4(a);
            }
        }
    }
    __syncthreads();
    GST(4);
}

constexpr int DP_QS = 0;
constexpr int DP_KSELF = 17408;
constexpr int DP_KSC = 34816;
constexpr int DP_KDT = 60928;
constexpr int DP_VT = 79360;
constexpr int DP_P = 97792;
constexpr int DP_TOT = 107008;
constexpr int DP_CODE = 111104;
constexpr int DP_QG = 115200;
constexpr int DP_END = 132608;

template <int MIX>
__device__ __forceinline__ void diag_prep_unit(const Ctx& c, int l, int cc) {
    constexpr int DK = (MIX == 1) ? 128 : 64;
    constexpr int PQ = DK + 8;
    const int n = cc % NCH, dir = (cc / NCH) & 1, h = (cc / (NCH * 2)) & 3, b = cc / (NCH * 8);
    const int tid = c.tid, lane = c.lane, wave = c.wave;
    LDSP unsigned char* L = c.lds;
    LDSP bf16_t* Qs = (LDSP bf16_t*)(L + DP_QS);
    LDSP bf16_t* Kself = (LDSP bf16_t*)(L + DP_KSELF);
    LDSP bf16_t* Ksc = (LDSP bf16_t*)(L + DP_KSC);
    LDSP bf16_t* KdT = (LDSP bf16_t*)(L + DP_KDT);
    LDSP bf16_t* VT = (LDSP bf16_t*)(L + DP_VT);
    LDSP bf16_t* Pm = (LDSP bf16_t*)(L + DP_P);
    LDSP float* tot = (LDSP float*)(L + DP_TOT);
    LDSP float* code = (LDSP float*)(L + DP_CODE);
    LDSP bf16_t* Qt = (LDSP bf16_t*)(L + DP_QG);
    const bf16_t* proj = (const bf16_t*)(c.ws + WS_RA + RA_PROJ);
    const size_t rowb = (size_t)b * T;
    bf16_t* Bg; bf16_t* Qg; bf16_t* Og; float* Ag;
    const size_t cs = (size_t)n * 32 + cc / NCH;
    if (MIX == 1) { Bg = (bf16_t*)(c.ws + WS_RA + RA_HB) + cs * 16384; Qg = (bf16_t*)(c.ws + WS_RA + RA_HQ) + cs * 8192;
                    Og = (bf16_t*)(c.ws + WS_RA + RA_HO) + cs * 8192; Ag = (float*)(c.ws + WS_RA + RA_HA) + cs * 128; }
    else          { Bg = (bf16_t*)(c.ws + WS_RA + RA_LB) + cs * 8192; Qg = (bf16_t*)(c.ws + WS_RA + RA_LQ) + cs * 4096;
                    Og = (bf16_t*)(c.ws + WS_RA + RA_LO) + cs * 8192; Ag = (float*)(c.ws + WS_RA + RA_LA) + cs * 64; }

    {
        constexpr int CPR = DK / 8;
        const int vcol = (MIX == 1 ? C_CI : C_BV) + h * 128;
        const int qcol = (MIX == 1 ? C_CQ + h * 128 : C_BQ + h * 64), kcol = (MIX == 1 ? C_CF + dir * 512 + h * 128 : C_BK + h * 64);
#pragma unroll
        for (int p = 0; p < 2; ++p) {
            const int id = p * 512 + tid, i = id >> 4, c8 = id & 15;
            *(LDSP u32x4*)(VT + i * 136 + c8 * 8) = *(const u32x4*)(proj + (rowb + tok_of(n, dir, i)) * NINP + vcol + c8 * 8);
        }
#pragma unroll
        for (int p = 0; p < (64 * CPR) / 512; ++p) {
            const int id = p * 512 + tid, i = id / CPR, c8 = id % CPR;
            const bf16_t* pr = proj + (rowb + tok_of(n, dir, i)) * NINP;
            *(LDSP u32x4*)(Qs + i * PQ + c8 * 8) = *(const u32x4*)(pr + qcol + c8 * 8);
            *(LDSP u32x4*)(Kself + i * PQ + c8 * 8) = *(const u32x4*)(pr + kcol + c8 * 8);
        }
        if (MIX == 2) for (int i = tid; i < 64 * 16; i += 512) code[i] = bf2f(proj[(rowb + tok_of(n, dir, i >> 4)) * NINP + C_BCODE + dir * 16 + (i & 15)]);
        for (int i = tid; i < 64 * 36; i += 512) ((LDSP unsigned*)Pm)[i] = 0u;
    }
    __syncthreads();
    constexpr int TPT = DK / 8, NSUB = 64 / TPT;
    const int d = tid % DK, J = tid / DK, I = (J * TPT) >> 4;
    float qv[TPT], kv[TPT], bl[TPT];
    {
        float lb = 0.f, wg[16], bg = 0.f;
        if (MIX == 1) {
            const float* gam = c.in[I_HGAM] + (size_t)dir * DEPTH * 512 + h * 128 + d;
            float mx = gam[0];
#pragma unroll
            for (int i = 1; i < DEPTH; ++i) mx = fmaxf(mx, gam[i * 512]);
            float den = 0.f, num = 0.f;
#pragma unroll
            for (int i = 0; i < DEPTH; ++i) { const float e = __expf(gam[i * 512] - mx); den += e; if (i >= 1 && i <= l) num += e; }
            lb = num / den;
        } else {
#pragma unroll
            for (int r = 0; r < 16; ++r) wg[r] = c.in[I_GLAW][((size_t)(l * 2 + dir) * 16 + r) * 256 + h * 64 + d];
            bg = c.in[I_GLAB][(l * 2 + dir) * 256 + h * 64 + d];
        }
        float run = 0.f;
#pragma unroll
        for (int s = 0; s < TPT; ++s) {
            const int i = J * TPT + s, t = tok_of(n, dir, i);
            float la;
            if (MIX == 1) {
                qv[s] = bf2f(Qs[i * PQ + d]);
                const float f = lb + (1.f - lb) * sigmoidf_(bf2f(Kself[i * PQ + d]));
                la = __logf(f); kv[s] = 1.f - f;
            } else {
                float q0 = bf2f(Qs[i * PQ + d]) * 0.125f, k0 = bf2f(Kself[i * PQ + d]);
                if (n >= 4) {
                    const int pos = t - CTX, hf = d >> 5, idx = d & 31, fi = idx & 15;
                    const float p = (float)(hf ? (pos & 63) : (pos >> 6));
                    const float inv = __expf(-(float)fi * (9.210340371976184f / 16.f));
                    float ang = p * inv;
                    const float kk = rintf(ang * 0.15915494309189535f);
                    ang = fmaf(-kk, 6.2831855f, ang); ang = fmaf(-kk, -1.7484555e-7f, ang);
                    const float cs = __cosf(ang), sn = __sinf(ang);
                    const int dp = idx < 16 ? d + 16 : d - 16;
                    const float q1 = bf2f(Qs[i * PQ + dp]) * 0.125f, k1 = bf2f(Kself[i * PQ + dp]);
                    if (idx < 16) { q0 = q0 * cs - q1 * sn; k0 = k0 * cs - k1 * sn; }
                    else          { q0 = q1 * sn + q0 * cs; k0 = k1 * sn + k0 * cs; }
                }
                qv[s] = q0; kv[s] = k0;
                float gt = bg;
#pragma unroll
                for (int r4 = 0; r4 < 4; ++r4) { const f32x4 cv = *(const LDSP f32x4*)(code + i * 16 + r4 * 4);
                    gt += cv[0] * wg[r4 * 4] + cv[1] * wg[r4 * 4 + 1] + cv[2] * wg[r4 * 4 + 2] + cv[3] * wg[r4 * 4 + 3]; }
                la = -softplusf_(-gt) * (1.f / 16.f);
            }
            run += la; bl[s] = run;
        }
        tot[J * 128 + d] = run;
    }
    __syncthreads();
    {
        float pre = 0.f, bend = 0.f, hb = 0.f, tI[4] = {0.f, 0.f, 0.f, 0.f};
#pragma unroll
        for (int m = 0; m < NSUB; ++m) {
            const float tm = tot[m * 128 + d]; const int Im = (m * TPT) >> 4;
            bend += tm; tI[Im] += tm;
            if (Im < I) pre += tm; else if (Im == I && m < J) hb += tm;
        }
        unsigned kd[TPT / 2];
        const float epre = __expf(pre), eend = __expf(bend - pre);
        float eoff[4]; { float off = 0.f;
#pragma unroll
            for (int Ip = 1; Ip < 4; ++Ip) { if (Ip > I) off += tI[Ip - 1]; eoff[Ip] = __expf(off); } }
#pragma unroll
        for (int s = 0; s < TPT; ++s) {
            const int i = J * TPT + s, s16 = i & 15;
            const float b16 = hb + bl[s];
            const float eb = __expf(b16), ebi = __builtin_amdgcn_rcpf(eb);
            Qs[i * PQ + d] = f2bf(qv[s] * eb);
            Kself[i * PQ + d] = f2bf(kv[s] * ebi);
            Qt[i * PQ + d] = f2bf(qv[s] * (epre * eb));
            const float kdv = kv[s] * (eend * ebi);
            if (s & 1) kd[s >> 1] = (kd[s >> 1] & 0xffffu) | ((unsigned)f2bf(kdv) << 16); else kd[s >> 1] = f2bf(kdv);
#pragma unroll
            for (int Ip = 1; Ip < 4; ++Ip) {
                if (Ip > I) Ksc[((Ip * (Ip - 1) / 2 + I) * 16 + s16) * PQ + d] = f2bf(kv[s] * (eoff[Ip] * ebi));
            }
        }
#pragma unroll
        for (int w8 = 0; w8 < TPT / 8; ++w8)
            *(LDSP u32x4*)(KdT + d * 72 + J * TPT + w8 * 8) = (u32x4){kd[w8 * 4], kd[w8 * 4 + 1], kd[w8 * 4 + 2], kd[w8 * 4 + 3]};
        if (J == 0) Ag[d] = __expf(bend);
    }
    __syncthreads();
#pragma unroll
    for (int p = 0; p < (64 * DK / 8) / 512; ++p) {
        const int id = p * 512 + tid, fl = id & 63, fr = id >> 6;
        const int ott_ = fr / (DK / 32), kk_ = fr % (DK / 32);
        *(u32x4*)(Qg + (size_t)id * 8) = *(const LDSP u32x4*)(Qt + (ott_ * 16 + (fl & 15)) * PQ + kk_ * 32 + (fl >> 4) * 8);
    }
    for (int blk = wave; blk < 10; blk += 8) {
        int Ib, Jb;
        if (blk < 4) { Ib = blk; Jb = blk; } else { const int s = blk - 4; Ib = s < 1 ? 1 : (s < 3 ? 2 : 3); Jb = s - (Ib * (Ib - 1) / 2); }
        const LDSP bf16_t* kp = (Ib == Jb) ? Kself + Jb * 16 * PQ : Ksc + (Ib * (Ib - 1) / 2 + Jb) * 16 * PQ;
        const f32x4 a = mma_tile<DK / 32>(kp, PQ, Qs + Ib * 16 * PQ, PQ, (f32x4){0.f, 0.f, 0.f, 0.f}, lane);
        const int r = lane & 15, q4 = lane >> 4;
        f32x4 o;
#pragma unroll
        for (int e = 0; e < 4; ++e) o[e] = (Ib > Jb || r >= q4 * 4 + e) ? a[e] : 0.f;
        *(LDSP u32x2*)(Pm + (Ib * 16 + r) * 72 + Jb * 16 + q4 * 4) = pack4(o);
    }
    __syncthreads();
    {
        const int r = lane & 15, q4 = lane >> 4;
        const f32x4 z = (f32x4){0.f, 0.f, 0.f, 0.f};
        constexpr int NT2 = (DK / 16) * 8;
        for (int id = wave; id < 32 + NT2; id += 8) {
            if (id < 32) {
                const int td = id >> 2, ti = id & 3;
                f32x4 a = z;
#pragma unroll
                for (int kk = 0; kk < 2; ++kk)
                    a = __builtin_amdgcn_mfma_f32_16x16x32_bf16(frag_tr16(VT + kk * 32 * 136 + td * 16, 136, lane), *(const LDSP bf16x8*)(Pm + (ti * 16 + r) * 72 + kk * 32 + q4 * 8), a, 0, 0, 0);
                *(u32x2*)(Og + ((ti * 8 + td) * 64 + lane) * 4) = pack4(a);
            } else {
                const int j = id - 32, tk = j >> 3, tv = j & 7;
                f32x4 a = z;
#pragma unroll
                for (int kk = 0; kk < 2; ++kk)
                    a = __builtin_amdgcn_mfma_f32_16x16x32_bf16(*(const LDSP bf16x8*)(KdT + (tk * 16 + r) * 72 + kk * 32 + q4 * 8), frag_tr16(VT + kk * 32 * 136 + tv * 16, 136, lane), a, 0, 0, 0);
                *(u32x2*)(Bg + ((tv * (DK / 16) + tk) * 64 + lane) * 4) = pack4(a);
            }
        }
    }
    __syncthreads();
}

template <int MIX, int DVS, int RING>
__device__ __forceinline__ void scan_unit(const Ctx& c, int chain, int slice) {
    constexpr int DK = (MIX == 2) ? 64 : 128;
    constexpr int PS = DK + 8;
    constexpr int NDK = DK / 16, NG = 8 / NDK;
    constexpr int NS = (DVS / 16) / NG;
    constexpr int NO = (DVS / 16) / 2;
    constexpr int KS = DK / 32;
    const int lane = c.lane, wave = c.wave, r = lane & 15, q4 = lane >> 4;
    const int dir = chain & 1, h = (chain >> 1) & 3, b = chain >> 3;
    LDSP bf16_t* ST = (LDSP bf16_t*)c.lds;
    constexpr int PO = DVS + 8;
    LDSP bf16_t* OS = ST + DVS * PS;
    for (int i = c.tid; i < DVS * PS / 2; i += 512) ((LDSP unsigned*)ST)[i] = 0u;
    const int dkt = wave % NDK;
    const int dvt0 = (wave / NDK) * NS;
    const int ott = wave >> 1;
    const int odv0 = (wave & 1) * NO;
    const bf16_t* Mg = (const bf16_t*)(c.ws + WS_RA + RA_GM);
    const bf16_t* Bg = (const bf16_t*)(c.ws + WS_RA + (MIX == 0 ? RA_GB : MIX == 1 ? RA_HB : RA_LB));
    const bf16_t* Qg = (const bf16_t*)(c.ws + WS_RA + (MIX == 0 ? RA_GQ : MIX == 1 ? RA_HQ : RA_LQ));
    const bf16_t* Og = (const bf16_t*)(c.ws + WS_RA + (MIX == 0 ? RA_GO : MIX == 1 ? RA_HO : RA_LO));
    const float* Ag = (const float*)(c.ws + WS_RA + (MIX == 1 ? RA_HA : RA_LA));
    bf16_t* OB = (bf16_t*)(c.ws + WS_RA + RA_OB) + ((size_t)(MIX * 2 + dir) * MROWS) * 512;
    f32x4 S[NS];
#pragma unroll
    for (int t = 0; t < NS; ++t) S[t] = (f32x4){0.f, 0.f, 0.f, 0.f};
    struct Ld { bf16x8 mf[KS]; u32x2 bt[NS]; f32x4 ae; bf16x8 qf[KS]; u32x2 ot[NO]; };
    Ld ring[RING];
    auto load = [&](Ld& d, int s) {
        const int n = dir ? (s < 4 ? 3 - s : 71 - s) : s;
        const size_t cc = (size_t)n * 32 + chain;
        if (MIX == 0) {
#pragma unroll
            for (int kk = 0; kk < KS; ++kk) d.mf[kk] = *(const bf16x8*)(Mg + cc * 16384 + ((dkt * 4 + kk) * 64 + lane) * 8);
        } else {
            d.ae = *(const f32x4*)(Ag + cc * DK + dkt * 16 + q4 * 4);
        }
#pragma unroll
        for (int t = 0; t < NS; ++t) d.bt[t] = *(const u32x2*)(Bg + cc * (128 * DK) + (((slice * (DVS / 16) + dvt0 + t) * NDK + dkt) * 64 + lane) * 4);
#pragma unroll
        for (int kk = 0; kk < KS; ++kk) d.qf[kk] = *(const bf16x8*)(Qg + cc * (64 * DK) + ((ott * KS + kk) * 64 + lane) * 8);
#pragma unroll
        for (int t = 0; t < NO; ++t) d.ot[t] = *(const u32x2*)(Og + cc * 8192 + ((ott * 8 + slice * (DVS / 16) + odv0 + t) * 64 + lane) * 4);
    };
#pragma unroll
    for (int k = 0; k < RING; ++k) load(ring[k], k);
    __syncthreads();
    for (int s0 = 0; s0 < NCH; s0 += RING) {
#pragma unroll
      for (int k = 0; k < RING; ++k) {
        const int s = s0 + k;
        if (s >= NCH) break;
        Ld& cur = ring[k];
        const int n = dir ? (s < 4 ? 3 - s : 71 - s) : s;
#pragma unroll
        for (int t = 0; t < NO; ++t) {
            f32x4 a = (f32x4){bflo(cur.ot[t].x), bfhi(cur.ot[t].x), bflo(cur.ot[t].y), bfhi(cur.ot[t].y)};
#pragma unroll
            for (int kk = 0; kk < KS; ++kk) {
                const bf16x8 sf = *(const LDSP bf16x8*)(ST + ((odv0 + t) * 16 + r) * PS + kk * 32 + q4 * 8);
                a = __builtin_amdgcn_mfma_f32_16x16x32_bf16(sf, cur.qf[kk], a, 0, 0, 0);
            }
            *(LDSP u32x2*)(OS + (s & 1) * 64 * PO + (ott * 16 + r) * PO + (odv0 + t) * 16 + q4 * 4) = pack4(a);
        }
        f32x4 Sn[NS];
#pragma unroll
        for (int t = 0; t < NS; ++t) {
            const f32x4 bm = (f32x4){bflo(cur.bt[t].x), bfhi(cur.bt[t].x), bflo(cur.bt[t].y), bfhi(cur.bt[t].y)};
            if (MIX == 0) {
                f32x4 a = bm;
#pragma unroll
                for (int kk = 0; kk < KS; ++kk) {
                    const bf16x8 sf = *(const LDSP bf16x8*)(ST + ((dvt0 + t) * 16 + r) * PS + kk * 32 + q4 * 8);
                    a = __builtin_amdgcn_mfma_f32_16x16x32_bf16(cur.mf[kk], sf, a, 0, 0, 0);
                }
                Sn[t] = a;
            } else {
                Sn[t] = cur.ae * S[t] + bm;
            }
        }
        if (s + RING < NCH) load(cur, s + RING);
        __syncthreads();
#pragma unroll
        for (int t = 0; t < NS; ++t) { S[t] = Sn[t]; *(LDSP u32x2*)(ST + ((dvt0 + t) * 16 + r) * PS + dkt * 16 + q4 * 4) = pack4(Sn[t]); }
#pragma unroll
        for (int id = c.tid; id < 64 * (DVS / 8); id += 512) {
            const int i = id / (DVS / 8), ch = id % (DVS / 8);
            *(u32x4*)(OB + ((size_t)b * T + tok_of(n, dir, i)) * 512 + h * 128 + slice * DVS + ch * 8) = *(const LDSP u32x4*)(OS + (s & 1) * 64 * PO + i * PO + ch * 8);
        }
        __syncthreads();
      }
    }
}

constexpr int NA_Q = 0, NA_K = 17408, NA_VT = 34816, NA_P = 53248, NA_GRP = 62464;
constexpr int NA_RPB = 2 * NA_GRP;
__device__ __forceinline__ void na_pair(const Ctx& c, int l, int pair) {
    const int tid = c.tid, lane = c.lane, wave = c.wave, grp = wave >> 2, gw = wave & 3, gt = tid & 255;
    const int r = lane & 15, q4 = lane >> 4;
    const bool is_lat = pair < 512;
    int b, h, gr = 0, qb = 0;
    if (is_lat) { const int u = pair * 2 + grp; b = u >> 8; h = (u >> 6) & 3; gr = u & 63; }
    else { const int u = (pair - 512) * 2 + grp; b = u >> 4; h = (u >> 2) & 3; qb = u & 3; }
    const int NT = is_lat ? 12 : 4;
    const int rs = gr - 4 < 0 ? 0 : (gr - 4 > 56 ? 56 : gr - 4);
    LDSP unsigned char* L = c.lds + grp * NA_GRP;
    LDSP bf16_t* Qs = (LDSP bf16_t*)(L + NA_Q);
    LDSP bf16_t* Kt = (LDSP bf16_t*)(L + NA_K);
    LDSP bf16_t* VT = (LDSP bf16_t*)(L + NA_VT);
    LDSP bf16_t* Pm = (LDSP bf16_t*)(L + NA_P);
    LDSP float* rpb = (LDSP float*)(c.lds + NA_RPB);
    const bf16_t* proj = (const bf16_t*)(c.ws + WS_RA + RA_PROJ);
    const size_t rowb = (size_t)b * T;
    const int qtok0 = is_lat ? CTX + gr * 64 : qb * 64;
#pragma unroll
    for (int p = 0; p < 4; ++p) {
        const int id = p * 256 + gt, qi = id >> 4, c8 = id & 15;
        *(LDSP u32x4*)(Qs + qi * 136 + c8 * 8) = *(const u32x4*)(proj + (rowb + qtok0 + qi) * NINP + C_DQ + h * 128 + c8 * 8);
    }
    if (tid < 465) rpb[tid] = c.in[I_RPB][(size_t)(l * 4 + h) * 465 + tid];
    float m_run = -1e30f, l_run = 0.f;
    f32x4 acc[8];
#pragma unroll
    for (int dt = 0; dt < 8; ++dt) acc[dt] = (f32x4){0.f, 0.f, 0.f, 0.f};
    const float SC = 0.08838834764831845f * 1.4426950408889634f;
    const int cq = gw * 16 + r;
    const int cs = cq - 8 < 0 ? 0 : (cq - 8 > 48 ? 48 : cq - 8);
    u32x4 kreg[4], vreg[4];
#define NA_KTOK0(kt_) (is_lat ? ((kt_) < 8 ? CTX + (rs + (kt_)) * 64 : ((kt_) - 8) * 64) : (kt_) * 64)
#define NA_PREFETCH(kt_) do { const int kb_ = NA_KTOK0(kt_); _Pragma("unroll") for (int p = 0; p < 4; ++p) { \
        const int id = p * 256 + gt; kreg[p] = *(const u32x4*)(proj + (rowb + kb_ + (id >> 4)) * NINP + C_DK + h * 128 + (id & 15) * 8); \
        vreg[p] = *(const u32x4*)(proj + (rowb + kb_ + (id >> 4)) * NINP + C_DV + h * 128 + (id & 15) * 8); } } while (0)
    NA_PREFETCH(0);
    for (int kt = 0; kt < NT; ++kt) {
        const bool loc = is_lat && kt < 8;
        __syncthreads();
#pragma unroll
        for (int p = 0; p < 4; ++p) {
            const int id = p * 256 + gt, j = id >> 4, c8 = id & 15;
            *(LDSP u32x4*)(Kt + j * 136 + c8 * 8) = kreg[p];
            *(LDSP u32x4*)(VT + j * 136 + c8 * 8) = vreg[p];
        }
        if (kt + 1 < NT) NA_PREFETCH(kt + 1);
        __syncthreads();
        f32x4 sc[4];
        float tmax = -1e30f;
        const int ct0 = loc ? (gw <= 1 ? 0 : gw - 1) : 0, ct1 = loc ? (gw >= 2 ? 3 : gw + 1) : 3;
#pragma unroll
        for (int ct = 0; ct < 4; ++ct) {
            if (ct < ct0 || ct > ct1) { sc[ct] = (f32x4){-INFINITY, -INFINITY, -INFINITY, -INFINITY}; continue; }
            sc[ct] = mma_tile<4>(Kt + ct * 16 * 136, 136, Qs + gw * 16 * 136, 136, (f32x4){0.f, 0.f, 0.f, 0.f}, lane);
#pragma unroll
            for (int e = 0; e < 4; ++e) {
                float s = sc[ct][e] * SC;
                if (loc) {
                    const int ck = ct * 16 + q4 * 4 + e;
                    int dc = ck - cq; dc = dc < -15 ? -15 : (dc > 15 ? 15 : dc);
                    const int dr = rs + kt - gr + 7;
                    s += rpb[dr * 31 + dc + 15] * 1.4426950408889634f;
                    if (ck < cs || ck >= cs + 16) s = -INFINITY;
                }
                sc[ct][e] = s; tmax = fmaxf(tmax, s);
            }
        }
        tmax = fmaxf(tmax, __shfl_xor(tmax, 16)); tmax = fmaxf(tmax, __shfl_xor(tmax, 32));
        const float m_new = fmaxf(m_run, tmax);
        const float alpha = __builtin_amdgcn_exp2f(m_run - m_new);
        float psum = 0.f;
#pragma unroll
        for (int ct = 0; ct < 4; ++ct) {
            f32x4 p;
#pragma unroll
            for (int e = 0; e < 4; ++e) { p[e] = __builtin_amdgcn_exp2f(sc[ct][e] - m_new); psum += p[e]; }
            *(LDSP u32x2*)(Pm + (gw * 16 + r) * 72 + ct * 16 + q4 * 4) = pack4(p);
        }
        psum += __shfl_xor(psum, 16); psum += __shfl_xor(psum, 32);
        l_run = l_run * alpha + psum; m_run = m_new;
#pragma unroll
        for (int dt = 0; dt < 8; ++dt) {
            acc[dt] = acc[dt] * alpha;
#pragma unroll
            for (int kk = 0; kk < 2; ++kk) {
                if (2 * kk + 1 < ct0 || 2 * kk > ct1) continue;
                const bf16x8 vf = frag_tr16(VT + kk * 32 * 136 + dt * 16, 136, lane);
                const bf16x8 pf = *(const LDSP bf16x8*)(Pm + (gw * 16 + r) * 72 + kk * 32 + q4 * 8);
                acc[dt] = __builtin_amdgcn_mfma_f32_16x16x32_bf16(vf, pf, acc[dt], 0, 0, 0);
            }
        }
    }
    const float inv = 1.f / l_run;
    bf16_t* mix = (bf16_t*)(c.ws + WS_MIX) + (rowb + qtok0 + gw * 16 + r) * D + 1536 + h * 128;
#pragma unroll
    for (int dt = 0; dt < 8; ++dt) *(u32x2*)(mix + dt * 16 + q4 * 4) = pack4(acc[dt] * inv);
    __syncthreads();
}

__device__ __forceinline__ void phase_combine(const Ctx& c, int l) {
    const bf16_t* proj = (const bf16_t*)(c.ws + WS_RA + RA_PROJ);
    const bf16_t* OB = (const bf16_t*)(c.ws + WS_RA + RA_OB);
    bf16_t* mix = (bf16_t*)(c.ws + WS_MIX);
    const int lane = c.lane, d0 = (lane & 15) * 8;
    for (int row = c.bid * 8 + c.wave; row < MROWS; row += c.G * 8) {
#pragma unroll
        for (int mx = 0; mx < 3; ++mx) {
            const int om = mx == 0 ? 0 : 3 - mx;
            const u32x4 a = *(const u32x4*)(OB + ((size_t)(om * 2 + 0) * MROWS + row) * 512 + lane * 8);
            const u32x4 bq = *(const u32x4*)(OB + ((size_t)(om * 2 + 1) * MROWS + row) * 512 + lane * 8);
            const u32x4 g = *(const u32x4*)(proj + (size_t)row * NINP + (mx == 0 ? C_AZ : mx == 1 ? C_BR : C_CG) + lane * 8);
            const float* nw = c.in[mx == 0 ? I_GDNN : mx == 1 ? I_GLAN : I_HGN] + l * 128 + d0;
            float o[8]; float ss = 0.f;
#pragma unroll
            for (int m = 0; m < 4; ++m) { o[2 * m] = bflo(a[m]) + bflo(bq[m]); o[2 * m + 1] = bfhi(a[m]) + bfhi(bq[m]); ss += o[2 * m] * o[2 * m] + o[2 * m + 1] * o[2 * m + 1]; }
#pragma unroll
            for (int m = 1; m < 16; m <<= 1) ss += __shfl_xor(ss, m);
            const float rn = rsqrtf(ss * (1.f / 128.f) + NORM_EPS);
            float y[8];
#pragma unroll
            for (int m = 0; m < 4; ++m) {
                const float g0 = bflo(g[m]), g1 = bfhi(g[m]);
                const float a0 = (mx == 2) ? sigmoidf_(g0) : siluf_(g0), a1 = (mx == 2) ? sigmoidf_(g1) : siluf_(g1);
                y[2 * m] = o[2 * m] * rn * nw[2 * m] * a0; y[2 * m + 1] = o[2 * m + 1] * rn * nw[2 * m + 1] * a1;
            }
            *(u32x4*)(mix + (size_t)row * D + mx * 512 + lane * 8) = (u32x4){pk2(y[0], y[1]), pk2(y[2], y[3]), pk2(y[4], y[5]), pk2(y[6], y[7])};
        }
    }
}

__device__ __forceinline__ void phase_ln_router(const Ctx& c, int l) {
    LDSP float* wr = (LDSP float*)c.lds;
    for (int i = c.tid; i < 2048 * 16; i += 512) { const int k = i >> 4, e = i & 15; wr[e * 2048 + k] = c.in[I_ROUT][(size_t)l * 2048 * 16 + i]; }
    __syncthreads();
    const float* modv = (const float*)(c.ws + WS_MODV);
    const float* tb = (const float*)(c.ws + WS_RA + RA_TBUF);
    float* X1 = (float*)(c.ws + WS_X1); bf16_t* U = (bf16_t*)(c.ws + WS_U); float* aff = (float*)(c.ws + WS_AFF);
    const float* lg = c.in[I_LNG] + (size_t)(l * 2 + 0) * D; const float* lbp = c.in[I_LNB] + (size_t)(l * 2 + 0) * D;
    const int lane = c.lane;
    for (int row = c.bid * 8 + c.wave; row < MROWS; row += c.G * 8) {
        const int b = row / T, t = row % T;
        if (l == DEPTH - 1 && t < CTX) continue;
        const int r = t < CTX ? 4 : b;
        f32x4 v[8];
#pragma unroll
        for (int j = 0; j < 8; ++j) v[j] = *(const f32x4*)(tb + (size_t)row * D + 256 * j + 4 * lane);
        float mu, rstd; row_stats(v, mu, rstd);
#pragma unroll
        for (int j = 0; j < 8; ++j) {
            const int col = 256 * j + 4 * lane;
            v[j] = (v[j] - mu) * rstd * *(const f32x4*)(lg + col) + *(const f32x4*)(lbp + col);
            *(f32x4*)(X1 + (size_t)row * D + col) = v[j];
        }
        row_stats(v, mu, rstd);
        const float* sh = modv + (size_t)(l * 5 + r) * 12288 + 3 * 2048; const float* scp = sh + 2048;
        float lg16[16];
#pragma unroll
        for (int e = 0; e < 16; ++e) lg16[e] = 0.f;
#pragma unroll
        for (int j = 0; j < 8; ++j) {
            const int col = 256 * j + 4 * lane;
            const f32x4 y = (v[j] - mu) * rstd * (*(const f32x4*)(scp + col) + 1.f) + *(const f32x4*)(sh + col);
            *(u32x2*)(U + (size_t)row * D + col) = pack4(y);
#pragma unroll
            for (int e = 0; e < 16; ++e) { const f32x4 w = *(const LDSP f32x4*)(wr + e * 2048 + col); lg16[e] += y[0] * w[0] + y[1] * w[1] + y[2] * w[2] + y[3] * w[3]; }
        }
        float mxv = -1e30f;
#pragma unroll
        for (int e = 0; e < 16; ++e) { lg16[e] = wsum(lg16[e]); mxv = fmaxf(mxv, lg16[e]); }
        float den = 0.f;
#pragma unroll
        for (int e = 0; e < 16; ++e) { lg16[e] = expf(lg16[e] - mxv); den += lg16[e]; }
        const float rd = 1.f / den;
        float mine = 0.f;
#pragma unroll
        for (int e = 0; e < 16; ++e) if (lane == e) mine = lg16[e] * rd;
        if (lane < 16) aff[((size_t)b * 16 + lane) * T + t] = mine;
    }
    __syncthreads();
}

__device__ __forceinline__ void topk_unit(const Ctx& c, int prob) {
    const bool lat = prob < 64; const int pe = lat ? prob : prob - 64, b = pe >> 4, e = pe & 15;
    const int n = lat ? 4096 : 256, kcap = lat ? 512 : 32, tok0 = lat ? CTX : 0;
    LDSP unsigned* keys = (LDSP unsigned*)c.lds;
    LDSP unsigned* hist = keys + 4096;
    LDSP unsigned* bc = hist + 256;
    LDSP unsigned* wsum_ = bc + 4;
    const float* aff = (const float*)(c.ws + WS_AFF);
    const int tid = c.tid, lane = c.lane, wave = c.wave;
    const size_t rowb = (size_t)b * T + tok0;
    for (int i = tid; i < n; i += 512) keys[i] = __float_as_uint(aff[((size_t)b * 16 + e) * T + tok0 + i]);
    unsigned prefix = 0u, mask = 0u, krem = (unsigned)kcap;
    for (int pass = 0; pass < 4; ++pass) {
        const int shift = 24 - 8 * pass;
        if (tid < 256) hist[tid] = 0u;
        __syncthreads();
        for (int i = tid; i < n; i += 512) { const unsigned k = keys[i]; if ((k & mask) == prefix) __hip_atomic_fetch_add(&hist[(k >> shift) & 255u], 1u, __ATOMIC_RELAXED, __HIP_MEMORY_SCOPE_WORKGROUP); }
        __syncthreads();
        if (wave == 0) {
            unsigned hh[4], tot4 = 0u;
#pragma unroll
            for (int j = 0; j < 4; ++j) { hh[j] = hist[255 - 4 * lane - j]; tot4 += hh[j]; }
            unsigned inc4 = tot4;
#pragma unroll
            for (int m = 1; m < 64; m <<= 1) { const unsigned o = __shfl_up(inc4, m); if (lane >= m) inc4 += o; }
            unsigned cum = inc4 - tot4;
            if (cum < krem && krem <= inc4) {
#pragma unroll
                for (int j = 0; j < 4; ++j) {
                    if (cum < krem && krem <= cum + hh[j]) { bc[0] = prefix | ((unsigned)(255 - 4 * lane - j) << shift); bc[1] = krem - cum; }
                    cum += hh[j];
                }
            }
        }
        __syncthreads();
        prefix = bc[0]; krem = bc[1]; mask |= 255u << shift;
        __syncthreads();
    }
    const int per = n / 512 > 0 ? n / 512 : 1;
    const int i0 = tid * per;
    unsigned cnt = 0u;
    if (i0 < n) for (int j = 0; j < per; ++j) { const unsigned k = keys[i0 + j]; cnt += (k > prefix) ? 1u : 0u; cnt += (k == prefix) ? 0x10000u : 0u; }
    unsigned inc = cnt;
#pragma unroll
    for (int m = 1; m < 64; m <<= 1) { const unsigned o = __shfl_up(inc, m); if (lane >= m) inc += o; }
    if (lane == 63) wsum_[wave] = inc;
    __syncthreads();
    unsigned base = 0u;
    for (int w = 0; w < wave; ++w) base += wsum_[w];
    unsigned excl = base + inc - cnt;
    int* idx = (int*)(c.ws + WS_IDX); float* gate = (float*)(c.ws + WS_GATE); int* inv = (int*)(c.ws + WS_INV);
    const int slot0 = lat ? b * 512 : 2048 + b * 32;
    if (i0 < n) for (int j = 0; j < per; ++j) {
        const unsigned k = keys[i0 + j];
        const unsigned gtb = excl & 0xffffu, eqb = excl >> 16;
        const bool sel = (k > prefix) || (k == prefix && eqb < krem);
        int srow = -1;
        if (sel) {
            srow = slot0 + (int)(gtb + (eqb < krem ? eqb : krem));
            idx[e * EROWS + srow] = (int)(rowb + i0 + j);
            gate[e * EROWS + srow] = __uint_as_float(k);
        }
        inv[(rowb + i0 + j) * 16 + e] = srow;
        excl += (k > prefix) ? 1u : 0u; excl += (k == prefix) ? 0x10000u : 0u;
    }
    __syncthreads();
}

__device__ __forceinline__ void phase_gather(const Ctx& c, int l) {
    const int* idx = (const int*)(c.ws + WS_IDX);
    const bf16_t* U = (const bf16_t*)(c.ws + WS_U); bf16_t* XS = (bf16_t*)(c.ws + WS_RA + RA_XS);
    const int nrow = (l == DEPTH - 1) ? 2048 : EROWS, nreal = (l == DEPTH - 1) ? 2048 : 2176;
    for (int g = c.bid * 8 + c.wave; g < NEXP * nrow; g += c.G * 8) {
        const int e = g / nrow, s = g % nrow;
        u32x4 v[4];
        if (s < nreal) {
            const int src = idx[e * EROWS + s];
#pragma unroll
            for (int j = 0; j < 4; ++j) v[j] = *(const u32x4*)(U + (size_t)src * D + j * 512 + c.lane * 8);
        } else {
#pragma unroll
            for (int j = 0; j < 4; ++j) v[j] = (u32x4){0u, 0u, 0u, 0u};
            if (c.lane == 0) ((float*)(c.ws + WS_GATE))[e * EROWS + s] = 0.f;
        }
#pragma unroll
        for (int j = 0; j < 4; ++j) *(u32x4*)(XS + ((size_t)e * EROWS + s) * D + j * 512 + c.lane * 8) = v[j];
    }
}

__device__ __forceinline__ void phase_final(const Ctx& c, int l) {
    const float* modv = (const float*)(c.ws + WS_MODV);
    const float* X1 = (const float*)(c.ws + WS_X1); float* X = (float*)(c.ws + WS_X); bf16_t* U = (bf16_t*)(c.ws + WS_U);
    const bf16_t* YS = (const bf16_t*)(c.ws + WS_RA + RA_YS); const int* inv = (const int*)(c.ws + WS_INV);
    const float* lg = c.in[I_LNG] + (size_t)(l * 2 + 1) * D; const float* lbp = c.in[I_LNB] + (size_t)(l * 2 + 1) * D;
    const int lane = c.lane;
    for (int row = c.bid * 8 + c.wave; row < MROWS; row += c.G * 8) {
        const int b = row / T, t = row % T;
        if (l == DEPTH - 1 && t < CTX) continue;
        const int r = t < CTX ? 4 : b;
        f32x4 y[8];
#pragma unroll
        for (int j = 0; j < 8; ++j) y[j] = (f32x4){0.f, 0.f, 0.f, 0.f};
        const int myinv = inv[(size_t)row * 16 + (lane & 15)];
        for (int e = 0; e < 16; ++e) {
            const int s = __shfl(myinv, e);
            if (s >= 0) {
                const bf16_t* yr = YS + ((size_t)e * EROWS + s) * D;
#pragma unroll
                for (int j = 0; j < 8; ++j) { const u32x2 w = *(const u32x2*)(yr + 256 * j + 4 * lane); y[j] += (f32x4){bflo(w.x), bfhi(w.x), bflo(w.y), bfhi(w.y)}; }
            }
        }
        const float* m5 = modv + (size_t)(l * 5 + r) * 12288 + 5 * 2048;
        f32x4 v[8];
#pragma unroll
        for (int j = 0; j < 8; ++j) { const int col = 256 * j + 4 * lane; v[j] = *(const f32x4*)(X1 + (size_t)row * D + col) * ALPHA + *(const f32x4*)(m5 + col) * y[j]; }
        float mu, rstd; row_stats(v, mu, rstd);
#pragma unroll
        for (int j = 0; j < 8; ++j) { const int col = 256 * j + 4 * lane; v[j] = (v[j] - mu) * rstd * *(const f32x4*)(lg + col) + *(const f32x4*)(lbp + col); }
        if (l == DEPTH - 1) {
            float* o = c.out + ((size_t)b * SEQ + (t - CTX)) * D;
#pragma unroll
            for (int j = 0; j < 8; ++j) *(f32x4*)(o + 256 * j + 4 * lane) = v[j];
        } else {
#pragma unroll
            for (int j = 0; j < 8; ++j) *(f32x4*)(X + (size_t)row * D + 256 * j + 4 * lane) = v[j];
            const float* sh = modv + (size_t)((l + 1) * 5 + r) * 12288;
            modulate_store(v, sh, sh + 2048, U + (size_t)row * D, lane);
        }
    }
}

struct EpiOut {
    static constexpr bool PERM = false, AFTER_DRAIN = false;
    const float* X; const float* modv_l; float* Tb;
    __device__ __forceinline__ void operator()(const pg8::f32x4 (&acc)[2][2][4][2], const pg8::Unit& u, int wr, int wc, int fr, int fq) const {
        const int row0 = u.pm * 256 + wr * 64 + fr, col0 = u.pn * 256 + wc * 32 + 4 * fq;
        const int r = (u.pm % 17 == 0) ? 4 : u.pm / 17;
        const float* m2 = modv_l + (size_t)r * 12288 + 2 * 2048 + col0;
        pg8::f32x4 mv[2][2];
#pragma unroll
        for (int bj = 0; bj < 2; ++bj)
#pragma unroll
            for (int n = 0; n < 2; ++n) mv[bj][n] = *(const pg8::f32x4*)(m2 + bj * 128 + n * 16);
#pragma unroll
        for (int ai = 0; ai < 2; ++ai)
#pragma unroll
            for (int m = 0; m < 4; ++m) {
                const size_t off = (size_t)(row0 + ai * 128 + m * 16) * D + col0;
#pragma unroll
                for (int bj = 0; bj < 2; ++bj)
#pragma unroll
                    for (int n = 0; n < 2; ++n)
                        *(pg8::f32x4*)(Tb + off + bj * 128 + n * 16) = *(const pg8::f32x4*)(X + off + bj * 128 + n * 16) * ALPHA + mv[bj][n] * acc[ai][bj][m][n];
            }
    }
};
struct EpiHid {
    static constexpr bool PERM = true, AFTER_DRAIN = false;
    bf16_t* H;
    __device__ __forceinline__ void operator()(const pg8::f32x4 (&acc)[2][2][4][2], const pg8::Unit& u, int wr, int wc, int fr, int fq) const {
        const int row0 = u.pm * 256 + wr * 64 + fr, col0 = (u.pn & 7) * 128 + wc * 32 + 8 * fq;
#pragma unroll
        for (int ai = 0; ai < 2; ++ai)
#pragma unroll
            for (int m = 0; m < 4; ++m) {
                float hv[8];
#pragma unroll
                for (int n = 0; n < 2; ++n)
#pragma unroll
                    for (int j = 0; j < 4; ++j) hv[n * 4 + j] = siluf_(acc[ai][0][m][n][j]) * acc[ai][1][m][n][j];
                *(u32x4*)(H + (size_t)(row0 + ai * 128 + m * 16) * 1024 + col0) = (u32x4){pk2(hv[0], hv[1]), pk2(hv[2], hv[3]), pk2(hv[4], hv[5]), pk2(hv[6], hv[7])};
            }
    }
};
struct EpiY {
    static constexpr bool PERM = true, AFTER_DRAIN = false;
    bf16_t* Y; const float* gate;
    __device__ __forceinline__ void operator()(const pg8::f32x4 (&acc)[2][2][4][2], const pg8::Unit& u, int wr, int wc, int fr, int fq) const {
        const int row0 = u.pm * 256 + wr * 64 + fr, col0 = (u.pn & 7) * 256 + wc * 32 + 8 * fq;
#pragma unroll
        for (int ai = 0; ai < 2; ++ai)
#pragma unroll
            for (int m = 0; m < 4; ++m) {
                const int row = row0 + ai * 128 + m * 16; const float g = gate[row];
#pragma unroll
                for (int bj = 0; bj < 2; ++bj) {
                    const pg8::f32x4 v0 = acc[ai][bj][m][0] * g, v1 = acc[ai][bj][m][1] * g;
                    *(u32x4*)(Y + (size_t)row * D + col0 + bj * 128) = (u32x4){pk2(v0[0], v0[1]), pk2(v0[2], v0[3]), pk2(v1[0], v1[1]), pk2(v1[2], v1[3])};
                }
            }
    }
};
struct SchedLin {
    int G, c, nUnits, nPn, skip_ctx;
    __device__ __forceinline__ bool next(int i, pg8::Unit& u) const {
        const int L = i * G + c; if (L >= nUnits) return false;
        const int pml = L / nPn; u.pn = L % nPn; u.pm = skip_ctx ? (pml >> 4) * 17 + 1 + (pml & 15) : pml; return true;
    }
    __device__ __forceinline__ void a_ready(const pg8::Unit&) const {}
    __device__ __forceinline__ void done(const pg8::Unit&) const {}
};
struct SchedMoe {
    int G, c, nPm, nUnits; const int* idx; int nreal;
    __device__ __forceinline__ int arow(const pg8::Unit& u, int lr) const {
        const int e = u.pm / 9, s = (u.pm - e * 9) * 256 + lr;
        return s < nreal ? idx[e * EROWS + s] : 0;
    }
    __device__ __forceinline__ bool next(int i, pg8::Unit& u) const {
        const int L = i * G + c; if (L >= nUnits) return false;
        const int per = nPm * 8, e = L / per, rem = L % per; u.pm = e * 9 + (rem >> 3); u.pn = e * 8 + (rem & 7); return true;
    }
    __device__ __forceinline__ void a_ready(const pg8::Unit&) const {}
    __device__ __forceinline__ void done(const pg8::Unit&) const {}
};
}

struct Args { const float* in[24]; float* out; unsigned char* ws; int ph_lo, ph_hi; };
constexpr int LDS_BYTES = 147456;
#ifndef MK_Q_IN
#define MK_Q_IN 8
#define MK_Q_OUT 8
#define MK_Q_G1 4
#define MK_Q_G2 3
#define MK_Q_TK 10
#endif
#ifndef MK_NG
#define MK_NG 128
#define MK_NH 48
#endif
constexpr int N_PHASES = 2 + 10 * mk::DEPTH;

__global__ __launch_bounds__(512, 2) void mega_fwd(Args a) {
    using namespace mk;
    extern __shared__ __attribute__((aligned(16))) unsigned char lds_raw[];
    Ctx c0;
#pragma unroll
    for (int i = 0; i < 24; ++i) c0.in[i] = a.in[i];
    c0.out = a.out; c0.ws = a.ws; c0.lds = (LDSP unsigned char*)lds_raw;
    const int wave_s = __builtin_amdgcn_readfirstlane((int)threadIdx.x >> 6);
    c0.tid = threadIdx.x; c0.lane = c0.tid & 63; c0.wave = wave_s; c0.G = gridDim.x; c0.bid = blockIdx.x;
    const int lo = a.ph_lo, hi = a.ph_hi;
    volatile LAS unsigned* st = (volatile LAS unsigned*)(lds_raw + LDS_BYTES - 16);
    if (c0.tid == 0) { st[0] = 0u; st[1] = 0u; st[2] = 0u; st[3] = 0u; }
    __syncthreads();
    XcdBarrier bar; bar.bar = (unsigned*)(a.ws + WS_BAR); bar.x = 0; bar.st = st;
    if (hi - lo > 1) bar = xcd_barrier_post((unsigned*)(a.ws + WS_BAR), st);
    int ph = 0;
#define PH_CTX Ctx c = c0; { int wz = wave_s; asm volatile("" : "+s"(wz)); unsigned zz = 0u; asm volatile("" : "+v"(zz)); const int lz = (int)__builtin_amdgcn_mbcnt_hi(~0u, __builtin_amdgcn_mbcnt_lo(~0u, zz)); int bz = c0.bid; asm volatile("" : "+s"(bz)); c.bid = bz; c.wave = wz; c.lane = lz; c.tid = wz * 64 + lz; }
#define PH_ON (ph >= lo && ph < hi)
#ifdef MK_DBL
#define REP(id) for (int rep_ = 0; rep_ < 1 + (((MK_DBL) >> (id)) & 1); ++rep_, __syncthreads())
#else
#define REP(id)
#endif
#ifdef MK_TPROBE_A
    volatile LAS unsigned long long* tp = (volatile LAS unsigned long long*)(lds_raw + LDS_BYTES - 48);
    if (c0.bid == (MK_TPROBE_WG) && c0.tid == 0) { tp[0] = __builtin_amdgcn_s_memrealtime(); tp[1] = 0ull; tp[2] = 0ull; tp[3] = 0ull; }
#ifdef MK_GSTAMP
    if (c0.tid == 0) { volatile LAS unsigned long long* g0 = (volatile LAS unsigned long long*)(lds_raw + LDS_BYTES - 48 - 80); for (int i = 0; i < 9; ++i) g0[i] = 0ull; }
    __syncthreads();
#endif
#define PH_END do { if (PH_ON && ph + 1 < hi) xcd_barrier(bar); \
        if (c0.bid == (MK_TPROBE_WG) && threadIdx.x == 0) { const unsigned long long now_ = __builtin_amdgcn_s_memrealtime(); const int kind_ = ph < 2 ? ph : 2 + (ph - 2) % 10; \
            if (kind_ >= (MK_TPROBE_A) && kind_ <= (MK_TPROBE_B)) tp[1] += now_ - tp[0]; tp[0] = now_; } ++ph; } while (0)
#else
#define PH_END do { if (PH_ON && ph + 1 < hi) xcd_barrier(bar); ++ph; } while (0)
#endif

    if (PH_ON) REP(0) { PH_CTX
        if (c.bid < 192) { modv_fill_s(c); for (int u = c.bid; u < 192; u += c.G) modv_unit(c, u); }
        convert_phase(c, 0);
    }
    PH_END;
    if (PH_ON) REP(1) { PH_CTX phase_l0_modulate(c); }
    PH_END;

    for (int l = 0; l < DEPTH; ++l) {
        const bool last = (l == DEPTH - 1);
        if (PH_ON) REP(2) { PH_CTX
            pg8::Gemm g{(const pg8::bf16_t*)(c.ws + WS_U), (const pg8::bf16_t*)(c.ws + WS_WIN + (l & 1) * WSET_BYTES), MROWS, NINP, D};
            pg8::StaticOrder S; S.init(MROWS, NINP, c.G, c.bid);
            pg8::EpiBf16<0> E{(pg8::bf16_t*)(c.ws + WS_RA + RA_PROJ), NINP, nullptr, 0, 0};
            pg8::gemm_phase<pg8::EpiBf16<0>, pg8::StaticOrder, false>((PG8_LAS unsigned char*)c.lds, g, S, E, nullptr, c.tid);
            if (!last && c.G == 256 && 8 * 256 + c.bid >= 68 * 31) convert_queue(c, l + 1, MK_Q_IN);
        }
        PH_END;
        if (PH_ON) REP(3) { PH_CTX
            for (int cc = c.bid; cc < NCC; cc += c.G) gdn_prep_unit(c, l, cc);
        }
        if (PH_ON) REP(4) { PH_CTX
            for (int cc = c.bid; cc < NCC; cc += c.G) diag_prep_unit<1>(c, l, cc);
        }
        if (PH_ON) REP(5) { PH_CTX
            for (int cc = c.bid; cc < NCC; cc += c.G) diag_prep_unit<2>(c, l, cc);
        }
        PH_END;
        if (PH_ON) REP(6) { PH_CTX
            for (int u = c.bid; u < 128; u += c.G) if (u < 64) { scan_unit<0, 64, 3>(c, u & 31, u >> 5); __syncthreads(); }
        }
        if (PH_ON) REP(7) { PH_CTX
            for (int u = c.bid; u < 128; u += c.G) if (u >= 64 && u < 96) { scan_unit<1, 128, 2>(c, u - 64, 0); __syncthreads(); }
        }
        if (PH_ON) REP(8) { PH_CTX
            for (int u = c.bid; u < 128; u += c.G) if (u >= 96) { scan_unit<2, 128, 4>(c, u - 96, 0); __syncthreads(); }
        }
#ifdef MK_TPROBE_A
        if (PH_ON && c0.bid == (MK_TPROBE_WG) && threadIdx.x == 0) { tp[2] += __builtin_amdgcn_s_memrealtime() - tp[0]; }
#endif
        if (PH_ON) REP(9) { PH_CTX
            const int nq = last ? 64 : 68, qx = c.bid & 7;
            unsigned* qhead = (unsigned*)(c.ws + WS_BAR) + 3584 + 8 * (l * 8 + qx);
            volatile LAS unsigned* tk = (volatile LAS unsigned*)(lds_raw + LDS_BYTES - 64);
            for (;;) {
                if (c.tid == 0) tk[0] = __hip_atomic_fetch_add(qhead, 1u, __ATOMIC_RELAXED, __HIP_MEMORY_SCOPE_AGENT);
                __syncthreads();
                const int t = (int)tk[0];
                if (t >= nq) break;
                na_pair(c, l, t < 64 ? 64 * qx + t : 512 + 4 * qx + (t - 64));
            }
        }
#ifdef MK_TPROBE_A
        if (PH_ON && c0.bid == (MK_TPROBE_WG) && threadIdx.x == 0) { tp[3] += __builtin_amdgcn_s_memrealtime() - tp[0]; }
#endif
        PH_END;
        if (PH_ON) REP(10) { PH_CTX phase_combine(c, l); }
        PH_END;
        if (PH_ON) REP(11) { PH_CTX
            pg8::Gemm g{(const pg8::bf16_t*)(c.ws + WS_MIX), (const pg8::bf16_t*)(c.ws + WS_WOUT + (l & 1) * WSET_BYTES), MROWS, D, D};
            SchedLin S{c.G, c.bid, (last ? 64 : 68) * 8, 8, last ? 1 : 0};
            EpiOut E{(const float*)(c.ws + WS_X), (const float*)(c.ws + WS_MODV) + (size_t)l * 5 * 12288, (float*)(c.ws + WS_RA + RA_TBUF)};
            pg8::gemm_phase<EpiOut, SchedLin, false>((PG8_LAS unsigned char*)c.lds, g, S, E, nullptr, c.tid);
            if (!last && c.G == 256 && 2 * 256 + c.bid >= 68 * 8) convert_queue(c, l + 1, MK_Q_OUT);
        }
        PH_END;
        if (PH_ON) REP(12) { PH_CTX phase_ln_router(c, l); }
        PH_END;
        if (PH_ON) REP(13) { PH_CTX const int nprob = last ? 64 : 128; for (int p = c.bid; p < nprob; p += c.G) topk_unit(c, p);
            if (!last && c.G == 256 && c.bid >= 64) convert_queue(c, l + 1, c.bid >= 128 ? MK_Q_TK : MK_Q_TK / 2); }
        PH_END;
        if (PH_ON) REP(15) { PH_CTX
            pg8::Gemm g{(const pg8::bf16_t*)(c.ws + WS_U), (const pg8::bf16_t*)(c.ws + WS_W13 + (l & 1) * WSET_BYTES), NEXP * EROWS, NEXP * 2048, D};
            SchedMoe S{c.G, c.bid, last ? 8 : 9, NEXP * (last ? 8 : 9) * 8, (const int*)(c.ws + WS_IDX), last ? 2048 : 2176};
            EpiHid E{(bf16_t*)(c.ws + WS_RA + RA_HID)};
            pg8::gemm_phase<EpiHid, SchedMoe, false, true>((PG8_LAS unsigned char*)c.lds, g, S, E, nullptr, c.tid);
            if (!last && c.G == 256 && 4 * 256 + c.bid >= 16 * 9 * 8) convert_queue(c, l + 1, MK_Q_G1);
        }
        PH_END;
        if (PH_ON) REP(16) { PH_CTX
            pg8::Gemm g{(const pg8::bf16_t*)(c.ws + WS_RA + RA_HID), (const pg8::bf16_t*)(c.ws + WS_W2 + (l & 1) * WSET_BYTES), NEXP * EROWS, NEXP * 2048, 1024};
            SchedMoe S{c.G, c.bid, last ? 8 : 9, NEXP * (last ? 8 : 9) * 8, nullptr, 0};
            EpiY E{(bf16_t*)(c.ws + WS_RA + RA_YS), (const float*)(c.ws + WS_GATE)};
            pg8::gemm_phase<EpiY, SchedMoe, false>((PG8_LAS unsigned char*)c.lds, g, S, E, nullptr, c.tid);
            if (!last && c.G == 256 && 4 * 256 + c.bid >= 16 * 9 * 8) convert_queue(c, l + 1, MK_Q_G2);
        }
        PH_END;
        if (PH_ON) REP(17) { PH_CTX phase_final(c, l); }
        if (PH_ON) REP(18) { PH_CTX if (!last) convert_queue(c, l + 1, CONV_JOBS); }
        PH_END;
    }
#ifdef MK_TPROBE_A
    if (c0.bid == (MK_TPROBE_WG) && threadIdx.x == 0) { const unsigned long long t0_ = __builtin_amdgcn_s_memrealtime(), w_ =
#ifdef MK_GSTAMP
        ((volatile LAS unsigned long long*)(lds_raw + LDS_BYTES - 48 - 80))[MK_GSTAMP] * (unsigned long long)(MK_TPROBE_MULT);
#else
        tp[MK_TPROBE_SEL] * (unsigned long long)(MK_TPROBE_MULT);
#endif
        while (__builtin_amdgcn_s_memrealtime() - t0_ < w_) __builtin_amdgcn_s_sleep(32); }
#endif
}

#ifdef MK_STOP
__global__ void digest_k(const unsigned* w0, size_t n0, const unsigned* w1, size_t n1, float* out, size_t nout) {
    for (size_t i = (size_t)blockIdx.x * blockDim.x + threadIdx.x; i < nout; i += (size_t)gridDim.x * blockDim.x) {
        unsigned h = 0u;
        for (size_t j = i; j < n0 + n1; j += nout) {
#ifdef MK_RW0
            const size_t rw = j < n0 ? (size_t)(MK_RW0) : (size_t)(MK_RW1); const size_t row = (j < n0 ? j : j - n0) / rw;
            if (row % 4352 < 256) continue;
#endif
#ifdef MK_NANCOUNT
            { const unsigned wv = (j < n0 ? w0[j] : w1[j - n0]);
#ifdef MK_BF16
              if ((wv & 0x7F800000u) == 0x7F800000u || (wv & 0x7F80u) == 0x7F80u) h += 1u; }
#else
              if ((wv & 0x7F800000u) == 0x7F800000u) h += 1u; }
#endif
#else
            h = h * 31u + (j < n0 ? w0[j] : w1[j - n0]);
#endif
        }
#ifdef MK_NANCOUNT
        out[i] = 1000.f * (float)h;
#else
        out[i] = (float)(h & 0xFFFFFu);
#endif
    }
}
#endif
extern "C" void kernel_launch(void* const* d_in, const int* in_sizes, int n_in, void* d_out, int out_size, void* d_ws, size_t ws_size, hipStream_t stream) {
    static int grid = 0;
    if (grid == 0) {
        if (n_in != 24 || ws_size < mk::WS_TOTAL) { fprintf(stderr, "kernel_launch: n_in %d ws %zu (need %zu)\n", n_in, ws_size, (size_t)mk::WS_TOTAL); grid = -1; return; }
        int dev = 0, cus = 0, per_cu = 0;
        if (hipGetDevice(&dev) != hipSuccess || hipDeviceGetAttribute(&cus, hipDeviceAttributeMultiprocessorCount, dev) != hipSuccess) { grid = -1; return; }
        if (hipFuncSetAttribute((const void*)mega_fwd, hipFuncAttributeMaxDynamicSharedMemorySize, LDS_BYTES) != hipSuccess) { fprintf(stderr, "kernel_launch: hipFuncSetAttribute failed\n"); grid = -1; return; }
        if (hipOccupancyMaxActiveBlocksPerMultiprocessor(&per_cu, (const void*)mega_fwd, 512, LDS_BYTES) != hipSuccess || per_cu < 1) fprintf(stderr, "kernel_launch: occupancy query says %d\n", per_cu);
        (void)hipGetLastError();
        grid = cus;
    }
    if (grid < 0) return;
    (void)hipMemsetAsync((char*)d_ws + mk::WS_BAR, 0, 16384, stream);
    Args a{};
    for (int i = 0; i < 24; ++i) a.in[i] = (const float*)d_in[i];
    a.out = (float*)d_out; a.ws = (unsigned char*)d_ws;
#if MK_N_LAUNCHES == 1
    a.ph_lo = 0; a.ph_hi = N_PHASES;
    hipLaunchKernelGGL(mega_fwd, dim3(grid), dim3(512), LDS_BYTES, stream, a);
#else
#ifdef MK_STOP
    for (int p = 0; p < MK_STOP; ++p) { a.ph_lo = p; a.ph_hi = p + 1; hipLaunchKernelGGL(mega_fwd, dim3(grid), dim3(512), LDS_BYTES, stream, a); }
    hipLaunchKernelGGL(digest_k, dim3(2048), dim3(256), 0, stream, (const unsigned*)((char*)d_ws + (size_t)(MK_D0)), (size_t)(MK_N0) / 4, (const unsigned*)((char*)d_ws + (size_t)(MK_D1)), (size_t)(MK_N1) / 4, (float*)d_out, (size_t)out_size);
#else
    for (int p = 0; p < N_PHASES; ++p) { a.ph_lo = p; a.ph_hi = p + 1; hipLaunchKernelGGL(mega_fwd, dim3(grid), dim3(512), LDS_BYTES, stream, a); }
#endif
#endif
}
```
